# Optimizing an MI355X kernel written in HIP

```python
import jax, jax.numpy as jnp
from jax import lax
import numpy as np

D_MODEL = 2048
BATCH = 2
SEQ = 4096
DEPTH = 2

N_BRANCH = 3
BRANCH_W = 1024
CONV_W = BRANCH_W
CONV_K = 3
ATT_HEADS = 8
ATT_HD = 128
ATT_W = ATT_HEADS * ATT_HD
ATT_BLOCK = 128
RWKV_HEADS = 16
RWKV_HD = 64
RWKV_W = RWKV_HEADS * RWKV_HD
DECAY_LORA = 96
AAA_LORA = 96
GATE_LORA = 256
RWKV_SHIFT_W = 3 * RWKV_W + DECAY_LORA + AAA_LORA + GATE_LORA
RWKV_SPLIT = (RWKV_W, 2 * RWKV_W, 3 * RWKV_W, 3 * RWKV_W + DECAY_LORA, 3 * RWKV_W + DECAY_LORA + AAA_LORA)
IN_COLS = 3 * CONV_W + 3 * ATT_W + RWKV_SHIFT_W + N_BRANCH * D_MODEL
SPLIT_IN = (3 * CONV_W, 3 * CONV_W + 3 * ATT_W, 3 * CONV_W + 3 * ATT_W + RWKV_SHIFT_W)
N_EXPERTS = 64
TOP_K = 8
N_GROUPS = 8
TOPK_GROUPS = 4
EXPERT_FF = 512
SHARED_FF = 512
ROUTED_SCALE = 2.5
LN_EPS = 1e-5
GN_EPS = 64e-5
DEEPNORM_ALPHA = (2 * DEPTH) ** 0.25
DEEPNORM_BETA = (8 * DEPTH) ** -0.25

kernel_name = 'hybrid_conv_stickbreak_rwkv7_moe_deepnorm'


def layer_norm(x, g, b):
    xf = x.astype(jnp.float32)
    mu = xf.mean(-1, keepdims=True)
    var = jnp.square(xf - mu).mean(-1, keepdims=True)
    return ((xf - mu) * lax.rsqrt(var + LN_EPS) * g + b).astype(x.dtype)


def short_conv(u, conv_w):
    return lax.conv_general_dilated(
        u, conv_w[:, None, :].astype(u.dtype), window_strides=(1,),
        padding=[(CONV_K - 1, 0)], dimension_numbers=('NWC', 'WIO', 'NWC'),
        feature_group_count=u.shape[-1])


def stick_breaking_attention(q, k, v):
    seq = q.shape[2]
    scale = ATT_HD ** -0.5
    outs = []
    for blk in range(seq // ATT_BLOCK):
        q0 = blk * ATT_BLOCK
        end = q0 + ATT_BLOCK
        z = jnp.einsum('bhqd,bhkd->bhqk', q[:, :, q0:end], k[:, :, :end],
                       preferred_element_type=jnp.float32) * scale
        causal = jnp.arange(end)[None, :] < (q0 + jnp.arange(ATT_BLOCK))[:, None]
        log_beta = jax.nn.log_sigmoid(z)
        log_1mb = jnp.where(causal, jax.nn.log_sigmoid(-z), 0.0)
        rev = lax.cumsum(log_1mb, axis=3, reverse=True)
        tail = jnp.concatenate([rev[..., 1:], jnp.zeros_like(rev[..., :1])], axis=-1)
        w = jnp.where(causal, jnp.exp(log_beta + tail), 0.0)
        outs.append(jnp.einsum('bhqk,bhkd->bhqd', w.astype(v.dtype), v[:, :, :end]))
    return jnp.concatenate(outs, axis=2)


def token_shift(p):
    return jnp.pad(p, ((0, 0), (1, 0), (0, 0)))[:, :-1]


def rwkv7_scan(r, w, k, v, a, b):
    bsz, _, nh, n = r.shape

    def step(state, inp):
        r_t, w_t, k_t, v_t, a_t, b_t = inp
        sa = jnp.einsum('bhij,bhj->bhi', state, a_t)
        state = (state * w_t[:, :, None, :] + sa[..., None] * b_t[:, :, None, :]
                 + v_t[..., None] * k_t[:, :, None, :])
        return state, jnp.einsum('bhij,bhj->bhi', state, r_t)

    xs = tuple(jnp.moveaxis(t.astype(jnp.float32), 1, 0) for t in (r, w, k, v, a, b))
    s0 = jnp.zeros((bsz, nh, n, n), jnp.float32)
    _, y = lax.scan(step, s0, xs)
    return jnp.moveaxis(y, 0, 1)


def rwkv7_mixer(p, mix, w0, w2, a0, a2, g2, k_k, k_a, r_k, lnx_g, lnx_b):
    bsz, seq, _ = p.shape
    p = p + (token_shift(p) - p) * mix
    r, k, v, lw, la, lg = jnp.split(p, RWKV_SPLIT, axis=-1)
    w_log = -jax.nn.softplus(-(w0 + jnp.tanh(lw) @ w2)) - 0.5
    decay = jnp.exp(-jnp.exp(w_log.astype(jnp.float32)))
    a = jax.nn.sigmoid(a0 + la @ a2)
    g = jax.nn.sigmoid(lg) @ g2
    heads = lambda t: t.reshape(bsz, seq, RWKV_HEADS, RWKV_HD)
    kk = heads(k * k_k).astype(jnp.float32)
    kk = kk / jnp.maximum(jnp.sqrt(jnp.sum(kk * kk, axis=-1, keepdims=True)), 1e-12)
    k = k * (1 + (a - 1) * k_a)
    r_h, k_h, v_h, a_h = heads(r), heads(k), heads(v), heads(a)
    y = rwkv7_scan(r_h, heads(decay), k_h, v_h, -kk, kk * a_h)
    mu = y.mean(-1, keepdims=True)
    var = jnp.square(y - mu).mean(-1, keepdims=True)
    y = ((y - mu) * lax.rsqrt(var + GN_EPS)).reshape(bsz, seq, RWKV_W) * lnx_g + lnx_b
    bonus = jnp.sum(r_h * k_h * r_k, axis=-1, keepdims=True) * v_h
    y = y + bonus.reshape(bsz, seq, RWKV_W)
    return (y * g).astype(p.dtype)


def moe_ffn(x, w_router, router_bias, w_e_gate, w_e_up, w_e_down, w_s_gate, w_s_up, w_s_down):
    bsz, seq, d = x.shape
    xt = x.reshape(-1, d)
    n_tok = xt.shape[0]
    scores = jax.nn.sigmoid((xt @ w_router).astype(jnp.float32))
    biased = scores + router_bias
    grp = biased.reshape(n_tok, N_GROUPS, N_EXPERTS // N_GROUPS)
    grp_score = lax.top_k(grp, 2)[0].sum(-1)
    _, grp_idx = lax.top_k(grp_score, TOPK_GROUPS)
    grp_mask = jnp.any(grp_idx[..., None] == jnp.arange(N_GROUPS), axis=1)
    exp_mask = jnp.repeat(grp_mask, N_EXPERTS // N_GROUPS, axis=1)
    _, top_i = lax.top_k(jnp.where(exp_mask, biased, -jnp.inf), TOP_K)
    top_s = jnp.take_along_axis(scores, top_i, axis=1)
    top_w = top_s / jnp.sum(top_s, axis=-1, keepdims=True) * ROUTED_SCALE
    flat_e = top_i.reshape(-1)
    order = jnp.argsort(flat_e)
    tok = order // TOP_K
    sizes = jnp.bincount(flat_e, length=N_EXPERTS).astype(jnp.int32)
    xs = xt[tok]
    h = jax.nn.silu(lax.ragged_dot(xs, w_e_gate, sizes)) * lax.ragged_dot(xs, w_e_up, sizes)
    ys = lax.ragged_dot(h, w_e_down, sizes) * top_w.reshape(-1)[order][:, None].astype(x.dtype)
    routed = jax.ops.segment_sum(ys, tok, num_segments=n_tok)
    shared = (jax.nn.silu(xt @ w_s_gate) * (xt @ w_s_up)) @ w_s_down
    return (routed + shared).reshape(bsz, seq, d)


def setup_inputs(seed: int = 0) -> dict:
    key = jax.random.key(seed)
    ks = iter(jax.random.split(key, 40))
    L, D = DEPTH, D_MODEL
    beta = DEEPNORM_BETA

    def nrm(shape, scale):
        return jax.random.normal(next(ks), shape, jnp.float32) * scale

    def unif(shape, lo, hi):
        return jax.random.uniform(next(ks), shape, jnp.float32, lo, hi)

    return {
        'x': nrm((BATCH, SEQ, D), 1.0),
        'w_in': nrm((L, D, IN_COLS), D ** -0.5),
        'conv_w': nrm((L, CONV_K, CONV_W), CONV_K ** -0.5),
        'rwkv_mix': unif((L, RWKV_SHIFT_W), 0.0, 1.0),
        'rwkv_w0': unif((L, RWKV_W), -6.0, -1.0),
        'rwkv_w2': nrm((L, DECAY_LORA, RWKV_W), DECAY_LORA ** -0.5),
        'rwkv_a0': nrm((L, RWKV_W), 0.1),
        'rwkv_a2': nrm((L, AAA_LORA, RWKV_W), AAA_LORA ** -0.5),
        'rwkv_g2': nrm((L, GATE_LORA, RWKV_W), GATE_LORA ** -0.5),
        'rwkv_kk': 0.85 + nrm((L, RWKV_W), 0.02),
        'rwkv_ka': 1.0 + nrm((L, RWKV_W), 0.02),
        'rwkv_rk': nrm((L, RWKV_HEADS, RWKV_HD), 0.1),
        'rwkv_lnx_g': 1.0 + nrm((L, RWKV_W), 0.02),
        'rwkv_lnx_b': nrm((L, RWKV_W), 0.02),
        'w_branch': nrm((L, N_BRANCH, BRANCH_W, D), beta * BRANCH_W ** -0.5),
        'w_o': nrm((L, D, D), beta * D ** -0.5),
        'ln1_g': 1.0 + nrm((L, D), 0.02),
        'ln1_b': nrm((L, D), 0.02),
        'w_router': nrm((L, D, N_EXPERTS), D ** -0.5),
        'router_bias': nrm((L, N_EXPERTS), 0.01),
        'w_e_gate': nrm((L, N_EXPERTS, D, EXPERT_FF), D ** -0.5),
        'w_e_up': nrm((L, N_EXPERTS, D, EXPERT_FF), D ** -0.5),
        'w_e_down': nrm((L, N_EXPERTS, EXPERT_FF, D), beta * EXPERT_FF ** -0.5),
        'w_s_gate': nrm((L, D, SHARED_FF), D ** -0.5),
        'w_s_up': nrm((L, D, SHARED_FF), D ** -0.5),
        'w_s_down': nrm((L, SHARED_FF, D), beta * SHARED_FF ** -0.5),
        'ln2_g': 1.0 + nrm((L, D), 0.02),
        'ln2_b': nrm((L, D), 0.02),
    }


def reference(x, w_in, conv_w, rwkv_mix, rwkv_w0, rwkv_w2, rwkv_a0, rwkv_a2, rwkv_g2,
              rwkv_kk, rwkv_ka, rwkv_rk, rwkv_lnx_g, rwkv_lnx_b, w_branch, w_o, ln1_g, ln1_b,
              w_router, router_bias, w_e_gate, w_e_up, w_e_down, w_s_gate, w_s_up, w_s_down,
              ln2_g, ln2_b):
    bsz, seq, _ = x.shape
    for l in range(DEPTH):
        p = x @ w_in[l]
        conv_p, att_p, rwkv_p, gate_p = jnp.split(p, SPLIT_IN, axis=-1)
        gb, gc, hc = jnp.split(conv_p, 3, axis=-1)
        y_conv = gb * short_conv(gc * hc, conv_w[l])
        q, k, v = (t.reshape(bsz, seq, ATT_HEADS, ATT_HD).transpose(0, 2, 1, 3)
                   for t in jnp.split(att_p, 3, axis=-1))
        y_att = stick_breaking_attention(q, k, v).transpose(0, 2, 1, 3).reshape(bsz, seq, ATT_W)
        y_rwkv = rwkv7_mixer(rwkv_p, rwkv_mix[l], rwkv_w0[l], rwkv_w2[l], rwkv_a0[l], rwkv_a2[l],
                             rwkv_g2[l], rwkv_kk[l], rwkv_ka[l], rwkv_rk[l],
                             rwkv_lnx_g[l], rwkv_lnx_b[l])
        branches = jnp.stack([y_conv, y_att, y_rwkv], axis=2)
        gates = jax.nn.sigmoid(gate_p.reshape(bsz, seq, N_BRANCH, D_MODEL))
        merged = jnp.sum(gates * jnp.einsum('bsnc,ncd->bsnd', branches, w_branch[l]), axis=2)
        x = layer_norm(DEEPNORM_ALPHA * x + merged @ w_o[l], ln1_g[l], ln1_b[l])
        y_moe = moe_ffn(x, w_router[l], router_bias[l], w_e_gate[l], w_e_up[l], w_e_down[l],
                        w_s_gate[l], w_s_up[l], w_s_down[l])
        x = layer_norm(DEEPNORM_ALPHA * x + y_moe, ln2_g[l], ln2_b[l])
    return x
```

```cpp
#include <hip/hip_runtime.h>
#include <cstdio>
#include <cstdint>
namespace pg8 {
#define PG8_LAS __attribute__((address_space(3)))
typedef unsigned short bf16_t;
typedef short bf16x8 __attribute__((ext_vector_type(8)));
typedef float f32x4 __attribute__((ext_vector_type(4)));
typedef unsigned u32x4 __attribute__((ext_vector_type(4)));
constexpr int BM = 256, BK = 64, HALF = 128, HTB = HALF * BK * 2  , STAGE_BYTES = 8 * HTB, NXCD = 8, WGM = 8;

__host__ __device__ __forceinline__ int lds_byte(int r, int c) { const int st = (r >> 4) * 2 + (c >> 5), rr = r & 15, cc = c & 31, ob = rr * 64 + cc * 2; return st * 1024 + (ob ^ (((ob >> 9) & 1) << 5)); }
__host__ __device__ __forceinline__ void stage_rc(int b, int& R, int& C) { const int st = b / 1024, sb = b % 1024, swz = sb ^ (((sb >> 9) & 1) << 5); R = (st >> 1) * 16 + swz / 64; C = (st & 1) * 32 + (swz % 64) / 2; }
__host__ __device__ __forceinline__ int perm32(int rho) { const int n = rho >> 4, i = rho & 15; return 8 * (i >> 2) + 4 * n + (i & 3); }

struct Unit { int pm, pn; };
struct Gemm { const bf16_t* A; const bf16_t* Bt; int M, N, K; };

struct StaticOrder {
    int nM, nN, nwg, G, c;
    __host__ __device__ void init(int M, int N, int G_, int c_) { nM = M / BM; nN = N / BM; nwg = nM * nN; G = G_; c = c_; }
    __host__ __device__ bool next(int i, Unit& u) const {
        const long L = (long)i * G + c; if (L >= nwg) return false;
        int wgid = (int)L; { const int q = nwg / NXCD, r = nwg % NXCD, xcd = wgid % NXCD, off = wgid / NXCD; wgid = (xcd < r ? xcd * (q + 1) : r * (q + 1) + (xcd - r) * q) + off; }
        const int nig = WGM * nN, gid = wgid / nig, fm = gid * WGM, gsz = (nM - fm) < WGM ? (nM - fm) : WGM;
        u.pm = fm + ((wgid % nig) % gsz); u.pn = (wgid % nig) / gsz; return true;
    }
    __device__ __forceinline__ void a_ready(const Unit&) const {}
    __device__ __forceinline__ void done(const Unit&) const {}
};

__device__ __forceinline__ int otid() { int t = threadIdx.x; asm volatile("" : "+v"(t)); return t; }
__device__ __forceinline__ int obid() { int t = blockIdx.x; asm volatile("" : "+s"(t)); return t; }
__device__ __forceinline__ unsigned cvt_pk_bf16(float lo, float hi) { unsigned r; asm volatile("v_cvt_pk_bf16_f32 %0, %1, %2" : "=v"(r) : "v"(lo), "v"(hi)); return r; }
__device__ __forceinline__ float bflo(unsigned w) { return __uint_as_float(w << 16); }
__device__ __forceinline__ float bfhi(unsigned w) { return __uint_as_float(w & 0xffff0000u); }
__device__ __forceinline__ float sigmoidf_(float x) { return 1.0f / (1.0f + __expf(-x)); }

struct EpiInProj {
    static constexpr bool PERM = true, AFTER_DRAIN = false;
    bf16_t *conv, *qkv, *rkv, *lora, *gate;
    __device__ __forceinline__ void operator()(const f32x4 (&acc)[2][2][4][2], const Unit& u, int wr, int wc, int fr, int fq) const {
        const int pn = u.pn; bf16_t* base; int ldc, colt;
        if (pn < 12) { base = conv; ldc = 3072; colt = pn * 256; }
        else if (pn < 24) { base = qkv; ldc = 3072; colt = (pn - 12) * 256; }
        else if (pn < 36) { base = rkv; ldc = 3072; colt = (pn - 24) * 256; }
        else if (pn < 38) { base = lora; ldc = 512; colt = (pn - 36) * 256; }
        else { base = gate; ldc = 6144; colt = (pn - 38) * 256; }
        const int row0 = u.pm * BM + wr * 64 + fr, col0 = colt + wc * 32 + 8 * fq;
#pragma unroll
        for (int ai = 0; ai < 2; ++ai)
#pragma unroll
            for (int m = 0; m < 4; ++m) { bf16_t* rowp = base + (size_t)(row0 + ai * HALF + m * 16) * ldc + col0;
#pragma unroll
                for (int bj = 0; bj < 2; ++bj) { const f32x4 v0 = acc[ai][bj][m][0], v1 = acc[ai][bj][m][1];
                    u32x4 w; w.x = cvt_pk_bf16(v0[0], v0[1]); w.y = cvt_pk_bf16(v0[2], v0[3]); w.z = cvt_pk_bf16(v1[0], v1[1]); w.w = cvt_pk_bf16(v1[2], v1[3]);
                    *(u32x4*)(rowp + bj * HALF) = w; } }
    }
};
struct EpiLora {
    static constexpr bool PERM = false, AFTER_DRAIN = false;
    float* Wd; long offA, offG; const float *w0, *a0;
    __device__ __forceinline__ void operator()(const f32x4 (&acc)[2][2][4][2], const Unit& u, int wr, int wc, int fr, int fq) const {
        const int sec = u.pn >> 2, colt = (u.pn & 3) * 256;
        float* out = Wd + (sec == 0 ? 0l : (sec == 1 ? offA : offG));
        const float* bp = sec == 0 ? w0 : a0;
        const int row0 = u.pm * BM + wr * 64 + fr, col0 = colt + wc * 32 + 4 * fq;
        f32x4 bv[2][2];
#pragma unroll
        for (int bj = 0; bj < 2; ++bj)
#pragma unroll
            for (int n = 0; n < 2; ++n) { const f32x4 t = *(const f32x4*)(bp + col0 + bj * HALF + n * 16); bv[bj][n] = sec == 2 ? (f32x4){0.f, 0.f, 0.f, 0.f} : t; }
#pragma unroll
        for (int ai = 0; ai < 2; ++ai)
#pragma unroll
            for (int m = 0; m < 4; ++m) { float* rowp = out + (size_t)(row0 + ai * HALF + m * 16) * 1024 + col0;
#pragma unroll
                for (int bj = 0; bj < 2; ++bj)
#pragma unroll
                    for (int n = 0; n < 2; ++n) { f32x4 v = acc[ai][bj][m][n] + bv[bj][n];
                        if (sec == 0) {
#pragma unroll
                            for (int j = 0; j < 4; ++j) { const float x = v[j]; const float sp = fmaxf(-x, 0.f) + __logf(1.0f + __expf(-fabsf(x)));
                                v[j] = __expf(-__expf(-sp - 0.5f)); }
                        } else if (sec == 1) {
#pragma unroll
                            for (int j = 0; j < 4; ++j) v[j] = 1.0f / (1.0f + __expf(-v[j]));
                        }
                        *(f32x4*)(rowp + bj * HALF + n * 16) = v; } }
    }
};
struct EpiGate {
    static constexpr bool PERM = true, AFTER_DRAIN = false;
    const bf16_t* gate; float* tmp; bf16_t* out; int mode;
    __device__ __forceinline__ void operator()(const f32x4 (&acc)[2][2][4][2], const Unit& u, int wr, int wc, int fr, int fq) const {
        const int row0 = u.pm * BM + wr * 64 + fr, col0 = u.pn * BM + wc * 32 + 8 * fq;
#pragma unroll
        for (int ai = 0; ai < 2; ++ai)
#pragma unroll
            for (int m = 0; m < 4; ++m) { const size_t row = (size_t)(row0 + ai * HALF + m * 16);
#pragma unroll
                for (int bj = 0; bj < 2; ++bj) { const int col = col0 + bj * HALF;
                    const u32x4 gw = *(const u32x4*)(gate + row * 6144 + col);
                    f32x4 v0 = acc[ai][bj][m][0], v1 = acc[ai][bj][m][1];
                    v0[0] *= sigmoidf_(bflo(gw.x)); v0[1] *= sigmoidf_(bfhi(gw.x)); v0[2] *= sigmoidf_(bflo(gw.y)); v0[3] *= sigmoidf_(bfhi(gw.y));
                    v1[0] *= sigmoidf_(bflo(gw.z)); v1[1] *= sigmoidf_(bfhi(gw.z)); v1[2] *= sigmoidf_(bflo(gw.w)); v1[3] *= sigmoidf_(bfhi(gw.w));
                    float* tp = tmp + row * 2048 + col;
                    if (mode != 0) { v0 += *(const f32x4*)tp; v1 += *(const f32x4*)(tp + 4); }
                    if (mode != 2) { *(f32x4*)tp = v0; *(f32x4*)(tp + 4) = v1; }
                    else { u32x4 w; w.x = cvt_pk_bf16(v0[0], v0[1]); w.y = cvt_pk_bf16(v0[2], v0[3]); w.z = cvt_pk_bf16(v1[0], v1[1]); w.w = cvt_pk_bf16(v1[2], v1[3]);
                        *(u32x4*)(out + row * 2048 + col) = w; } } }
    }
};
struct EpiWo {
    static constexpr bool PERM = false, AFTER_DRAIN = false;
    const float* xin; float* out; float alpha;
    __device__ __forceinline__ void operator()(const f32x4 (&acc)[2][2][4][2], const Unit& u, int wr, int wc, int fr, int fq) const {
        const int row0 = u.pm * BM + wr * 64 + fr, col0 = u.pn * BM + wc * 32 + 4 * fq;
#pragma unroll
        for (int ai = 0; ai < 2; ++ai)
#pragma unroll
            for (int m = 0; m < 4; ++m) { const size_t off = (size_t)(row0 + ai * HALF + m * 16) * 2048 + col0;
#pragma unroll
                for (int bj = 0; bj < 2; ++bj)
#pragma unroll
                    for (int n = 0; n < 2; ++n) { const f32x4 xv = *(const f32x4*)(xin + off + bj * HALF + n * 16);
                        *(f32x4*)(out + off + bj * HALF + n * 16) = xv * alpha + acc[ai][bj][m][n]; } }
    }
};
struct EpiSwiglu {
    static constexpr bool PERM = true, AFTER_DRAIN = false;
    bf16_t* H;
    __device__ __forceinline__ void operator()(const f32x4 (&acc)[2][2][4][2], const Unit& u, int wr, int wc, int fr, int fq) const {
        const int row0 = u.pm * BM + wr * 64 + fr, col0 = (u.pn & 3) * 128 + wc * 32 + 8 * fq;
#pragma unroll
        for (int ai = 0; ai < 2; ++ai)
#pragma unroll
            for (int m = 0; m < 4; ++m) { bf16_t* rowp = H + (size_t)(row0 + ai * HALF + m * 16) * 512 + col0;
                float h[8];
#pragma unroll
                for (int n = 0; n < 2; ++n)
#pragma unroll
                    for (int j = 0; j < 4; ++j) { const float g = acc[ai][0][m][n][j], up = acc[ai][1][m][n][j]; h[n * 4 + j] = g * sigmoidf_(g) * up; }
                u32x4 w; w.x = cvt_pk_bf16(h[0], h[1]); w.y = cvt_pk_bf16(h[2], h[3]); w.z = cvt_pk_bf16(h[4], h[5]); w.w = cvt_pk_bf16(h[6], h[7]);
                *(u32x4*)rowp = w; }
    }
};
struct EpiDown {
    static constexpr bool PERM = true, AFTER_DRAIN = false;
    bf16_t* Y; const float* roww;
    __device__ __forceinline__ void operator()(const f32x4 (&acc)[2][2][4][2], const Unit& u, int wr, int wc, int fr, int fq) const {
        const int row0 = u.pm * BM + wr * 64 + fr, col0 = (u.pn & 7) * 256 + wc * 32 + 8 * fq;
#pragma unroll
        for (int ai = 0; ai < 2; ++ai)
#pragma unroll
            for (int m = 0; m < 4; ++m) { const int row = row0 + ai * HALF + m * 16; const float s = roww[row]; bf16_t* rowp = Y + (size_t)row * 2048 + col0;
#pragma unroll
                for (int bj = 0; bj < 2; ++bj) { const f32x4 v0 = acc[ai][bj][m][0] * s, v1 = acc[ai][bj][m][1] * s;
                    u32x4 w; w.x = cvt_pk_bf16(v0[0], v0[1]); w.y = cvt_pk_bf16(v0[2], v0[3]); w.z = cvt_pk_bf16(v1[0], v1[1]); w.w = cvt_pk_bf16(v1[2], v1[3]);
                    *(u32x4*)(rowp + bj * HALF) = w; } }
    }
};
struct MoeOrder {
    const int* seg; int ntiles, npn, G, c;
    __device__ __forceinline__ bool next(int i, Unit& u) const {
        const long L = (long)i * G + c; if (L >= (long)ntiles * npn) return false;
        const int pm = (int)(L / npn), pl = (int)(L % npn); u.pm = pm; u.pn = __builtin_amdgcn_readfirstlane(__hip_atomic_load(seg + pm, __ATOMIC_RELAXED, __HIP_MEMORY_SCOPE_AGENT)) * npn + pl; return true;
    }
    __device__ __forceinline__ void a_ready(const Unit&) const {}
    __device__ __forceinline__ void done(const Unit&) const {}
};
template <class Epi, class Sched, bool ALIGN_EPI = false, bool SP2 = false>
__device__ __forceinline__ void gemm_phase(PG8_LAS unsigned char* lds, const Gemm g, const Sched& S, const Epi& E) {
    const int tid = otid(), wid = __builtin_amdgcn_readfirstlane(tid >> 6), lane = tid & 63, wr = wid >> 2, wc = wid & 3, fr = lane & 15, fq = lane >> 4;
    const int K = g.K, nt = K / BK;
    unsigned voffA[2], voffB[2];
#pragma unroll
    for (int i = 0; i < 2; ++i) { int R, C; stage_rc(tid * 16 + i * 8192, R, C); const int Rb = Epi::PERM ? ((R & ~31) + perm32(R & 31)) : R;
        voffA[i] = (unsigned)(R * K + C) * 2u; voffB[i] = (unsigned)(Rb * K + C) * 2u; }
    const size_t kstep = (size_t)(BK * 2);
    const size_t hstep = (size_t)HALF * K * 2;
    const size_t tstep = 2 * hstep;
    const unsigned ldsw = (unsigned)wid * 1024u;
    const int aoff = lds_byte(wr * 64 + fr, fq * 8), boff = lds_byte(wc * 32 + fr, fq * 8);
#define PG8_SA(b, h) (((b) * 2 + (h)) * HTB)
#define PG8_SB(b, h) ((4 + (b) * 2 + (h)) * HTB)
#define PG8_STAGE(bufoff, gbase, voff) do { _Pragma("unroll") for (int _i = 0; _i < 2; ++_i) \
        __builtin_amdgcn_global_load_lds((const unsigned*)((const char*)(gbase) + (voff)[_i]), (PG8_LAS unsigned*)(lds + (bufoff) + ldsw + _i * 8192), 16, 0, 0); } while (0)
#define PG8_LDA(dst, b, h) do { _Pragma("unroll") for (int m = 0; m < 4; ++m) _Pragma("unroll") for (int k = 0; k < 2; ++k) dst[m][k] = *(const PG8_LAS bf16x8*)(lds + PG8_SA(b, h) + aoff + m * 2048 + k * 1024); } while (0)
#define PG8_LDB(dst, b, h) do { _Pragma("unroll") for (int n = 0; n < 2; ++n) _Pragma("unroll") for (int k = 0; k < 2; ++k) dst[n][k] = *(const PG8_LAS bf16x8*)(lds + PG8_SB(b, h) + boff + n * 2048 + k * 1024); } while (0)
#define PG8_MMA(ai, bj, At, Bt) do { __builtin_amdgcn_s_setprio(1); _Pragma("unroll") for (int m = 0; m < 4; ++m) _Pragma("unroll") for (int n = 0; n < 2; ++n) _Pragma("unroll") for (int k = 0; k < 2; ++k) \
        acc[ai][bj][m][n] = __builtin_amdgcn_mfma_f32_16x16x32_bf16(Bt[n][k], At[m][k], acc[ai][bj][m][n], 0, 0, 0); __builtin_amdgcn_s_setprio(0); } while (0)
#define PG8_WAIT_V(n) asm volatile("s_waitcnt vmcnt(" #n ")" ::: "memory")
#define PG8_WAIT_L(n) asm volatile("s_waitcnt lgkmcnt(" #n ")" ::: "memory")
#define PG8_BAR __builtin_amdgcn_s_barrier()
#define PG8_SCHED __builtin_amdgcn_sched_barrier(0)
    Unit cur, nxt; int ui = 0;
    if (!S.next(0, cur)) return;
    f32x4 acc[2][2][4][2];
#pragma unroll
    for (int a = 0; a < 2; ++a)
#pragma unroll
        for (int b = 0; b < 2; ++b)
#pragma unroll
            for (int m = 0; m < 4; ++m)
#pragma unroll
                for (int n = 0; n < 2; ++n) acc[a][b][m][n] = (f32x4){0.f, 0.f, 0.f, 0.f};
    bf16x8 At[4][2], B0[2][2], B1[2][2];
    const char* cA = (const char*)g.A + (size_t)cur.pm * tstep; const char* cB = (const char*)g.Bt + (size_t)cur.pn * tstep;
    S.a_ready(cur);
    if constexpr (SP2) {
        PG8_STAGE(PG8_SB(0, 0), cB, voffB); PG8_STAGE(PG8_SB(0, 1), cB + hstep, voffB); PG8_STAGE(PG8_SA(0, 0), cA, voffA); PG8_STAGE(PG8_SA(0, 1), cA + hstep, voffA);
        if (wr == 1) PG8_BAR;
        PG8_WAIT_V(2); PG8_BAR;
        PG8_STAGE(PG8_SB(1, 0), cB + kstep, voffB); PG8_STAGE(PG8_SA(1, 0), cA + kstep, voffA); PG8_STAGE(PG8_SB(1, 1), cB + hstep + kstep, voffB);
        PG8_WAIT_V(6); PG8_BAR;
    } else {
        PG8_STAGE(PG8_SB(0, 0), cB, voffB); PG8_STAGE(PG8_SA(0, 0), cA, voffA); PG8_STAGE(PG8_SB(0, 1), cB + hstep, voffB); PG8_STAGE(PG8_SA(0, 1), cA + hstep, voffA);
        if (wr == 1) PG8_BAR;
        PG8_WAIT_V(4); PG8_BAR;
        PG8_STAGE(PG8_SB(1, 0), cB + kstep, voffB); PG8_STAGE(PG8_SA(1, 0), cA + kstep, voffA); PG8_STAGE(PG8_SB(1, 1), cB + hstep + kstep, voffB);
        PG8_WAIT_V(6); PG8_BAR;
    }
    for (;;) {
        const bool has_next = S.next(ui + 1, nxt);
        const char* nA = has_next ? (const char*)g.A + (size_t)nxt.pm * tstep : cA; const char* nB = has_next ? (const char*)g.Bt + (size_t)nxt.pn * tstep : cB;
        for (int t = 0; t < nt; t += 2) {
            const bool last = (t == nt - 2);
            const char* a1 = cA + (size_t)(t + 1) * kstep;
            const char* a2 = last ? nA : cA + (size_t)(t + 2) * kstep; const char* b2 = last ? nB : cB + (size_t)(t + 2) * kstep;
            const char* a3 = a2 + kstep; const char* b3 = b2 + kstep;
            if (last && has_next) S.a_ready(nxt);
            if constexpr (SP2) {
            PG8_LDB(B0, 0, 0); PG8_LDB(B1, 0, 1); PG8_SCHED; PG8_LDA(At, 0, 0); PG8_STAGE(PG8_SA(1, 1), a1 + hstep, voffA);
            PG8_WAIT_V(8); PG8_WAIT_L(0); PG8_BAR; PG8_MMA(0, 0, At, B0); PG8_MMA(0, 1, At, B1); PG8_BAR; PG8_SCHED;
            PG8_LDA(At, 0, 1); PG8_STAGE(PG8_SB(0, 0), b2, voffB); PG8_STAGE(PG8_SB(0, 1), b2 + hstep, voffB); PG8_STAGE(PG8_SA(0, 0), a2, voffA);
            PG8_WAIT_V(8); PG8_WAIT_L(0); PG8_BAR; PG8_MMA(1, 0, At, B0); PG8_MMA(1, 1, At, B1); PG8_BAR; PG8_SCHED;
            PG8_LDB(B0, 1, 0); PG8_LDB(B1, 1, 1); PG8_SCHED; PG8_LDA(At, 1, 0); PG8_STAGE(PG8_SA(0, 1), a2 + hstep, voffA);
            PG8_WAIT_V(8); PG8_WAIT_L(0); PG8_BAR; PG8_MMA(0, 0, At, B0); PG8_MMA(0, 1, At, B1); PG8_BAR; PG8_SCHED;
            PG8_LDA(At, 1, 1); PG8_STAGE(PG8_SB(1, 0), b3, voffB); PG8_STAGE(PG8_SB(1, 1), b3 + hstep, voffB); PG8_STAGE(PG8_SA(1, 0), a3, voffA);
            PG8_WAIT_V(8); PG8_WAIT_L(0); PG8_BAR; PG8_MMA(1, 0, At, B0); PG8_MMA(1, 1, At, B1); PG8_BAR; PG8_SCHED;
            } else {
            PG8_LDB(B0, 0, 0); PG8_SCHED; PG8_LDA(At, 0, 0); PG8_STAGE(PG8_SA(1, 1), a1 + hstep, voffA);
            PG8_WAIT_L(8); PG8_BAR; PG8_WAIT_L(0); PG8_MMA(0, 0, At, B0); PG8_BAR; PG8_SCHED;
            PG8_LDB(B1, 0, 1); PG8_STAGE(PG8_SB(0, 0), b2, voffB);
            PG8_BAR; PG8_WAIT_L(0); PG8_MMA(0, 1, At, B1); PG8_BAR;
            PG8_LDA(At, 0, 1); PG8_STAGE(PG8_SA(0, 0), a2, voffA);
            PG8_BAR; PG8_WAIT_L(0); PG8_MMA(1, 0, At, B0); PG8_BAR; PG8_SCHED;
            PG8_STAGE(PG8_SB(0, 1), b2 + hstep, voffB);
            PG8_WAIT_V(6); PG8_BAR; PG8_MMA(1, 1, At, B1); PG8_BAR;
            PG8_LDB(B0, 1, 0); PG8_SCHED; PG8_LDA(At, 1, 0); PG8_STAGE(PG8_SA(0, 1), a2 + hstep, voffA);
            PG8_WAIT_L(8); PG8_BAR; PG8_WAIT_L(0); PG8_MMA(0, 0, At, B0); PG8_BAR; PG8_SCHED;
            PG8_LDB(B1, 1, 1); PG8_STAGE(PG8_SB(1, 0), b3, voffB);
            PG8_BAR; PG8_WAIT_L(0); PG8_MMA(0, 1, At, B1); PG8_BAR;
            PG8_LDA(At, 1, 1); PG8_STAGE(PG8_SA(1, 0), a3, voffA);
            PG8_BAR; PG8_WAIT_L(0); PG8_MMA(1, 0, At, B0); PG8_BAR; PG8_SCHED;
            PG8_STAGE(PG8_SB(1, 1), b3 + hstep, voffB);
            PG8_WAIT_V(6); PG8_BAR; PG8_MMA(1, 1, At, B1); PG8_BAR;
            }
        }
        if constexpr (ALIGN_EPI) { if (wr == 0) PG8_BAR; }
        if constexpr (!Epi::AFTER_DRAIN) { E(acc, cur, wr, wc, fr, fq); S.done(cur); }
        if (!has_next) break;
#pragma unroll
        for (int a = 0; a < 2; ++a)
#pragma unroll
            for (int b = 0; b < 2; ++b)
#pragma unroll
                for (int m = 0; m < 4; ++m)
#pragma unroll
                    for (int n = 0; n < 2; ++n) acc[a][b][m][n] = (f32x4){0.f, 0.f, 0.f, 0.f};
        cur = nxt; cA = nA; cB = nB; ++ui;
        if constexpr (ALIGN_EPI) { if (wr == 1) PG8_BAR; }
    }
    PG8_WAIT_V(0);
    if constexpr (!ALIGN_EPI) { if (wr == 0) PG8_BAR; }
    PG8_BAR;
    if constexpr (Epi::AFTER_DRAIN) { E.fused(acc, cur, wr, wc, fr, fq, lds, wid, lane); S.done(cur); }
#undef PG8_SA
#undef PG8_SB
#undef PG8_STAGE
#undef PG8_LDA
#undef PG8_LDB
#undef PG8_MMA
#undef PG8_WAIT_V
#undef PG8_WAIT_L
#undef PG8_BAR
#undef PG8_SCHED
}
}


constexpr int NTOK = 8192, SEQ = 4096, DM = 2048, NLAYER = 2;
constexpr int IN_COLS = 15808, INP = 15872;
constexpr int NSEG = 65;
constexpr int XS_ROWS = 8192 + 65536 + 64 * 256;
constexpr int NPHASE = 14;
constexpr float LN_EPS = 1e-5f, GN_EPS = 64e-5f, ALPHA = 1.4142135623730951f  , ROUTED_SCALE = 2.5f;

constexpr size_t MiB = 1u << 20, KiB = 1u << 10;
constexpr size_t WS_CTL = 0, CTL_ZERO_BYTES = 1 * MiB;
constexpr size_t WS_HIST = 1 * MiB;
constexpr size_t WS_SELE = WS_HIST + 64 * KiB;
constexpr size_t WS_SELW = WS_SELE + 256 * KiB;
constexpr size_t WS_SLOT = WS_SELW + 256 * KiB;
constexpr size_t WS_ROWW = WS_SLOT + 256 * KiB;
constexpr size_t WS_TSEG = WS_ROWW + 352 * KiB;
constexpr size_t WS_BON = WS_TSEG + 4 * KiB;
constexpr size_t WS_WIN = 4 * MiB;
constexpr size_t WS_WLORA = 66 * MiB;
constexpr size_t WS_WBR = 69 * MiB;
constexpr size_t WS_WO = 81 * MiB;
constexpr size_t WS_WGU = 89 * MiB;
constexpr size_t WS_WD = 349 * MiB;
constexpr size_t WS_XB = 479 * MiB;
constexpr size_t WS_MERGED = 511 * MiB;
constexpr size_t WS_PRELN = 543 * MiB;
constexpr size_t WS_X1 = 607 * MiB;
constexpr size_t WS_X2 = 671 * MiB;
constexpr size_t WS_M = 735 * MiB;
constexpr size_t WS_PCONV = WS_M, WS_PQKV = WS_M + 48 * MiB, WS_PRKV = WS_M + 96 * MiB, WS_PLORA = WS_M + 144 * MiB, WS_PGATE = WS_M + 152 * MiB;
constexpr size_t WS_YBR = WS_M + 248 * MiB;
constexpr size_t WS_LORAA = WS_M + 296 * MiB;
constexpr size_t WS_RWR = WS_M + 304 * MiB, WS_RWW = WS_RWR + 32 * MiB, WS_RWK = WS_RWW + 32 * MiB, WS_RWV = WS_RWK + 32 * MiB, WS_RWKK = WS_RWV + 32 * MiB,
                 WS_RWB = WS_RWKK + 32 * MiB, WS_RWA = WS_RWB + 32 * MiB, WS_RWG = WS_RWA + 32 * MiB, WS_RWY = WS_RWG + 32 * MiB;
constexpr size_t WS_XS = WS_M;
constexpr size_t WS_H = WS_XS + 352 * MiB;
constexpr size_t WS_YS = WS_H + 88 * MiB;
constexpr size_t WS_END = WS_YS + 352 * MiB;
static_assert(WS_RWY + 32 * MiB <= WS_END && (size_t)XS_ROWS * 2048 * 2 == 352 * MiB && (size_t)XS_ROWS * 512 * 2 == 88 * MiB, "ws map");
static_assert(WS_BON + 512 * KiB <= WS_WIN && WS_WIN + (size_t)INP * 2048 * 2 <= WS_WLORA && WS_WGU + (size_t)65 * 1024 * 2048 * 2 <= WS_WD && WS_WD + (size_t)65 * 2048 * 512 * 2 <= WS_XB, "ws map 2");
constexpr int CW_TMO = 0, CW_BAR = 4096;

constexpr int RING_OFF = 0, RING_BYTES = 131072;
constexpr int LDSCTL_OFF = RING_BYTES, MISC_OFF = LDSCTL_OFF + 320;
constexpr int LDS_BYTES = 147456;
constexpr int NWAVES = 8;

#define GAS __attribute__((address_space(1)))
#define LAS __attribute__((address_space(3)))
typedef unsigned short bf16;
typedef unsigned v4u __attribute__((ext_vector_type(4)));
typedef unsigned v2u __attribute__((ext_vector_type(2)));
typedef float f32x4 __attribute__((ext_vector_type(4)));
typedef float f32x16 __attribute__((ext_vector_type(16)));
typedef short bf16x8 __attribute__((ext_vector_type(8)));
typedef short s16x4 __attribute__((ext_vector_type(4)));
typedef GAS unsigned gu32;
#define RLX_AGENT __ATOMIC_RELAXED, __HIP_MEMORY_SCOPE_AGENT
#define LDS_WAIT() asm volatile("s_waitcnt lgkmcnt(0)" ::: "memory")
#define VM_WAIT() asm volatile("s_waitcnt vmcnt(0)" ::: "memory")
__device__ __forceinline__ unsigned f2bf(float f) { unsigned u = __builtin_bit_cast(unsigned, f); return (u + 0x7fffu + ((u >> 16) & 1u)) >> 16; }
__device__ __forceinline__ unsigned pk2(float lo, float hi) { return f2bf(lo) | (f2bf(hi) << 16); }
__device__ __forceinline__ float bf2f(bf16 b) { return __uint_as_float((unsigned)b << 16); }
__device__ __forceinline__ float blo(unsigned w) { return __uint_as_float(w << 16); }
__device__ __forceinline__ float bhi(unsigned w) { return __uint_as_float(w & 0xffff0000u); }
__device__ __forceinline__ int ld_i32(const int* p) { return __hip_atomic_load(p, RLX_AGENT); }
__device__ __forceinline__ float ld_f32(const float* p) { return __hip_atomic_load(p, RLX_AGENT); }

#define XB_TMO      128
#define XB_XCNT(j)  (256  + 64 * (j))
#define XB_XSUB(j)  (1280 + 64 * (j))
#define XB_XGEN(j)  (2304 + 64 * (j))
#define XB_TOP      3328
#define XB_TOPGEN   3392
#define XCD_BAR_WORDS 3456
#define XB_SPIN_CAP (1u << 18)

__device__ __forceinline__ unsigned xb_ld(unsigned* p)              { return __hip_atomic_load(p, __ATOMIC_RELAXED, __HIP_MEMORY_SCOPE_AGENT); }
__device__ __forceinline__ unsigned xb_add(unsigned* p, unsigned v) { return __hip_atomic_fetch_add(p, v, __ATOMIC_RELAXED, __HIP_MEMORY_SCOPE_AGENT); }
__device__ __forceinline__ unsigned xb_xcc_id() { return (unsigned)__builtin_amdgcn_s_getreg((3 << 11) | 20) & 0xFu; }
#define XB_SPIN(cond, bar) do { unsigned _sp = 0; while (cond) { __builtin_amdgcn_s_sleep(1); \
    if ((++_sp & 255u) == 0u) { if (xb_ld(&(bar)[XB_TMO])) break; if (_sp > XB_SPIN_CAP) { atomicAdd(&(bar)[XB_TMO], 1u); break; } } } } while (0)

struct XcdBarrier {
    unsigned* bar; unsigned x;
    volatile LAS unsigned* st;
};

__device__ __forceinline__ XcdBarrier xcd_barrier_post(unsigned* bar, volatile LAS unsigned* st) {
    XcdBarrier b; b.bar = bar; b.x = xb_xcc_id(); b.st = st;
    if (threadIdx.x == 0) (void)xb_add(&bar[XB_XCNT(b.x)], 1u);
    return b;
}
__device__ __forceinline__ void xcd_barrier_complete(unsigned* bar, unsigned x, unsigned& nloc, unsigned& nx) {
    const unsigned G = gridDim.x * gridDim.y * gridDim.z;
    unsigned sum, cnt, mine, sp = 0u;
    for (;;) {
        sum = 0u; cnt = 0u; mine = 0u;
#pragma unroll
        for (unsigned j = 0; j < 16; ++j) { const unsigned c = xb_ld(&bar[XB_XCNT(j)]); sum += c; cnt += (c > 0u) ? 1u : 0u; mine = (j == x) ? c : mine; }
        if (sum == G) break;
        __builtin_amdgcn_s_sleep(1);
        if ((++sp & 255u) == 0u) { if (xb_ld(&bar[XB_TMO])) break; if (sp > XB_SPIN_CAP) { atomicAdd(&bar[XB_TMO], 1u); break; } }
    }
    nloc = mine > 0u ? mine : 1u; nx = cnt > 0u ? cnt : 1u;
}

__device__ __forceinline__ void xcd_barrier(const XcdBarrier& b) {
    asm volatile("s_waitcnt vmcnt(0)" ::: "memory");
    __syncthreads();
    if (threadIdx.x == 0) {
        unsigned* bar = b.bar;
        __builtin_amdgcn_s_waitcnt(0);
        unsigned nloc = b.st[0], nx = b.st[1];
        if (nloc == 0u) { xcd_barrier_complete(bar, b.x, nloc, nx); b.st[0] = nloc; b.st[1] = nx; }
        const unsigned old = xb_add(&bar[XB_XSUB(b.x)], 1u);
        const unsigned gen = old / nloc;
        if (old + 1u == (gen + 1u) * nloc) {
            __builtin_amdgcn_fence(__ATOMIC_RELEASE, "agent");
            asm volatile("s_waitcnt vmcnt(0)" ::: "memory");
            const unsigned og = xb_add(&bar[XB_TOP], 1u);
            const unsigned tg = og / nx;
            if (og + 1u == (tg + 1u) * nx) xb_add(&bar[XB_TOPGEN], 1u);
            else XB_SPIN(xb_ld(&bar[XB_TOPGEN]) == tg, bar);
            __builtin_amdgcn_fence(__ATOMIC_ACQUIRE, "agent");
            xb_add(&bar[XB_XGEN(b.x)], 1u);
            asm volatile("s_waitcnt vmcnt(0)" ::: "memory");
        } else {
            XB_SPIN(xb_ld(&bar[XB_XGEN(b.x)]) == gen, bar);
            __builtin_amdgcn_fence(__ATOMIC_ACQUIRE, "agent");
            asm volatile("s_waitcnt vmcnt(0)" ::: "memory");
        }
    }
    __syncthreads();
}

struct Args { const float* in[28]; float* out; unsigned char* ws; int ph_lo, ph_hi, li, pad; };
typedef const __attribute__((address_space(4))) Args* KArgs;
struct Frame {
    LAS unsigned char* lds;
    volatile LAS unsigned* MISC;
    gu32* ctl;
    unsigned char* ws;
    int tid, lane, wave, vcu, G;
};
__device__ __forceinline__ float wave_sum(float v) {
#pragma unroll
    for (int o = 1; o < 64; o <<= 1) v += __shfl_xor(v, o);
    return v;
}
__device__ __forceinline__ v4u pack8(const float* v) { v4u o; o.x = pk2(v[0], v[1]); o.y = pk2(v[2], v[3]); o.z = pk2(v[4], v[5]); o.w = pk2(v[6], v[7]); return o; }
__device__ __forceinline__ void unpack8(v4u w, float* v) { v[0] = blo(w.x); v[1] = bhi(w.x); v[2] = blo(w.y); v[3] = bhi(w.y); v[4] = blo(w.z); v[5] = bhi(w.z); v[6] = blo(w.w); v[7] = bhi(w.w); }

__device__ __forceinline__ void tr_item(const float* W, int ldn, int k0, int n0, bf16* WT, size_t drow0, int Kd, LAS float* scr, int lane) {
#pragma unroll 8
    for (int i = 0; i < 32; ++i) { const int kk = 2 * i + (lane >> 5); scr[kk * 33 + (lane & 31)] = W[(size_t)(k0 + kk) * ldn + n0 + (lane & 31)]; }
    LDS_WAIT(); asm volatile("" ::: "memory");
    const int c = lane & 7;
#pragma unroll
    for (int j = 0; j < 4; ++j) { const int n = (lane >> 3) + 8 * j; const LAS float* s = scr + (8 * c) * 33 + n;
        v4u o; o.x = pk2(s[0 * 33], s[1 * 33]); o.y = pk2(s[2 * 33], s[3 * 33]); o.z = pk2(s[4 * 33], s[5 * 33]); o.w = pk2(s[6 * 33], s[7 * 33]);
        *(GAS v4u*)(WT + (drow0 + n) * Kd + k0 + 8 * c) = o; }
    LDS_WAIT(); asm volatile("" ::: "memory");
}
__device__ __forceinline__ void ph0_convert(KArgs a, Frame& F, int l) {
    LAS float* scr = (LAS float*)(F.lds + RING_OFF + F.wave * 16384);
    const int gw = F.vcu * NWAVES + F.wave, NGW = F.G * NWAVES;
    bf16* WIN = (bf16*)(F.ws + WS_WIN); bf16* WLORA = (bf16*)(F.ws + WS_WLORA); bf16* WBR = (bf16*)(F.ws + WS_WBR); bf16* WO = (bf16*)(F.ws + WS_WO);
    bf16* WGU = (bf16*)(F.ws + WS_WGU); bf16* WD = (bf16*)(F.ws + WS_WD);
    const float* w_in = a->in[1] + (size_t)l * 2048 * IN_COLS;
    const float* w_br = a->in[14] + (size_t)l * 3 * 1024 * 2048;
    const float* w_o = a->in[15] + (size_t)l * 2048 * 2048;
    constexpr int I_IN = 32 * 494, I_BR = 3 * 16 * 64, I_WO = 32 * 64, I_G = 65 * 512, I_D = 65 * 512;
    constexpr int NIT = I_IN + I_BR + I_WO + 2 * I_G + I_D;
    for (int it = gw; it < NIT; it += NGW) {
        int r = it;
        if (r < I_IN) { const int kb = r / 494, nb = r % 494, n0 = 32 * nb; tr_item(w_in, IN_COLS, 64 * kb, n0, WIN, (size_t)(n0 + (n0 >= 9408 ? 64 : 0)), 2048, scr, F.lane); continue; }
        r -= I_IN;
        if (r < I_BR) { const int nbr = r / 1024, rr = r % 1024, kb = rr / 64, nb = rr % 64; tr_item(w_br + (size_t)nbr * 1024 * 2048, 2048, 64 * kb, 32 * nb, WBR + (size_t)nbr * 2048 * 1024, (size_t)(32 * nb), 1024, scr, F.lane); continue; }
        r -= I_BR;
        if (r < I_WO) { const int kb = r / 64, nb = r % 64; tr_item(w_o, 2048, 64 * kb, 32 * nb, WO, (size_t)(32 * nb), 2048, scr, F.lane); continue; }
        r -= I_WO;
        if (r < 2 * I_G) { const int up = r >= I_G ? 1 : 0; if (up) r -= I_G; const int seg = r / 512, rr = r % 512, kb = rr / 16, nb = rr % 16, n0 = 32 * nb;
            const float* src = seg == 0 ? (up ? a->in[24] : a->in[23]) + (size_t)l * 2048 * 512 : (up ? a->in[21] : a->in[20]) + (size_t)(l * 64 + seg - 1) * 2048 * 512;
            tr_item(src, 512, 64 * kb, n0, WGU, (size_t)(seg * 1024 + (n0 >> 7) * 256 + (n0 & 127) + up * 128), 2048, scr, F.lane); continue; }
        r -= 2 * I_G;
        { const int seg = r / 512, rr = r % 512, kb = rr / 64, nb = rr % 64;
            const float* src = seg == 0 ? a->in[25] + (size_t)l * 512 * 2048 : a->in[22] + (size_t)(l * 64 + seg - 1) * 512 * 2048;
            tr_item(src, 2048, 64 * kb, 32 * nb, WD, (size_t)(seg * 2048 + 32 * nb), 512, scr, F.lane); }
    }
    const size_t gt = (size_t)F.vcu * 512 + F.tid, NT = (size_t)F.G * 512;
    for (size_t i = gt; i < 64 * 2048 / 8; i += NT) ((v4u*)(WIN + (size_t)9408 * 2048))[i] = (v4u){0u, 0u, 0u, 0u};
    { const float* w2 = a->in[5] + (size_t)l * 96 * 1024; const float* a2 = a->in[7] + (size_t)l * 96 * 1024; const float* g2 = a->in[8] + (size_t)l * 256 * 1024;
      for (size_t i = gt; i < (size_t)3072 * 512; i += NT) { const int k = (int)(i / 3072), n = (int)(i % 3072), sec = n >> 10, nn = n & 1023; float v = 0.f;
          if (sec == 0) { if (k < 96) v = w2[k * 1024 + nn]; } else if (sec == 1) { if (k >= 96 && k < 192) v = a2[(k - 96) * 1024 + nn]; } else { if (k >= 256) v = g2[(k - 256) * 1024 + nn]; }
          WLORA[(size_t)n * 512 + k] = (bf16)f2bf(v); } }
    if (l == 0) { const f32x4* x = (const f32x4*)a->in[0]; v4u* xb = (v4u*)(F.ws + WS_XB);
        for (size_t i = gt; i < (size_t)NTOK * DM / 8; i += NT) { const f32x4 p = x[2 * i], q = x[2 * i + 1]; v4u o; o.x = pk2(p[0], p[1]); o.y = pk2(p[2], p[3]); o.z = pk2(q[0], q[1]); o.w = pk2(q[2], q[3]); xb[i] = o; } }
}

__device__ __forceinline__ void ph2_elementwise(KArgs a, Frame& F, int l) {
    const size_t gt = (size_t)F.vcu * 512 + F.tid, NT = (size_t)F.G * 512;
    const bf16* PC = (const bf16*)(F.ws + WS_PCONV); bf16* Y0 = (bf16*)(F.ws + WS_YBR);
    const float* cw = a->in[2] + (size_t)l * 3 * 1024;
    for (size_t i = gt; i < (size_t)NTOK * 128; i += NT) { const int t = (int)(i >> 7), c = (int)(i & 127) * 8, tt = t & (SEQ - 1);
        const bf16* row = PC + (size_t)t * 3072;
        float gb[8], g0[8], h0[8], u0[8], u1[8], u2[8];
        unpack8(*(const v4u*)(row + c), gb); unpack8(*(const v4u*)(row + 1024 + c), g0); unpack8(*(const v4u*)(row + 2048 + c), h0);
#pragma unroll
        for (int j = 0; j < 8; ++j) { u0[j] = g0[j] * h0[j]; u1[j] = 0.f; u2[j] = 0.f; }
        if (tt >= 1) { unpack8(*(const v4u*)(row - 3072 + 1024 + c), g0); unpack8(*(const v4u*)(row - 3072 + 2048 + c), h0);
#pragma unroll
            for (int j = 0; j < 8; ++j) u1[j] = g0[j] * h0[j]; }
        if (tt >= 2) { unpack8(*(const v4u*)(row - 6144 + 1024 + c), g0); unpack8(*(const v4u*)(row - 6144 + 2048 + c), h0);
#pragma unroll
            for (int j = 0; j < 8; ++j) u2[j] = g0[j] * h0[j]; }
        float y[8];
#pragma unroll
        for (int j = 0; j < 8; ++j) y[j] = gb[j] * (cw[c + j] * u2[j] + cw[1024 + c + j] * u1[j] + cw[2048 + c + j] * u0[j]);
        *(v4u*)(Y0 + (size_t)t * 1024 + c) = pack8(y); }
    const bf16* PR = (const bf16*)(F.ws + WS_PRKV); const float* mix = a->in[3] + (size_t)l * 3520;
    float* RWR = (float*)(F.ws + WS_RWR); float* RWK = (float*)(F.ws + WS_RWK); float* RWV = (float*)(F.ws + WS_RWV);
    for (size_t i = gt; i < (size_t)NTOK * 384; i += NT) { const int t = (int)(i / 384), c = (int)(i % 384) * 8, tt = t & (SEQ - 1);
        float p[8], q[8];
        unpack8(*(const v4u*)(PR + (size_t)t * 3072 + c), p);
        if (tt >= 1) unpack8(*(const v4u*)(PR + (size_t)(t - 1) * 3072 + c), q); else {
#pragma unroll
            for (int j = 0; j < 8; ++j) q[j] = 0.f; }
#pragma unroll
        for (int j = 0; j < 8; ++j) p[j] = p[j] + (q[j] - p[j]) * mix[c + j];
        float* dst = (c < 1024 ? RWR : (c < 2048 ? RWK : RWV)) + (size_t)t * 1024 + (c & 1023);
        *(f32x4*)dst = (f32x4){p[0], p[1], p[2], p[3]}; *(f32x4*)(dst + 4) = (f32x4){p[4], p[5], p[6], p[7]}; }
    const bf16* PL = (const bf16*)(F.ws + WS_PLORA); bf16* LA = (bf16*)(F.ws + WS_LORAA);
    for (size_t i = gt; i < (size_t)NTOK * 64; i += NT) { const int t = (int)(i >> 6), c = (int)(i & 63) * 8, tt = t & (SEQ - 1);
        float p[8], q[8];
        if (c >= 192 && c < 256) {
#pragma unroll
            for (int j = 0; j < 8; ++j) p[j] = 0.f;
        } else {
            unpack8(*(const v4u*)(PL + (size_t)t * 512 + c), p);
            if (tt >= 1) unpack8(*(const v4u*)(PL + (size_t)(t - 1) * 512 + c), q); else {
#pragma unroll
                for (int j = 0; j < 8; ++j) q[j] = 0.f; }
            const int mi = c < 96 ? 3072 + c : (c < 192 ? 3168 + (c - 96) : 3264 + (c - 256));
#pragma unroll
            for (int j = 0; j < 8; ++j) { const float v = p[j] + (q[j] - p[j]) * mix[mi + j]; p[j] = c < 96 ? tanhf(v) : (c < 192 ? v : 1.0f / (1.0f + expf(-v))); }
        }
        *(v4u*)(LA + (size_t)t * 512 + c) = pack8(p); }
}

__device__ __forceinline__ void ph4_prep(KArgs a, Frame& F, int l) {
    const int gw = F.vcu * NWAVES + F.wave, NGW = F.G * NWAVES;
    float* RWR = (float*)(F.ws + WS_RWR); float* RWK = (float*)(F.ws + WS_RWK); float* RWKK = (float*)(F.ws + WS_RWKK); float* RWB = (float*)(F.ws + WS_RWB);
    const float* RWA = (const float*)(F.ws + WS_RWA); float* BON = (float*)(F.ws + WS_BON);
    const float* kkw = a->in[9] + (size_t)l * 1024; const float* kaw = a->in[10] + (size_t)l * 1024; const float* rkw = a->in[11] + (size_t)l * 1024;
    for (int task = gw; task < NTOK * 16; task += NGW) { const int t = task >> 4, h = task & 15, c = h * 64 + F.lane; const size_t idx = (size_t)t * 1024 + c;
        const float r = RWR[idx], k = RWK[idx], av = RWA[idx];
        const float kkr = k * kkw[c]; const float n2 = wave_sum(kkr * kkr); const float kk = kkr / fmaxf(sqrtf(n2), 1e-12f);
        const float k2 = k * (1.0f + (av - 1.0f) * kaw[c]);
        RWK[idx] = k2; RWKK[idx] = kk; RWB[idx] = kk * av;
        const float bon = wave_sum(r * k2 * rkw[c]);
        if (F.lane == 0) BON[task] = bon; }
}
__device__ __forceinline__ void ph6_rwkv_out(KArgs a, Frame& F, int l) {
    const int gw = F.vcu * NWAVES + F.wave, NGW = F.G * NWAVES;
    const float* RWY = (const float*)(F.ws + WS_RWY); const float* RWV = (const float*)(F.ws + WS_RWV); const float* RWG = (const float*)(F.ws + WS_RWG); const float* BON = (const float*)(F.ws + WS_BON);
    bf16* Y2 = (bf16*)(F.ws + WS_YBR) + (size_t)2 * NTOK * 1024;
    const float* lg = a->in[12] + (size_t)l * 1024; const float* lb = a->in[13] + (size_t)l * 1024;
    for (int task = gw; task < NTOK * 16; task += NGW) { const int t = task >> 4, h = task & 15, c = h * 64 + F.lane; const size_t idx = (size_t)t * 1024 + c;
        const float y = RWY[idx]; const float mu = wave_sum(y) * (1.0f / 64.0f); const float d = y - mu; const float var = wave_sum(d * d) * (1.0f / 64.0f);
        float yn = d * rsqrtf(var + GN_EPS) * lg[c] + lb[c];
        yn += ld_f32(BON + task) * RWV[idx];
        yn *= RWG[idx];
        const float other = __shfl_xor(yn, 1);
        if ((F.lane & 1) == 0) *(unsigned*)(Y2 + idx) = pk2(yn, other); }
}

__device__ __forceinline__ float dpp_add16(float v) {
    v += __builtin_bit_cast(float, __builtin_amdgcn_update_dpp(0, __builtin_bit_cast(int, v), 0xB1, 0xF, 0xF, true));
    v += __builtin_bit_cast(float, __builtin_amdgcn_update_dpp(0, __builtin_bit_cast(int, v), 0x4E, 0xF, 0xF, true));
    v += __builtin_bit_cast(float, __builtin_amdgcn_update_dpp(0, __builtin_bit_cast(int, v), 0x141, 0xF, 0xF, true));
    v += __builtin_bit_cast(float, __builtin_amdgcn_update_dpp(0, __builtin_bit_cast(int, v), 0x140, 0xF, 0xF, true));
    return v;
}
__device__ __forceinline__ void ph5_scan(Frame& F) {
    const int bx = pg8::obid();
    if (bx >= 128) return;
    const int seq = bx >> 2, b = seq >> 4, h = seq & 15, i0 = (bx & 3) * 16 + F.wave * 4;
    const bool active = F.wave < 4;
    LAS float* buf = (LAS float*)(F.lds + RING_OFF);
    const float* A0 = (const float*)(F.ws + WS_RWKK); const float* A1 = (const float*)(F.ws + WS_RWB); const float* A2 = (const float*)(F.ws + WS_RWW);
    const float* A3 = (const float*)(F.ws + WS_RWK); const float* A4 = (const float*)(F.ws + WS_RWR); const float* A5 = (const float*)(F.ws + WS_RWV);
    float* RWY = (float*)(F.ws + WS_RWY);
    const size_t tok0 = (size_t)b * SEQ; const int col0 = h * 64;
    const int st = F.tid >> 4, sq = F.tid & 15;
    const size_t soff = (tok0 + st) * 1024 + col0 + sq * 4;
    const int loff = st * 64 + sq * 4;
    f32x4 s0 = *(const f32x4*)(A0 + soff), s1 = *(const f32x4*)(A1 + soff), s2 = *(const f32x4*)(A2 + soff), s3 = *(const f32x4*)(A3 + soff), s4 = *(const f32x4*)(A4 + soff), s5 = *(const f32x4*)(A5 + soff);
    *(LAS f32x4*)(buf + 0 * 2048 + loff) = s0; *(LAS f32x4*)(buf + 1 * 2048 + loff) = s1; *(LAS f32x4*)(buf + 2 * 2048 + loff) = s2;
    *(LAS f32x4*)(buf + 3 * 2048 + loff) = s3; *(LAS f32x4*)(buf + 4 * 2048 + loff) = s4; *(LAS f32x4*)(buf + 5 * 2048 + loff) = s5;
    const int rl = F.lane >> 4, jq = F.lane & 15, irow = i0 + rl;
    float S0 = 0.f, S1 = 0.f, S2 = 0.f, S3 = 0.f, yreg = 0.f;
    for (int blk = 0; blk < SEQ / 32; ++blk) {
        const int cur = blk & 1;
        if (blk + 1 < SEQ / 32) { const size_t o = soff + (size_t)(blk + 1) * 32 * 1024;
            s0 = *(const f32x4*)(A0 + o); s1 = *(const f32x4*)(A1 + o); s2 = *(const f32x4*)(A2 + o); s3 = *(const f32x4*)(A3 + o); s4 = *(const f32x4*)(A4 + o); s5 = *(const f32x4*)(A5 + o); }
        __syncthreads();
        if (active) {
            const LAS float* bb = buf + cur * 12288;
#pragma unroll 4
            for (int tl = 0; tl < 32; ++tl) {
                const LAS float* base = bb + tl * 64;
                const f32x4 kk4 = *(const LAS f32x4*)(base + 0 * 2048 + 4 * jq), b4 = *(const LAS f32x4*)(base + 1 * 2048 + 4 * jq), w4 = *(const LAS f32x4*)(base + 2 * 2048 + 4 * jq),
                            k4 = *(const LAS f32x4*)(base + 3 * 2048 + 4 * jq), r4 = *(const LAS f32x4*)(base + 4 * 2048 + 4 * jq);
                const float v = base[5 * 2048 + irow];
                float p = S0 * kk4[0] + S1 * kk4[1] + S2 * kk4[2] + S3 * kk4[3];
                const float sa = -dpp_add16(p);
                S0 = S0 * w4[0] + (sa * b4[0] + v * k4[0]); S1 = S1 * w4[1] + (sa * b4[1] + v * k4[1]);
                S2 = S2 * w4[2] + (sa * b4[2] + v * k4[2]); S3 = S3 * w4[3] + (sa * b4[3] + v * k4[3]);
                float q = S0 * r4[0] + S1 * r4[1] + S2 * r4[2] + S3 * r4[3];
                q = dpp_add16(q);
                if (jq == (tl & 15)) yreg = q;
                if ((tl & 15) == 15) RWY[(tok0 + (size_t)blk * 32 + (tl - 15) + jq) * 1024 + col0 + irow] = yreg;
            }
        }
        if (blk + 1 < SEQ / 32) { LAS float* nb = buf + (cur ^ 1) * 12288;
            *(LAS f32x4*)(nb + 0 * 2048 + loff) = s0; *(LAS f32x4*)(nb + 1 * 2048 + loff) = s1; *(LAS f32x4*)(nb + 2 * 2048 + loff) = s2;
            *(LAS f32x4*)(nb + 3 * 2048 + loff) = s3; *(LAS f32x4*)(nb + 4 * 2048 + loff) = s4; *(LAS f32x4*)(nb + 5 * 2048 + loff) = s5; }
    }
    __syncthreads();
}
namespace att {
constexpr int SHM_K = 64 * 128 * 2, SHM_V = 64 * 128 * 2;
constexpr float ATT_STOP = -40.0f;
#define KSWZ(row, colB) ((row) * 256 + ((colB) ^ (((row) & 7) << 4)))
__device__ __forceinline__ int v_st(int k, int c) { const int kk = (k & ~0xC) | ((k & 4) << 1) | ((k & 8) >> 1); return ((kk >> 3) * 4 + (c >> 5)) * 512 + ((kk & 7) * 32 + (c & 31)) * 2; }
__device__ __forceinline__ int v_rd_base(int lane) { return ((lane & 3) << 3) | (((lane >> 2) & 3) << 6) | (((lane >> 4) & 1) << 5) | (((lane >> 5) & 1) << 8); }
constexpr int v_rd_off(int d0, int ks, int half) { return d0 * 512 + ks * 4096 + half * 2048; }
__device__ __forceinline__ int crow(int r, int hi) { return (r & 3) + 8 * (r >> 2) + 4 * hi; }
__device__ __forceinline__ unsigned cvtpk(float lo, float hi) { unsigned r; asm volatile("v_cvt_pk_bf16_f32 %0, %1, %2" : "=v"(r) : "v"(lo), "v"(hi)); return r; }
__device__ __forceinline__ int kperm(int m) { return 16 * ((m >> 2) & 1) + 4 * (m >> 3) + (m & 3); }

__device__ __forceinline__ void qkt(f32x16& p0, f32x16& p1, LAS const char* K_lds, int r32, int hi, const bf16x8* qr) {
    p0 = f32x16{}; p1 = f32x16{};
    LAS const char* kb[4];
#pragma unroll
    for (int dd = 0; dd < 4; ++dd) kb[dd] = K_lds + KSWZ(r32, (dd * 16 + hi * 8) * 2);
#pragma unroll
    for (int d0 = 0; d0 < 8; ++d0) { LAS const char* ap = kb[d0 & 3] + (d0 >> 2) * 128;
        const bf16x8 b0 = *(LAS const bf16x8*)ap;
        const bf16x8 b1 = *(LAS const bf16x8*)(ap + 32 * 256);
        p0 = __builtin_amdgcn_mfma_f32_32x32x16_bf16(b0, qr[d0], p0, 0, 0, 0);
        p1 = __builtin_amdgcn_mfma_f32_32x32x16_bf16(b1, qr[d0], p1, 0, 0, 0); }
}
__device__ __forceinline__ void pv_tile(f32x16* o, int vb0, bf16x8 pa0, bf16x8 pa1, bf16x8 pa2, bf16x8 pa3) {
#define TRRD(dst, off) asm volatile("ds_read_b64_tr_b16 %0, %1 offset:%2" : "=&v"(dst) : "v"(vb0), "i"(off) : "memory")
#define PV_D0(d0) do { s16x4 l0, l1, l2, l3, h0, h1, h2, h3; constexpr int b_ = v_rd_off(d0, 0, 0); \
        TRRD(l0, b_); TRRD(h0, b_ + 2048); TRRD(l1, b_ + 4096); TRRD(h1, b_ + 6144); TRRD(l2, b_ + 8192); TRRD(h2, b_ + 10240); TRRD(l3, b_ + 12288); TRRD(h3, b_ + 14336); \
        asm volatile("s_waitcnt lgkmcnt(0)" ::: "memory"); __builtin_amdgcn_sched_barrier(0); \
        o[d0] = __builtin_amdgcn_mfma_f32_32x32x16_bf16(pa0, (bf16x8){l0[0], l0[1], l0[2], l0[3], h0[0], h0[1], h0[2], h0[3]}, o[d0], 0, 0, 0);   \
        o[d0] = __builtin_amdgcn_mfma_f32_32x32x16_bf16(pa1, (bf16x8){l1[0], l1[1], l1[2], l1[3], h1[0], h1[1], h1[2], h1[3]}, o[d0], 0, 0, 0);   \
        o[d0] = __builtin_amdgcn_mfma_f32_32x32x16_bf16(pa2, (bf16x8){l2[0], l2[1], l2[2], l2[3], h2[0], h2[1], h2[2], h2[3]}, o[d0], 0, 0, 0);   \
        o[d0] = __builtin_amdgcn_mfma_f32_32x32x16_bf16(pa3, (bf16x8){l3[0], l3[1], l3[2], l3[3], h3[0], h3[1], h3[2], h3[3]}, o[d0], 0, 0, 0); } while (0)
    PV_D0(0); PV_D0(1); PV_D0(2); PV_D0(3);
#undef PV_D0
#undef TRRD
}
__device__ __forceinline__ void stick_tile(f32x16& p0, f32x16& p1, float& c, int t, int kb0, int hi) {
    const float CS = 0.08838834764831845f * 1.4426950408889634f;
    const int k0 = kb0 + 16 * hi, k1 = k0 + 32;
    float f0[16], f1[16]; float T0 = 0.f, T1 = 0.f;
#pragma unroll
    for (int r = 0; r < 16; ++r) {
        const float y0 = p0[r] * CS, y1 = p1[r] * CS;
        const float sp0 = __builtin_amdgcn_logf(1.0f + __builtin_amdgcn_exp2f(y0)), sp1 = __builtin_amdgcn_logf(1.0f + __builtin_amdgcn_exp2f(y1));
        f0[r] = (k0 + r < t) ? -sp0 : 0.f; f1[r] = (k1 + r < t) ? -sp1 : 0.f;
        p0[r] = y0 - sp0; p1[r] = y1 - sp1;
        T0 += f0[r]; T1 += f1[r];
    }
    const auto s1 = __builtin_amdgcn_permlane32_swap(__float_as_uint(T1), __float_as_uint(T1), false, false);
    const auto s0 = __builtin_amdgcn_permlane32_swap(__float_as_uint(T0), __float_as_uint(T0), false, false);
    const float T1lo = __uint_as_float(s1[0]), T1hi = __uint_as_float(s1[1]), T0lo = __uint_as_float(s0[0]), T0hi = __uint_as_float(s0[1]);
    const float c1 = c + T1hi, c2 = c1 + T1lo, c3 = c2 + T0hi, c4 = c3 + T0lo;
    float run1 = hi ? c : c1, run0 = hi ? c2 : c3;
#pragma unroll
    for (int r = 15; r >= 0; --r) {
        const float w1 = (k1 + r < t) ? __builtin_amdgcn_exp2f(p1[r] + run1) : 0.f; run1 += f1[r]; p1[r] = w1;
        const float w0 = (k0 + r < t) ? __builtin_amdgcn_exp2f(p0[r] + run0) : 0.f; run0 += f0[r]; p0[r] = w0;
    }
    c = c4;
}
#define PK4(P, B_, OUT) do { unsigned a0 = cvtpk(P[B_+0], P[B_+1]), a1 = cvtpk(P[B_+2], P[B_+3]);                          \
        unsigned b0 = cvtpk(P[B_+4], P[B_+5]), b1 = cvtpk(P[B_+6], P[B_+7]);                                             \
        auto r0 = __builtin_amdgcn_permlane32_swap(a0, b0, false, false); auto r1 = __builtin_amdgcn_permlane32_swap(a1, b1, false, false); \
        v4u w = {r0[0], r1[0], r0[1], r1[1]}; OUT = __builtin_bit_cast(bf16x8, w); } while (0)

__device__ __forceinline__ void attn_unit(LAS unsigned char* lds, const bf16* QKV, bf16* O, int b, int h, int qb) {
    const int tid = pg8::otid(), wid = __builtin_amdgcn_readfirstlane(tid >> 6), lane = tid & 63, r32 = lane & 31, hi = lane >> 5;
    LAS char* V_lds = (LAS char*)lds; LAS char* K_lds = (LAS char*)lds + SHM_V; volatile LAS int* flags = (volatile LAS int*)(lds + SHM_V + SHM_K);
    const bf16* Qp = QKV + (size_t)b * SEQ * 3072 + h * 128; const bf16* Kp = Qp + 1024; const bf16* Vp = Qp + 2048;
    const int qlo = qb * 256 + wid * 32, t = qlo + r32;
    bf16x8 qr[8];
#pragma unroll
    for (int d0 = 0; d0 < 8; ++d0) qr[d0] = *(const bf16x8*)(Qp + (size_t)t * 3072 + d0 * 16 + hi * 8);
    const int sr = tid >> 4, sc = (tid & 15) * 8, kr = kperm(sr);
    const int kws = KSWZ(sr, sc * 2), vst0 = v_st(sr, sc), vst1 = v_st(32 + sr, sc);
    const int vb0 = (int)(unsigned)(uintptr_t)V_lds + v_rd_base(lane);
    f32x16 o[4] = {}; float c = 0.f; bool done = false;
    if (tid < 8) flags[tid] = 0;
    for (int j = 4 * qb + 3; j >= 0; --j) {
        const int kb0 = j * 64;
        const bf16x8 k0v = *(const bf16x8*)(Kp + (size_t)(kb0 + kr) * 3072 + sc), k1v = *(const bf16x8*)(Kp + (size_t)(kb0 + 32 + kr) * 3072 + sc);
        const bf16x8 v0v = *(const bf16x8*)(Vp + (size_t)(kb0 + kr) * 3072 + sc), v1v = *(const bf16x8*)(Vp + (size_t)(kb0 + 32 + kr) * 3072 + sc);
        __syncthreads();
        bool all_done = true;
#pragma unroll
        for (int w = 0; w < 8; ++w) all_done = all_done && (flags[w] != 0);
        if (all_done) break;
        *(LAS bf16x8*)(K_lds + kws) = k0v; *(LAS bf16x8*)(K_lds + kws + 32 * 256) = k1v;
        *(LAS bf16x8*)(V_lds + vst0) = v0v; *(LAS bf16x8*)(V_lds + vst1) = v1v;
        __syncthreads();
        if (!done && kb0 <= qlo + 30) {
            f32x16 p0, p1;
            qkt(p0, p1, K_lds, r32, hi, qr);
            stick_tile(p0, p1, c, t, kb0, hi);
            bf16x8 pa0, pa1, pa2, pa3;
            PK4(p0, 0, pa0); PK4(p0, 8, pa1); PK4(p1, 0, pa2); PK4(p1, 8, pa3);
            pv_tile(o, vb0, pa0, pa1, pa2, pa3);
            done = __all(c < ATT_STOP) != 0;
            if (lane == 0 && done) flags[wid] = 1;
        }
    }
    bf16* Ow = O + ((size_t)b * SEQ + qlo) * 1024 + h * 128;
#pragma unroll
    for (int r = 0; r < 16; ++r) { const int orow = crow(r, hi);
#pragma unroll
        for (int d0 = 0; d0 < 4; ++d0) { const float v = o[d0][r]; const float vn = __shfl_xor(v, 1);
            if ((r32 & 1) == 0) *(unsigned*)(Ow + (size_t)orow * 1024 + d0 * 32 + r32) = cvtpk(v, vn); } }
    __syncthreads();
}
#undef PK4
#undef KSWZ
}
__device__ __forceinline__ float shx(float v, int m) { return __shfl_xor(v, m); }
__device__ __forceinline__ float rdl(float v, int l) { return __builtin_bit_cast(float, __builtin_amdgcn_readlane(__builtin_bit_cast(int, v), l)); }
__device__ __forceinline__ void ph9_ln_router(KArgs a, Frame& F, int l) {
    volatile LAS int* lhist = (volatile LAS int*)(F.lds + RING_OFF);
    const float* PRE = (const float*)(F.ws + WS_PRELN); float* X1 = (float*)(F.ws + WS_X1); bf16* XS = (bf16*)(F.ws + WS_XS);
    int* HIST = (int*)(F.ws + WS_HIST); int* SELE = (int*)(F.ws + WS_SELE); float* SELW = (float*)(F.ws + WS_SELW);
    const float* g1 = a->in[16] + (size_t)l * DM; const float* b1 = a->in[17] + (size_t)l * DM;
    const float* WR = a->in[18] + (size_t)l * DM * 64; const float* rbias = a->in[19] + (size_t)l * 64;
    const int lane = F.lane;
    for (int grp = pg8::obid(); grp < 256; grp += F.G) {
        if (F.tid < 64) lhist[F.tid] = 0;
        __syncthreads();
        const int t0 = grp * 32 + F.wave * 4;
        f32x4 v[4][8];
#pragma unroll
        for (int k = 0; k < 4; ++k) {
            const f32x4* row = (const f32x4*)(PRE + (size_t)(t0 + k) * DM) + lane; float s = 0.f;
#pragma unroll
            for (int j = 0; j < 8; ++j) { v[k][j] = row[64 * j]; s += (v[k][j][0] + v[k][j][1]) + (v[k][j][2] + v[k][j][3]); }
            const float mean = wave_sum(s) * (1.0f / DM); float s2 = 0.f;
#pragma unroll
            for (int j = 0; j < 8; ++j) { v[k][j] = v[k][j] - mean; s2 += (v[k][j][0] * v[k][j][0] + v[k][j][1] * v[k][j][1]) + (v[k][j][2] * v[k][j][2] + v[k][j][3] * v[k][j][3]); }
            const float rstd = 1.0f / sqrtf(wave_sum(s2) * (1.0f / DM) + LN_EPS);
            f32x4* xo = (f32x4*)(X1 + (size_t)(t0 + k) * DM) + lane; v2u* bo = (v2u*)(XS + (size_t)(t0 + k) * DM) + lane;
#pragma unroll
            for (int j = 0; j < 8; ++j) { const f32x4 gg = ((const f32x4*)g1)[64 * j + lane], bb = ((const f32x4*)b1)[64 * j + lane];
                v[k][j] = v[k][j] * rstd * gg + bb; xo[64 * j] = v[k][j];
                v2u w; w.x = pk2(v[k][j][0], v[k][j][1]); w.y = pk2(v[k][j][2], v[k][j][3]); bo[64 * j] = w; }
        }
        float acc[4] = {0.f, 0.f, 0.f, 0.f};
#pragma unroll
        for (int j = 0; j < 8; ++j) {
            for (int ls = 0; ls < 64; ++ls) {
                const float* wrow = WR + (size_t)(256 * j + 4 * ls) * 64 + lane;
                const float w0 = wrow[0], w1 = wrow[64], w2 = wrow[128], w3 = wrow[192];
#pragma unroll
                for (int k = 0; k < 4; ++k) {
                    acc[k] += rdl(v[k][j][0], ls) * w0; acc[k] += rdl(v[k][j][1], ls) * w1; acc[k] += rdl(v[k][j][2], ls) * w2; acc[k] += rdl(v[k][j][3], ls) * w3; }
            }
        }
        const float rb = rbias[lane];
#pragma unroll
        for (int k = 0; k < 4; ++k) {
            const int t = t0 + k;
            const float sc = 1.0f / (1.0f + expf(-acc[k])); const float bz = sc + rb;
            float m1 = bz; m1 = fmaxf(m1, shx(m1, 1)); m1 = fmaxf(m1, shx(m1, 2)); m1 = fmaxf(m1, shx(m1, 4));
            const unsigned long long eq = __ballot(bz == m1);
            const int g = lane >> 3; const unsigned gb = (unsigned)((eq >> (8 * g)) & 0xffull); const int first = __ffs((int)gb) - 1;
            float m2 = ((lane & 7) == first) ? -__builtin_inff() : bz; m2 = fmaxf(m2, shx(m2, 1)); m2 = fmaxf(m2, shx(m2, 2)); m2 = fmaxf(m2, shx(m2, 4));
            const float gs = m1 + m2;
            int grank = 0;
#pragma unroll
            for (int g2 = 0; g2 < 8; ++g2) { const float o = rdl(gs, 8 * g2); grank += ((o > gs) || (o == gs && g2 < g)) ? 1 : 0; }
            const bool gsel = grank < 4;
            const float mv = gsel ? bz : -__builtin_inff();
            int rank = 0;
            for (int e2 = 0; e2 < 64; ++e2) { const float o = rdl(mv, e2); rank += ((o > mv) || (o == mv && e2 < lane)) ? 1 : 0; }
            const bool sel = gsel && rank < 8;
            const float ssum = wave_sum(sel ? sc : 0.f);
            const float wgt = sc / ssum * ROUTED_SCALE;
            const unsigned long long m = __ballot(sel);
            const int slot = __popcll(m & ((1ull << lane) - 1ull));
            if (sel) { SELE[t * 8 + slot] = lane; SELW[t * 8 + slot] = wgt; __hip_atomic_fetch_add((LAS int*)&lhist[lane], 1, __ATOMIC_RELAXED, __HIP_MEMORY_SCOPE_WORKGROUP); }
        }
        __syncthreads();
        if (F.tid < 64) HIST[grp * 64 + F.tid] = lhist[F.tid];
        __syncthreads();
    }
}
__device__ __forceinline__ void ph10_lists(Frame& F) {
    volatile LAS int* L = (volatile LAS int*)(F.lds + RING_OFF);
    volatile LAS int* partT = L, * partB = L + 512, * rowbase = L + 1024, * lsel = L + 1088, * lpos = L + 1344;
    const int* HIST = (const int*)(F.ws + WS_HIST); const int* SELE = (const int*)(F.ws + WS_SELE); const float* SELW = (const float*)(F.ws + WS_SELW);
    int* SLOT = (int*)(F.ws + WS_SLOT); float* ROWW = (float*)(F.ws + WS_ROWW); int* TSEG = (int*)(F.ws + WS_TSEG); bf16* XS = (bf16*)(F.ws + WS_XS);
    for (int grp = pg8::obid(); grp < 256; grp += F.G) {
        { const int e = F.tid & 63, part = F.tid >> 6; int s = 0, bs = 0;
          for (int w = 32 * part; w < 32 * part + 32; ++w) { const int hv = HIST[w * 64 + e]; s += hv; bs += (w < grp) ? hv : 0; }
          partT[part * 64 + e] = s; partB[part * 64 + e] = bs; }
        __syncthreads();
        if (F.tid < 64) { int tot = 0, bef = 0;
#pragma unroll
            for (int p = 0; p < 8; ++p) { tot += partT[p * 64 + F.tid]; bef += partB[p * 64 + F.tid]; }
            const int nt = (tot + 255) >> 8; int incl = nt;
#pragma unroll
            for (int o = 1; o < 64; o <<= 1) { const int u = __shfl_up(incl, o); if (F.lane >= o) incl += u; }
            const int excl = incl - nt;
            rowbase[F.tid] = 8192 + 256 * excl + bef;
            if (grp == 0) { for (int i = 0; i < nt; ++i) TSEG[16 + 32 + excl + i] = F.tid + 1;
                if (F.tid < 32) TSEG[16 + F.tid] = 0;
                if (F.tid == 63) TSEG[0] = 32 + incl; } }
        if (F.tid < 256) lsel[F.tid] = SELE[grp * 256 + F.tid];
        __syncthreads();
        if (F.tid < 256) { const int j = F.tid >> 3, e = lsel[F.tid]; int rank = 0;
            for (int q = 0; q < 8 * j; ++q) rank += (lsel[q] == e) ? 1 : 0;
            const int pos = rowbase[e] + rank; const int t = grp * 32 + j;
            SLOT[t * 8 + (F.tid & 7)] = pos; ROWW[pos] = SELW[grp * 256 + F.tid]; lpos[F.tid] = pos; }
        else if (F.tid < 288) ROWW[grp * 32 + F.tid - 256] = 1.0f;
        __syncthreads();
        for (int p = F.wave * 32; p < F.wave * 32 + 32; ++p) { const int t = grp * 32 + (p >> 3), pos = lpos[p];
            const v4u* src = (const v4u*)(XS + (size_t)t * DM) + F.lane; v4u* dst = (v4u*)(XS + (size_t)pos * DM) + F.lane;
            const v4u c0 = src[0], c1 = src[64], c2 = src[128], c3 = src[192]; dst[0] = c0; dst[64] = c1; dst[128] = c2; dst[192] = c3; }
        __syncthreads();
    }
}
__device__ __forceinline__ void ph13_combine(KArgs a, Frame& F, int l) {
    const int gw = F.vcu * NWAVES + F.wave, NGW = F.G * NWAVES, lane = F.lane;
    const float* X1 = (const float*)(F.ws + WS_X1); const bf16* YS = (const bf16*)(F.ws + WS_YS); const int* SLOT = (const int*)(F.ws + WS_SLOT);
    float* outf = (l == NLAYER - 1) ? a->out : (float*)(F.ws + WS_X2); bf16* XB = (bf16*)(F.ws + WS_XB);
    const float* g2 = a->in[26] + (size_t)l * DM; const float* b2 = a->in[27] + (size_t)l * DM;
    for (int t = gw; t < NTOK; t += NGW) {
        const int mypos = (lane < 8) ? SLOT[t * 8 + lane] : t;
        float acc[4][8];
#pragma unroll
        for (int q = 0; q < 4; ++q) { const f32x4 p0 = *(const f32x4*)(X1 + (size_t)t * DM + 512 * q + 8 * lane), p1 = *(const f32x4*)(X1 + (size_t)t * DM + 512 * q + 8 * lane + 4);
#pragma unroll
            for (int j = 0; j < 4; ++j) { acc[q][j] = ALPHA * p0[j]; acc[q][4 + j] = ALPHA * p1[j]; } }
#pragma unroll
        for (int s = 0; s < 9; ++s) { const int row = __builtin_amdgcn_readlane(mypos, s); const v4u* yr = (const v4u*)(YS + (size_t)row * DM) + lane;
#pragma unroll
            for (int q = 0; q < 4; ++q) { float u[8]; unpack8(yr[64 * q], u);
#pragma unroll
                for (int j = 0; j < 8; ++j) acc[q][j] += u[j]; } }
        float s1 = 0.f;
#pragma unroll
        for (int q = 0; q < 4; ++q)
#pragma unroll
            for (int j = 0; j < 8; ++j) s1 += acc[q][j];
        const float mean = wave_sum(s1) * (1.0f / DM); float s2 = 0.f;
#pragma unroll
        for (int q = 0; q < 4; ++q)
#pragma unroll
            for (int j = 0; j < 8; ++j) { acc[q][j] -= mean; s2 += acc[q][j] * acc[q][j]; }
        const float rstd = 1.0f / sqrtf(wave_sum(s2) * (1.0f / DM) + LN_EPS);
#pragma unroll
        for (int q = 0; q < 4; ++q) { const int col = 512 * q + 8 * lane;
            const f32x4 ga = *(const f32x4*)(g2 + col), gb = *(const f32x4*)(g2 + col + 4), ba = *(const f32x4*)(b2 + col), bb = *(const f32x4*)(b2 + col + 4);
            float y[8];
#pragma unroll
            for (int j = 0; j < 4; ++j) { y[j] = acc[q][j] * rstd * ga[j] + ba[j]; y[4 + j] = acc[q][4 + j] * rstd * gb[j] + bb[j]; }
            *(f32x4*)(outf + (size_t)t * DM + col) = (f32x4){y[0], y[1], y[2], y[3]}; *(f32x4*)(outf + (size_t)t * DM + col + 4) = (f32x4){y[4], y[5], y[6], y[7]};
            *(v4u*)(XB + (size_t)t * DM + col) = pack8(y); }
    }
}
__device__ __forceinline__ KArgs kargs() { KArgs p = (KArgs)__builtin_amdgcn_kernarg_segment_ptr(); asm volatile("" : "+s"(p)); return p; }
__device__ __forceinline__ Frame mkframe(LAS unsigned char* lds) {
    Frame F; KArgs ka = kargs();
    F.lds = lds; F.MISC = (volatile LAS unsigned*)(lds + MISC_OFF);
    F.tid = pg8::otid(); F.lane = F.tid & 63; F.wave = __builtin_amdgcn_readfirstlane(F.tid >> 6);
    F.G = gridDim.x; { const int bx = pg8::obid(); F.vcu = (F.G % 8 == 0) ? (bx % 8) * (F.G / 8) + bx / 8 : bx; }
    F.ws = ka->ws; F.ctl = (gu32*)(ka->ws + WS_CTL);
    return F;
}
__device__ __forceinline__ void grid_seam(LAS unsigned char* lds) {
    XcdBarrier b; b.bar = (unsigned*)((gu32*)(kargs()->ws + WS_CTL) + CW_BAR); b.x = xb_xcc_id(); b.st = (volatile LAS unsigned*)(lds + MISC_OFF) + 8;
    xcd_barrier(b);
}
__global__ void __launch_bounds__(NWAVES * 64, 2) fwd_kernel(Args args_unused) {
    extern __shared__ __attribute__((aligned(16))) unsigned char lds_raw[];
    LAS unsigned char* lds = (LAS unsigned char*)lds_raw;
    for (int u = threadIdx.x; u < (LDS_BYTES - LDSCTL_OFF) / 4; u += NWAVES * 64) ((LAS unsigned*)(lds + LDSCTL_OFF))[u] = 0u;
    __syncthreads();
    if (kargs()->ph_hi - kargs()->ph_lo > 1) (void)xcd_barrier_post((unsigned*)((gu32*)(kargs()->ws + WS_CTL) + CW_BAR), (volatile LAS unsigned*)(lds + MISC_OFF) + 8);
#ifndef PH_MASK
#define PH_MASK 0x3fff
#endif
#define IN(k) (((PH_MASK >> (k)) & 1) && kargs()->ph_lo <= (pb + (k)) && (pb + (k)) < kargs()->ph_hi)
#define SEAM(k) do { if (IN(k) && (pb + (k) + 1) < kargs()->ph_hi) grid_seam(lds); } while (0)
#pragma unroll 1
    for (int l = 0; l < NLAYER; ++l) {
        const int pb = l * NPHASE;
        if (IN(0)) { Frame F = mkframe(lds); ph0_convert(kargs(), F, l); } SEAM(0);
        if (IN(1)) { unsigned char* ws = kargs()->ws;
            pg8::Gemm g{(const pg8::bf16_t*)(ws + WS_XB), (const pg8::bf16_t*)(ws + WS_WIN), NTOK, INP, DM}; pg8::StaticOrder S; S.init(NTOK, INP, (int)gridDim.x, pg8::obid());
            pg8::EpiInProj E{(pg8::bf16_t*)(ws + WS_PCONV), (pg8::bf16_t*)(ws + WS_PQKV), (pg8::bf16_t*)(ws + WS_PRKV), (pg8::bf16_t*)(ws + WS_PLORA), (pg8::bf16_t*)(ws + WS_PGATE)};
            pg8::gemm_phase<pg8::EpiInProj, pg8::StaticOrder, true, true>(lds + RING_OFF, g, S, E);
        } SEAM(1);
        if (IN(2)) { unsigned char* ws = kargs()->ws;
            for (int u = pg8::obid(); u < 256; u += gridDim.x) att::attn_unit(lds + RING_OFF, (const bf16*)(ws + WS_PQKV), (bf16*)(ws + WS_YBR) + (size_t)NTOK * 1024, u >> 7, (u >> 4) & 7, u & 15);
            Frame F = mkframe(lds); ph2_elementwise(kargs(), F, l);
        } SEAM(2);
        if (IN(3)) { unsigned char* ws = kargs()->ws;
            pg8::Gemm g{(const pg8::bf16_t*)(ws + WS_LORAA), (const pg8::bf16_t*)(ws + WS_WLORA), NTOK, 3072, 512}; pg8::StaticOrder S; S.init(NTOK, 3072, (int)gridDim.x, pg8::obid());
            pg8::EpiLora E{(float*)(ws + WS_RWW), (long)((WS_RWA - WS_RWW) / 4), (long)((WS_RWG - WS_RWW) / 4), kargs()->in[4] + (size_t)l * 1024, kargs()->in[6] + (size_t)l * 1024};
            pg8::gemm_phase<pg8::EpiLora, pg8::StaticOrder, true, true>(lds + RING_OFF, g, S, E);
        } SEAM(3);
        if (IN(4)) { Frame F = mkframe(lds); ph4_prep(kargs(), F, l); } SEAM(4);
        if (IN(5)) { Frame F = mkframe(lds); ph5_scan(F); } SEAM(5);
        if (IN(6)) { Frame F = mkframe(lds); ph6_rwkv_out(kargs(), F, l); } SEAM(6);
        if (IN(7)) {
#pragma unroll 1
            for (int n = 0; n < 3; ++n) { unsigned char* ws = kargs()->ws;
                pg8::Gemm g{(const pg8::bf16_t*)(ws + WS_YBR) + (size_t)n * NTOK * 1024, (const pg8::bf16_t*)(ws + WS_WBR) + (size_t)n * 2048 * 1024, NTOK, DM, 1024}; pg8::StaticOrder S; S.init(NTOK, DM, (int)gridDim.x, pg8::obid());
                pg8::EpiGate E{(const pg8::bf16_t*)(ws + WS_PGATE) + n * 2048, (float*)(ws + WS_PRELN), (pg8::bf16_t*)(ws + WS_MERGED), n};
                pg8::gemm_phase<pg8::EpiGate, pg8::StaticOrder, true, true>(lds + RING_OFF, g, S, E);
            }
        } SEAM(7);
        if (IN(8)) { unsigned char* ws = kargs()->ws;
            pg8::Gemm g{(const pg8::bf16_t*)(ws + WS_MERGED), (const pg8::bf16_t*)(ws + WS_WO), NTOK, DM, DM}; pg8::StaticOrder S; S.init(NTOK, DM, (int)gridDim.x, pg8::obid());
            pg8::EpiWo E{l == 0 ? kargs()->in[0] : (const float*)(ws + WS_X2), (float*)(ws + WS_PRELN), ALPHA};
            pg8::gemm_phase<pg8::EpiWo, pg8::StaticOrder, true, true>(lds + RING_OFF, g, S, E);
        } SEAM(8);
        if (IN(9)) { Frame F = mkframe(lds); ph9_ln_router(kargs(), F, l); } SEAM(9);
        if (IN(10)) { Frame F = mkframe(lds); ph10_lists(F); } SEAM(10);
        if (IN(11)) { unsigned char* ws = kargs()->ws;
            const int ntiles = __builtin_amdgcn_readfirstlane(ld_i32((const int*)(ws + WS_TSEG)));
            pg8::Gemm g{(const pg8::bf16_t*)(ws + WS_XS), (const pg8::bf16_t*)(ws + WS_WGU), ntiles * 256, NSEG * 1024, DM};
            pg8::MoeOrder S{(const int*)(ws + WS_TSEG) + 16, ntiles, 4, (int)gridDim.x, pg8::obid()};
            pg8::EpiSwiglu E{(pg8::bf16_t*)(ws + WS_H)};
            pg8::gemm_phase<pg8::EpiSwiglu, pg8::MoeOrder, true, true>(lds + RING_OFF, g, S, E);
        } SEAM(11);
        if (IN(12)) { unsigned char* ws = kargs()->ws;
            const int ntiles = __builtin_amdgcn_readfirstlane(ld_i32((const int*)(ws + WS_TSEG)));
            pg8::Gemm g{(const pg8::bf16_t*)(ws + WS_H), (const pg8::bf16_t*)(ws + WS_WD), ntiles * 256, NSEG * 2048, 512};
            pg8::MoeOrder S{(const int*)(ws + WS_TSEG) + 16, ntiles, 8, (int)gridDim.x, pg8::obid()};
            pg8::EpiDown E{(pg8::bf16_t*)(ws + WS_YS), (const float*)(ws + WS_ROWW)};
            pg8::gemm_phase<pg8::EpiDown, pg8::MoeOrder, true, true>(lds + RING_OFF, g, S, E);
        } SEAM(12);
        if (IN(13)) { Frame F = mkframe(lds); ph13_combine(kargs(), F, l); } SEAM(13);
    }
#undef IN
#undef SEAM
}

#ifndef MK_PER_PHASE
#define MK_PER_PHASE 0
#endif
extern "C" void kernel_launch(void* const* d_in, const int* in_sizes, int n_in, void* d_out, int out_size, void* d_ws, size_t ws_size, hipStream_t stream) {
    static int grid = 0;
    if (grid == 0) {
        if (n_in != 28 || out_size != NTOK * DM || ws_size < WS_END) { fprintf(stderr, "kernel_launch: unexpected problem shape (n_in %d out %d ws %zu)\n", n_in, out_size, ws_size); grid = -1; return; }
        int dev = 0, cus = 0, per_cu = 0;
        if (hipGetDevice(&dev) != hipSuccess || hipDeviceGetAttribute(&cus, hipDeviceAttributeMultiprocessorCount, dev) != hipSuccess) { grid = -1; return; }
        if (hipFuncSetAttribute((const void*)fwd_kernel, hipFuncAttributeMaxDynamicSharedMemorySize, LDS_BYTES) != hipSuccess) { fprintf(stderr, "kernel_launch: hipFuncSetAttribute failed\n"); grid = -1; return; }
        if (hipOccupancyMaxActiveBlocksPerMultiprocessor(&per_cu, (const void*)fwd_kernel, NWAVES * 64, LDS_BYTES) != hipSuccess || per_cu < 1) fprintf(stderr, "kernel_launch: occupancy query reports %d\n", per_cu);
        (void)hipGetLastError();
        grid = cus;
    }
    if (grid < 0) return;
    (void)hipMemsetAsync((char*)d_ws + WS_CTL, 0, CTL_ZERO_BYTES, stream);
    Args a{};
    for (int i = 0; i < 28; ++i) a.in[i] = (const float*)d_in[i];
    a.out = (float*)d_out; a.ws = (unsigned char*)d_ws; a.li = 0; a.pad = 0;
#if MK_PER_PHASE
    for (int p = 0; p < NLAYER * NPHASE; ++p) { a.ph_lo = p; a.ph_hi = p + 1; hipLaunchKernelGGL(fwd_kernel, dim3(grid), dim3(NWAVES * 64), LDS_BYTES, stream, a); }
#else
    a.ph_lo = 0; a.ph_hi = NLAYER * NPHASE;
    hipLaunchKernelGGL(fwd_kernel, dim3(grid), dim3(NWAVES * 64), LDS_BYTES, stream, a);
#endif
}
```

```cpp
#include <hip/hip_runtime.h>
#include <cstdio>
#include <cstdint>
namespace pg8 {
#define PG8_LAS __attribute__((address_space(3)))
typedef unsigned short bf16_t;
typedef short bf16x8 __attribute__((ext_vector_type(8)));
typedef float f32x4 __attribute__((ext_vector_type(4)));
typedef unsigned u32x4 __attribute__((ext_vector_type(4)));
constexpr int BM = 256, BK = 64, HALF = 128, HTB = HALF * BK * 2  , STAGE_BYTES = 8 * HTB, NXCD = 8, WGM = 8;

__host__ __device__ __forceinline__ int lds_byte(int r, int c) { const int st = (r >> 4) * 2 + (c >> 5), rr = r & 15, cc = c & 31, ob = rr * 64 + cc * 2; return st * 1024 + (ob ^ (((ob >> 9) & 1) << 5)); }
__host__ __device__ __forceinline__ void stage_rc(int b, int& R, int& C) { const int st = b / 1024, sb = b % 1024, swz = sb ^ (((sb >> 9) & 1) << 5); R = (st >> 1) * 16 + swz / 64; C = (st & 1) * 32 + (swz % 64) / 2; }
__host__ __device__ __forceinline__ int perm32(int rho) { const int n = rho >> 4, i = rho & 15; return 8 * (i >> 2) + 4 * n + (i & 3); }

struct Unit { int pm, pn; };
struct Gemm { const bf16_t* A; const bf16_t* Bt; int M, N, K; };

struct StaticOrder {
    int nM, nN, nwg, G, c;
    __host__ __device__ void init(int M, int N, int G_, int c_) { nM = M / BM; nN = N / BM; nwg = nM * nN; G = G_; c = c_; }
    __host__ __device__ bool next(int i, Unit& u) const {
        const long L = (long)i * G + c; if (L >= nwg) return false;
        int wgid = (int)L; { const int q = nwg / NXCD, r = nwg % NXCD, xcd = wgid % NXCD, off = wgid / NXCD; wgid = (xcd < r ? xcd * (q + 1) : r * (q + 1) + (xcd - r) * q) + off; }
        const int nig = WGM * nN, gid = wgid / nig, fm = gid * WGM, gsz = (nM - fm) < WGM ? (nM - fm) : WGM;
        u.pm = fm + ((wgid % nig) % gsz); u.pn = (wgid % nig) / gsz; return true;
    }
    __device__ __forceinline__ void a_ready(const Unit&) const {}
    __device__ __forceinline__ void done(const Unit&) const {}
};

__device__ __forceinline__ int otid() { int t = threadIdx.x; asm volatile("" : "+v"(t)); return t; }
__device__ __forceinline__ int obid() { int t = blockIdx.x; asm volatile("" : "+s"(t)); return t; }
__device__ __forceinline__ unsigned cvt_pk_bf16(float lo, float hi) { unsigned r; asm volatile("v_cvt_pk_bf16_f32 %0, %1, %2" : "=v"(r) : "v"(lo), "v"(hi)); return r; }
__device__ __forceinline__ float bflo(unsigned w) { return __uint_as_float(w << 16); }
__device__ __forceinline__ float bfhi(unsigned w) { return __uint_as_float(w & 0xffff0000u); }
__device__ __forceinline__ float sigmoidf_(float x) { return 1.0f / (1.0f + __expf(-x)); }

struct EpiInProj {
    static constexpr bool PERM = true, AFTER_DRAIN = false;
    bf16_t *conv, *qkv, *rkv, *lora, *gate;
    __device__ __forceinline__ void operator()(const f32x4 (&acc)[2][2][4][2], const Unit& u, int wr, int wc, int fr, int fq) const {
        const int pn = u.pn; bf16_t* base; int ldc, colt;
        if (pn < 12) { base = conv; ldc = 3072; colt = pn * 256; }
        else if (pn < 24) { base = qkv; ldc = 3072; colt = (pn - 12) * 256; }
        else if (pn < 36) { base = rkv; ldc = 3072; colt = (pn - 24) * 256; }
        else if (pn < 38) { base = lora; ldc = 512; colt = (pn - 36) * 256; }
        else { base = gate; ldc = 6144; colt = (pn - 38) * 256; }
        const int row0 = u.pm * BM + wr * 64 + fr, col0 = colt + wc * 32 + 8 * fq;
#pragma unroll
        for (int ai = 0; ai < 2; ++ai)
#pragma unroll
            for (int m = 0; m < 4; ++m) { bf16_t* rowp = base + (size_t)(row0 + ai * HALF + m * 16) * ldc + col0;
#pragma unroll
                for (int bj = 0; bj < 2; ++bj) { const f32x4 v0 = acc[ai][bj][m][0], v1 = acc[ai][bj][m][1];
                    u32x4 w; w.x = cvt_pk_bf16(v0[0], v0[1]); w.y = cvt_pk_bf16(v0[2], v0[3]); w.z = cvt_pk_bf16(v1[0], v1[1]); w.w = cvt_pk_bf16(v1[2], v1[3]);
                    *(u32x4*)(rowp + bj * HALF) = w; } }
    }
};
struct EpiLora {
    static constexpr bool PERM = false, AFTER_DRAIN = false;
    float* Wd; long offA, offG; const float *w0, *a0;
    __device__ __forceinline__ void operator()(const f32x4 (&acc)[2][2][4][2], const Unit& u, int wr, int wc, int fr, int fq) const {
        const int sec = u.pn >> 2, colt = (u.pn & 3) * 256;
        float* out = Wd + (sec == 0 ? 0l : (sec == 1 ? offA : offG));
        const float* bp = sec == 0 ? w0 : a0;
        const int row0 = u.pm * BM + wr * 64 + fr, col0 = colt + wc * 32 + 4 * fq;
        f32x4 bv[2][2];
#pragma unroll
        for (int bj = 0; bj < 2; ++bj)
#pragma unroll
            for (int n = 0; n < 2; ++n) { const f32x4 t = *(const f32x4*)(bp + col0 + bj * HALF + n * 16); bv[bj][n] = sec == 2 ? (f32x4){0.f, 0.f, 0.f, 0.f} : t; }
#pragma unroll
        for (int ai = 0; ai < 2; ++ai)
#pragma unroll
            for (int m = 0; m < 4; ++m) { float* rowp = out + (size_t)(row0 + ai * HALF + m * 16) * 1024 + col0;
#pragma unroll
                for (int bj = 0; bj < 2; ++bj)
#pragma unroll
                    for (int n = 0; n < 2; ++n) { f32x4 v = acc[ai][bj][m][n] + bv[bj][n];
                        if (sec == 0) {
#pragma unroll
                            for (int j = 0; j < 4; ++j) { const float x = v[j]; const float sp = fmaxf(-x, 0.f) + __logf(1.0f + __expf(-fabsf(x)));
                                v[j] = __expf(-__expf(-sp - 0.5f)); }
                        } else if (sec == 1) {
#pragma unroll
                            for (int j = 0; j < 4; ++j) v[j] = 1.0f / (1.0f + __expf(-v[j]));
                        }
                        *(f32x4*)(rowp + bj * HALF + n * 16) = v; } }
    }
};
struct EpiGate {
    static constexpr bool PERM = true, AFTER_DRAIN = false;
    const bf16_t* gate; float* tmp; bf16_t* out;
    __device__ __forceinline__ void operator()(const f32x4 (&acc)[2][2][4][2], const Unit& u, int wr, int wc, int fr, int fq) const {
        const int mode = u.pn >> 3;
        const int row0 = (u.pm & 31) * BM + wr * 64 + fr, col0 = (u.pn & 7) * BM + wc * 32 + 8 * fq;
        const bf16_t* gp = gate + mode * 2048;
#pragma unroll
        for (int ai = 0; ai < 2; ++ai)
#pragma unroll
            for (int m = 0; m < 4; ++m) { const size_t row = (size_t)(row0 + ai * HALF + m * 16);
#pragma unroll
                for (int bj = 0; bj < 2; ++bj) { const int col = col0 + bj * HALF;
                    const u32x4 gw = *(const u32x4*)(gp + row * 6144 + col);
                    f32x4 v0 = acc[ai][bj][m][0], v1 = acc[ai][bj][m][1];
                    v0[0] *= sigmoidf_(bflo(gw.x)); v0[1] *= sigmoidf_(bfhi(gw.x)); v0[2] *= sigmoidf_(bflo(gw.y)); v0[3] *= sigmoidf_(bfhi(gw.y));
                    v1[0] *= sigmoidf_(bflo(gw.z)); v1[1] *= sigmoidf_(bfhi(gw.z)); v1[2] *= sigmoidf_(bflo(gw.w)); v1[3] *= sigmoidf_(bfhi(gw.w));
                    float* tp = tmp + row * 2048 + col;
                    if (mode != 0) { v0 += *(const f32x4*)tp; v1 += *(const f32x4*)(tp + 4); }
                    if (mode != 2) { *(f32x4*)tp = v0; *(f32x4*)(tp + 4) = v1; }
                    else { u32x4 w; w.x = cvt_pk_bf16(v0[0], v0[1]); w.y = cvt_pk_bf16(v0[2], v0[3]); w.z = cvt_pk_bf16(v1[0], v1[1]); w.w = cvt_pk_bf16(v1[2], v1[3]);
                        *(u32x4*)(out + row * 2048 + col) = w; } } }
    }
};
struct BranchOrder {
    StaticOrder so;
    __device__ __forceinline__ bool next(int i, Unit& u) const { Unit t; if (!so.next(i / 3, t)) return false; const int n = i % 3; u.pm = n * 32 + t.pm; u.pn = n * 8 + t.pn; return true; }
    __device__ __forceinline__ void a_ready(const Unit&) const {}
    __device__ __forceinline__ void done(const Unit&) const {}
};
struct EpiWo {
    static constexpr bool PERM = false, AFTER_DRAIN = false;
    const float* xin; float* out; float alpha;
    __device__ __forceinline__ void operator()(const f32x4 (&acc)[2][2][4][2], const Unit& u, int wr, int wc, int fr, int fq) const {
        const int row0 = u.pm * BM + wr * 64 + fr, col0 = u.pn * BM + wc * 32 + 4 * fq;
#pragma unroll
        for (int ai = 0; ai < 2; ++ai)
#pragma unroll
            for (int m = 0; m < 4; ++m) { const size_t off = (size_t)(row0 + ai * HALF + m * 16) * 2048 + col0;
#pragma unroll
                for (int bj = 0; bj < 2; ++bj)
#pragma unroll
                    for (int n = 0; n < 2; ++n) { const f32x4 xv = *(const f32x4*)(xin + off + bj * HALF + n * 16);
                        *(f32x4*)(out + off + bj * HALF + n * 16) = xv * alpha + acc[ai][bj][m][n]; } }
    }
};
struct EpiSwiglu {
    static constexpr bool PERM = true, AFTER_DRAIN = false;
    bf16_t* H;
    __device__ __forceinline__ void operator()(const f32x4 (&acc)[2][2][4][2], const Unit& u, int wr, int wc, int fr, int fq) const {
        const int row0 = u.pm * BM + wr * 64 + fr, col0 = (u.pn & 3) * 128 + wc * 32 + 8 * fq;
#pragma unroll
        for (int ai = 0; ai < 2; ++ai)
#pragma unroll
            for (int m = 0; m < 4; ++m) { bf16_t* rowp = H + (size_t)(row0 + ai * HALF + m * 16) * 512 + col0;
                float h[8];
#pragma unroll
                for (int n = 0; n < 2; ++n)
#pragma unroll
                    for (int j = 0; j < 4; ++j) { const float g = acc[ai][0][m][n][j], up = acc[ai][1][m][n][j]; h[n * 4 + j] = g * sigmoidf_(g) * up; }
                u32x4 w; w.x = cvt_pk_bf16(h[0], h[1]); w.y = cvt_pk_bf16(h[2], h[3]); w.z = cvt_pk_bf16(h[4], h[5]); w.w = cvt_pk_bf16(h[6], h[7]);
                *(u32x4*)rowp = w; }
    }
};
struct EpiDown {
    static constexpr bool PERM = true, AFTER_DRAIN = false;
    bf16_t* Y; const float* roww;
    __device__ __forceinline__ void operator()(const f32x4 (&acc)[2][2][4][2], const Unit& u, int wr, int wc, int fr, int fq) const {
        const int row0 = u.pm * BM + wr * 64 + fr, col0 = (u.pn & 7) * 256 + wc * 32 + 8 * fq;
#pragma unroll
        for (int ai = 0; ai < 2; ++ai)
#pragma unroll
            for (int m = 0; m < 4; ++m) { const int row = row0 + ai * HALF + m * 16; const float s = roww[row]; bf16_t* rowp = Y + (size_t)row * 2048 + col0;
#pragma unroll
                for (int bj = 0; bj < 2; ++bj) { const f32x4 v0 = acc[ai][bj][m][0] * s, v1 = acc[ai][bj][m][1] * s;
                    u32x4 w; w.x = cvt_pk_bf16(v0[0], v0[1]); w.y = cvt_pk_bf16(v0[2], v0[3]); w.z = cvt_pk_bf16(v1[0], v1[1]); w.w = cvt_pk_bf16(v1[2], v1[3]);
                    *(u32x4*)(rowp + bj * HALF) = w; } }
    }
};
struct MoeOrder {
    const int* seg; int ntiles, npn, G, c;
    __device__ __forceinline__ bool next(int i, Unit& u) const {
        const long L = (long)i * G + c; if (L >= (long)ntiles * npn) return false;
        const int pm = (int)(L / npn), pl = (int)(L % npn); u.pm = pm; u.pn = __builtin_amdgcn_readfirstlane(__hip_atomic_load(seg + pm, __ATOMIC_RELAXED, __HIP_MEMORY_SCOPE_AGENT)) * npn + pl; return true;
    }
    __device__ __forceinline__ void a_ready(const Unit&) const {}
    __device__ __forceinline__ void done(const Unit&) const {}
};
template <class Epi, class Sched, bool ALIGN_EPI = false, bool SP2 = false>
__device__ __forceinline__ void gemm_phase(PG8_LAS unsigned char* lds, const Gemm g, const Sched& S, const Epi& E) {
    const int tid = otid(), wid = __builtin_amdgcn_readfirstlane(tid >> 6), lane = tid & 63, wr = wid >> 2, wc = wid & 3, fr = lane & 15, fq = lane >> 4;
    const int K = g.K, nt = K / BK;
    unsigned voffA[2], voffB[2];
#pragma unroll
    for (int i = 0; i < 2; ++i) { int R, C; stage_rc(tid * 16 + i * 8192, R, C); const int Rb = Epi::PERM ? ((R & ~31) + perm32(R & 31)) : R;
        voffA[i] = (unsigned)(R * K + C) * 2u; voffB[i] = (unsigned)(Rb * K + C) * 2u; }
    const size_t kstep = (size_t)(BK * 2);
    const size_t hstep = (size_t)HALF * K * 2;
    const size_t tstep = 2 * hstep;
    const unsigned ldsw = (unsigned)wid * 1024u;
    const int aoff = lds_byte(wr * 64 + fr, fq * 8), boff = lds_byte(wc * 32 + fr, fq * 8);
#define PG8_SA(b, h) (((b) * 2 + (h)) * HTB)
#define PG8_SB(b, h) ((4 + (b) * 2 + (h)) * HTB)
#define PG8_STAGE(bufoff, gbase, voff) do { _Pragma("unroll") for (int _i = 0; _i < 2; ++_i) \
        __builtin_amdgcn_global_load_lds((const unsigned*)((const char*)(gbase) + (voff)[_i]), (PG8_LAS unsigned*)(lds + (bufoff) + ldsw + _i * 8192), 16, 0, 0); } while (0)
#define PG8_LDA(dst, b, h) do { _Pragma("unroll") for (int m = 0; m < 4; ++m) _Pragma("unroll") for (int k = 0; k < 2; ++k) dst[m][k] = *(const PG8_LAS bf16x8*)(lds + PG8_SA(b, h) + aoff + m * 2048 + k * 1024); } while (0)
#define PG8_LDB(dst, b, h) do { _Pragma("unroll") for (int n = 0; n < 2; ++n) _Pragma("unroll") for (int k = 0; k < 2; ++k) dst[n][k] = *(const PG8_LAS bf16x8*)(lds + PG8_SB(b, h) + boff + n * 2048 + k * 1024); } while (0)
#define PG8_MMA(ai, bj, At, Bt) do { __builtin_amdgcn_s_setprio(1); _Pragma("unroll") for (int m = 0; m < 4; ++m) _Pragma("unroll") for (int n = 0; n < 2; ++n) _Pragma("unroll") for (int k = 0; k < 2; ++k) \
        acc[ai][bj][m][n] = __builtin_amdgcn_mfma_f32_16x16x32_bf16(Bt[n][k], At[m][k], acc[ai][bj][m][n], 0, 0, 0); __builtin_amdgcn_s_setprio(0); } while (0)
#define PG8_WAIT_V(n) asm volatile("s_waitcnt vmcnt(" #n ")" ::: "memory")
#define PG8_WAIT_L(n) asm volatile("s_waitcnt lgkmcnt(" #n ")" ::: "memory")
#define PG8_BAR __builtin_amdgcn_s_barrier()
#define PG8_SCHED __builtin_amdgcn_sched_barrier(0)
    Unit cur, nxt; int ui = 0;
    if (!S.next(0, cur)) return;
    f32x4 acc[2][2][4][2];
#pragma unroll
    for (int a = 0; a < 2; ++a)
#pragma unroll
        for (int b = 0; b < 2; ++b)
#pragma unroll
            for (int m = 0; m < 4; ++m)
#pragma unroll
                for (int n = 0; n < 2; ++n) acc[a][b][m][n] = (f32x4){0.f, 0.f, 0.f, 0.f};
    bf16x8 At[4][2], B0[2][2], B1[2][2];
    const char* cA = (const char*)g.A + (size_t)cur.pm * tstep; const char* cB = (const char*)g.Bt + (size_t)cur.pn * tstep;
    S.a_ready(cur);
    if constexpr (SP2) {
        PG8_STAGE(PG8_SB(0, 0), cB, voffB); PG8_STAGE(PG8_SB(0, 1), cB + hstep, voffB); PG8_STAGE(PG8_SA(0, 0), cA, voffA); PG8_STAGE(PG8_SA(0, 1), cA + hstep, voffA);
        if (wr == 1) PG8_BAR;
        PG8_WAIT_V(2); PG8_BAR;
        PG8_STAGE(PG8_SB(1, 0), cB + kstep, voffB); PG8_STAGE(PG8_SA(1, 0), cA + kstep, voffA); PG8_STAGE(PG8_SB(1, 1), cB + hstep + kstep, voffB);
        PG8_WAIT_V(6); PG8_BAR;
    } else {
        PG8_STAGE(PG8_SB(0, 0), cB, voffB); PG8_STAGE(PG8_SA(0, 0), cA, voffA); PG8_STAGE(PG8_SB(0, 1), cB + hstep, voffB); PG8_STAGE(PG8_SA(0, 1), cA + hstep, voffA);
        if (wr == 1) PG8_BAR;
        PG8_WAIT_V(4); PG8_BAR;
        PG8_STAGE(PG8_SB(1, 0), cB + kstep, voffB); PG8_STAGE(PG8_SA(1, 0), cA + kstep, voffA); PG8_STAGE(PG8_SB(1, 1), cB + hstep + kstep, voffB);
        PG8_WAIT_V(6); PG8_BAR;
    }
    for (;;) {
        const bool has_next = S.next(ui + 1, nxt);
        const char* nA = has_next ? (const char*)g.A + (size_t)nxt.pm * tstep : cA; const char* nB = has_next ? (const char*)g.Bt + (size_t)nxt.pn * tstep : cB;
        for (int t = 0; t < nt; t += 2) {
            const bool last = (t == nt - 2);
            const char* a1 = cA + (size_t)(t + 1) * kstep;
            const char* a2 = last ? nA : cA + (size_t)(t + 2) * kstep; const char* b2 = last ? nB : cB + (size_t)(t + 2) * kstep;
            const char* a3 = a2 + kstep; const char* b3 = b2 + kstep;
            if (last && has_next) S.a_ready(nxt);
            if constexpr (SP2) {
            PG8_LDB(B0, 0, 0); PG8_LDB(B1, 0, 1); PG8_SCHED; PG8_LDA(At, 0, 0); PG8_STAGE(PG8_SA(1, 1), a1 + hstep, voffA);
            PG8_WAIT_V(8); PG8_WAIT_L(0); PG8_BAR; PG8_MMA(0, 0, At, B0); PG8_MMA(0, 1, At, B1); PG8_BAR; PG8_SCHED;
            PG8_LDA(At, 0, 1); PG8_STAGE(PG8_SB(0, 0), b2, voffB); PG8_STAGE(PG8_SB(0, 1), b2 + hstep, voffB); PG8_STAGE(PG8_SA(0, 0), a2, voffA);
            PG8_WAIT_V(8); PG8_WAIT_L(0); PG8_BAR; PG8_MMA(1, 0, At, B0); PG8_MMA(1, 1, At, B1); PG8_BAR; PG8_SCHED;
            PG8_LDB(B0, 1, 0); PG8_LDB(B1, 1, 1); PG8_SCHED; PG8_LDA(At, 1, 0); PG8_STAGE(PG8_SA(0, 1), a2 + hstep, voffA);
            PG8_WAIT_V(8); PG8_WAIT_L(0); PG8_BAR; PG8_MMA(0, 0, At, B0); PG8_MMA(0, 1, At, B1); PG8_BAR; PG8_SCHED;
            PG8_LDA(At, 1, 1); PG8_STAGE(PG8_SB(1, 0), b3, voffB); PG8_STAGE(PG8_SB(1, 1), b3 + hstep, voffB); PG8_STAGE(PG8_SA(1, 0), a3, voffA);
            PG8_WAIT_V(8); PG8_WAIT_L(0); PG8_BAR; PG8_MMA(1, 0, At, B0); PG8_MMA(1, 1, At, B1); PG8_BAR; PG8_SCHED;
            } else {
            PG8_LDB(B0, 0, 0); PG8_SCHED; PG8_LDA(At, 0, 0); PG8_STAGE(PG8_SA(1, 1), a1 + hstep, voffA);
            PG8_WAIT_L(8); PG8_BAR; PG8_WAIT_L(0); PG8_MMA(0, 0, At, B0); PG8_BAR; PG8_SCHED;
            PG8_LDB(B1, 0, 1); PG8_STAGE(PG8_SB(0, 0), b2, voffB);
            PG8_BAR; PG8_WAIT_L(0); PG8_MMA(0, 1, At, B1); PG8_BAR;
            PG8_LDA(At, 0, 1); PG8_STAGE(PG8_SA(0, 0), a2, voffA);
            PG8_BAR; PG8_WAIT_L(0); PG8_MMA(1, 0, At, B0); PG8_BAR; PG8_SCHED;
            PG8_STAGE(PG8_SB(0, 1), b2 + hstep, voffB);
            PG8_WAIT_V(6); PG8_BAR; PG8_MMA(1, 1, At, B1); PG8_BAR;
            PG8_LDB(B0, 1, 0); PG8_SCHED; PG8_LDA(At, 1, 0); PG8_STAGE(PG8_SA(0, 1), a2 + hstep, voffA);
            PG8_WAIT_L(8); PG8_BAR; PG8_WAIT_L(0); PG8_MMA(0, 0, At, B0); PG8_BAR; PG8_SCHED;
            PG8_LDB(B1, 1, 1); PG8_STAGE(PG8_SB(1, 0), b3, voffB);
            PG8_BAR; PG8_WAIT_L(0); PG8_MMA(0, 1, At, B1); PG8_BAR;
            PG8_LDA(At, 1, 1); PG8_STAGE(PG8_SA(1, 0), a3, voffA);
            PG8_BAR; PG8_WAIT_L(0); PG8_MMA(1, 0, At, B0); PG8_BAR; PG8_SCHED;
            PG8_STAGE(PG8_SB(1, 1), b3 + hstep, voffB);
            PG8_WAIT_V(6); PG8_BAR; PG8_MMA(1, 1, At, B1); PG8_BAR;
            }
        }
        if constexpr (ALIGN_EPI) { if (wr == 0) PG8_BAR; }
        if constexpr (!Epi::AFTER_DRAIN) { E(acc, cur, wr, wc, fr, fq); S.done(cur); }
        if (!has_next) break;
#pragma unroll
        for (int a = 0; a < 2; ++a)
#pragma unroll
            for (int b = 0; b < 2; ++b)
#pragma unroll
                for (int m = 0; m < 4; ++m)
#pragma unroll
                    for (int n = 0; n < 2; ++n) acc[a][b][m][n] = (f32x4){0.f, 0.f, 0.f, 0.f};
        cur = nxt; cA = nA; cB = nB; ++ui;
        if constexpr (ALIGN_EPI) { if (wr == 1) PG8_BAR; }
    }
    PG8_WAIT_V(0);
    if constexpr (!ALIGN_EPI) { if (wr == 0) PG8_BAR; }
    PG8_BAR;
    if constexpr (Epi::AFTER_DRAIN) { E.fused(acc, cur, wr, wc, fr, fq, lds, wid, lane); S.done(cur); }
#undef PG8_SA
#undef PG8_SB
#undef PG8_STAGE
#undef PG8_LDA
#undef PG8_LDB
#undef PG8_MMA
#undef PG8_WAIT_V
#undef PG8_WAIT_L
#undef PG8_BAR
#undef PG8_SCHED
}
}


constexpr int NTOK = 8192, SEQ = 4096, DM = 2048, NLAYER = 2;
constexpr int IN_COLS = 15808, INP = 15872;
constexpr int NSEG = 65;
constexpr int XS_ROWS = 8192 + 65536 + 64 * 256;
constexpr int NPHASE = 14;
constexpr float LN_EPS = 1e-5f, GN_EPS = 64e-5f, ALPHA = 1.4142135623730951f  , ROUTED_SCALE = 2.5f;

constexpr size_t MiB = 1u << 20, KiB = 1u << 10;
constexpr size_t WS_CTL = 0, CTL_ZERO_BYTES = 1 * MiB;
constexpr size_t WS_HIST = 1 * MiB;
constexpr size_t WS_SELE = WS_HIST + 64 * KiB;
constexpr size_t WS_SELW = WS_SELE + 256 * KiB;
constexpr size_t WS_SLOT = WS_SELW + 256 * KiB;
constexpr size_t WS_ROWW = WS_SLOT + 256 * KiB;
constexpr size_t WS_TSEG = WS_ROWW + 352 * KiB;
constexpr size_t WS_BON = WS_TSEG + 4 * KiB;
constexpr size_t WS_WIN = 4 * MiB;
constexpr size_t WS_WLORA = 66 * MiB;
constexpr size_t WS_WBR = 69 * MiB;
constexpr size_t WS_WO = 81 * MiB;
constexpr size_t WS_WGU = 89 * MiB;
constexpr size_t WS_WD = 349 * MiB;
constexpr size_t WS_XB = 479 * MiB;
constexpr size_t WS_MERGED = 511 * MiB;
constexpr size_t WS_PRELN = 543 * MiB;
constexpr size_t WS_X1 = 607 * MiB;
constexpr size_t WS_X2 = 671 * MiB;
constexpr size_t WS_M = 735 * MiB;
constexpr size_t WS_PCONV = WS_M, WS_PQKV = WS_M + 48 * MiB, WS_PRKV = WS_M + 96 * MiB, WS_PLORA = WS_M + 144 * MiB, WS_PGATE = WS_M + 152 * MiB;
constexpr size_t WS_YBR = WS_M + 248 * MiB;
constexpr size_t WS_LORAA = WS_M + 296 * MiB;
constexpr size_t WS_RWR = WS_M + 304 * MiB, WS_RWW = WS_RWR + 32 * MiB, WS_RWK = WS_RWW + 32 * MiB, WS_RWV = WS_RWK + 32 * MiB, WS_RWKK = WS_RWV + 32 * MiB,
                 WS_RWB = WS_RWKK + 32 * MiB, WS_RWA = WS_RWB + 32 * MiB, WS_RWG = WS_RWA + 32 * MiB, WS_RWY = WS_RWG + 32 * MiB;
constexpr size_t WS_XS = WS_M;
constexpr size_t WS_H = WS_XS + 352 * MiB;
constexpr size_t WS_YS = WS_H + 88 * MiB;
constexpr size_t WS_END = WS_YS + 352 * MiB;
static_assert(WS_RWY + 32 * MiB <= WS_END && (size_t)XS_ROWS * 2048 * 2 == 352 * MiB && (size_t)XS_ROWS * 512 * 2 == 88 * MiB, "ws map");
static_assert(WS_BON + 512 * KiB <= WS_WIN && WS_WIN + (size_t)INP * 2048 * 2 <= WS_WLORA && WS_WGU + (size_t)65 * 1024 * 2048 * 2 <= WS_WD && WS_WD + (size_t)65 * 2048 * 512 * 2 <= WS_XB, "ws map 2");
constexpr int CW_TMO = 0, CW_BAR = 4096;

constexpr int RING_OFF = 0, RING_BYTES = 131072;
constexpr int LDSCTL_OFF = RING_BYTES, MISC_OFF = LDSCTL_OFF + 320;
constexpr int LDS_BYTES = 147456;
constexpr int NWAVES = 8;

#define GAS __attribute__((address_space(1)))
#define LAS __attribute__((address_space(3)))
typedef unsigned short bf16;
typedef unsigned v4u __attribute__((ext_vector_type(4)));
typedef unsigned v2u __attribute__((ext_vector_type(2)));
typedef float f32x4 __attribute__((ext_vector_type(4)));
typedef float f32x16 __attribute__((ext_vector_type(16)));
typedef short bf16x8 __attribute__((ext_vector_type(8)));
typedef short s16x4 __attribute__((ext_vector_type(4)));
typedef GAS unsigned gu32;
#define RLX_AGENT __ATOMIC_RELAXED, __HIP_MEMORY_SCOPE_AGENT
#define LDS_WAIT() asm volatile("s_waitcnt lgkmcnt(0)" ::: "memory")
#define VM_WAIT() asm volatile("s_waitcnt vmcnt(0)" ::: "memory")
__device__ __forceinline__ unsigned f2bf(float f) { unsigned u = __builtin_bit_cast(unsigned, f); return (u + 0x7fffu + ((u >> 16) & 1u)) >> 16; }
__device__ __forceinline__ unsigned pk2(float lo, float hi) { return f2bf(lo) | (f2bf(hi) << 16); }
__device__ __forceinline__ float bf2f(bf16 b) { return __uint_as_float((unsigned)b << 16); }
__device__ __forceinline__ float blo(unsigned w) { return __uint_as_float(w << 16); }
__device__ __forceinline__ float bhi(unsigned w) { return __uint_as_float(w & 0xffff0000u); }
__device__ __forceinline__ int ld_i32(const int* p) { return __hip_atomic_load(p, RLX_AGENT); }
__device__ __forceinline__ float ld_f32(const float* p) { return __hip_atomic_load(p, RLX_AGENT); }

#define XB_TMO      128
#define XB_XCNT(j)  (256  + 64 * (j))
#define XB_XSUB(j)  (1280 + 64 * (j))
#define XB_XGEN(j)  (2304 + 64 * (j))
#define XB_TOP      3328
#define XB_TOPGEN   3392
#define XCD_BAR_WORDS 3456
#define XB_SPIN_CAP (1u << 18)

__device__ __forceinline__ unsigned xb_ld(unsigned* p)              { return __hip_atomic_load(p, __ATOMIC_RELAXED, __HIP_MEMORY_SCOPE_AGENT); }
__device__ __forceinline__ unsigned xb_add(unsigned* p, unsigned v) { return __hip_atomic_fetch_add(p, v, __ATOMIC_RELAXED, __HIP_MEMORY_SCOPE_AGENT); }
__device__ __forceinline__ unsigned xb_xcc_id() { return (unsigned)__builtin_amdgcn_s_getreg((3 << 11) | 20) & 0xFu; }
#define XB_SPIN(cond, bar) do { unsigned _sp = 0; while (cond) { __builtin_amdgcn_s_sleep(1); \
    if ((++_sp & 255u) == 0u) { if (xb_ld(&(bar)[XB_TMO])) break; if (_sp > XB_SPIN_CAP) { atomicAdd(&(bar)[XB_TMO], 1u); break; } } } } while (0)

struct XcdBarrier {
    unsigned* bar; unsigned x;
    volatile LAS unsigned* st;
};

__device__ __forceinline__ XcdBarrier xcd_barrier_post(unsigned* bar, volatile LAS unsigned* st) {
    XcdBarrier b; b.bar = bar; b.x = xb_xcc_id(); b.st = st;
    if (threadIdx.x == 0) (void)xb_add(&bar[XB_XCNT(b.x)], 1u);
    return b;
}
__device__ __forceinline__ void xcd_barrier_complete(unsigned* bar, unsigned x, unsigned& nloc, unsigned& nx) {
    const unsigned G = gridDim.x * gridDim.y * gridDim.z;
    unsigned sum, cnt, mine, sp = 0u;
    for (;;) {
        sum = 0u; cnt = 0u; mine = 0u;
#pragma unroll
        for (unsigned j = 0; j < 16; ++j) { const unsigned c = xb_ld(&bar[XB_XCNT(j)]); sum += c; cnt += (c > 0u) ? 1u : 0u; mine = (j == x) ? c : mine; }
        if (sum == G) break;
        __builtin_amdgcn_s_sleep(1);
        if ((++sp & 255u) == 0u) { if (xb_ld(&bar[XB_TMO])) break; if (sp > XB_SPIN_CAP) { atomicAdd(&bar[XB_TMO], 1u); break; } }
    }
    nloc = mine > 0u ? mine : 1u; nx = cnt > 0u ? cnt : 1u;
}

__device__ __forceinline__ void xcd_barrier(const XcdBarrier& b) {
    asm volatile("s_waitcnt vmcnt(0)" ::: "memory");
    __syncthreads();
    if (threadIdx.x == 0) {
        unsigned* bar = b.bar;
        __builtin_amdgcn_s_waitcnt(0);
        unsigned nloc = b.st[0], nx = b.st[1];
        if (nloc == 0u) { xcd_barrier_complete(bar, b.x, nloc, nx); b.st[0] = nloc; b.st[1] = nx; }
        const unsigned old = xb_add(&bar[XB_XSUB(b.x)], 1u);
        const unsigned gen = old / nloc;
        if (old + 1u == (gen + 1u) * nloc) {
            __builtin_amdgcn_fence(__ATOMIC_RELEASE, "agent");
            asm volatile("s_waitcnt vmcnt(0)" ::: "memory");
            const unsigned og = xb_add(&bar[XB_TOP], 1u);
            const unsigned tg = og / nx;
            if (og + 1u == (tg + 1u) * nx) xb_add(&bar[XB_TOPGEN], 1u);
            else XB_SPIN(xb_ld(&bar[XB_TOPGEN]) == tg, bar);
            __builtin_amdgcn_fence(__ATOMIC_ACQUIRE, "agent");
            xb_add(&bar[XB_XGEN(b.x)], 1u);
            asm volatile("s_waitcnt vmcnt(0)" ::: "memory");
        } else {
            XB_SPIN(xb_ld(&bar[XB_XGEN(b.x)]) == gen, bar);
            __builtin_amdgcn_fence(__ATOMIC_ACQUIRE, "agent");
            asm volatile("s_waitcnt vmcnt(0)" ::: "memory");
        }
    }
    __syncthreads();
}

struct Args { const float* in[28]; float* out; unsigned char* ws; int ph_lo, ph_hi, li, pad; };
typedef const __attribute__((address_space(4))) Args* KArgs;
struct Frame {
    LAS unsigned char* lds;
    volatile LAS unsigned* MISC;
    gu32* ctl;
    unsigned char* ws;
    int tid, lane, wave, vcu, G;
};
__device__ __forceinline__ float wave_sum(float v) {
#pragma unroll
    for (int o = 1; o < 64; o <<= 1) v += __shfl_xor(v, o);
    return v;
}
__device__ __forceinline__ float dpp16(float v) {
    v += __builtin_bit_cast(float, __builtin_amdgcn_update_dpp(0, __builtin_bit_cast(int, v), 0xB1, 0xF, 0xF, true));
    v += __builtin_bit_cast(float, __builtin_amdgcn_update_dpp(0, __builtin_bit_cast(int, v), 0x4E, 0xF, 0xF, true));
    v += __builtin_bit_cast(float, __builtin_amdgcn_update_dpp(0, __builtin_bit_cast(int, v), 0x141, 0xF, 0xF, true));
    v += __builtin_bit_cast(float, __builtin_amdgcn_update_dpp(0, __builtin_bit_cast(int, v), 0x140, 0xF, 0xF, true));
    return v;
}
__device__ __forceinline__ v4u pack8(const float* v) { v4u o; o.x = pk2(v[0], v[1]); o.y = pk2(v[2], v[3]); o.z = pk2(v[4], v[5]); o.w = pk2(v[6], v[7]); return o; }
__device__ __forceinline__ void unpack8(v4u w, float* v) { v[0] = blo(w.x); v[1] = bhi(w.x); v[2] = blo(w.y); v[3] = bhi(w.y); v[4] = blo(w.z); v[5] = bhi(w.z); v[6] = blo(w.w); v[7] = bhi(w.w); }

struct TrItem { const float* src; bf16* dst; int ldn, k0, n0, Kd; };
__device__ __forceinline__ void tr_issue(const TrItem& d, int lane, float (&hv)[32]) {
#pragma unroll
    for (int i = 0; i < 32; ++i) { const int kk = 2 * i + (lane >> 5); hv[i] = d.src[(size_t)(d.k0 + kk) * d.ldn + d.n0 + (lane & 31)]; }
}
__device__ __forceinline__ void tr_finish(const TrItem& d, int lane, const float (&hv)[32], LAS float* scr) {
#pragma unroll
    for (int i = 0; i < 32; ++i) { const int kk = 2 * i + (lane >> 5); scr[kk * 33 + (lane & 31)] = hv[i]; }
    LDS_WAIT(); asm volatile("" ::: "memory");
    const int c = lane & 7;
#pragma unroll
    for (int j = 0; j < 4; ++j) { const int n = (lane >> 3) + 8 * j; const LAS float* s = scr + (8 * c) * 33 + n;
        v4u o; o.x = pg8::cvt_pk_bf16(s[0 * 33], s[1 * 33]); o.y = pg8::cvt_pk_bf16(s[2 * 33], s[3 * 33]); o.z = pg8::cvt_pk_bf16(s[4 * 33], s[5 * 33]); o.w = pg8::cvt_pk_bf16(s[6 * 33], s[7 * 33]);
        *(GAS v4u*)(d.dst + (size_t)n * d.Kd + d.k0 + 8 * c) = o; }
    LDS_WAIT(); asm volatile("" ::: "memory");
}
constexpr int I_IN = 32 * 494, I_BR = 3 * 16 * 64, I_WO = 32 * 64, I_G = 65 * 512, I_D = 65 * 512;
constexpr int NIT = I_IN + I_BR + I_WO + 2 * I_G + I_D;
__device__ __forceinline__ TrItem decode_item(KArgs a, unsigned char* ws, int l, int it) {
    bf16* WIN = (bf16*)(ws + WS_WIN); bf16* WBR = (bf16*)(ws + WS_WBR); bf16* WO = (bf16*)(ws + WS_WO); bf16* WGU = (bf16*)(ws + WS_WGU); bf16* WD = (bf16*)(ws + WS_WD);
    int r = it; TrItem d;
    if (r < I_IN) { const int kb = r / 494, nb = r % 494, n0 = 32 * nb; d.src = a->in[1] + (size_t)l * 2048 * IN_COLS; d.ldn = IN_COLS; d.k0 = 64 * kb; d.n0 = n0; d.dst = WIN + (size_t)(n0 + (n0 >= 9408 ? 64 : 0)) * 2048; d.Kd = 2048; return d; }
    r -= I_IN;
    if (r < I_BR) { const int nbr = r / 1024, rr = r % 1024, kb = rr / 64, nb = rr % 64; d.src = a->in[14] + (size_t)l * 3 * 1024 * 2048 + (size_t)nbr * 1024 * 2048; d.ldn = 2048; d.k0 = 64 * kb; d.n0 = 32 * nb;
        d.dst = WBR + (size_t)nbr * 2048 * 1024 + (size_t)(32 * nb) * 1024; d.Kd = 1024; return d; }
    r -= I_BR;
    if (r < I_WO) { const int kb = r / 64, nb = r % 64; d.src = a->in[15] + (size_t)l * 2048 * 2048; d.ldn = 2048; d.k0 = 64 * kb; d.n0 = 32 * nb; d.dst = WO + (size_t)(32 * nb) * 2048; d.Kd = 2048; return d; }
    r -= I_WO;
    if (r < 2 * I_G) { const int up = r >= I_G ? 1 : 0; if (up) r -= I_G; const int seg = r / 512, rr = r % 512, kb = rr / 16, nb = rr % 16, n0 = 32 * nb;
        d.src = seg == 0 ? (up ? a->in[24] : a->in[23]) + (size_t)l * 2048 * 512 : (up ? a->in[21] : a->in[20]) + (size_t)(l * 64 + seg - 1) * 2048 * 512;
        d.ldn = 512; d.k0 = 64 * kb; d.n0 = n0; d.dst = WGU + (size_t)(seg * 1024 + (n0 >> 7) * 256 + (n0 & 127) + up * 128) * 2048; d.Kd = 2048; return d; }
    r -= 2 * I_G;
    { const int seg = r / 512, rr = r % 512, kb = rr / 64, nb = rr % 64;
        d.src = seg == 0 ? a->in[25] + (size_t)l * 512 * 2048 : a->in[22] + (size_t)(l * 64 + seg - 1) * 512 * 2048;
        d.ldn = 2048; d.k0 = 64 * kb; d.n0 = 32 * nb; d.dst = WD + (size_t)(seg * 2048 + 32 * nb) * 512; d.Kd = 512; return d; }
}
__device__ __forceinline__ void convert_item(KArgs a, unsigned char* ws, int l, int it, LAS float* scr, int lane) {
    const TrItem d = decode_item(a, ws, l, it); float hv[32]; tr_issue(d, lane, hv); tr_finish(d, lane, hv, scr);
}
#ifndef SHADOW_CONVERT
#define SHADOW_CONVERT 1
#endif
__device__ __forceinline__ void ph0_convert(KArgs a, Frame& F, int l) {
    LAS float* scr = (LAS float*)(F.lds + RING_OFF + F.wave * 16384);
    const int gw = F.vcu * NWAVES + F.wave, NGW = F.G * NWAVES;
    bf16* WIN = (bf16*)(F.ws + WS_WIN); bf16* WLORA = (bf16*)(F.ws + WS_WLORA);
    for (int it = gw; it < (SHADOW_CONVERT ? I_IN : NIT); it += NGW) convert_item(a, F.ws, l, it, scr, F.lane);
    const size_t gt = (size_t)F.vcu * 512 + F.tid, NT = (size_t)F.G * 512;
    for (size_t i = gt; i < 64 * 2048 / 8; i += NT) ((v4u*)(WIN + (size_t)9408 * 2048))[i] = (v4u){0u, 0u, 0u, 0u};
    { const float* w2 = a->in[5] + (size_t)l * 96 * 1024; const float* a2 = a->in[7] + (size_t)l * 96 * 1024; const float* g2 = a->in[8] + (size_t)l * 256 * 1024;
      for (size_t i = gt; i < (size_t)3072 * 512; i += NT) { const int k = (int)(i / 3072), n = (int)(i % 3072), sec = n >> 10, nn = n & 1023; float v = 0.f;
          if (sec == 0) { if (k < 96) v = w2[k * 1024 + nn]; } else if (sec == 1) { if (k >= 96 && k < 192) v = a2[(k - 96) * 1024 + nn]; } else { if (k >= 256) v = g2[(k - 256) * 1024 + nn]; }
          WLORA[(size_t)n * 512 + k] = (bf16)f2bf(v); } }
    if (l == 0) { const f32x4* x = (const f32x4*)a->in[0]; v4u* xb = (v4u*)(F.ws + WS_XB);
        for (size_t i = gt; i < (size_t)NTOK * DM / 8; i += NT) { const f32x4 p = x[2 * i], q = x[2 * i + 1]; v4u o; o.x = pk2(p[0], p[1]); o.y = pk2(p[2], p[3]); o.z = pk2(q[0], q[1]); o.w = pk2(q[2], q[3]); xb[i] = o; } }
}

__device__ __forceinline__ void ph2_elementwise(KArgs a, Frame& F, int l) {
    const size_t gt = (size_t)F.vcu * 512 + F.tid, NT = (size_t)F.G * 512;
    const bf16* PC = (const bf16*)(F.ws + WS_PCONV); bf16* Y0 = (bf16*)(F.ws + WS_YBR);
    const float* cw = a->in[2] + (size_t)l * 3 * 1024;
    for (size_t i = gt; i < (size_t)NTOK * 128; i += NT) { const int t = (int)(i >> 7), c = (int)(i & 127) * 8, tt = t & (SEQ - 1);
        const bf16* row = PC + (size_t)t * 3072;
        float gb[8], g0[8], h0[8], u0[8], u1[8], u2[8];
        unpack8(*(const v4u*)(row + c), gb); unpack8(*(const v4u*)(row + 1024 + c), g0); unpack8(*(const v4u*)(row + 2048 + c), h0);
#pragma unroll
        for (int j = 0; j < 8; ++j) { u0[j] = g0[j] * h0[j]; u1[j] = 0.f; u2[j] = 0.f; }
        if (tt >= 1) { unpack8(*(const v4u*)(row - 3072 + 1024 + c), g0); unpack8(*(const v4u*)(row - 3072 + 2048 + c), h0);
#pragma unroll
            for (int j = 0; j < 8; ++j) u1[j] = g0[j] * h0[j]; }
        if (tt >= 2) { unpack8(*(const v4u*)(row - 6144 + 1024 + c), g0); unpack8(*(const v4u*)(row - 6144 + 2048 + c), h0);
#pragma unroll
            for (int j = 0; j < 8; ++j) u2[j] = g0[j] * h0[j]; }
        float y[8];
#pragma unroll
        for (int j = 0; j < 8; ++j) y[j] = gb[j] * (cw[c + j] * u2[j] + cw[1024 + c + j] * u1[j] + cw[2048 + c + j] * u0[j]);
        *(v4u*)(Y0 + (size_t)t * 1024 + c) = pack8(y); }
    const bf16* PR = (const bf16*)(F.ws + WS_PRKV); const float* mix = a->in[3] + (size_t)l * 3520;
    float* RWR = (float*)(F.ws + WS_RWR); float* RWK = (float*)(F.ws + WS_RWK); float* RWV = (float*)(F.ws + WS_RWV);
    for (size_t i = gt; i < (size_t)NTOK * 384; i += NT) { const int t = (int)(i / 384), c = (int)(i % 384) * 8, tt = t & (SEQ - 1);
        float p[8], q[8];
        unpack8(*(const v4u*)(PR + (size_t)t * 3072 + c), p);
        if (tt >= 1) unpack8(*(const v4u*)(PR + (size_t)(t - 1) * 3072 + c), q); else {
#pragma unroll
            for (int j = 0; j < 8; ++j) q[j] = 0.f; }
#pragma unroll
        for (int j = 0; j < 8; ++j) p[j] = p[j] + (q[j] - p[j]) * mix[c + j];
        float* dst = (c < 1024 ? RWR : (c < 2048 ? RWK : RWV)) + (size_t)t * 1024 + (c & 1023);
        *(f32x4*)dst = (f32x4){p[0], p[1], p[2], p[3]}; *(f32x4*)(dst + 4) = (f32x4){p[4], p[5], p[6], p[7]}; }
    const bf16* PL = (const bf16*)(F.ws + WS_PLORA); bf16* LA = (bf16*)(F.ws + WS_LORAA);
    for (size_t i = gt; i < (size_t)NTOK * 64; i += NT) { const int t = (int)(i >> 6), c = (int)(i & 63) * 8, tt = t & (SEQ - 1);
        float p[8], q[8];
        if (c >= 192 && c < 256) {
#pragma unroll
            for (int j = 0; j < 8; ++j) p[j] = 0.f;
        } else {
            unpack8(*(const v4u*)(PL + (size_t)t * 512 + c), p);
            if (tt >= 1) unpack8(*(const v4u*)(PL + (size_t)(t - 1) * 512 + c), q); else {
#pragma unroll
                for (int j = 0; j < 8; ++j) q[j] = 0.f; }
            const int mi = c < 96 ? 3072 + c : (c < 192 ? 3168 + (c - 96) : 3264 + (c - 256));
#pragma unroll
            for (int j = 0; j < 8; ++j) { const float v = p[j] + (q[j] - p[j]) * mix[mi + j]; p[j] = c < 96 ? tanhf(v) : (c < 192 ? v : 1.0f / (1.0f + expf(-v))); }
        }
        *(v4u*)(LA + (size_t)t * 512 + c) = pack8(p); }
}

__device__ __forceinline__ void ph4_prep(KArgs a, Frame& F, int l) {
    const int gw = F.vcu * NWAVES + F.wave, NGW = F.G * NWAVES;
    float* RWR = (float*)(F.ws + WS_RWR); float* RWK = (float*)(F.ws + WS_RWK); float* RWKK = (float*)(F.ws + WS_RWKK); float* RWB = (float*)(F.ws + WS_RWB);
    const float* RWA = (const float*)(F.ws + WS_RWA); float* BON = (float*)(F.ws + WS_BON);
    const float* kkw = a->in[9] + (size_t)l * 1024; const float* kaw = a->in[10] + (size_t)l * 1024; const float* rkw = a->in[11] + (size_t)l * 1024;
    for (int task = gw; task < NTOK * 4; task += NGW) { const int t = task >> 2, hq = task & 3, c = hq * 256 + 4 * F.lane; const size_t idx = (size_t)t * 1024 + c;
        const f32x4 r = *(const f32x4*)(RWR + idx), k = *(const f32x4*)(RWK + idx), av = *(const f32x4*)(RWA + idx);
        const f32x4 kkr = k * *(const f32x4*)(kkw + c);
        const float n2 = dpp16((kkr[0] * kkr[0] + kkr[1] * kkr[1]) + (kkr[2] * kkr[2] + kkr[3] * kkr[3]));
        const f32x4 kk = kkr * (1.0f / fmaxf(sqrtf(n2), 1e-12f));
        const f32x4 k2 = k * (1.0f + (av - 1.0f) * *(const f32x4*)(kaw + c));
        *(f32x4*)(RWK + idx) = k2; *(f32x4*)(RWKK + idx) = kk; *(f32x4*)(RWB + idx) = kk * av;
        const f32x4 pr = r * k2 * *(const f32x4*)(rkw + c);
        const float bon = dpp16((pr[0] + pr[1]) + (pr[2] + pr[3]));
        if ((F.lane & 15) == 0) BON[t * 16 + hq * 4 + (F.lane >> 4)] = bon; }
}
__device__ __forceinline__ void ph6_rwkv_out(KArgs a, Frame& F, int l) {
    const int gw = F.vcu * NWAVES + F.wave, NGW = F.G * NWAVES;
    const float* RWY = (const float*)(F.ws + WS_RWY); const float* RWV = (const float*)(F.ws + WS_RWV); const float* RWG = (const float*)(F.ws + WS_RWG); const float* BON = (const float*)(F.ws + WS_BON);
    bf16* Y2 = (bf16*)(F.ws + WS_YBR) + (size_t)2 * NTOK * 1024;
    const float* lg = a->in[12] + (size_t)l * 1024; const float* lb = a->in[13] + (size_t)l * 1024;
    for (int task = gw; task < NTOK * 4; task += NGW) { const int t = task >> 2, hq = task & 3, c = hq * 256 + 4 * F.lane; const size_t idx = (size_t)t * 1024 + c;
        const f32x4 y = *(const f32x4*)(RWY + idx);
        const float mu = dpp16((y[0] + y[1]) + (y[2] + y[3])) * (1.0f / 64.0f); const f32x4 d = y - mu;
        const float var = dpp16((d[0] * d[0] + d[1] * d[1]) + (d[2] * d[2] + d[3] * d[3])) * (1.0f / 64.0f);
        f32x4 yn = d * rsqrtf(var + GN_EPS) * *(const f32x4*)(lg + c) + *(const f32x4*)(lb + c);
        yn += BON[t * 16 + hq * 4 + (F.lane >> 4)] * *(const f32x4*)(RWV + idx);
        yn *= *(const f32x4*)(RWG + idx);
        v2u w; w.x = pk2(yn[0], yn[1]); w.y = pk2(yn[2], yn[3]); *(v2u*)(Y2 + idx) = w; }
}

typedef float f32x2_t __attribute__((ext_vector_type(2)));
__device__ __forceinline__ void reduce2(float q, float p, float& Q, float& P) {
    const auto a = __builtin_amdgcn_permlane16_swap(__float_as_uint(q), __float_as_uint(p), false, false);
    float x = __uint_as_float(a[0]) + __uint_as_float(a[1]);
    x = dpp16(x);
    const auto b = __builtin_amdgcn_permlane16_swap(__float_as_uint(x), __float_as_uint(x), false, false);
    Q = __uint_as_float(b[0]); P = __uint_as_float(b[1]);
}
template <int MODE  > __device__ __forceinline__ void ph5_scan(KArgs a, Frame& F, int l) {
#define LDS_BAR() do { asm volatile("s_waitcnt lgkmcnt(0)" ::: "memory"); __builtin_amdgcn_s_barrier(); asm volatile("" ::: "memory"); } while (0)
    const int bx = pg8::obid();
    const int seq = bx >> 3, b = seq >> 4, h = seq & 15, i0 = (bx & 7) * 8 + F.wave * 2;
    const bool active = F.wave < 4;
    LAS float* buf = (LAS float*)(F.lds + RING_OFF);
    constexpr int BSZ = 6 * 32 * 64, ASZ = 32 * 64, NBLK = SEQ / 32;
    const float* A0 = (const float*)(F.ws + WS_RWKK) + 1024; const float* A1 = (const float*)(F.ws + WS_RWB); const float* A2 = (const float*)(F.ws + WS_RWW);
    const float* A3 = (const float*)(F.ws + WS_RWK); const float* A4 = (const float*)(F.ws + WS_RWR); const float* A5 = (const float*)(F.ws + WS_RWV);
    float* RWY = (float*)(F.ws + (MODE == 0 ? WS_RWY : WS_M + 600 * MiB));
    const size_t tok0 = (size_t)b * SEQ; const int col0 = h * 64;
    const int st = F.tid >> 4, sq = F.tid & 15;
    const size_t soff = (tok0 + st) * 1024 + col0 + sq * 4;
    const int loff = st * 64 + sq * 4;
    const int rl = F.lane >> 5, jq = F.lane & 31, irow = i0 + rl;
    float S0 = 0.f, S1 = 0.f, yreg = 0.f, sa = 0.f;
#define SC_LOAD(R, blk_) do { if (MODE == 1) break; const size_t o_ = soff + (size_t)(blk_) * 32 * 1024; R##0 = *(const f32x4*)(A0 + o_); R##1 = *(const f32x4*)(A1 + o_); R##2 = *(const f32x4*)(A2 + o_); \
        R##3 = *(const f32x4*)(A3 + o_); R##4 = *(const f32x4*)(A4 + o_); R##5 = *(const f32x4*)(A5 + o_); } while (0)
#define SC_WRITE(R, bufi) do { if (MODE == 1) break; LAS float* nb_ = buf + (bufi) * BSZ; *(LAS f32x4*)(nb_ + 0 * ASZ + loff) = R##0; *(LAS f32x4*)(nb_ + 1 * ASZ + loff) = R##1; *(LAS f32x4*)(nb_ + 2 * ASZ + loff) = R##2; \
        *(LAS f32x4*)(nb_ + 3 * ASZ + loff) = R##3; *(LAS f32x4*)(nb_ + 4 * ASZ + loff) = R##4; *(LAS f32x4*)(nb_ + 5 * ASZ + loff) = R##5; } while (0)
#define SC_COMPUTE(bufi, blk_) do { if (active) { const LAS float* bb = buf + (bufi) * BSZ; \
        _Pragma("unroll 4") for (int tl = 0; tl < 32; ++tl) { const LAS float* base = bb + tl * 64; \
            const f32x2_t b2 = *(const LAS f32x2_t*)(base + 1 * ASZ + 2 * jq), w2 = *(const LAS f32x2_t*)(base + 2 * ASZ + 2 * jq), k2 = *(const LAS f32x2_t*)(base + 3 * ASZ + 2 * jq), \
                          r2 = *(const LAS f32x2_t*)(base + 4 * ASZ + 2 * jq), kn = *(const LAS f32x2_t*)(base + 0 * ASZ + 2 * jq); \
            const float v = base[5 * ASZ + irow]; \
            S0 = S0 * w2[0] + (sa * b2[0] + v * k2[0]); S1 = S1 * w2[1] + (sa * b2[1] + v * k2[1]); \
            float Q, P; reduce2(S0 * r2[0] + S1 * r2[1], S0 * kn[0] + S1 * kn[1], Q, P); \
            sa = -P; \
            if (jq == (tl & 15)) yreg = Q; \
            if ((tl & 15) == 15) { if (jq < 16) RWY[(tok0 + (size_t)(blk_) * 32 + (tl - 15) + jq) * 1024 + col0 + irow] = yreg; } } } } while (0)
    int hit = (SHADOW_CONVERT && MODE == 0 && !active) ? I_IN + (bx * 4 + (F.wave - 4)) : NIT;
    LAS float* hscr = (LAS float*)(F.lds + RING_OFF + (F.wave < 7 ? 98304 + (F.wave - 4) * 8448 : 132096));
    float hv[32]; TrItem hd = {}; bool hpend = false;
    if (active) __builtin_amdgcn_s_setprio(3);
#define SC_HELP() do { if (hpend) { tr_finish(hd, F.lane, hv, hscr); hpend = false; } if (hit < NIT) { hd = decode_item(a, F.ws, l, hit); tr_issue(hd, F.lane, hv); hpend = true; hit += 4 * (int)gridDim.x; } } while (0)
    f32x4 ra0 = {}, ra1 = {}, ra2 = {}, ra3 = {}, ra4 = {}, ra5 = {}, rb0 = {}, rb1 = {}, rb2 = {}, rb3 = {}, rb4 = {}, rb5 = {};
    SC_LOAD(ra, 0); SC_LOAD(rb, 1);
    SC_WRITE(ra, 0);
    SC_LOAD(ra, 2);
    for (int blk = 0; blk < NBLK; blk += 2) {
        LDS_BAR();
        SC_COMPUTE(0, blk);
        SC_WRITE(rb, 1);
        if (blk + 3 < NBLK) SC_LOAD(rb, blk + 3);
        SC_HELP();
        LDS_BAR();
        SC_COMPUTE(1, blk + 1);
        if (blk + 2 < NBLK) { SC_WRITE(ra, 0); if (blk + 4 < NBLK) SC_LOAD(ra, blk + 4); }
        SC_HELP();
    }
    __builtin_amdgcn_s_setprio(0);
    while (hit < NIT || hpend) SC_HELP();
    LDS_BAR();
#undef SC_HELP
#undef LDS_BAR
#undef SC_LOAD
#undef SC_WRITE
#undef SC_COMPUTE
}
namespace att {
constexpr int SHM_K = 64 * 128 * 2, SHM_V = 64 * 128 * 2;
constexpr float ATT_STOP = -40.0f;
#define KSWZ(row, colB) ((row) * 256 + ((colB) ^ (((row) & 7) << 4)))
__device__ __forceinline__ int v_st(int k, int c) { const int kk = (k & ~0xC) | ((k & 4) << 1) | ((k & 8) >> 1); return ((kk >> 3) * 4 + (c >> 5)) * 512 + ((kk & 7) * 32 + (c & 31)) * 2; }
__device__ __forceinline__ int v_rd_base(int lane) { return ((lane & 3) << 3) | (((lane >> 2) & 3) << 6) | (((lane >> 4) & 1) << 5) | (((lane >> 5) & 1) << 8); }
constexpr int v_rd_off(int d0, int ks, int half) { return d0 * 512 + ks * 4096 + half * 2048; }
__device__ __forceinline__ int crow(int r, int hi) { return (r & 3) + 8 * (r >> 2) + 4 * hi; }
__device__ __forceinline__ unsigned cvtpk(float lo, float hi) { unsigned r; asm volatile("v_cvt_pk_bf16_f32 %0, %1, %2" : "=v"(r) : "v"(lo), "v"(hi)); return r; }
__device__ __forceinline__ int kperm(int m) { return 16 * ((m >> 2) & 1) + 4 * (m >> 3) + (m & 3); }

__device__ __forceinline__ void qkt(f32x16& p0, f32x16& p1, LAS const char* K_lds, int r32, int hi, const bf16x8* qr) {
    p0 = f32x16{}; p1 = f32x16{};
    LAS const char* kb[4];
#pragma unroll
    for (int dd = 0; dd < 4; ++dd) kb[dd] = K_lds + KSWZ(r32, (dd * 16 + hi * 8) * 2);
#pragma unroll
    for (int d0 = 0; d0 < 8; ++d0) { LAS const char* ap = kb[d0 & 3] + (d0 >> 2) * 128;
        const bf16x8 b0 = *(LAS const bf16x8*)ap;
        const bf16x8 b1 = *(LAS const bf16x8*)(ap + 32 * 256);
        p0 = __builtin_amdgcn_mfma_f32_32x32x16_bf16(b0, qr[d0], p0, 0, 0, 0);
        p1 = __builtin_amdgcn_mfma_f32_32x32x16_bf16(b1, qr[d0], p1, 0, 0, 0); }
}
__device__ __forceinline__ void pv_tile(f32x16* o, int vb0, bf16x8 pa0, bf16x8 pa1, bf16x8 pa2, bf16x8 pa3) {
#define TRRD(dst, off) asm volatile("ds_read_b64_tr_b16 %0, %1 offset:%2" : "=&v"(dst) : "v"(vb0), "i"(off) : "memory")
#define PV_D0(d0) do { s16x4 l0, l1, l2, l3, h0, h1, h2, h3; constexpr int b_ = v_rd_off(d0, 0, 0); \
        TRRD(l0, b_); TRRD(h0, b_ + 2048); TRRD(l1, b_ + 4096); TRRD(h1, b_ + 6144); TRRD(l2, b_ + 8192); TRRD(h2, b_ + 10240); TRRD(l3, b_ + 12288); TRRD(h3, b_ + 14336); \
        asm volatile("s_waitcnt lgkmcnt(0)" ::: "memory"); __builtin_amdgcn_sched_barrier(0); \
        o[d0] = __builtin_amdgcn_mfma_f32_32x32x16_bf16(pa0, (bf16x8){l0[0], l0[1], l0[2], l0[3], h0[0], h0[1], h0[2], h0[3]}, o[d0], 0, 0, 0);   \
        o[d0] = __builtin_amdgcn_mfma_f32_32x32x16_bf16(pa1, (bf16x8){l1[0], l1[1], l1[2], l1[3], h1[0], h1[1], h1[2], h1[3]}, o[d0], 0, 0, 0);   \
        o[d0] = __builtin_amdgcn_mfma_f32_32x32x16_bf16(pa2, (bf16x8){l2[0], l2[1], l2[2], l2[3], h2[0], h2[1], h2[2], h2[3]}, o[d0], 0, 0, 0);   \
        o[d0] = __builtin_amdgcn_mfma_f32_32x32x16_bf16(pa3, (bf16x8){l3[0], l3[1], l3[2], l3[3], h3[0], h3[1], h3[2], h3[3]}, o[d0], 0, 0, 0); } while (0)
    PV_D0(0); PV_D0(1); PV_D0(2); PV_D0(3);
#undef PV_D0
#undef TRRD
}
__device__ __forceinline__ void stick_tile(f32x16& p0, f32x16& p1, float& c, int t, int kb0, int hi) {
    const float CS = 0.08838834764831845f * 1.4426950408889634f;
    const int k0 = kb0 + 16 * hi, k1 = k0 + 32;
    float f0[16], f1[16]; float T0 = 0.f, T1 = 0.f;
#pragma unroll
    for (int r = 0; r < 16; ++r) {
        const float y0 = p0[r] * CS, y1 = p1[r] * CS;
        const float sp0 = __builtin_amdgcn_logf(1.0f + __builtin_amdgcn_exp2f(y0)), sp1 = __builtin_amdgcn_logf(1.0f + __builtin_amdgcn_exp2f(y1));
        f0[r] = (k0 + r < t) ? -sp0 : 0.f; f1[r] = (k1 + r < t) ? -sp1 : 0.f;
        p0[r] = y0 - sp0; p1[r] = y1 - sp1;
        T0 += f0[r]; T1 += f1[r];
    }
    const auto s1 = __builtin_amdgcn_permlane32_swap(__float_as_uint(T1), __float_as_uint(T1), false, false);
    const auto s0 = __builtin_amdgcn_permlane32_swap(__float_as_uint(T0), __float_as_uint(T0), false, false);
    const float T1lo = __uint_as_float(s1[0]), T1hi = __uint_as_float(s1[1]), T0lo = __uint_as_float(s0[0]), T0hi = __uint_as_float(s0[1]);
    const float c1 = c + T1hi, c2 = c1 + T1lo, c3 = c2 + T0hi, c4 = c3 + T0lo;
    float run1 = hi ? c : c1, run0 = hi ? c2 : c3;
#pragma unroll
    for (int r = 15; r >= 0; --r) {
        const float w1 = (k1 + r < t) ? __builtin_amdgcn_exp2f(p1[r] + run1) : 0.f; run1 += f1[r]; p1[r] = w1;
        const float w0 = (k0 + r < t) ? __builtin_amdgcn_exp2f(p0[r] + run0) : 0.f; run0 += f0[r]; p0[r] = w0;
    }
    c = c4;
}
#define PK4(P, B_, OUT) do { unsigned a0 = cvtpk(P[B_+0], P[B_+1]), a1 = cvtpk(P[B_+2], P[B_+3]);                          \
        unsigned b0 = cvtpk(P[B_+4], P[B_+5]), b1 = cvtpk(P[B_+6], P[B_+7]);                                             \
        auto r0 = __builtin_amdgcn_permlane32_swap(a0, b0, false, false); auto r1 = __builtin_amdgcn_permlane32_swap(a1, b1, false, false); \
        v4u w = {r0[0], r1[0], r0[1], r1[1]}; OUT = __builtin_bit_cast(bf16x8, w); } while (0)

__device__ __forceinline__ void attn_unit(LAS unsigned char* lds, const bf16* QKV, bf16* O, int b, int h, int qb) {
    const int tid = pg8::otid(), wid = __builtin_amdgcn_readfirstlane(tid >> 6), lane = tid & 63, r32 = lane & 31, hi = lane >> 5;
    LAS char* V_lds = (LAS char*)lds; LAS char* K_lds = (LAS char*)lds + SHM_V; volatile LAS int* flags = (volatile LAS int*)(lds + SHM_V + SHM_K);
    const bf16* Qp = QKV + (size_t)b * SEQ * 3072 + h * 128; const bf16* Kp = Qp + 1024; const bf16* Vp = Qp + 2048;
    const int qlo = qb * 256 + wid * 32, t = qlo + r32;
    bf16x8 qr[8];
#pragma unroll
    for (int d0 = 0; d0 < 8; ++d0) qr[d0] = *(const bf16x8*)(Qp + (size_t)t * 3072 + d0 * 16 + hi * 8);
    const int sr = tid >> 4, sc = (tid & 15) * 8, kr = kperm(sr);
    const int kws = KSWZ(sr, sc * 2), vst0 = v_st(sr, sc), vst1 = v_st(32 + sr, sc);
    const int vb0 = (int)(unsigned)(uintptr_t)V_lds + v_rd_base(lane);
    f32x16 o[4] = {}; float c = 0.f; bool done = false;
    if (tid < 8) flags[tid] = 0;
    for (int j = 4 * qb + 3; j >= 0; --j) {
        const int kb0 = j * 64;
        const bf16x8 k0v = *(const bf16x8*)(Kp + (size_t)(kb0 + kr) * 3072 + sc), k1v = *(const bf16x8*)(Kp + (size_t)(kb0 + 32 + kr) * 3072 + sc);
        const bf16x8 v0v = *(const bf16x8*)(Vp + (size_t)(kb0 + kr) * 3072 + sc), v1v = *(const bf16x8*)(Vp + (size_t)(kb0 + 32 + kr) * 3072 + sc);
        __syncthreads();
        bool all_done = true;
#pragma unroll
        for (int w = 0; w < 8; ++w) all_done = all_done && (flags[w] != 0);
        if (all_done) break;
        *(LAS bf16x8*)(K_lds + kws) = k0v; *(LAS bf16x8*)(K_lds + kws + 32 * 256) = k1v;
        *(LAS bf16x8*)(V_lds + vst0) = v0v; *(LAS bf16x8*)(V_lds + vst1) = v1v;
        __syncthreads();
        if (!done && kb0 <= qlo + 30) {
            f32x16 p0, p1;
            qkt(p0, p1, K_lds, r32, hi, qr);
            stick_tile(p0, p1, c, t, kb0, hi);
            bf16x8 pa0, pa1, pa2, pa3;
            PK4(p0, 0, pa0); PK4(p0, 8, pa1); PK4(p1, 0, pa2); PK4(p1, 8, pa3);
            pv_tile(o, vb0, pa0, pa1, pa2, pa3);
            done = __all(c < ATT_STOP) != 0;
            if (lane == 0 && done) flags[wid] = 1;
        }
    }
    bf16* Ow = O + ((size_t)b * SEQ + qlo) * 1024 + h * 128;
#pragma unroll
    for (int r = 0; r < 16; ++r) { const int orow = crow(r, hi);
#pragma unroll
        for (int d0 = 0; d0 < 4; ++d0) { const float v = o[d0][r]; const float vn = __shfl_xor(v, 1);
            if ((r32 & 1) == 0) *(unsigned*)(Ow + (size_t)orow * 1024 + d0 * 32 + r32) = cvtpk(v, vn); } }
    __syncthreads();
}
#undef PK4
#undef KSWZ
}
__device__ __forceinline__ float shx(float v, int m) { return __shfl_xor(v, m); }
__device__ __forceinline__ float rdl(float v, int l) { return __builtin_bit_cast(float, __builtin_amdgcn_readlane(__builtin_bit_cast(int, v), l)); }
__device__ __forceinline__ void ph9_ln_router(KArgs a, Frame& F, int l) {
    volatile LAS int* lhist = (volatile LAS int*)(F.lds + RING_OFF);
    const float* PRE = (const float*)(F.ws + WS_PRELN); float* X1 = (float*)(F.ws + WS_X1); bf16* XS = (bf16*)(F.ws + WS_XS);
    int* HIST = (int*)(F.ws + WS_HIST); int* SELE = (int*)(F.ws + WS_SELE); float* SELW = (float*)(F.ws + WS_SELW);
    const float* g1 = a->in[16] + (size_t)l * DM; const float* b1 = a->in[17] + (size_t)l * DM;
    const float* WR = a->in[18] + (size_t)l * DM * 64; const float* rbias = a->in[19] + (size_t)l * 64;
    const int lane = F.lane;
    for (int grp = pg8::obid(); grp < 256; grp += F.G) {
        if (F.tid < 64) lhist[F.tid] = 0;
        __syncthreads();
        const int t0 = grp * 32 + F.wave * 4;
#pragma unroll 1
        for (int k = 0; k < 4; ++k) {
            f32x4 v[8];
            const f32x4* row = (const f32x4*)(PRE + (size_t)(t0 + k) * DM) + lane; float s = 0.f;
#pragma unroll
            for (int j = 0; j < 8; ++j) { v[j] = row[64 * j]; s += (v[j][0] + v[j][1]) + (v[j][2] + v[j][3]); }
            const float mean = wave_sum(s) * (1.0f / DM); float s2 = 0.f;
#pragma unroll
            for (int j = 0; j < 8; ++j) { v[j] = v[j] - mean; s2 += (v[j][0] * v[j][0] + v[j][1] * v[j][1]) + (v[j][2] * v[j][2] + v[j][3] * v[j][3]); }
            const float rstd = 1.0f / sqrtf(wave_sum(s2) * (1.0f / DM) + LN_EPS);
            f32x4* xo = (f32x4*)(X1 + (size_t)(t0 + k) * DM) + lane; v2u* bo = (v2u*)(XS + (size_t)(t0 + k) * DM) + lane;
#pragma unroll
            for (int j = 0; j < 8; ++j) { const f32x4 gg = ((const f32x4*)g1)[64 * j + lane], bb = ((const f32x4*)b1)[64 * j + lane];
                v[j] = v[j] * rstd * gg + bb; xo[64 * j] = v[j];
                v2u w; w.x = pk2(v[j][0], v[j][1]); w.y = pk2(v[j][2], v[j][3]); bo[64 * j] = w; }
        }
        __syncthreads();
        LAS float* XC = (LAS float*)(F.lds + RING_OFF + 1024);
        LAS float* WC = (LAS float*)(F.lds + RING_OFF + 1024 + 33024);
        f32x16 ac0 = {}, ac1 = {};
#pragma unroll 1
        for (int j = 0; j < 8; ++j) {
            __syncthreads();
#pragma unroll
            for (int i = 0; i < 4; ++i) { const int idx = F.tid + 512 * i, xrow = idx >> 6, c4 = idx & 63;
                const f32x4 xv = *(const f32x4*)(X1 + (size_t)(grp * 32 + xrow) * DM + 256 * j + 4 * c4);
                LAS float* xr = XC + xrow * 257 + 4 * c4; xr[0] = xv[0]; xr[1] = xv[1]; xr[2] = xv[2]; xr[3] = xv[3]; }
            { const f32x4* wsrc = (const f32x4*)(WR + (size_t)256 * j * 64);
#pragma unroll
              for (int i = 0; i < 8; ++i) ((LAS f32x4*)WC)[F.tid + 512 * i] = wsrc[F.tid + 512 * i]; }
            __syncthreads();
#pragma unroll
            for (int kk = 0; kk < 16; ++kk) { const int kidx = 32 * F.wave + 2 * kk + (lane >> 5);
                const float av = XC[(lane & 31) * 257 + kidx], b0 = WC[kidx * 64 + (lane & 31)], b1 = WC[kidx * 64 + 32 + (lane & 31)];
                ac0 = __builtin_amdgcn_mfma_f32_32x32x2f32(av, b0, ac0, 0, 0, 0); ac1 = __builtin_amdgcn_mfma_f32_32x32x2f32(av, b1, ac1, 0, 0, 0); }
        }
        __syncthreads();
        { LAS float* RED = WC; const int hi = lane >> 5, e = lane & 31;
#pragma unroll
          for (int r = 0; r < 16; ++r) { const int tok = (r & 3) + 8 * (r >> 2) + 4 * hi; RED[(F.wave * 32 + tok) * 64 + e] = ac0[r]; RED[(F.wave * 32 + tok) * 64 + 32 + e] = ac1[r]; } }
        __syncthreads();
        float acc[4];
#pragma unroll
        for (int k = 0; k < 4; ++k) { float sacc = 0.f;
#pragma unroll
            for (int w2 = 0; w2 < 8; ++w2) sacc += WC[(w2 * 32 + F.wave * 4 + k) * 64 + lane];
            acc[k] = sacc; }
        const float rb = rbias[lane];
#pragma unroll
        for (int k = 0; k < 4; ++k) {
            const int t = t0 + k;
            const float sc = 1.0f / (1.0f + expf(-acc[k])); const float bz = sc + rb;
            float m1 = bz; m1 = fmaxf(m1, shx(m1, 1)); m1 = fmaxf(m1, shx(m1, 2)); m1 = fmaxf(m1, shx(m1, 4));
            const unsigned long long eq = __ballot(bz == m1);
            const int g = lane >> 3; const unsigned gb = (unsigned)((eq >> (8 * g)) & 0xffull); const int first = __ffs((int)gb) - 1;
            float m2 = ((lane & 7) == first) ? -__builtin_inff() : bz; m2 = fmaxf(m2, shx(m2, 1)); m2 = fmaxf(m2, shx(m2, 2)); m2 = fmaxf(m2, shx(m2, 4));
            const float gs = m1 + m2;
            int grank = 0;
#pragma unroll
            for (int g2 = 0; g2 < 8; ++g2) { const float o = rdl(gs, 8 * g2); grank += ((o > gs) || (o == gs && g2 < g)) ? 1 : 0; }
            const bool gsel = grank < 4;
            const float mv = gsel ? bz : -__builtin_inff();
            int rank = 0;
            for (int e2 = 0; e2 < 64; ++e2) { const float o = rdl(mv, e2); rank += ((o > mv) || (o == mv && e2 < lane)) ? 1 : 0; }
            const bool sel = gsel && rank < 8;
            const float ssum = wave_sum(sel ? sc : 0.f);
            const float wgt = sc / ssum * ROUTED_SCALE;
            const unsigned long long m = __ballot(sel);
            const int slot = __popcll(m & ((1ull << lane) - 1ull));
            if (sel) { SELE[t * 8 + slot] = lane; SELW[t * 8 + slot] = wgt; __hip_atomic_fetch_add((LAS int*)&lhist[lane], 1, __ATOMIC_RELAXED, __HIP_MEMORY_SCOPE_WORKGROUP); }
        }
        __syncthreads();
        if (F.tid < 64) HIST[grp * 64 + F.tid] = lhist[F.tid];
        __syncthreads();
    }
}
__device__ __forceinline__ void ph10_lists(Frame& F) {
    volatile LAS int* L = (volatile LAS int*)(F.lds + RING_OFF);
    volatile LAS int* partT = L, * partB = L + 512, * rowbase = L + 1024, * lsel = L + 1088, * lpos = L + 1344;
    const int* HIST = (const int*)(F.ws + WS_HIST); const int* SELE = (const int*)(F.ws + WS_SELE); const float* SELW = (const float*)(F.ws + WS_SELW);
    int* SLOT = (int*)(F.ws + WS_SLOT); float* ROWW = (float*)(F.ws + WS_ROWW); int* TSEG = (int*)(F.ws + WS_TSEG); bf16* XS = (bf16*)(F.ws + WS_XS);
    for (int grp = pg8::obid(); grp < 256; grp += F.G) {
        { const int e = F.tid & 63, part = F.tid >> 6; int s = 0, bs = 0;
          for (int w = 32 * part; w < 32 * part + 32; ++w) { const int hv = HIST[w * 64 + e]; s += hv; bs += (w < grp) ? hv : 0; }
          partT[part * 64 + e] = s; partB[part * 64 + e] = bs; }
        __syncthreads();
        if (F.tid < 64) { int tot = 0, bef = 0;
#pragma unroll
            for (int p = 0; p < 8; ++p) { tot += partT[p * 64 + F.tid]; bef += partB[p * 64 + F.tid]; }
            const int nt = (tot + 255) >> 8; int incl = nt;
#pragma unroll
            for (int o = 1; o < 64; o <<= 1) { const int u = __shfl_up(incl, o); if (F.lane >= o) incl += u; }
            const int excl = incl - nt;
            rowbase[F.tid] = 8192 + 256 * excl + bef;
            if (grp == 0) { for (int i = 0; i < nt; ++i) TSEG[16 + 32 + excl + i] = F.tid + 1;
                if (F.tid < 32) TSEG[16 + F.tid] = 0;
                if (F.tid == 63) TSEG[0] = 32 + incl; } }
        if (F.tid < 256) lsel[F.tid] = SELE[grp * 256 + F.tid];
        __syncthreads();
        if (F.tid < 256) { const int j = F.tid >> 3, e = lsel[F.tid]; int rank = 0;
            for (int q = 0; q < 8 * j; ++q) rank += (lsel[q] == e) ? 1 : 0;
            const int pos = rowbase[e] + rank; const int t = grp * 32 + j;
            SLOT[t * 8 + (F.tid & 7)] = pos; ROWW[pos] = SELW[grp * 256 + F.tid]; lpos[F.tid] = pos; }
        else if (F.tid < 288) ROWW[grp * 32 + F.tid - 256] = 1.0f;
        __syncthreads();
        for (int p = F.wave * 32; p < F.wave * 32 + 32; ++p) { const int t = grp * 32 + (p >> 3), pos = lpos[p];
            const v4u* src = (const v4u*)(XS + (size_t)t * DM) + F.lane; v4u* dst = (v4u*)(XS + (size_t)pos * DM) + F.lane;
            const v4u c0 = src[0], c1 = src[64], c2 = src[128], c3 = src[192]; dst[0] = c0; dst[64] = c1; dst[128] = c2; dst[192] = c3; }
        __syncthreads();
    }
}
__device__ __forceinline__ void ph13_combine(KArgs a, Frame& F, int l) {
    const int gw = F.vcu * NWAVES + F.wave, NGW = F.G * NWAVES, lane = F.lane;
    const float* X1 = (const float*)(F.ws + WS_X1); const bf16* YS = (const bf16*)(F.ws + WS_YS); const int* SLOT = (const int*)(F.ws + WS_SLOT);
    float* outf = (l == NLAYER - 1) ? a->out : (float*)(F.ws + WS_X2); bf16* XB = (bf16*)(F.ws + WS_XB);
    const float* g2 = a->in[26] + (size_t)l * DM; const float* b2 = a->in[27] + (size_t)l * DM;
    for (int t = gw; t < NTOK; t += NGW) {
        const int mypos = (lane < 8) ? SLOT[t * 8 + lane] : t;
        float acc[4][8];
#pragma unroll
        for (int q = 0; q < 4; ++q) { const f32x4 p0 = *(const f32x4*)(X1 + (size_t)t * DM + 512 * q + 8 * lane), p1 = *(const f32x4*)(X1 + (size_t)t * DM + 512 * q + 8 * lane + 4);
#pragma unroll
            for (int j = 0; j < 4; ++j) { acc[q][j] = ALPHA * p0[j]; acc[q][4 + j] = ALPHA * p1[j]; } }
#pragma unroll
        for (int s = 0; s < 9; ++s) { const int row = __builtin_amdgcn_readlane(mypos, s); const v4u* yr = (const v4u*)(YS + (size_t)row * DM) + lane;
#pragma unroll
            for (int q = 0; q < 4; ++q) { float u[8]; unpack8(yr[64 * q], u);
#pragma unroll
                for (int j = 0; j < 8; ++j) acc[q][j] += u[j]; } }
        float s1 = 0.f;
#pragma unroll
        for (int q = 0; q < 4; ++q)
#pragma unroll
            for (int j = 0; j < 8; ++j) s1 += acc[q][j];
        const float mean = wave_sum(s1) * (1.0f / DM); float s2 = 0.f;
#pragma unroll
        for (int q = 0; q < 4; ++q)
#pragma unroll
            for (int j = 0; j < 8; ++j) { acc[q][j] -= mean; s2 += acc[q][j] * acc[q][j]; }
        const float rstd = 1.0f / sqrtf(wave_sum(s2) * (1.0f / DM) + LN_EPS);
#pragma unroll
        for (int q = 0; q < 4; ++q) { const int col = 512 * q + 8 * lane;
            const f32x4 ga = *(const f32x4*)(g2 + col), gb = *(const f32x4*)(g2 + col + 4), ba = *(const f32x4*)(b2 + col), bb = *(const f32x4*)(b2 + col + 4);
            float y[8];
#pragma unroll
            for (int j = 0; j < 4; ++j) { y[j] = acc[q][j] * rstd * ga[j] + ba[j]; y[4 + j] = acc[q][4 + j] * rstd * gb[j] + bb[j]; }
            *(f32x4*)(outf + (size_t)t * DM + col) = (f32x4){y[0], y[1], y[2], y[3]}; *(f32x4*)(outf + (size_t)t * DM + col + 4) = (f32x4){y[4], y[5], y[6], y[7]};
            *(v4u*)(XB + (size_t)t * DM + col) = pack8(y); }
    }
}
__device__ __forceinline__ KArgs kargs() { KArgs p = (KArgs)__builtin_amdgcn_kernarg_segment_ptr(); asm volatile("" : "+s"(p)); return p; }
__device__ __forceinline__ Frame mkframe(LAS unsigned char* lds) {
    Frame F; KArgs ka = kargs();
    F.lds = lds; F.MISC = (volatile LAS unsigned*)(lds + MISC_OFF);
    F.tid = pg8::otid(); F.lane = F.tid & 63; F.wave = __builtin_amdgcn_readfirstlane(F.tid >> 6);
    F.G = gridDim.x; { const int bx = pg8::obid(); F.vcu = (F.G % 8 == 0) ? (bx % 8) * (F.G / 8) + bx / 8 : bx; }
    F.ws = ka->ws; F.ctl = (gu32*)(ka->ws + WS_CTL);
    return F;
}
__device__ __forceinline__ void grid_seam(LAS unsigned char* lds) {
    XcdBarrier b; b.bar = (unsigned*)((gu32*)(kargs()->ws + WS_CTL) + CW_BAR); b.x = xb_xcc_id(); b.st = (volatile LAS unsigned*)(lds + MISC_OFF) + 8;
    xcd_barrier(b);
}
__global__ void __launch_bounds__(NWAVES * 64, 2) fwd_kernel(Args args_unused) {
    extern __shared__ __attribute__((aligned(16))) unsigned char lds_raw[];
    LAS unsigned char* lds = (LAS unsigned char*)lds_raw;
    for (int u = threadIdx.x; u < (LDS_BYTES - LDSCTL_OFF) / 4; u += NWAVES * 64) ((LAS unsigned*)(lds + LDSCTL_OFF))[u] = 0u;
    __syncthreads();
    if (kargs()->ph_hi - kargs()->ph_lo > 1) (void)xcd_barrier_post((unsigned*)((gu32*)(kargs()->ws + WS_CTL) + CW_BAR), (volatile LAS unsigned*)(lds + MISC_OFF) + 8);
#ifndef PH_MASK
#define PH_MASK 0x3fff
#endif
#define IN(k) (((PH_MASK >> (k)) & 1) && kargs()->ph_lo <= (pb + (k)) && (pb + (k)) < kargs()->ph_hi)
#ifndef REP_MASK
#define REP_MASK 0
#endif
#define REPS(k) _Pragma("unroll 1") for (int rep_ = 0; rep_ < ((((REP_MASK) >> (k)) & 1) ? 2 : 1); ++rep_)
#define REPSEAM() do { if (rep_) grid_seam(lds); } while (0)
#define SEAM(k) do { if (IN(k) && (pb + (k) + 1) < kargs()->ph_hi) grid_seam(lds); } while (0)
#pragma unroll 1
    for (int l = 0; l < NLAYER; ++l) {
        const int pb = l * NPHASE;
        if (IN(0)) REPS(0) { REPSEAM(); Frame F = mkframe(lds); ph0_convert(kargs(), F, l); } SEAM(0);
        if (IN(1)) REPS(1) { REPSEAM(); unsigned char* ws = kargs()->ws;
            pg8::Gemm g{(const pg8::bf16_t*)(ws + WS_XB), (const pg8::bf16_t*)(ws + WS_WIN), NTOK, INP, DM}; pg8::StaticOrder S; S.init(NTOK, INP, (int)gridDim.x, pg8::obid());
            pg8::EpiInProj E{(pg8::bf16_t*)(ws + WS_PCONV), (pg8::bf16_t*)(ws + WS_PQKV), (pg8::bf16_t*)(ws + WS_PRKV), (pg8::bf16_t*)(ws + WS_PLORA), (pg8::bf16_t*)(ws + WS_PGATE)};
            pg8::gemm_phase<pg8::EpiInProj, pg8::StaticOrder, true, true>(lds + RING_OFF, g, S, E);
        } SEAM(1);
        if (IN(2)) REPS(2) { REPSEAM(); unsigned char* ws = kargs()->ws;
            for (int u = pg8::obid(); u < 256; u += gridDim.x) att::attn_unit(lds + RING_OFF, (const bf16*)(ws + WS_PQKV), (bf16*)(ws + WS_YBR) + (size_t)NTOK * 1024, u >> 7, (u >> 4) & 7, u & 15);
            Frame F = mkframe(lds); ph2_elementwise(kargs(), F, l);
        } SEAM(2);
        if (IN(3)) REPS(3) { REPSEAM(); unsigned char* ws = kargs()->ws;
            pg8::Gemm g{(const pg8::bf16_t*)(ws + WS_LORAA), (const pg8::bf16_t*)(ws + WS_WLORA), NTOK, 3072, 512}; pg8::StaticOrder S; S.init(NTOK, 3072, (int)gridDim.x, pg8::obid());
            pg8::EpiLora E{(float*)(ws + WS_RWW), (long)((WS_RWA - WS_RWW) / 4), (long)((WS_RWG - WS_RWW) / 4), kargs()->in[4] + (size_t)l * 1024, kargs()->in[6] + (size_t)l * 1024};
            pg8::gemm_phase<pg8::EpiLora, pg8::StaticOrder, true, true>(lds + RING_OFF, g, S, E);
        } SEAM(3);
        if (IN(4)) REPS(4) { REPSEAM(); Frame F = mkframe(lds); ph4_prep(kargs(), F, l); } SEAM(4);
        if (IN(5)) REPS(5) { REPSEAM(); Frame F = mkframe(lds); ph5_scan<0>(kargs(), F, l); } SEAM(5);
#ifdef SCAN_PROBE
        if (IN(5)) { Frame F = mkframe(lds); ph5_scan<SCAN_PROBE>(kargs(), F, l); grid_seam(lds); }
#endif
        if (IN(6)) REPS(6) { REPSEAM(); Frame F = mkframe(lds); ph6_rwkv_out(kargs(), F, l); } SEAM(6);
        if (IN(7)) REPS(7) { REPSEAM(); unsigned char* ws = kargs()->ws;
            pg8::Gemm g{(const pg8::bf16_t*)(ws + WS_YBR), (const pg8::bf16_t*)(ws + WS_WBR), 3 * NTOK, 3 * DM, 1024}; pg8::BranchOrder S; S.so.init(NTOK, DM, (int)gridDim.x, pg8::obid());
            pg8::EpiGate E{(const pg8::bf16_t*)(ws + WS_PGATE), (float*)(ws + WS_PRELN), (pg8::bf16_t*)(ws + WS_MERGED)};
            pg8::gemm_phase<pg8::EpiGate, pg8::BranchOrder, true, true>(lds + RING_OFF, g, S, E);
        } SEAM(7);
        if (IN(8)) REPS(8) { REPSEAM(); unsigned char* ws = kargs()->ws;
            pg8::Gemm g{(const pg8::bf16_t*)(ws + WS_MERGED), (const pg8::bf16_t*)(ws + WS_WO), NTOK, DM, DM}; pg8::StaticOrder S; S.init(NTOK, DM, (int)gridDim.x, pg8::obid());
            pg8::EpiWo E{l == 0 ? kargs()->in[0] : (const float*)(ws + WS_X2), (float*)(ws + WS_PRELN), ALPHA};
            pg8::gemm_phase<pg8::EpiWo, pg8::StaticOrder, true, true>(lds + RING_OFF, g, S, E);
        } SEAM(8);
        if (IN(9)) REPS(9) { REPSEAM(); Frame F = mkframe(lds); ph9_ln_router(kargs(), F, l); } SEAM(9);
        if (IN(10)) REPS(10) { REPSEAM(); Frame F = mkframe(lds); ph10_lists(F); } SEAM(10);
        if (IN(11)) REPS(11) { REPSEAM(); unsigned char* ws = kargs()->ws;
            const int ntiles = __builtin_amdgcn_readfirstlane(ld_i32((const int*)(ws + WS_TSEG)));
            pg8::Gemm g{(const pg8::bf16_t*)(ws + WS_XS), (const pg8::bf16_t*)(ws + WS_WGU), ntiles * 256, NSEG * 1024, DM};
            pg8::MoeOrder S{(const int*)(ws + WS_TSEG) + 16, ntiles, 4, (int)gridDim.x, pg8::obid()};
            pg8::EpiSwiglu E{(pg8::bf16_t*)(ws + WS_H)};
            pg8::gemm_phase<pg8::EpiSwiglu, pg8::MoeOrder, true, true>(lds + RING_OFF, g, S, E);
        } SEAM(11);
        if (IN(12)) REPS(12) { REPSEAM(); unsigned char* ws = kargs()->ws;
            const int ntiles = __builtin_amdgcn_readfirstlane(ld_i32((const int*)(ws + WS_TSEG)));
            pg8::Gemm g{(const pg8::bf16_t*)(ws + WS_H), (const pg8::bf16_t*)(ws + WS_WD), ntiles * 256, NSEG * 2048, 512};
            pg8::MoeOrder S{(const int*)(ws + WS_TSEG) + 16, ntiles, 8, (int)gridDim.x, pg8::obid()};
            pg8::EpiDown E{(pg8::bf16_t*)(ws + WS_YS), (const float*)(ws + WS_ROWW)};
            pg8::gemm_phase<pg8::EpiDown, pg8::MoeOrder, true, true>(lds + RING_OFF, g, S, E);
        } SEAM(12);
        if (IN(13)) REPS(13) { REPSEAM(); Frame F = mkframe(lds); ph13_combine(kargs(), F, l); } SEAM(13);
    }
#undef IN
#undef SEAM
}

#ifndef MK_PER_PHASE
#define MK_PER_PHASE 0
#endif
extern "C" void kernel_launch(void* const* d_in, const int* in_sizes, int n_in, void* d_out, int out_size, void* d_ws, size_t ws_size, hipStream_t stream) {
    static int grid = 0;
    if (grid == 0) {
        if (n_in != 28 || out_size != NTOK * DM || ws_size < WS_END) { fprintf(stderr, "kernel_launch: unexpected problem shape (n_in %d out %d ws %zu)\n", n_in, out_size, ws_size); grid = -1; return; }
        int dev = 0, cus = 0, per_cu = 0;
        if (hipGetDevice(&dev) != hipSuccess || hipDeviceGetAttribute(&cus, hipDeviceAttributeMultiprocessorCount, dev) != hipSuccess) { grid = -1; return; }
        if (hipFuncSetAttribute((const void*)fwd_kernel, hipFuncAttributeMaxDynamicSharedMemorySize, LDS_BYTES) != hipSuccess) { fprintf(stderr, "kernel_launch: hipFuncSetAttribute failed\n"); grid = -1; return; }
        if (hipOccupancyMaxActiveBlocksPerMultiprocessor(&per_cu, (const void*)fwd_kernel, NWAVES * 64, LDS_BYTES) != hipSuccess || per_cu < 1) fprintf(stderr, "kernel_launch: occupancy query reports %d\n", per_cu);
        (void)hipGetLastError();
        grid = cus;
    }
    if (grid < 0) return;
    (void)hipMemsetAsync((char*)d_ws + WS_CTL, 0, CTL_ZERO_BYTES, stream);
    Args a{};
    for (int i = 0; i < 28; ++i) a.in[i] = (const float*)d_in[i];
    a.out = (float*)d_out; a.ws = (unsigned char*)d_ws; a.li = 0; a.pad = 0;
#if MK_PER_PHASE
    for (int p = 0; p < NLAYER * NPHASE; ++p) { a.ph_lo = p; a.ph_hi = p + 1; hipLaunchKernelGGL(fwd_kernel, dim3(grid), dim3(NWAVES * 64), LDS_BYTES, stream, a); }
#else
    a.ph_lo = 0; a.ph_hi = NLAYER * NPHASE;
    hipLaunchKernelGGL(fwd_kernel, dim3(grid), dim3(NWAVES * 64), LDS_BYTES, stream, a);
#endif
}
```

```cpp
#include <hip/hip_runtime.h>
#include <cstdio>
#include <cstdint>
namespace pg8 {
#define PG8_LAS __attribute__((address_space(3)))
typedef unsigned short bf16_t;
typedef short bf16x8 __attribute__((ext_vector_type(8)));
typedef float f32x4 __attribute__((ext_vector_type(4)));
typedef unsigned u32x4 __attribute__((ext_vector_type(4)));
constexpr int BM = 256, BK = 64, HALF = 128, HTB = HALF * BK * 2  , STAGE_BYTES = 8 * HTB, NXCD = 8, WGM = 8;

__host__ __device__ __forceinline__ int lds_byte(int r, int c) { const int st = (r >> 4) * 2 + (c >> 5), rr = r & 15, cc = c & 31, ob = rr * 64 + cc * 2; return st * 1024 + (ob ^ (((ob >> 9) & 1) << 5)); }
__host__ __device__ __forceinline__ void stage_rc(int b, int& R, int& C) { const int st = b / 1024, sb = b % 1024, swz = sb ^ (((sb >> 9) & 1) << 5); R = (st >> 1) * 16 + swz / 64; C = (st & 1) * 32 + (swz % 64) / 2; }
__host__ __device__ __forceinline__ int perm32(int rho) { const int n = rho >> 4, i = rho & 15; return 8 * (i >> 2) + 4 * n + (i & 3); }

struct Unit { int pm, pn; };
struct Gemm { const bf16_t* A; const bf16_t* Bt; int M, N, K; };

struct StaticOrder {
    int nM, nN, nwg, G, c;
    __host__ __device__ void init(int M, int N, int G_, int c_) { nM = M / BM; nN = N / BM; nwg = nM * nN; G = G_; c = c_; }
    __host__ __device__ bool next(int i, Unit& u) const {
        const long L = (long)i * G + c; if (L >= nwg) return false;
        int wgid = (int)L; { const int q = nwg / NXCD, r = nwg % NXCD, xcd = wgid % NXCD, off = wgid / NXCD; wgid = (xcd < r ? xcd * (q + 1) : r * (q + 1) + (xcd - r) * q) + off; }
        const int nig = WGM * nN, gid = wgid / nig, fm = gid * WGM, gsz = (nM - fm) < WGM ? (nM - fm) : WGM;
        u.pm = fm + ((wgid % nig) % gsz); u.pn = (wgid % nig) / gsz; return true;
    }
    __device__ __forceinline__ void a_ready(const Unit&) const {}
    __device__ __forceinline__ void done(const Unit&) const {}
};

__device__ __forceinline__ int otid() { int t = threadIdx.x; asm volatile("" : "+v"(t)); return t; }
__device__ __forceinline__ int obid() { int t = blockIdx.x; asm volatile("" : "+s"(t)); return t; }
__device__ __forceinline__ unsigned cvt_pk_bf16(float lo, float hi) { unsigned r; asm volatile("v_cvt_pk_bf16_f32 %0, %1, %2" : "=v"(r) : "v"(lo), "v"(hi)); return r; }
__device__ __forceinline__ float bflo(unsigned w) { return __uint_as_float(w << 16); }
__device__ __forceinline__ float bfhi(unsigned w) { return __uint_as_float(w & 0xffff0000u); }
__device__ __forceinline__ float sigmoidf_(float x) { return 1.0f / (1.0f + __expf(-x)); }

struct EpiInProj {
    static constexpr bool PERM = true, AFTER_DRAIN = false;
    bf16_t *conv, *qkv, *rkv, *lora, *gate;
    __device__ __forceinline__ void operator()(const f32x4 (&acc)[2][2][4][2], const Unit& u, int wr, int wc, int fr, int fq) const {
        const int pn = u.pn; bf16_t* base; int ldc, colt;
        if (pn < 12) { base = conv; ldc = 3072; colt = pn * 256; }
        else if (pn < 24) { base = qkv; ldc = 3072; colt = (pn - 12) * 256; }
        else if (pn < 36) { base = rkv; ldc = 3072; colt = (pn - 24) * 256; }
        else if (pn < 38) { base = lora; ldc = 512; colt = (pn - 36) * 256; }
        else { base = gate; ldc = 6144; colt = (pn - 38) * 256; }
        const int row0 = u.pm * BM + wr * 64 + fr, col0 = colt + wc * 32 + 8 * fq;
#pragma unroll
        for (int ai = 0; ai < 2; ++ai)
#pragma unroll
            for (int m = 0; m < 4; ++m) { bf16_t* rowp = base + (size_t)(row0 + ai * HALF + m * 16) * ldc + col0;
#pragma unroll
                for (int bj = 0; bj < 2; ++bj) { const f32x4 v0 = acc[ai][bj][m][0], v1 = acc[ai][bj][m][1];
                    u32x4 w; w.x = cvt_pk_bf16(v0[0], v0[1]); w.y = cvt_pk_bf16(v0[2], v0[3]); w.z = cvt_pk_bf16(v1[0], v1[1]); w.w = cvt_pk_bf16(v1[2], v1[3]);
                    *(u32x4*)(rowp + bj * HALF) = w; } }
    }
};
struct EpiLora {
    static constexpr bool PERM = false, AFTER_DRAIN = false;
    float* Wd; long offA, offG; const float *w0, *a0;
    __device__ __forceinline__ void operator()(const f32x4 (&acc)[2][2][4][2], const Unit& u, int wr, int wc, int fr, int fq) const {
        const int sec = u.pn >> 2, colt = (u.pn & 3) * 256;
        float* out = Wd + (sec == 0 ? 0l : (sec == 1 ? offA : offG));
        const float* bp = sec == 0 ? w0 : a0;
        const int row0 = u.pm * BM + wr * 64 + fr, col0 = colt + wc * 32 + 4 * fq;
        f32x4 bv[2][2];
#pragma unroll
        for (int bj = 0; bj < 2; ++bj)
#pragma unroll
            for (int n = 0; n < 2; ++n) { const f32x4 t = *(const f32x4*)(bp + col0 + bj * HALF + n * 16); bv[bj][n] = sec == 2 ? (f32x4){0.f, 0.f, 0.f, 0.f} : t; }
#pragma unroll
        for (int ai = 0; ai < 2; ++ai)
#pragma unroll
            for (int m = 0; m < 4; ++m) { float* rowp = out + (size_t)(row0 + ai * HALF + m * 16) * 1024 + col0;
#pragma unroll
                for (int bj = 0; bj < 2; ++bj)
#pragma unroll
                    for (int n = 0; n < 2; ++n) { f32x4 v = acc[ai][bj][m][n] + bv[bj][n];
                        if (sec == 0) {
#pragma unroll
                            for (int j = 0; j < 4; ++j) { const float x = v[j]; const float sp = fmaxf(-x, 0.f) + __logf(1.0f + __expf(-fabsf(x)));
                                v[j] = __expf(-__expf(-sp - 0.5f)); }
                        } else if (sec == 1) {
#pragma unroll
                            for (int j = 0; j < 4; ++j) v[j] = 1.0f / (1.0f + __expf(-v[j]));
                        }
                        *(f32x4*)(rowp + bj * HALF + n * 16) = v; } }
    }
};
struct EpiGate {
    static constexpr bool PERM = true, AFTER_DRAIN = false;
    const bf16_t* gate; float* tmp; bf16_t* out;
    __device__ __forceinline__ void operator()(const f32x4 (&acc)[2][2][4][2], const Unit& u, int wr, int wc, int fr, int fq) const {
        const int mode = u.pn >> 3;
        const int row0 = (u.pm & 31) * BM + wr * 64 + fr, col0 = (u.pn & 7) * BM + wc * 32 + 8 * fq;
        const bf16_t* gp = gate + mode * 2048;
#pragma unroll
        for (int ai = 0; ai < 2; ++ai)
#pragma unroll
            for (int m = 0; m < 4; ++m) { const size_t row = (size_t)(row0 + ai * HALF + m * 16);
#pragma unroll
                for (int bj = 0; bj < 2; ++bj) { const int col = col0 + bj * HALF;
                    const u32x4 gw = *(const u32x4*)(gp + row * 6144 + col);
                    f32x4 v0 = acc[ai][bj][m][0], v1 = acc[ai][bj][m][1];
                    v0[0] *= sigmoidf_(bflo(gw.x)); v0[1] *= sigmoidf_(bfhi(gw.x)); v0[2] *= sigmoidf_(bflo(gw.y)); v0[3] *= sigmoidf_(bfhi(gw.y));
                    v1[0] *= sigmoidf_(bflo(gw.z)); v1[1] *= sigmoidf_(bfhi(gw.z)); v1[2] *= sigmoidf_(bflo(gw.w)); v1[3] *= sigmoidf_(bfhi(gw.w));
                    float* tp = tmp + row * 2048 + col;
                    if (mode != 0) { v0 += *(const f32x4*)tp; v1 += *(const f32x4*)(tp + 4); }
                    if (mode != 2) { *(f32x4*)tp = v0; *(f32x4*)(tp + 4) = v1; }
                    else { u32x4 w; w.x = cvt_pk_bf16(v0[0], v0[1]); w.y = cvt_pk_bf16(v0[2], v0[3]); w.z = cvt_pk_bf16(v1[0], v1[1]); w.w = cvt_pk_bf16(v1[2], v1[3]);
                        *(u32x4*)(out + row * 2048 + col) = w; } } }
    }
};
struct BranchOrder {
    StaticOrder so;
    __device__ __forceinline__ bool next(int i, Unit& u) const { Unit t; if (!so.next(i / 3, t)) return false; const int n = i % 3; u.pm = n * 32 + t.pm; u.pn = n * 8 + t.pn; return true; }
    __device__ __forceinline__ void a_ready(const Unit&) const {}
    __device__ __forceinline__ void done(const Unit&) const {}
};
struct EpiWo {
    static constexpr bool PERM = false, AFTER_DRAIN = false;
    const float* xin; float* out; float alpha;
    __device__ __forceinline__ void operator()(const f32x4 (&acc)[2][2][4][2], const Unit& u, int wr, int wc, int fr, int fq) const {
        const int row0 = u.pm * BM + wr * 64 + fr, col0 = u.pn * BM + wc * 32 + 4 * fq;
#pragma unroll
        for (int ai = 0; ai < 2; ++ai)
#pragma unroll
            for (int m = 0; m < 4; ++m) { const size_t off = (size_t)(row0 + ai * HALF + m * 16) * 2048 + col0;
#pragma unroll
                for (int bj = 0; bj < 2; ++bj)
#pragma unroll
                    for (int n = 0; n < 2; ++n) { const f32x4 xv = *(const f32x4*)(xin + off + bj * HALF + n * 16);
                        *(f32x4*)(out + off + bj * HALF + n * 16) = xv * alpha + acc[ai][bj][m][n]; } }
    }
};
struct EpiSwiglu {
    static constexpr bool PERM = true, AFTER_DRAIN = false;
    bf16_t* H;
    __device__ __forceinline__ void operator()(const f32x4 (&acc)[2][2][4][2], const Unit& u, int wr, int wc, int fr, int fq) const {
        const int row0 = u.pm * BM + wr * 64 + fr, col0 = (u.pn & 3) * 128 + wc * 32 + 8 * fq;
#pragma unroll
        for (int ai = 0; ai < 2; ++ai)
#pragma unroll
            for (int m = 0; m < 4; ++m) { bf16_t* rowp = H + (size_t)(row0 + ai * HALF + m * 16) * 512 + col0;
                float h[8];
#pragma unroll
                for (int n = 0; n < 2; ++n)
#pragma unroll
                    for (int j = 0; j < 4; ++j) { const float g = acc[ai][0][m][n][j], up = acc[ai][1][m][n][j]; h[n * 4 + j] = g * sigmoidf_(g) * up; }
                u32x4 w; w.x = cvt_pk_bf16(h[0], h[1]); w.y = cvt_pk_bf16(h[2], h[3]); w.z = cvt_pk_bf16(h[4], h[5]); w.w = cvt_pk_bf16(h[6], h[7]);
                *(u32x4*)rowp = w; }
    }
};
struct EpiDown {
    static constexpr bool PERM = true, AFTER_DRAIN = false;
    bf16_t* Y; const float* roww;
    __device__ __forceinline__ void operator()(const f32x4 (&acc)[2][2][4][2], const Unit& u, int wr, int wc, int fr, int fq) const {
        const int row0 = u.pm * BM + wr * 64 + fr, col0 = (u.pn & 7) * 256 + wc * 32 + 8 * fq;
#pragma unroll
        for (int ai = 0; ai < 2; ++ai)
#pragma unroll
            for (int m = 0; m < 4; ++m) { const int row = row0 + ai * HALF + m * 16; const float s = roww[row]; bf16_t* rowp = Y + (size_t)row * 2048 + col0;
#pragma unroll
                for (int bj = 0; bj < 2; ++bj) { const f32x4 v0 = acc[ai][bj][m][0] * s, v1 = acc[ai][bj][m][1] * s;
                    u32x4 w; w.x = cvt_pk_bf16(v0[0], v0[1]); w.y = cvt_pk_bf16(v0[2], v0[3]); w.z = cvt_pk_bf16(v1[0], v1[1]); w.w = cvt_pk_bf16(v1[2], v1[3]);
                    *(u32x4*)(rowp + bj * HALF) = w; } }
    }
};
struct MoeOrder {
    const int* seg; int ntiles, npn, G, c;
    __device__ __forceinline__ bool next(int i, Unit& u) const {
        const long L = (long)i * G + c; if (L >= (long)ntiles * npn) return false;
        const int pm = (int)(L / npn), pl = (int)(L % npn); u.pm = pm; u.pn = __builtin_amdgcn_readfirstlane(__hip_atomic_load(seg + pm, __ATOMIC_RELAXED, __HIP_MEMORY_SCOPE_AGENT)) * npn + pl; return true;
    }
    __device__ __forceinline__ void a_ready(const Unit&) const {}
    __device__ __forceinline__ void done(const Unit&) const {}
};
template <class Epi, class Sched, bool ALIGN_EPI = false, bool SP2 = false>
__device__ __forceinline__ void gemm_phase(PG8_LAS unsigned char* lds, const Gemm g, const Sched& S, const Epi& E) {
    const int tid = otid(), wid = __builtin_amdgcn_readfirstlane(tid >> 6), lane = tid & 63, wr = wid >> 2, wc = wid & 3, fr = lane & 15, fq = lane >> 4;
    const int K = g.K, nt = K / BK;
    unsigned voffA[2], voffB[2];
#pragma unroll
    for (int i = 0; i < 2; ++i) { int R, C; stage_rc(tid * 16 + i * 8192, R, C); const int Rb = Epi::PERM ? ((R & ~31) + perm32(R & 31)) : R;
        voffA[i] = (unsigned)(R * K + C) * 2u; voffB[i] = (unsigned)(Rb * K + C) * 2u; }
    const size_t kstep = (size_t)(BK * 2);
    const size_t hstep = (size_t)HALF * K * 2;
    const size_t tstep = 2 * hstep;
    const unsigned ldsw = (unsigned)wid * 1024u;
    const int aoff = lds_byte(wr * 64 + fr, fq * 8), boff = lds_byte(wc * 32 + fr, fq * 8);
#define PG8_SA(b, h) (((b) * 2 + (h)) * HTB)
#define PG8_SB(b, h) ((4 + (b) * 2 + (h)) * HTB)
#define PG8_STAGE(bufoff, gbase, voff) do { _Pragma("unroll") for (int _i = 0; _i < 2; ++_i) \
        __builtin_amdgcn_global_load_lds((const unsigned*)((const char*)(gbase) + (voff)[_i]), (PG8_LAS unsigned*)(lds + (bufoff) + ldsw + _i * 8192), 16, 0, 0); } while (0)
#define PG8_LDA(dst, b, h) do { _Pragma("unroll") for (int m = 0; m < 4; ++m) _Pragma("unroll") for (int k = 0; k < 2; ++k) dst[m][k] = *(const PG8_LAS bf16x8*)(lds + PG8_SA(b, h) + aoff + m * 2048 + k * 1024); } while (0)
#define PG8_LDB(dst, b, h) do { _Pragma("unroll") for (int n = 0; n < 2; ++n) _Pragma("unroll") for (int k = 0; k < 2; ++k) dst[n][k] = *(const PG8_LAS bf16x8*)(lds + PG8_SB(b, h) + boff + n * 2048 + k * 1024); } while (0)
#define PG8_MMA(ai, bj, At, Bt) do { __builtin_amdgcn_s_setprio(1); _Pragma("unroll") for (int m = 0; m < 4; ++m) _Pragma("unroll") for (int n = 0; n < 2; ++n) _Pragma("unroll") for (int k = 0; k < 2; ++k) \
        acc[ai][bj][m][n] = __builtin_amdgcn_mfma_f32_16x16x32_bf16(Bt[n][k], At[m][k], acc[ai][bj][m][n], 0, 0, 0); __builtin_amdgcn_s_setprio(0); } while (0)
#define PG8_WAIT_V(n) asm volatile("s_waitcnt vmcnt(" #n ")" ::: "memory")
#define PG8_WAIT_L(n) asm volatile("s_waitcnt lgkmcnt(" #n ")" ::: "memory")
#define PG8_BAR __builtin_amdgcn_s_barrier()
#define PG8_SCHED __builtin_amdgcn_sched_barrier(0)
    Unit cur, nxt; int ui = 0;
    if (!S.next(0, cur)) return;
    f32x4 acc[2][2][4][2];
#pragma unroll
    for (int a = 0; a < 2; ++a)
#pragma unroll
        for (int b = 0; b < 2; ++b)
#pragma unroll
            for (int m = 0; m < 4; ++m)
#pragma unroll
                for (int n = 0; n < 2; ++n) acc[a][b][m][n] = (f32x4){0.f, 0.f, 0.f, 0.f};
    bf16x8 At[4][2], B0[2][2], B1[2][2];
    const char* cA = (const char*)g.A + (size_t)cur.pm * tstep; const char* cB = (const char*)g.Bt + (size_t)cur.pn * tstep;
    S.a_ready(cur);
    if constexpr (SP2) {
        PG8_STAGE(PG8_SB(0, 0), cB, voffB); PG8_STAGE(PG8_SB(0, 1), cB + hstep, voffB); PG8_STAGE(PG8_SA(0, 0), cA, voffA); PG8_STAGE(PG8_SA(0, 1), cA + hstep, voffA);
        if (wr == 1) PG8_BAR;
        PG8_WAIT_V(2); PG8_BAR;
        PG8_STAGE(PG8_SB(1, 0), cB + kstep, voffB); PG8_STAGE(PG8_SA(1, 0), cA + kstep, voffA); PG8_STAGE(PG8_SB(1, 1), cB + hstep + kstep, voffB);
        PG8_WAIT_V(6); PG8_BAR;
    } else {
        PG8_STAGE(PG8_SB(0, 0), cB, voffB); PG8_STAGE(PG8_SA(0, 0), cA, voffA); PG8_STAGE(PG8_SB(0, 1), cB + hstep, voffB); PG8_STAGE(PG8_SA(0, 1), cA + hstep, voffA);
        if (wr == 1) PG8_BAR;
        PG8_WAIT_V(4); PG8_BAR;
        PG8_STAGE(PG8_SB(1, 0), cB + kstep, voffB); PG8_STAGE(PG8_SA(1, 0), cA + kstep, voffA); PG8_STAGE(PG8_SB(1, 1), cB + hstep + kstep, voffB);
        PG8_WAIT_V(6); PG8_BAR;
    }
    for (;;) {
        const bool has_next = S.next(ui + 1, nxt);
        const char* nA = has_next ? (const char*)g.A + (size_t)nxt.pm * tstep : cA; const char* nB = has_next ? (const char*)g.Bt + (size_t)nxt.pn * tstep : cB;
        for (int t = 0; t < nt; t += 2) {
            const bool last = (t == nt - 2);
            const char* a1 = cA + (size_t)(t + 1) * kstep;
            const char* a2 = last ? nA : cA + (size_t)(t + 2) * kstep; const char* b2 = last ? nB : cB + (size_t)(t + 2) * kstep;
            const char* a3 = a2 + kstep; const char* b3 = b2 + kstep;
            if (last && has_next) S.a_ready(nxt);
            if constexpr (SP2) {
            PG8_LDB(B0, 0, 0); PG8_LDB(B1, 0, 1); PG8_SCHED; PG8_LDA(At, 0, 0); PG8_STAGE(PG8_SA(1, 1), a1 + hstep, voffA);
            PG8_WAIT_V(8); PG8_WAIT_L(0); PG8_BAR; PG8_MMA(0, 0, At, B0); PG8_MMA(0, 1, At, B1); PG8_BAR; PG8_SCHED;
            PG8_LDA(At, 0, 1); PG8_STAGE(PG8_SB(0, 0), b2, voffB); PG8_STAGE(PG8_SB(0, 1), b2 + hstep, voffB); PG8_STAGE(PG8_SA(0, 0), a2, voffA);
            PG8_WAIT_V(8); PG8_WAIT_L(0); PG8_BAR; PG8_MMA(1, 0, At, B0); PG8_MMA(1, 1, At, B1); PG8_BAR; PG8_SCHED;
            PG8_LDB(B0, 1, 0); PG8_LDB(B1, 1, 1); PG8_SCHED; PG8_LDA(At, 1, 0); PG8_STAGE(PG8_SA(0, 1), a2 + hstep, voffA);
            PG8_WAIT_V(8); PG8_WAIT_L(0); PG8_BAR; PG8_MMA(0, 0, At, B0); PG8_MMA(0, 1, At, B1); PG8_BAR; PG8_SCHED;
            PG8_LDA(At, 1, 1); PG8_STAGE(PG8_SB(1, 0), b3, voffB); PG8_STAGE(PG8_SB(1, 1), b3 + hstep, voffB); PG8_STAGE(PG8_SA(1, 0), a3, voffA);
            PG8_WAIT_V(8); PG8_WAIT_L(0); PG8_BAR; PG8_MMA(1, 0, At, B0); PG8_MMA(1, 1, At, B1); PG8_BAR; PG8_SCHED;
            } else {
            PG8_LDB(B0, 0, 0); PG8_SCHED; PG8_LDA(At, 0, 0); PG8_STAGE(PG8_SA(1, 1), a1 + hstep, voffA);
            PG8_WAIT_L(8); PG8_BAR; PG8_WAIT_L(0); PG8_MMA(0, 0, At, B0); PG8_BAR; PG8_SCHED;
            PG8_LDB(B1, 0, 1); PG8_STAGE(PG8_SB(0, 0), b2, voffB);
            PG8_BAR; PG8_WAIT_L(0); PG8_MMA(0, 1, At, B1); PG8_BAR;
            PG8_LDA(At, 0, 1); PG8_STAGE(PG8_SA(0, 0), a2, voffA);
            PG8_BAR; PG8_WAIT_L(0); PG8_MMA(1, 0, At, B0); PG8_BAR; PG8_SCHED;
            PG8_STAGE(PG8_SB(0, 1), b2 + hstep, voffB);
            PG8_WAIT_V(6); PG8_BAR; PG8_MMA(1, 1, At, B1); PG8_BAR;
            PG8_LDB(B0, 1, 0); PG8_SCHED; PG8_LDA(At, 1, 0); PG8_STAGE(PG8_SA(0, 1), a2 + hstep, voffA);
            PG8_WAIT_L(8); PG8_BAR; PG8_WAIT_L(0); PG8_MMA(0, 0, At, B0); PG8_BAR; PG8_SCHED;
            PG8_LDB(B1, 1, 1); PG8_STAGE(PG8_SB(1, 0), b3, voffB);
            PG8_BAR; PG8_WAIT_L(0); PG8_MMA(0, 1, At, B1); PG8_BAR;
            PG8_LDA(At, 1, 1); PG8_STAGE(PG8_SA(1, 0), a3, voffA);
            PG8_BAR; PG8_WAIT_L(0); PG8_MMA(1, 0, At, B0); PG8_BAR; PG8_SCHED;
            PG8_STAGE(PG8_SB(1, 1), b3 + hstep, voffB);
            PG8_WAIT_V(6); PG8_BAR; PG8_MMA(1, 1, At, B1); PG8_BAR;
            }
        }
        if constexpr (ALIGN_EPI) { if (wr == 0) PG8_BAR; }
        if constexpr (!Epi::AFTER_DRAIN) { E(acc, cur, wr, wc, fr, fq); S.done(cur); }
        if (!has_next) break;
#pragma unroll
        for (int a = 0; a < 2; ++a)
#pragma unroll
            for (int b = 0; b < 2; ++b)
#pragma unroll
                for (int m = 0; m < 4; ++m)
#pragma unroll
                    for (int n = 0; n < 2; ++n) acc[a][b][m][n] = (f32x4){0.f, 0.f, 0.f, 0.f};
        cur = nxt; cA = nA; cB = nB; ++ui;
        if constexpr (ALIGN_EPI) { if (wr == 1) PG8_BAR; }
    }
    PG8_WAIT_V(0);
    if constexpr (!ALIGN_EPI) { if (wr == 0) PG8_BAR; }
    PG8_BAR;
    if constexpr (Epi::AFTER_DRAIN) { E.fused(acc, cur, wr, wc, fr, fq, lds, wid, lane); S.done(cur); }
#undef PG8_SA
#undef PG8_SB
#undef PG8_STAGE
#undef PG8_LDA
#undef PG8_LDB
#undef PG8_MMA
#undef PG8_WAIT_V
#undef PG8_WAIT_L
#undef PG8_BAR
#undef PG8_SCHED
}

template <class Epi, class Sched, bool ALIGN_EPI = false, bool SP2 = true>
__device__ __forceinline__ void gemm_phase_gather(PG8_LAS unsigned char* lds, const Gemm g, const Sched& S, const Epi& E, const int* rowtab) {
    static_assert(SP2, "gather variant: SP2 loop only");
    const int tid = otid(), wid = __builtin_amdgcn_readfirstlane(tid >> 6), lane = tid & 63, wr = wid >> 2, wc = wid & 3, fr = lane & 15, fq = lane >> 4;
    const int K = g.K, nt = K / BK;
    unsigned voffA[2], voffB[2]; int RA[2]; unsigned CA[2];
#pragma unroll
    for (int i = 0; i < 2; ++i) { int R, C; stage_rc(tid * 16 + i * 8192, R, C); const int Rb = Epi::PERM ? ((R & ~31) + perm32(R & 31)) : R;
        voffA[i] = (unsigned)(R * K + C) * 2u; voffB[i] = (unsigned)(Rb * K + C) * 2u; RA[i] = R; CA[i] = (unsigned)C * 2u; }
    unsigned gA[4], gN[4];
#define PG8_GLOAD(G, pm_) do { _Pragma("unroll") for (int h_ = 0; h_ < 2; ++h_) _Pragma("unroll") for (int i_ = 0; i_ < 2; ++i_) \
        G[2 * h_ + i_] = (unsigned)rowtab[(pm_) * BM + h_ * HALF + RA[i_]] * (unsigned)(K * 2) + CA[i_]; } while (0)
#define PG8_STAGEG(bufoff, gbase, G, h_) do { _Pragma("unroll") for (int _i = 0; _i < 2; ++_i) \
        __builtin_amdgcn_global_load_lds((const unsigned*)((const char*)(gbase) + G[2 * (h_) + _i]), (PG8_LAS unsigned*)(lds + (bufoff) + ldsw + _i * 8192), 16, 0, 0); } while (0)
    const size_t kstep = (size_t)(BK * 2);
    const size_t hstep = (size_t)HALF * K * 2;
    const size_t tstep = 2 * hstep;
    const unsigned ldsw = (unsigned)wid * 1024u;
    const int aoff = lds_byte(wr * 64 + fr, fq * 8), boff = lds_byte(wc * 32 + fr, fq * 8);
#define PG8_SA(b, h) (((b) * 2 + (h)) * HTB)
#define PG8_SB(b, h) ((4 + (b) * 2 + (h)) * HTB)
#define PG8_STAGE(bufoff, gbase, voff) do { _Pragma("unroll") for (int _i = 0; _i < 2; ++_i) \
        __builtin_amdgcn_global_load_lds((const unsigned*)((const char*)(gbase) + (voff)[_i]), (PG8_LAS unsigned*)(lds + (bufoff) + ldsw + _i * 8192), 16, 0, 0); } while (0)
#define PG8_LDA(dst, b, h) do { _Pragma("unroll") for (int m = 0; m < 4; ++m) _Pragma("unroll") for (int k = 0; k < 2; ++k) dst[m][k] = *(const PG8_LAS bf16x8*)(lds + PG8_SA(b, h) + aoff + m * 2048 + k * 1024); } while (0)
#define PG8_LDB(dst, b, h) do { _Pragma("unroll") for (int n = 0; n < 2; ++n) _Pragma("unroll") for (int k = 0; k < 2; ++k) dst[n][k] = *(const PG8_LAS bf16x8*)(lds + PG8_SB(b, h) + boff + n * 2048 + k * 1024); } while (0)
#define PG8_MMA(ai, bj, At, Bt) do { __builtin_amdgcn_s_setprio(1); _Pragma("unroll") for (int m = 0; m < 4; ++m) _Pragma("unroll") for (int n = 0; n < 2; ++n) _Pragma("unroll") for (int k = 0; k < 2; ++k) \
        acc[ai][bj][m][n] = __builtin_amdgcn_mfma_f32_16x16x32_bf16(Bt[n][k], At[m][k], acc[ai][bj][m][n], 0, 0, 0); __builtin_amdgcn_s_setprio(0); } while (0)
#define PG8_WAIT_V(n) asm volatile("s_waitcnt vmcnt(" #n ")" ::: "memory")
#define PG8_WAIT_L(n) asm volatile("s_waitcnt lgkmcnt(" #n ")" ::: "memory")
#define PG8_BAR __builtin_amdgcn_s_barrier()
#define PG8_SCHED __builtin_amdgcn_sched_barrier(0)
    Unit cur, nxt; int ui = 0;
    if (!S.next(0, cur)) return;
    f32x4 acc[2][2][4][2];
#pragma unroll
    for (int a = 0; a < 2; ++a)
#pragma unroll
        for (int b = 0; b < 2; ++b)
#pragma unroll
            for (int m = 0; m < 4; ++m)
#pragma unroll
                for (int n = 0; n < 2; ++n) acc[a][b][m][n] = (f32x4){0.f, 0.f, 0.f, 0.f};
    bf16x8 At[4][2], B0[2][2], B1[2][2];
    const char* A0 = (const char*)g.A; const char* cB = (const char*)g.Bt + (size_t)cur.pn * tstep;
    PG8_GLOAD(gA, cur.pm);
    S.a_ready(cur);
    if constexpr (SP2) {
        PG8_STAGE(PG8_SB(0, 0), cB, voffB); PG8_STAGE(PG8_SB(0, 1), cB + hstep, voffB); PG8_STAGEG(PG8_SA(0, 0), A0, gA, 0); PG8_STAGEG(PG8_SA(0, 1), A0, gA, 1);
        if (wr == 1) PG8_BAR;
        PG8_WAIT_V(2); PG8_BAR;
        PG8_STAGE(PG8_SB(1, 0), cB + kstep, voffB); PG8_STAGEG(PG8_SA(1, 0), A0 + kstep, gA, 0); PG8_STAGE(PG8_SB(1, 1), cB + hstep + kstep, voffB);
        PG8_WAIT_V(6); PG8_BAR;
    } else {
        ;
    }
    for (;;) {
        const bool has_next = S.next(ui + 1, nxt);
        const char* nB = has_next ? (const char*)g.Bt + (size_t)nxt.pn * tstep : cB;
        if (has_next) PG8_GLOAD(gN, nxt.pm); else { gN[0] = gA[0]; gN[1] = gA[1]; gN[2] = gA[2]; gN[3] = gA[3]; }
        for (int t = 0; t < nt; t += 2) {
            const bool last = (t == nt - 2);
            const char* a1 = A0 + (size_t)(t + 1) * kstep;
            const char* a2 = last ? A0 : A0 + (size_t)(t + 2) * kstep; const char* b2 = last ? nB : cB + (size_t)(t + 2) * kstep;
            unsigned gs[4] = {gA[0], gA[1], gA[2], gA[3]};
            if (last) { gs[0] = gN[0]; gs[1] = gN[1]; gs[2] = gN[2]; gs[3] = gN[3]; }
            const char* a3 = a2 + kstep; const char* b3 = b2 + kstep;
            if (last && has_next) S.a_ready(nxt);
            if constexpr (SP2) {
            PG8_LDB(B0, 0, 0); PG8_LDB(B1, 0, 1); PG8_SCHED; PG8_LDA(At, 0, 0); PG8_STAGEG(PG8_SA(1, 1), a1, gA, 1);
            PG8_WAIT_V(8); PG8_WAIT_L(0); PG8_BAR; PG8_MMA(0, 0, At, B0); PG8_MMA(0, 1, At, B1); PG8_BAR; PG8_SCHED;
            PG8_LDA(At, 0, 1); PG8_STAGE(PG8_SB(0, 0), b2, voffB); PG8_STAGE(PG8_SB(0, 1), b2 + hstep, voffB); PG8_STAGEG(PG8_SA(0, 0), a2, gs, 0);
            PG8_WAIT_V(8); PG8_WAIT_L(0); PG8_BAR; PG8_MMA(1, 0, At, B0); PG8_MMA(1, 1, At, B1); PG8_BAR; PG8_SCHED;
            PG8_LDB(B0, 1, 0); PG8_LDB(B1, 1, 1); PG8_SCHED; PG8_LDA(At, 1, 0); PG8_STAGEG(PG8_SA(0, 1), a2, gs, 1);
            PG8_WAIT_V(8); PG8_WAIT_L(0); PG8_BAR; PG8_MMA(0, 0, At, B0); PG8_MMA(0, 1, At, B1); PG8_BAR; PG8_SCHED;
            PG8_LDA(At, 1, 1); PG8_STAGE(PG8_SB(1, 0), b3, voffB); PG8_STAGE(PG8_SB(1, 1), b3 + hstep, voffB); PG8_STAGEG(PG8_SA(1, 0), a3, gs, 0);
            PG8_WAIT_V(8); PG8_WAIT_L(0); PG8_BAR; PG8_MMA(1, 0, At, B0); PG8_MMA(1, 1, At, B1); PG8_BAR; PG8_SCHED;
            }
        }
        if constexpr (ALIGN_EPI) { if (wr == 0) PG8_BAR; }
        if constexpr (!Epi::AFTER_DRAIN) { E(acc, cur, wr, wc, fr, fq); S.done(cur); }
        if (!has_next) break;
#pragma unroll
        for (int a = 0; a < 2; ++a)
#pragma unroll
            for (int b = 0; b < 2; ++b)
#pragma unroll
                for (int m = 0; m < 4; ++m)
#pragma unroll
                    for (int n = 0; n < 2; ++n) acc[a][b][m][n] = (f32x4){0.f, 0.f, 0.f, 0.f};
        cur = nxt; cB = nB; ++ui; gA[0] = gN[0]; gA[1] = gN[1]; gA[2] = gN[2]; gA[3] = gN[3];
        if constexpr (ALIGN_EPI) { if (wr == 1) PG8_BAR; }
    }
    PG8_WAIT_V(0);
    if constexpr (!ALIGN_EPI) { if (wr == 0) PG8_BAR; }
    PG8_BAR;
    if constexpr (Epi::AFTER_DRAIN) { E.fused(acc, cur, wr, wc, fr, fq, lds, wid, lane); S.done(cur); }
#undef PG8_SA
#undef PG8_SB
#undef PG8_STAGE
#undef PG8_STAGEG
#undef PG8_GLOAD
#undef PG8_LDA
#undef PG8_LDB
#undef PG8_MMA
#undef PG8_WAIT_V
#undef PG8_WAIT_L
#undef PG8_BAR
#undef PG8_SCHED
}
}

constexpr int NTOK = 8192, SEQ = 4096, DM = 2048, NLAYER = 2;
constexpr int IN_COLS = 15808, INP = 15872;
constexpr int NSEG = 65;
constexpr int XS_ROWS = 8192 + 65536 + 64 * 256;
constexpr int NPHASE = 16;
constexpr float LN_EPS = 1e-5f, GN_EPS = 64e-5f, ALPHA = 1.4142135623730951f  , ROUTED_SCALE = 2.5f;

constexpr size_t MiB = 1u << 20, KiB = 1u << 10;
constexpr size_t WS_CTL = 0, CTL_ZERO_BYTES = 1 * MiB;
constexpr size_t WS_HIST = 1 * MiB;
constexpr size_t WS_SELE = WS_HIST + 64 * KiB;
constexpr size_t WS_SELW = WS_SELE + 256 * KiB;
constexpr size_t WS_SLOT = WS_SELW + 256 * KiB;
constexpr size_t WS_ROWW = WS_SLOT + 256 * KiB;
constexpr size_t WS_TSEG = WS_ROWW + 352 * KiB;
constexpr size_t WS_BON = WS_TSEG + 4 * KiB;
constexpr size_t WS_ROWT = WS_BON + 576 * KiB;
constexpr size_t WS_WIN = 4 * MiB;
constexpr size_t WS_WLORA = 66 * MiB;
constexpr size_t WS_WBR = 69 * MiB;
constexpr size_t WS_WO = 81 * MiB;
constexpr size_t WS_WGU = 89 * MiB;
constexpr size_t WS_WD = 349 * MiB;
constexpr size_t WS_XB = 479 * MiB;
constexpr size_t WS_MERGED = 511 * MiB;
constexpr size_t WS_PRELN = 543 * MiB;
constexpr size_t WS_X1 = 607 * MiB;
constexpr size_t WS_X2 = 671 * MiB;
constexpr size_t WS_M = 735 * MiB;
constexpr size_t WS_PCONV = WS_M, WS_PQKV = WS_M + 48 * MiB, WS_PRKV = WS_M + 96 * MiB, WS_PLORA = WS_M + 144 * MiB, WS_PGATE = WS_M + 152 * MiB;
constexpr size_t WS_YBR = WS_M + 248 * MiB;
constexpr size_t WS_LORAA = WS_M + 296 * MiB;
constexpr size_t WS_RWR = WS_M + 304 * MiB, WS_RWW = WS_RWR + 32 * MiB, WS_RWK = WS_RWW + 32 * MiB, WS_RWV = WS_RWK + 32 * MiB, WS_RWKK = WS_RWV + 32 * MiB,
                 WS_RWB = WS_RWKK + 32 * MiB, WS_RWA = WS_RWB + 32 * MiB, WS_RWG = WS_RWA + 32 * MiB, WS_RWY = WS_RWG + 32 * MiB;
constexpr size_t WS_XS = WS_M;
constexpr size_t WS_H = WS_XS + 352 * MiB;
constexpr size_t WS_YS = WS_H + 88 * MiB;
constexpr size_t WS_END = WS_YS + 352 * MiB;
static_assert(WS_RWY + 32 * MiB <= WS_END && (size_t)XS_ROWS * 2048 * 2 == 352 * MiB && (size_t)XS_ROWS * 512 * 2 == 88 * MiB, "ws map");
static_assert(WS_ROWT + 352 * KiB <= WS_WIN && WS_WIN + (size_t)INP * 2048 * 2 <= WS_WLORA && WS_WGU + (size_t)65 * 1024 * 2048 * 2 <= WS_WD && WS_WD + (size_t)65 * 2048 * 512 * 2 <= WS_XB, "ws map 2");
constexpr int CW_TMO = 0, CW_BAR = 4096;

constexpr int RING_OFF = 0, RING_BYTES = 131072;
constexpr int LDS_BYTES = 147456;
constexpr int LDSCTL_OFF = LDS_BYTES - 1024, MISC_OFF = LDSCTL_OFF + 320;
constexpr int NWAVES = 8;

#define GAS __attribute__((address_space(1)))
#define LAS __attribute__((address_space(3)))
typedef unsigned short bf16;
typedef unsigned v4u __attribute__((ext_vector_type(4)));
typedef unsigned v2u __attribute__((ext_vector_type(2)));
typedef float f32x4 __attribute__((ext_vector_type(4)));
typedef float f32x16 __attribute__((ext_vector_type(16)));
typedef short bf16x8 __attribute__((ext_vector_type(8)));
typedef short s16x4 __attribute__((ext_vector_type(4)));
typedef GAS unsigned gu32;
#define RLX_AGENT __ATOMIC_RELAXED, __HIP_MEMORY_SCOPE_AGENT
#define LDS_WAIT() asm volatile("s_waitcnt lgkmcnt(0)" ::: "memory")
#define VM_WAIT() asm volatile("s_waitcnt vmcnt(0)" ::: "memory")
__device__ __forceinline__ unsigned f2bf(float f) { unsigned u = __builtin_bit_cast(unsigned, f); return (u + 0x7fffu + ((u >> 16) & 1u)) >> 16; }
__device__ __forceinline__ unsigned pk2(float lo, float hi) { return f2bf(lo) | (f2bf(hi) << 16); }
__device__ __forceinline__ float bf2f(bf16 b) { return __uint_as_float((unsigned)b << 16); }
__device__ __forceinline__ float blo(unsigned w) { return __uint_as_float(w << 16); }
__device__ __forceinline__ float bhi(unsigned w) { return __uint_as_float(w & 0xffff0000u); }
__device__ __forceinline__ int ld_i32(const int* p) { return __hip_atomic_load(p, RLX_AGENT); }
__device__ __forceinline__ float ld_f32(const float* p) { return __hip_atomic_load(p, RLX_AGENT); }

#define XB_TMO      128
#define XB_XCNT(j)  (256  + 64 * (j))
#define XB_XSUB(j)  (1280 + 64 * (j))
#define XB_XGEN(j)  (2304 + 64 * (j))
#define XB_TOP      3328
#define XB_TOPGEN   3392
#define XCD_BAR_WORDS 3456
#define XB_SPIN_CAP (1u << 18)

__device__ __forceinline__ unsigned xb_ld(unsigned* p)              { return __hip_atomic_load(p, __ATOMIC_RELAXED, __HIP_MEMORY_SCOPE_AGENT); }
__device__ __forceinline__ unsigned xb_add(unsigned* p, unsigned v) { return __hip_atomic_fetch_add(p, v, __ATOMIC_RELAXED, __HIP_MEMORY_SCOPE_AGENT); }
__device__ __forceinline__ unsigned xb_xcc_id() { return (unsigned)__builtin_amdgcn_s_getreg((3 << 11) | 20) & 0xFu; }
#define XB_SPIN(cond, bar) do { unsigned _sp = 0; while (cond) { __builtin_amdgcn_s_sleep(1); \
    if ((++_sp & 255u) == 0u) { if (xb_ld(&(bar)[XB_TMO])) break; if (_sp > XB_SPIN_CAP) { atomicAdd(&(bar)[XB_TMO], 1u); break; } } } } while (0)

struct XcdBarrier {
    unsigned* bar; unsigned x;
    volatile LAS unsigned* st;
};

__device__ __forceinline__ XcdBarrier xcd_barrier_post(unsigned* bar, volatile LAS unsigned* st) {
    XcdBarrier b; b.bar = bar; b.x = xb_xcc_id(); b.st = st;
    if (threadIdx.x == 0) (void)xb_add(&bar[XB_XCNT(b.x)], 1u);
    return b;
}
__device__ __forceinline__ void xcd_barrier_complete(unsigned* bar, unsigned x, unsigned& nloc, unsigned& nx) {
    const unsigned G = gridDim.x * gridDim.y * gridDim.z;
    unsigned sum, cnt, mine, sp = 0u;
    for (;;) {
        sum = 0u; cnt = 0u; mine = 0u;
#pragma unroll
        for (unsigned j = 0; j < 16; ++j) { const unsigned c = xb_ld(&bar[XB_XCNT(j)]); sum += c; cnt += (c > 0u) ? 1u : 0u; mine = (j == x) ? c : mine; }
        if (sum == G) break;
        __builtin_amdgcn_s_sleep(1);
        if ((++sp & 255u) == 0u) { if (xb_ld(&bar[XB_TMO])) break; if (sp > XB_SPIN_CAP) { atomicAdd(&bar[XB_TMO], 1u); break; } }
    }
    nloc = mine > 0u ? mine : 1u; nx = cnt > 0u ? cnt : 1u;
}

__device__ __forceinline__ void xcd_barrier(const XcdBarrier& b) {
    asm volatile("s_waitcnt vmcnt(0)" ::: "memory");
    __syncthreads();
    if (threadIdx.x == 0) {
        unsigned* bar = b.bar;
        __builtin_amdgcn_s_waitcnt(0);
        unsigned nloc = b.st[0], nx = b.st[1];
        if (nloc == 0u) { xcd_barrier_complete(bar, b.x, nloc, nx); b.st[0] = nloc; b.st[1] = nx; }
        const unsigned old = xb_add(&bar[XB_XSUB(b.x)], 1u);
        const unsigned gen = old / nloc;
        if (old + 1u == (gen + 1u) * nloc) {
            __builtin_amdgcn_fence(__ATOMIC_RELEASE, "agent");
            asm volatile("s_waitcnt vmcnt(0)" ::: "memory");
            const unsigned og = xb_add(&bar[XB_TOP], 1u);
            const unsigned tg = og / nx;
            if (og + 1u == (tg + 1u) * nx) xb_add(&bar[XB_TOPGEN], 1u);
            else XB_SPIN(xb_ld(&bar[XB_TOPGEN]) == tg, bar);
            __builtin_amdgcn_fence(__ATOMIC_ACQUIRE, "agent");
            xb_add(&bar[XB_XGEN(b.x)], 1u);
            asm volatile("s_waitcnt vmcnt(0)" ::: "memory");
        } else {
            XB_SPIN(xb_ld(&bar[XB_XGEN(b.x)]) == gen, bar);
            __builtin_amdgcn_fence(__ATOMIC_ACQUIRE, "agent");
            asm volatile("s_waitcnt vmcnt(0)" ::: "memory");
        }
    }
    __syncthreads();
}

struct Args { const float* in[28]; float* out; unsigned char* ws; int ph_lo, ph_hi, li, pad; };
typedef const __attribute__((address_space(4))) Args* KArgs;
struct Frame {
    LAS unsigned char* lds;
    volatile LAS unsigned* MISC;
    gu32* ctl;
    unsigned char* ws;
    int tid, lane, wave, vcu, G;
};
__device__ __forceinline__ float wave_sum(float v) {
#pragma unroll
    for (int o = 1; o < 64; o <<= 1) v += __shfl_xor(v, o);
    return v;
}
__device__ __forceinline__ float dpp16(float v) {
    v += __builtin_bit_cast(float, __builtin_amdgcn_update_dpp(0, __builtin_bit_cast(int, v), 0xB1, 0xF, 0xF, true));
    v += __builtin_bit_cast(float, __builtin_amdgcn_update_dpp(0, __builtin_bit_cast(int, v), 0x4E, 0xF, 0xF, true));
    v += __builtin_bit_cast(float, __builtin_amdgcn_update_dpp(0, __builtin_bit_cast(int, v), 0x141, 0xF, 0xF, true));
    v += __builtin_bit_cast(float, __builtin_amdgcn_update_dpp(0, __builtin_bit_cast(int, v), 0x140, 0xF, 0xF, true));
    return v;
}
__device__ __forceinline__ v4u pack8(const float* v) { v4u o; o.x = pk2(v[0], v[1]); o.y = pk2(v[2], v[3]); o.z = pk2(v[4], v[5]); o.w = pk2(v[6], v[7]); return o; }
__device__ __forceinline__ void unpack8(v4u w, float* v) { v[0] = blo(w.x); v[1] = bhi(w.x); v[2] = blo(w.y); v[3] = bhi(w.y); v[4] = blo(w.z); v[5] = bhi(w.z); v[6] = blo(w.w); v[7] = bhi(w.w); }

struct TrItem { const float* src; bf16* dst; int ldn, k0, n0, Kd; };
__device__ __forceinline__ void tr_issue(const TrItem& d, int lane, float (&hv)[32]) {
    const float* base = d.src + (size_t)d.k0 * d.ldn + d.n0;
    const unsigned off = (unsigned)(lane >> 3) * (unsigned)d.ldn + 4u * (unsigned)(lane & 7), step = 8u * (unsigned)d.ldn;
#pragma unroll
    for (int i = 0; i < 8; ++i) { const f32x4 v = *(const f32x4*)(base + (off + (unsigned)i * step)); hv[4 * i] = v[0]; hv[4 * i + 1] = v[1]; hv[4 * i + 2] = v[2]; hv[4 * i + 3] = v[3]; }
}
__device__ __forceinline__ void tr_finish(const TrItem& d, int lane, const float (&hv)[32], LAS float* scr) {
    { LAS float* w = scr + (lane >> 3) * 33 + 4 * (lane & 7);
#pragma unroll
      for (int i = 0; i < 8; ++i) { w[i * 8 * 33] = hv[4 * i]; w[i * 8 * 33 + 1] = hv[4 * i + 1]; w[i * 8 * 33 + 2] = hv[4 * i + 2]; w[i * 8 * 33 + 3] = hv[4 * i + 3]; } }
    LDS_WAIT(); asm volatile("" ::: "memory");
    const int c = lane & 7;
#pragma unroll
    for (int j = 0; j < 4; ++j) { const int n = (lane >> 3) + 8 * j; const LAS float* s = scr + (8 * c) * 33 + n;
        v4u o; o.x = pg8::cvt_pk_bf16(s[0 * 33], s[1 * 33]); o.y = pg8::cvt_pk_bf16(s[2 * 33], s[3 * 33]); o.z = pg8::cvt_pk_bf16(s[4 * 33], s[5 * 33]); o.w = pg8::cvt_pk_bf16(s[6 * 33], s[7 * 33]);
        *(GAS v4u*)(d.dst + (size_t)n * d.Kd + d.k0 + 8 * c) = o; }
    LDS_WAIT(); asm volatile("" ::: "memory");
}
constexpr int I_IN = 32 * 494, I_BR = 3 * 16 * 64, I_WO = 32 * 64, I_G = 65 * 512, I_D = 65 * 512;
constexpr int NIT = I_IN + I_BR + I_WO + 2 * I_G + I_D;
__device__ __forceinline__ TrItem decode_item(KArgs a, unsigned char* ws, int l, int it) {
    bf16* WIN = (bf16*)(ws + WS_WIN); bf16* WBR = (bf16*)(ws + WS_WBR); bf16* WO = (bf16*)(ws + WS_WO); bf16* WGU = (bf16*)(ws + WS_WGU); bf16* WD = (bf16*)(ws + WS_WD);
    int r = it; TrItem d;
    if (r < I_IN) { const int kb = r / 494, nb = r % 494, n0 = 32 * nb; d.src = a->in[1] + (size_t)l * 2048 * IN_COLS; d.ldn = IN_COLS; d.k0 = 64 * kb; d.n0 = n0; d.dst = WIN + (size_t)(n0 + (n0 >= 9408 ? 64 : 0)) * 2048; d.Kd = 2048; return d; }
    r -= I_IN;
    if (r < I_BR) { const int nbr = r / 1024, rr = r % 1024, kb = rr / 64, nb = rr % 64; d.src = a->in[14] + (size_t)l * 3 * 1024 * 2048 + (size_t)nbr * 1024 * 2048; d.ldn = 2048; d.k0 = 64 * kb; d.n0 = 32 * nb;
        d.dst = WBR + (size_t)nbr * 2048 * 1024 + (size_t)(32 * nb) * 1024; d.Kd = 1024; return d; }
    r -= I_BR;
    if (r < I_WO) { const int kb = r / 64, nb = r % 64; d.src = a->in[15] + (size_t)l * 2048 * 2048; d.ldn = 2048; d.k0 = 64 * kb; d.n0 = 32 * nb; d.dst = WO + (size_t)(32 * nb) * 2048; d.Kd = 2048; return d; }
    r -= I_WO;
    if (r < 2 * I_G) { const int up = r >= I_G ? 1 : 0; if (up) r -= I_G; const int seg = r / 512, rr = r % 512, kb = rr / 16, nb = rr % 16, n0 = 32 * nb;
        d.src = seg == 0 ? (up ? a->in[24] : a->in[23]) + (size_t)l * 2048 * 512 : (up ? a->in[21] : a->in[20]) + (size_t)(l * 64 + seg - 1) * 2048 * 512;
        d.ldn = 512; d.k0 = 64 * kb; d.n0 = n0; d.dst = WGU + (size_t)(seg * 1024 + (n0 >> 7) * 256 + (n0 & 127) + up * 128) * 2048; d.Kd = 2048; return d; }
    r -= 2 * I_G;
    { const int seg = r / 512, rr = r % 512, kb = rr / 64, nb = rr % 64;
        d.src = seg == 0 ? a->in[25] + (size_t)l * 512 * 2048 : a->in[22] + (size_t)(l * 64 + seg - 1) * 512 * 2048;
        d.ldn = 2048; d.k0 = 64 * kb; d.n0 = 32 * nb; d.dst = WD + (size_t)(seg * 2048 + 32 * nb) * 512; d.Kd = 512; return d; }
}
__device__ __forceinline__ void convert_item(KArgs a, unsigned char* ws, int l, int it, LAS float* scr, int lane) {
    const TrItem d = decode_item(a, ws, l, it); float hv[32]; tr_issue(d, lane, hv); tr_finish(d, lane, hv, scr);
}
#ifndef SHADOW_CONVERT
#define SHADOW_CONVERT 1
#endif
__device__ __forceinline__ void ph0_convert(KArgs a, Frame& F, int l) {
    LAS float* scr = (LAS float*)(F.lds + RING_OFF + F.wave * 16384);
    const int gw = F.vcu * NWAVES + F.wave, NGW = F.G * NWAVES;
    bf16* WIN = (bf16*)(F.ws + WS_WIN); bf16* WLORA = (bf16*)(F.ws + WS_WLORA);
    for (int it = gw; it < (SHADOW_CONVERT ? I_IN : NIT); it += NGW) convert_item(a, F.ws, l, it, scr, F.lane);
    const size_t gt = (size_t)F.vcu * 512 + F.tid, NT = (size_t)F.G * 512;
    for (size_t i = gt; i < 64 * 2048 / 8; i += NT) ((v4u*)(WIN + (size_t)9408 * 2048))[i] = (v4u){0u, 0u, 0u, 0u};
    { const float* w2 = a->in[5] + (size_t)l * 96 * 1024; const float* a2 = a->in[7] + (size_t)l * 96 * 1024; const float* g2 = a->in[8] + (size_t)l * 256 * 1024;
      for (size_t i = gt; i < (size_t)3072 * 512; i += NT) { const int k = (int)(i / 3072), n = (int)(i % 3072), sec = n >> 10, nn = n & 1023; float v = 0.f;
          if (sec == 0) { if (k < 96) v = w2[k * 1024 + nn]; } else if (sec == 1) { if (k >= 96 && k < 192) v = a2[(k - 96) * 1024 + nn]; } else { if (k >= 256) v = g2[(k - 256) * 1024 + nn]; }
          WLORA[(size_t)n * 512 + k] = (bf16)f2bf(v); } }
    if (l == 0) { const f32x4* x = (const f32x4*)a->in[0]; v4u* xb = (v4u*)(F.ws + WS_XB);
        for (size_t i = gt; i < (size_t)NTOK * DM / 8; i += NT) { const f32x4 p = x[2 * i], q = x[2 * i + 1]; v4u o; o.x = pk2(p[0], p[1]); o.y = pk2(p[2], p[3]); o.z = pk2(q[0], q[1]); o.w = pk2(q[2], q[3]); xb[i] = o; } }
}

__device__ __forceinline__ void ph2_elementwise(KArgs a, Frame& F, int l) {
    const size_t gt = (size_t)F.vcu * 512 + F.tid, NT = (size_t)F.G * 512;
    const bf16* PC = (const bf16*)(F.ws + WS_PCONV); bf16* Y0 = (bf16*)(F.ws + WS_YBR);
    const float* cw = a->in[2] + (size_t)l * 3 * 1024;
    for (size_t i = gt; i < (size_t)NTOK * 128; i += NT) { const int t = (int)(i >> 7), c = (int)(i & 127) * 8, tt = t & (SEQ - 1);
        const bf16* row = PC + (size_t)t * 3072;
        float gb[8], g0[8], h0[8], u0[8], u1[8], u2[8];
        unpack8(*(const v4u*)(row + c), gb); unpack8(*(const v4u*)(row + 1024 + c), g0); unpack8(*(const v4u*)(row + 2048 + c), h0);
#pragma unroll
        for (int j = 0; j < 8; ++j) { u0[j] = g0[j] * h0[j]; u1[j] = 0.f; u2[j] = 0.f; }
        if (tt >= 1) { unpack8(*(const v4u*)(row - 3072 + 1024 + c), g0); unpack8(*(const v4u*)(row - 3072 + 2048 + c), h0);
#pragma unroll
            for (int j = 0; j < 8; ++j) u1[j] = g0[j] * h0[j]; }
        if (tt >= 2) { unpack8(*(const v4u*)(row - 6144 + 1024 + c), g0); unpack8(*(const v4u*)(row - 6144 + 2048 + c), h0);
#pragma unroll
            for (int j = 0; j < 8; ++j) u2[j] = g0[j] * h0[j]; }
        float y[8];
#pragma unroll
        for (int j = 0; j < 8; ++j) y[j] = gb[j] * (cw[c + j] * u2[j] + cw[1024 + c + j] * u1[j] + cw[2048 + c + j] * u0[j]);
        *(v4u*)(Y0 + (size_t)t * 1024 + c) = pack8(y); }
    const bf16* PR = (const bf16*)(F.ws + WS_PRKV); const float* mix = a->in[3] + (size_t)l * 3520;
    float* RWR = (float*)(F.ws + WS_RWR); float* RWK = (float*)(F.ws + WS_RWK); float* RWV = (float*)(F.ws + WS_RWV);
    for (size_t i = gt; i < (size_t)NTOK * 384; i += NT) { const int t = (int)(i / 384), c = (int)(i % 384) * 8, tt = t & (SEQ - 1);
        float p[8], q[8];
        unpack8(*(const v4u*)(PR + (size_t)t * 3072 + c), p);
        if (tt >= 1) unpack8(*(const v4u*)(PR + (size_t)(t - 1) * 3072 + c), q); else {
#pragma unroll
            for (int j = 0; j < 8; ++j) q[j] = 0.f; }
#pragma unroll
        for (int j = 0; j < 8; ++j) p[j] = p[j] + (q[j] - p[j]) * mix[c + j];
        float* dst = (c < 1024 ? RWR : (c < 2048 ? RWK : RWV)) + (size_t)t * 1024 + (c & 1023);
        *(f32x4*)dst = (f32x4){p[0], p[1], p[2], p[3]}; *(f32x4*)(dst + 4) = (f32x4){p[4], p[5], p[6], p[7]}; }
    const bf16* PL = (const bf16*)(F.ws + WS_PLORA); bf16* LA = (bf16*)(F.ws + WS_LORAA);
    for (size_t i = gt; i < (size_t)NTOK * 64; i += NT) { const int t = (int)(i >> 6), c = (int)(i & 63) * 8, tt = t & (SEQ - 1);
        float p[8], q[8];
        if (c >= 192 && c < 256) {
#pragma unroll
            for (int j = 0; j < 8; ++j) p[j] = 0.f;
        } else {
            unpack8(*(const v4u*)(PL + (size_t)t * 512 + c), p);
            if (tt >= 1) unpack8(*(const v4u*)(PL + (size_t)(t - 1) * 512 + c), q); else {
#pragma unroll
                for (int j = 0; j < 8; ++j) q[j] = 0.f; }
            const int mi = c < 96 ? 3072 + c : (c < 192 ? 3168 + (c - 96) : 3264 + (c - 256));
#pragma unroll
            for (int j = 0; j < 8; ++j) { const float v = p[j] + (q[j] - p[j]) * mix[mi + j]; p[j] = c < 96 ? tanhf(v) : (c < 192 ? v : 1.0f / (1.0f + expf(-v))); }
        }
        *(v4u*)(LA + (size_t)t * 512 + c) = pack8(p); }
}

__device__ __forceinline__ void ph4_prep(KArgs a, Frame& F, int l) {
    const int gw = F.vcu * NWAVES + F.wave, NGW = F.G * NWAVES;
    float* RWR = (float*)(F.ws + WS_RWR); float* RWK = (float*)(F.ws + WS_RWK); float* RWKK = (float*)(F.ws + WS_RWKK); float* RWB = (float*)(F.ws + WS_RWB);
    const float* RWA = (const float*)(F.ws + WS_RWA); float* BON = (float*)(F.ws + WS_BON);
    const float* kkw = a->in[9] + (size_t)l * 1024; const float* kaw = a->in[10] + (size_t)l * 1024; const float* rkw = a->in[11] + (size_t)l * 1024;
    for (int task = gw; task < NTOK * 4; task += NGW) { const int t = task >> 2, hq = task & 3, c = hq * 256 + 4 * F.lane; const size_t idx = (size_t)t * 1024 + c;
        const f32x4 r = *(const f32x4*)(RWR + idx), k = *(const f32x4*)(RWK + idx), av = *(const f32x4*)(RWA + idx);
        const f32x4 kkr = k * *(const f32x4*)(kkw + c);
        const float n2 = dpp16((kkr[0] * kkr[0] + kkr[1] * kkr[1]) + (kkr[2] * kkr[2] + kkr[3] * kkr[3]));
        const f32x4 kk = kkr * (1.0f / fmaxf(sqrtf(n2), 1e-12f));
        const f32x4 k2 = k * (1.0f + (av - 1.0f) * *(const f32x4*)(kaw + c));
        *(f32x4*)(RWK + idx) = k2; *(f32x4*)(RWKK + idx) = kk; *(f32x4*)(RWB + idx) = kk * av;
        const f32x4 pr = r * k2 * *(const f32x4*)(rkw + c);
        const float bon = dpp16((pr[0] + pr[1]) + (pr[2] + pr[3]));
        if ((F.lane & 15) == 0) BON[t * 16 + hq * 4 + (F.lane >> 4)] = bon; }
}
__device__ __forceinline__ void ph6_rwkv_out(KArgs a, Frame& F, int l) {
    const int gw = F.vcu * NWAVES + F.wave, NGW = F.G * NWAVES;
    const float* RWY = (const float*)(F.ws + WS_RWY); const float* RWV = (const float*)(F.ws + WS_RWV); const float* RWG = (const float*)(F.ws + WS_RWG); const float* BON = (const float*)(F.ws + WS_BON);
    bf16* Y2 = (bf16*)(F.ws + WS_YBR) + (size_t)2 * NTOK * 1024;
    const float* lg = a->in[12] + (size_t)l * 1024; const float* lb = a->in[13] + (size_t)l * 1024;
    for (int task = gw; task < NTOK * 4; task += NGW) { const int t = task >> 2, hq = task & 3, c = hq * 256 + 4 * F.lane; const size_t idx = (size_t)t * 1024 + c;
        const f32x4 y = *(const f32x4*)(RWY + idx);
        const float mu = dpp16((y[0] + y[1]) + (y[2] + y[3])) * (1.0f / 64.0f); const f32x4 d = y - mu;
        const float var = dpp16((d[0] * d[0] + d[1] * d[1]) + (d[2] * d[2] + d[3] * d[3])) * (1.0f / 64.0f);
        f32x4 yn = d * rsqrtf(var + GN_EPS) * *(const f32x4*)(lg + c) + *(const f32x4*)(lb + c);
        yn += BON[t * 16 + hq * 4 + (F.lane >> 4)] * *(const f32x4*)(RWV + idx);
        yn *= *(const f32x4*)(RWG + idx);
        v2u w; w.x = pk2(yn[0], yn[1]); w.y = pk2(yn[2], yn[3]); *(v2u*)(Y2 + idx) = w; }
}

typedef float f32x2_t __attribute__((ext_vector_type(2)));
__device__ __forceinline__ void reduce2(float q, float p, float& Q, float& P) {
    const auto a = __builtin_amdgcn_permlane16_swap(__float_as_uint(q), __float_as_uint(p), false, false);
    float x = __uint_as_float(a[0]) + __uint_as_float(a[1]);
    x = dpp16(x);
    const auto b = __builtin_amdgcn_permlane16_swap(__float_as_uint(x), __float_as_uint(x), false, false);
    Q = __uint_as_float(b[0]); P = __uint_as_float(b[1]);
}
template <int MODE  > __device__ __forceinline__ void ph5_scan(KArgs a, Frame& F, int l) {
#define LDS_BAR() do { asm volatile("s_waitcnt lgkmcnt(0)" ::: "memory"); __builtin_amdgcn_s_barrier(); asm volatile("" ::: "memory"); } while (0)
    const int bx = pg8::obid();
    const int seq = bx >> 3, b = seq >> 4, h = seq & 15, i0 = (bx & 7) * 8 + F.wave * 2;
    const bool active = F.wave < 4;
    LAS float* buf = (LAS float*)(F.lds + RING_OFF);
    constexpr int BSZ = 6 * 32 * 64, ASZ = 32 * 64, NBLK = SEQ / 32;
    const float* A0 = (const float*)(F.ws + WS_RWKK) + 1024; const float* A1 = (const float*)(F.ws + WS_RWB); const float* A2 = (const float*)(F.ws + WS_RWW);
    const float* A3 = (const float*)(F.ws + WS_RWK); const float* A4 = (const float*)(F.ws + WS_RWR); const float* A5 = (const float*)(F.ws + WS_RWV);
    float* RWY = (float*)(F.ws + (MODE == 0 ? WS_RWY : WS_M + 600 * MiB));
    const size_t tok0 = (size_t)b * SEQ; const int col0 = h * 64;
    const int st = F.tid >> 4, sq = F.tid & 15;
    const size_t soff = (tok0 + st) * 1024 + col0 + sq * 4;
    const int loff = st * 64 + sq * 4;
    const int rl = F.lane >> 5, jq = F.lane & 31, irow = i0 + rl;
    float S0 = 0.f, S1 = 0.f, yreg = 0.f, sa = 0.f;
#define SC_LOAD(R, blk_) do { if (MODE == 1) break; const size_t o_ = soff + (size_t)(blk_) * 32 * 1024; R##0 = *(const f32x4*)(A0 + o_); R##1 = *(const f32x4*)(A1 + o_); R##2 = *(const f32x4*)(A2 + o_); \
        R##3 = *(const f32x4*)(A3 + o_); R##4 = *(const f32x4*)(A4 + o_); R##5 = *(const f32x4*)(A5 + o_); } while (0)
#define SC_WRITE(R, bufi) do { if (MODE == 1) break; LAS float* nb_ = buf + (bufi) * BSZ; *(LAS f32x4*)(nb_ + 0 * ASZ + loff) = R##0; *(LAS f32x4*)(nb_ + 1 * ASZ + loff) = R##1; *(LAS f32x4*)(nb_ + 2 * ASZ + loff) = R##2; \
        *(LAS f32x4*)(nb_ + 3 * ASZ + loff) = R##3; *(LAS f32x4*)(nb_ + 4 * ASZ + loff) = R##4; *(LAS f32x4*)(nb_ + 5 * ASZ + loff) = R##5; } while (0)
#define SC_COMPUTE(bufi, blk_) do { if (active) { const LAS float* bb = buf + (bufi) * BSZ; \
        _Pragma("unroll 4") for (int tl = 0; tl < 32; ++tl) { const LAS float* base = bb + tl * 64; \
            const f32x2_t b2 = *(const LAS f32x2_t*)(base + 1 * ASZ + 2 * jq), w2 = *(const LAS f32x2_t*)(base + 2 * ASZ + 2 * jq), k2 = *(const LAS f32x2_t*)(base + 3 * ASZ + 2 * jq), \
                          r2 = *(const LAS f32x2_t*)(base + 4 * ASZ + 2 * jq), kn = *(const LAS f32x2_t*)(base + 0 * ASZ + 2 * jq); \
            const float v = base[5 * ASZ + irow]; \
            S0 = S0 * w2[0] + (sa * b2[0] + v * k2[0]); S1 = S1 * w2[1] + (sa * b2[1] + v * k2[1]); \
            float Q, P; reduce2(S0 * r2[0] + S1 * r2[1], S0 * kn[0] + S1 * kn[1], Q, P); \
            sa = -P; \
            if (jq == (tl & 15)) yreg = Q; \
            if ((tl & 15) == 15) { if (jq < 16) RWY[(tok0 + (size_t)(blk_) * 32 + (tl - 15) + jq) * 1024 + col0 + irow] = yreg; } } } } while (0)
    int hit = (SHADOW_CONVERT && MODE == 0 && !active) ? I_IN + (bx * 4 + (F.wave - 4)) : NIT;
    LAS float* hscr = (LAS float*)(F.lds + RING_OFF + (F.wave < 7 ? 98304 + (F.wave - 4) * 8448 : 132096));
    float hv[32]; TrItem hd = {}; bool hpend = false;
    if (active) __builtin_amdgcn_s_setprio(3);
#define SC_HELP() do { if (hpend) { tr_finish(hd, F.lane, hv, hscr); hpend = false; } if (hit < NIT) { hd = decode_item(a, F.ws, l, hit); tr_issue(hd, F.lane, hv); hpend = true; hit += 4 * (int)gridDim.x; } } while (0)
    f32x4 ra0 = {}, ra1 = {}, ra2 = {}, ra3 = {}, ra4 = {}, ra5 = {}, rb0 = {}, rb1 = {}, rb2 = {}, rb3 = {}, rb4 = {}, rb5 = {};
    SC_LOAD(ra, 0); SC_LOAD(rb, 1);
    SC_WRITE(ra, 0);
    SC_LOAD(ra, 2);
    for (int blk = 0; blk < NBLK; blk += 2) {
        LDS_BAR();
        SC_COMPUTE(0, blk);
        SC_WRITE(rb, 1);
        if (blk + 3 < NBLK) SC_LOAD(rb, blk + 3);
        SC_HELP();
        LDS_BAR();
        SC_COMPUTE(1, blk + 1);
        if (blk + 2 < NBLK) { SC_WRITE(ra, 0); if (blk + 4 < NBLK) SC_LOAD(ra, blk + 4); }
        SC_HELP();
    }
    __builtin_amdgcn_s_setprio(0);
    while (hit < NIT || hpend) SC_HELP();
    LDS_BAR();
#undef SC_HELP
#undef LDS_BAR
#undef SC_LOAD
#undef SC_WRITE
#undef SC_COMPUTE
}
namespace rk {
constexpr int NCHUNK = 32 * 64;
constexpr size_t BLOB = 57344;
constexpr size_t O_RH = 0, O_PT = 8192, O_Y0 = 16384, O_LMT = 32768, O_SC = 49152;
constexpr size_t WS_RKC = WS_M + 600 * MiB;
static_assert(WS_RKC + (size_t)NCHUNK * BLOB <= WS_END, "chunk blobs");
constexpr int B_AB = 0, B_KT = 16384, B_RT = 24576, B_VT = 32768, B_ATT = 40960, B_BHT = 49152, B_KHT = 57344, B_LAK = 65536, B_LRB = 73728, B_LRK = 81920, B_T = 90112, B_MISC = 98304, B_HSCR = 100352;
static_assert(B_HSCR + 4 * 8448 <= LDSCTL_OFF, "phase A LDS map");
#define RSW(row, col) ((row) * 128 + ((((col) * 2)) ^ (((row) & 7) << 4)))
__device__ __forceinline__ int crow(int r, int hi) { return (r & 3) + 8 * (r >> 2) + 4 * hi; }
__device__ __forceinline__ unsigned cvtpk(float lo, float hi) { unsigned r; asm volatile("v_cvt_pk_bf16_f32 %0, %1, %2" : "=v"(r) : "v"(lo), "v"(hi)); return r; }
__device__ __forceinline__ void mm(f32x16& acc, LAS const char* A, LAS const char* Bt, int tm, int tn, int r32, int hi) {
#pragma unroll
    for (int s = 0; s < 4; ++s) { const bf16x8 a = *(LAS const bf16x8*)(A + RSW(32 * tm + r32, 16 * s + 8 * hi)), b = *(LAS const bf16x8*)(Bt + RSW(32 * tn + r32, 16 * s + 8 * hi));
        acc = __builtin_amdgcn_mfma_f32_32x32x16_bf16(a, b, acc, 0, 0, 0); }
}
__device__ __forceinline__ void store_n(const f32x16& acc, LAS char* dst, int tm, int tn, int r32, int hi) {
#pragma unroll
    for (int r = 0; r < 16; ++r) *(LAS bf16*)(dst + RSW(32 * tm + crow(r, hi), 32 * tn + r32)) = (bf16)f2bf(acc[r]);
}
__device__ __forceinline__ void store_t(const f32x16& acc, LAS char* dst, int tm, int tn, int r32, int hi) {
#pragma unroll
    for (int g = 0; g < 4; ++g) { v2u w; w.x = cvtpk(acc[4 * g], acc[4 * g + 1]); w.y = cvtpk(acc[4 * g + 2], acc[4 * g + 3]); *(LAS v2u*)(dst + RSW(32 * tn + r32, 32 * tm + 8 * g + 4 * hi)) = w; }
}
__device__ __forceinline__ v4u frag8(const f32x16& acc, int sl) {
    v4u w; w.x = cvtpk(acc[8 * sl], acc[8 * sl + 1]); w.y = cvtpk(acc[8 * sl + 2], acc[8 * sl + 3]); w.z = cvtpk(acc[8 * sl + 4], acc[8 * sl + 5]); w.w = cvtpk(acc[8 * sl + 6], acc[8 * sl + 7]); return w;
}
#define RK_BAR() do { asm volatile("s_waitcnt lgkmcnt(0)" ::: "memory"); __builtin_amdgcn_s_barrier(); asm volatile("" ::: "memory"); } while (0)

template <int HELP, int FUSE_PREP, int VAR = 0  > __device__ __forceinline__ void rk_chunk_local(KArgs a, Frame& F, int l) {
    LAS char* L = (LAS char*)(F.lds + RING_OFF);
    const int lane0 = F.lane, wv = F.wave;
    const bool cw = wv < 4; const int tm = (wv >> 1) & 1, tn = wv & 1;
    const float* GW = (const float*)(F.ws + WS_RWW); const float* GKK = (const float*)(F.ws + (FUSE_PREP ? WS_RWA : WS_RWKK)); const float* GB = (const float*)(F.ws + WS_RWB);
    const float* GK = (const float*)(F.ws + WS_RWK); const float* GR = (const float*)(F.ws + WS_RWR); const float* GV = (const float*)(F.ws + WS_RWV);
    unsigned char* blobs = F.ws + WS_RKC;
    int hit = (HELP && !cw) ? I_IN + (pg8::obid() * 4 + (wv - 4)) : NIT; const int hstride = 4 * (int)gridDim.x;
    LAS float* hscr = (LAS float*)(L + B_HSCR + (wv & 3) * 8448);
    float hva[32], hvb[32]; TrItem hda = {}, hdb = {}; bool pa = false, pb = false;
#define RK_FIN(hv, hd, pp) do { if (pp) { tr_finish(hd, lane0, hv, hscr); pp = false; } } while (0)
#define RK_ISS(hv, hd, pp) do { if (hit < NIT) { hd = decode_item(a, F.ws, l, hit); tr_issue(hd, lane0, hv); pp = true; hit += hstride; } } while (0)
#define RK_HELP2() do { RK_FIN(hva, hda, pa); RK_FIN(hvb, hdb, pb); RK_ISS(hva, hda, pa); RK_ISS(hvb, hdb, pb); } while (0)
#define RK_SYNC() RK_BAR()
    if (!cw) {
#pragma unroll 1
        for (int chunk = pg8::obid(); chunk < NCHUNK; chunk += (int)gridDim.x) {
#pragma unroll 1
            for (int k = 0; k < 7; ++k) { if (HELP) RK_HELP2(); RK_BAR(); } }
        if (HELP) { while (hit < NIT || pa || pb) RK_HELP2(); }
        return;
    }
#pragma unroll 1
    for (int chunk = pg8::obid(); chunk < NCHUNK; chunk += (int)gridDim.x) {
        int lane = lane0; asm volatile("" : "+v"(lane));
        const int r32 = lane & 31, hi = lane >> 5;
        const int seq = chunk >> 6, c = chunk & 63, b = seq >> 4, h = seq & 15;
        const size_t tok0 = (size_t)b * SEQ + (size_t)c * 64;
        unsigned char* blob = VAR ? F.ws + WS_M + 724 * MiB + (size_t)(chunk & 63) * BLOB : blobs + (size_t)chunk * BLOB;
        float cs[16]; float kkv[16], bbv[16], kv[16], rv[16], vv[16];
        const int j = lane, tg = wv & 3;
        if (cw) {
            const size_t g0 = (tok0 + 16 * tg) * 1024 + h * 64 + j;
            float run = 0.f;
            if (FUSE_PREP) {
                const int cj = h * 64 + j; const float kkw = a->in[9][(size_t)l * 1024 + cj], kaw = a->in[10][(size_t)l * 1024 + cj], rkw = a->in[11][(size_t)l * 1024 + cj];
                float* BON = (float*)(F.ws + WS_BON);
#pragma unroll
                for (int tt = 0; tt < 16; ++tt) { const size_t o = g0 + (size_t)tt * 1024; const float lw = __logf(GW[o]); run += lw; cs[tt] = run;
                    const float kraw = GK[o], av = GKK[o];
                    rv[tt] = GR[o]; vv[tt] = GV[o];
                    const float kkr = kraw * kkw; const float n2 = wave_sum(kkr * kkr); const float kk = kkr / fmaxf(sqrtf(n2), 1e-12f);
                    const float k2 = kraw * (1.0f + (av - 1.0f) * kaw);
                    kkv[tt] = kk; bbv[tt] = kk * av; kv[tt] = k2;
                    const float bon = wave_sum(rv[tt] * k2 * rkw);
                    if (lane == 0) BON[(tok0 + 16 * tg + tt) * 16 + h] = bon; }
            } else {
#pragma unroll
                for (int tt = 0; tt < 16; ++tt) { const size_t o = g0 + (size_t)tt * 1024; const float lw = __logf(GW[o]); run += lw; cs[tt] = run;
                    kkv[tt] = GKK[o]; bbv[tt] = GB[o]; kv[tt] = GK[o]; rv[tt] = GR[o]; vv[tt] = GV[o]; }
            }
            ((LAS float*)(L + B_MISC))[tg * 64 + j] = run;
        }
        RK_SYNC();
        if (cw) {
            const LAS float* ct = (const LAS float*)(L + B_MISC);
            const float t0 = ct[j], t1 = ct[64 + j], t2 = ct[128 + j], t3 = ct[192 + j];
            const float base = tg == 0 ? 0.f : (tg == 1 ? t0 : (tg == 2 ? t0 + t1 : t0 + t1 + t2)), total = (t0 + t1) + (t2 + t3);
            float prev = base;
#pragma unroll
            for (int tt = 0; tt < 16; ++tt) { const int t = 16 * tg + tt; const float cum = base + cs[tt];
                const float eP = __expf(cum), eM = __expf(-cum), ePm1 = __expf(prev), eC = __expf(total - cum); prev = cum;
                const float at = -kkv[tt] * ePm1;
                *(LAS bf16*)(L + B_AB + RSW(t, j)) = (bf16)f2bf(at);
                *(LAS bf16*)(L + B_AB + 8192 + RSW(t, j)) = (bf16)f2bf(bbv[tt] * eM);
                *(LAS bf16*)(L + B_KT + RSW(t, j)) = (bf16)f2bf(kv[tt] * eM);
                *(LAS bf16*)(L + B_RT + RSW(t, j)) = (bf16)f2bf(rv[tt] * eP);
                *(LAS bf16*)(L + B_VT + RSW(j, t)) = (bf16)f2bf(vv[tt]);
                *(LAS bf16*)(L + B_ATT + RSW(j, t)) = (bf16)f2bf(at);
                *(LAS bf16*)(L + B_BHT + RSW(j, t)) = (bf16)f2bf(bbv[tt] * eC);
                *(LAS bf16*)(L + B_KHT + RSW(j, t)) = (bf16)f2bf(kv[tt] * eC); }
            if (tg == 0) ((LAS float*)(L + B_MISC))[256 + j] = __expf(total);
        }
        RK_SYNC();
        f32x16 qab = {}, qak = {}, qrb = {}, qrk = {};
        if (cw && !(VAR & 2)) { mm(qab, L + B_AB, L + B_AB + 8192, tm, tn, r32, hi); mm(qak, L + B_AB, L + B_KT, tm, tn, r32, hi); mm(qrb, L + B_RT, L + B_AB + 8192, tm, tn, r32, hi); mm(qrk, L + B_RT, L + B_KT, tm, tn, r32, hi); }
        RK_SYNC();
        if (cw && !(VAR & 2)) {
#pragma unroll
            for (int r = 0; r < 16; ++r) { const int t = 32 * tm + crow(r, hi), s = 32 * tn + r32;
                ((LAS float*)(L + B_AB))[t * 64 + s] = s < t ? qab[r] : 0.f;
                qak[r] = s < t ? qak[r] : 0.f; qrb[r] = s <= t ? qrb[r] : 0.f; qrk[r] = s <= t ? qrk[r] : 0.f; }
            store_n(qak, L + B_LAK, tm, tn, r32, hi); store_n(qrb, L + B_LRB, tm, tn, r32, hi); store_n(qrk, L + B_LRK, tm, tn, r32, hi);
        }
        RK_SYNC();
        if (wv == 0 && !(VAR & 7)) {
            const LAS float* Lf = (const LAS float*)(L + B_AB);
            float Tr[64];
#pragma unroll
            for (int t = 0; t < 64; ++t) Tr[t] = 0.f;
#pragma unroll
            for (int t = 0; t < 64; ++t) { float a0 = Lf[t * 64 + lane], a1 = 0.f, a2 = 0.f, a3 = 0.f;
#pragma unroll
                for (int q = 0; q < (t + 3) / 4; ++q) { const f32x4 lv = *(const LAS f32x4*)(Lf + t * 64 + 4 * q);
                    a0 += lv[0] * Tr[4 * q + 0]; a1 += lv[1] * Tr[4 * q + 1]; a2 += lv[2] * Tr[4 * q + 2]; a3 += lv[3] * Tr[4 * q + 3]; }
                const float acc = (a0 + a1) + (a2 + a3);
                Tr[t] = acc; *(LAS bf16*)(L + B_T + RSW(t, lane)) = (bf16)f2bf(lane == t ? 1.0f + acc : acc); }
        } else if (cw && !(VAR & 6)) {
            for (int tile = (wv == 1 ? 0 : wv); tile < (wv == 1 ? 2 : wv + 1); ++tile) { f32x16 x = {}; mm(x, L + B_LAK, L + B_VT, tile >> 1, tile & 1, r32, hi); store_t(x, L + B_KT, tile >> 1, tile & 1, r32, hi); }
        }
        RK_SYNC();
        if (cw && !(VAR & 6)) { f32x16 u = {}, w = {}; mm(u, L + B_T, L + B_KT, tm, tn, r32, hi); mm(w, L + B_T, L + B_ATT, tm, tn, r32, hi);
            store_t(u, L + B_LAK, tm, tn, r32, hi); store_t(w, L + B_AB, tm, tn, r32, hi); }
        RK_SYNC();
        if (cw && !(VAR & 6)) {
            { f32x16 q = {}; mm(q, L + B_AB, L + B_LRB, tm, tn, r32, hi);
#pragma unroll
              for (int g = 0; g < 4; ++g) { const v2u rw = *(LAS const v2u*)(L + B_RT + RSW(32 * tn + r32, 32 * tm + 8 * g + 4 * hi));
                  q[4 * g] += blo(rw.x); q[4 * g + 1] += bhi(rw.x); q[4 * g + 2] += blo(rw.y); q[4 * g + 3] += bhi(rw.y); }
              v4u* dst = (v4u*)(blob + O_RH) + (size_t)(tn * 4 + 2 * tm) * 64 + lane; dst[0] = frag8(q, 0); dst[64] = frag8(q, 1); }
            { f32x16 q = {}; mm(q, L + B_AB, L + B_BHT, tm, tn, r32, hi);
              const float gcv = ((const LAS float*)(L + B_MISC))[256 + 32 * tn + r32];
#pragma unroll
              for (int r = 0; r < 16; ++r) if (32 * tm + crow(r, hi) == 32 * tn + r32) q[r] += gcv;
              v4u* dst = (v4u*)(blob + O_PT) + (size_t)(tn * 4 + 2 * tm) * 64 + lane; dst[0] = frag8(q, 0); dst[64] = frag8(q, 1); }
            { f32x16 q = {}; mm(q, L + B_LRB, L + B_LAK, tm, tn, r32, hi); mm(q, L + B_LRK, L + B_VT, tm, tn, r32, hi);
              float* dst = (float*)(blob + O_Y0) + (size_t)(2 * tm + tn) * 1024 + lane;
#pragma unroll
              for (int r = 0; r < 16; ++r) dst[r * 64] = q[r]; }
            { f32x16 q = {}; mm(q, L + B_BHT, L + B_LAK, tm, tn, r32, hi); mm(q, L + B_KHT, L + B_VT, tm, tn, r32, hi);
              float* dst = (float*)(blob + O_LMT) + (size_t)(2 * tm + tn) * 1024 + lane;
#pragma unroll
              for (int r = 0; r < 16; ++r) dst[r * 64] = q[r]; }
        }
        RK_SYNC();
    }
#undef RK_HELP2
#undef RK_FIN
#undef RK_ISS
#undef RK_SYNC
}
__device__ __forceinline__ void rk_sequential(Frame& F) {
    const int bx = pg8::obid();
    if (bx >= 32 || F.wave >= 2) return;
    const int ii = F.wave, lane = F.lane; unsigned char* blobs = F.ws + WS_RKC + (size_t)bx * 64 * BLOB;
    f32x16 xa0 = {}, xa1 = {}, xb0, xb1, xc0, xc1; v4u pa[8], pb[8], pc[8];
#define RKS_LDP(P, c_) do { if ((c_) < 64) { const v4u* pt_ = (const v4u*)(blobs + (size_t)(c_) * BLOB + O_PT) + lane; _Pragma("unroll") for (int q = 0; q < 8; ++q) P[q] = pt_[q * 64]; } } while (0)
#define RKS_LDL(L0, L1, c_) do { if ((c_) < 64) { const float* lm_ = (const float*)(blobs + (size_t)(c_) * BLOB + O_LMT) + lane; \
        _Pragma("unroll") for (int r = 0; r < 16; ++r) { L0[r] = lm_[(size_t)(0 + ii) * 1024 + r * 64]; L1[r] = lm_[(size_t)(2 + ii) * 1024 + r * 64]; } } } while (0)
#define RKS_STEP(P, s0, s1, l0, l1, c_) do { unsigned char* blob = blobs + (size_t)(c_) * BLOB; \
        v4u bf[4]; bf[0] = frag8(s0, 0); bf[1] = frag8(s0, 1); bf[2] = frag8(s1, 0); bf[3] = frag8(s1, 1); \
        { v4u* sc = (v4u*)(blob + O_SC) + (size_t)ii * 256 + lane; sc[0] = bf[0]; sc[64] = bf[1]; sc[128] = bf[2]; sc[192] = bf[3]; } \
        RKS_LDL(s0, s1, (c_) + 2); \
        _Pragma("unroll") for (int ks = 0; ks < 4; ++ks) { l0 = __builtin_amdgcn_mfma_f32_32x32x16_bf16(__builtin_bit_cast(bf16x8, P[ks]), __builtin_bit_cast(bf16x8, bf[ks]), l0, 0, 0, 0); \
                                                         l1 = __builtin_amdgcn_mfma_f32_32x32x16_bf16(__builtin_bit_cast(bf16x8, P[4 + ks]), __builtin_bit_cast(bf16x8, bf[ks]), l1, 0, 0, 0); } \
        RKS_LDP(P, (c_) + 3); } while (0)
    RKS_LDP(pa, 0); RKS_LDL(xb0, xb1, 0); RKS_LDP(pb, 1); RKS_LDL(xc0, xc1, 1); RKS_LDP(pc, 2);
#pragma unroll 1
    for (int c = 0; c < 63; c += 3) {
        RKS_STEP(pa, xa0, xa1, xb0, xb1, c);
        RKS_STEP(pb, xb0, xb1, xc0, xc1, c + 1);
        RKS_STEP(pc, xc0, xc1, xa0, xa1, c + 2);
    }
    RKS_STEP(pa, xa0, xa1, xb0, xb1, 63);
#undef RKS_LDP
#undef RKS_LDL
#undef RKS_STEP
}
template <int CHECK> __device__ __forceinline__ void rk_output(Frame& F, float* RWY, const float* REF, float* errw) {
    float e2 = 0.f, r2 = 0.f;
    const int gw = F.vcu * NWAVES + F.wave, NGW = F.G * NWAVES, lane = F.lane, r32 = lane & 31, hi = lane >> 5;
    for (int task = gw; task < NCHUNK * 2; task += NGW) { const int chunk = task >> 1, ii = task & 1; const int seq = chunk >> 6, c = chunk & 63, b = seq >> 4, h = seq & 15;
        const unsigned char* blob = F.ws + WS_RKC + (size_t)chunk * BLOB;
        v4u bf[4]; { const v4u* sc = (const v4u*)(blob + O_SC) + (size_t)ii * 256 + lane; bf[0] = sc[0]; bf[1] = sc[64]; bf[2] = sc[128]; bf[3] = sc[192]; }
#pragma unroll
        for (int tt = 0; tt < 2; ++tt) { f32x16 y; const float* y0 = (const float*)(blob + O_Y0) + (size_t)(2 * tt + ii) * 1024 + lane;
#pragma unroll
            for (int r = 0; r < 16; ++r) y[r] = y0[r * 64];
            const v4u* rh = (const v4u*)(blob + O_RH) + (size_t)(tt * 4) * 64 + lane;
#pragma unroll
            for (int ks = 0; ks < 4; ++ks) y = __builtin_amdgcn_mfma_f32_32x32x16_bf16(__builtin_bit_cast(bf16x8, rh[ks * 64]), __builtin_bit_cast(bf16x8, bf[ks]), y, 0, 0, 0);
            float* dst = RWY + ((size_t)b * SEQ + (size_t)c * 64 + 32 * tt) * 1024 + h * 64 + 32 * ii + r32;
#pragma unroll
            for (int r = 0; r < 16; ++r) dst[(size_t)crow(r, hi) * 1024] = y[r];
            if (CHECK) { const float* rf = REF + (dst - RWY);
#pragma unroll
                for (int r = 0; r < 16; ++r) { const float o = rf[(size_t)crow(r, hi) * 1024], d = y[r] - o; e2 += d * d; r2 += o * o; } } }
    }
    if (CHECK) { e2 = wave_sum(e2); r2 = wave_sum(r2); if (lane == 0) { atomicAdd(errw, e2); atomicAdd(errw + 1, r2); } }
}
#undef RSW
}
namespace att {
constexpr int SHM_K = 64 * 128 * 2, SHM_V = 64 * 128 * 2;
constexpr float ATT_STOP = -40.0f;
#define KSWZ(row, colB) ((row) * 256 + ((colB) ^ (((row) & 7) << 4)))
__device__ __forceinline__ int v_st(int k, int c) { const int kk = (k & ~0xC) | ((k & 4) << 1) | ((k & 8) >> 1); return ((kk >> 3) * 4 + (c >> 5)) * 512 + ((kk & 7) * 32 + (c & 31)) * 2; }
__device__ __forceinline__ int v_rd_base(int lane) { return ((lane & 3) << 3) | (((lane >> 2) & 3) << 6) | (((lane >> 4) & 1) << 5) | (((lane >> 5) & 1) << 8); }
constexpr int v_rd_off(int d0, int ks, int half) { return d0 * 512 + ks * 4096 + half * 2048; }
__device__ __forceinline__ int crow(int r, int hi) { return (r & 3) + 8 * (r >> 2) + 4 * hi; }
__device__ __forceinline__ unsigned cvtpk(float lo, float hi) { unsigned r; asm volatile("v_cvt_pk_bf16_f32 %0, %1, %2" : "=v"(r) : "v"(lo), "v"(hi)); return r; }
__device__ __forceinline__ int kperm(int m) { return 16 * ((m >> 2) & 1) + 4 * (m >> 3) + (m & 3); }

__device__ __forceinline__ void qkt(f32x16& p0, f32x16& p1, LAS const char* K_lds, int r32, int hi, const bf16x8* qr) {
    p0 = f32x16{}; p1 = f32x16{};
    LAS const char* kb[4];
#pragma unroll
    for (int dd = 0; dd < 4; ++dd) kb[dd] = K_lds + KSWZ(r32, (dd * 16 + hi * 8) * 2);
#pragma unroll
    for (int d0 = 0; d0 < 8; ++d0) { LAS const char* ap = kb[d0 & 3] + (d0 >> 2) * 128;
        const bf16x8 b0 = *(LAS const bf16x8*)ap;
        const bf16x8 b1 = *(LAS const bf16x8*)(ap + 32 * 256);
        p0 = __builtin_amdgcn_mfma_f32_32x32x16_bf16(b0, qr[d0], p0, 0, 0, 0);
        p1 = __builtin_amdgcn_mfma_f32_32x32x16_bf16(b1, qr[d0], p1, 0, 0, 0); }
}
__device__ __forceinline__ void pv_tile(f32x16* o, int vb0, bf16x8 pa0, bf16x8 pa1, bf16x8 pa2, bf16x8 pa3) {
#define TRRD(dst, off) asm volatile("ds_read_b64_tr_b16 %0, %1 offset:%2" : "=&v"(dst) : "v"(vb0), "i"(off) : "memory")
#define PV_D0(d0) do { s16x4 l0, l1, l2, l3, h0, h1, h2, h3; constexpr int b_ = v_rd_off(d0, 0, 0); \
        TRRD(l0, b_); TRRD(h0, b_ + 2048); TRRD(l1, b_ + 4096); TRRD(h1, b_ + 6144); TRRD(l2, b_ + 8192); TRRD(h2, b_ + 10240); TRRD(l3, b_ + 12288); TRRD(h3, b_ + 14336); \
        asm volatile("s_waitcnt lgkmcnt(0)" ::: "memory"); __builtin_amdgcn_sched_barrier(0); \
        o[d0] = __builtin_amdgcn_mfma_f32_32x32x16_bf16(pa0, (bf16x8){l0[0], l0[1], l0[2], l0[3], h0[0], h0[1], h0[2], h0[3]}, o[d0], 0, 0, 0);   \
        o[d0] = __builtin_amdgcn_mfma_f32_32x32x16_bf16(pa1, (bf16x8){l1[0], l1[1], l1[2], l1[3], h1[0], h1[1], h1[2], h1[3]}, o[d0], 0, 0, 0);   \
        o[d0] = __builtin_amdgcn_mfma_f32_32x32x16_bf16(pa2, (bf16x8){l2[0], l2[1], l2[2], l2[3], h2[0], h2[1], h2[2], h2[3]}, o[d0], 0, 0, 0);   \
        o[d0] = __builtin_amdgcn_mfma_f32_32x32x16_bf16(pa3, (bf16x8){l3[0], l3[1], l3[2], l3[3], h3[0], h3[1], h3[2], h3[3]}, o[d0], 0, 0, 0); } while (0)
    PV_D0(0); PV_D0(1); PV_D0(2); PV_D0(3);
#undef PV_D0
#undef TRRD
}
__device__ __forceinline__ void stick_tile(f32x16& p0, f32x16& p1, float& c, int t, int kb0, int hi) {
    const float CS = 0.08838834764831845f * 1.4426950408889634f;
    const int k0 = kb0 + 16 * hi, k1 = k0 + 32;
    float f0[16], f1[16]; float T0 = 0.f, T1 = 0.f;
#pragma unroll
    for (int r = 0; r < 16; ++r) {
        const float y0 = p0[r] * CS, y1 = p1[r] * CS;
        const float sp0 = __builtin_amdgcn_logf(1.0f + __builtin_amdgcn_exp2f(y0)), sp1 = __builtin_amdgcn_logf(1.0f + __builtin_amdgcn_exp2f(y1));
        f0[r] = (k0 + r < t) ? -sp0 : 0.f; f1[r] = (k1 + r < t) ? -sp1 : 0.f;
        p0[r] = y0 - sp0; p1[r] = y1 - sp1;
        T0 += f0[r]; T1 += f1[r];
    }
    const auto s1 = __builtin_amdgcn_permlane32_swap(__float_as_uint(T1), __float_as_uint(T1), false, false);
    const auto s0 = __builtin_amdgcn_permlane32_swap(__float_as_uint(T0), __float_as_uint(T0), false, false);
    const float T1lo = __uint_as_float(s1[0]), T1hi = __uint_as_float(s1[1]), T0lo = __uint_as_float(s0[0]), T0hi = __uint_as_float(s0[1]);
    const float c1 = c + T1hi, c2 = c1 + T1lo, c3 = c2 + T0hi, c4 = c3 + T0lo;
    float run1 = hi ? c : c1, run0 = hi ? c2 : c3;
#pragma unroll
    for (int r = 15; r >= 0; --r) {
        const float w1 = (k1 + r < t) ? __builtin_amdgcn_exp2f(p1[r] + run1) : 0.f; run1 += f1[r]; p1[r] = w1;
        const float w0 = (k0 + r < t) ? __builtin_amdgcn_exp2f(p0[r] + run0) : 0.f; run0 += f0[r]; p0[r] = w0;
    }
    c = c4;
}
#define PK4(P, B_, OUT) do { unsigned a0 = cvtpk(P[B_+0], P[B_+1]), a1 = cvtpk(P[B_+2], P[B_+3]);                          \
        unsigned b0 = cvtpk(P[B_+4], P[B_+5]), b1 = cvtpk(P[B_+6], P[B_+7]);                                             \
        auto r0 = __builtin_amdgcn_permlane32_swap(a0, b0, false, false); auto r1 = __builtin_amdgcn_permlane32_swap(a1, b1, false, false); \
        v4u w = {r0[0], r1[0], r0[1], r1[1]}; OUT = __builtin_bit_cast(bf16x8, w); } while (0)

__device__ __forceinline__ void attn_unit(LAS unsigned char* lds, const bf16* QKV, bf16* O, int b, int h, int qb) {
    const int tid = pg8::otid(), wid = __builtin_amdgcn_readfirstlane(tid >> 6), lane = tid & 63, r32 = lane & 31, hi = lane >> 5;
    LAS char* V_lds = (LAS char*)lds; LAS char* K_lds = (LAS char*)lds + SHM_V; volatile LAS int* flags = (volatile LAS int*)(lds + SHM_V + SHM_K);
    const bf16* Qp = QKV + (size_t)b * SEQ * 3072 + h * 128; const bf16* Kp = Qp + 1024; const bf16* Vp = Qp + 2048;
    const int qlo = qb * 256 + wid * 32, t = qlo + r32;
    bf16x8 qr[8];
#pragma unroll
    for (int d0 = 0; d0 < 8; ++d0) qr[d0] = *(const bf16x8*)(Qp + (size_t)t * 3072 + d0 * 16 + hi * 8);
    const int sr = tid >> 4, sc = (tid & 15) * 8, kr = kperm(sr);
    const int kws = KSWZ(sr, sc * 2), vst0 = v_st(sr, sc), vst1 = v_st(32 + sr, sc);
    const int vb0 = (int)(unsigned)(uintptr_t)V_lds + v_rd_base(lane);
    f32x16 o[4] = {}; float c = 0.f; bool done = false;
    if (tid < 8) flags[tid] = 0;
    for (int j = 4 * qb + 3; j >= 0; --j) {
        const int kb0 = j * 64;
        const bf16x8 k0v = *(const bf16x8*)(Kp + (size_t)(kb0 + kr) * 3072 + sc), k1v = *(const bf16x8*)(Kp + (size_t)(kb0 + 32 + kr) * 3072 + sc);
        const bf16x8 v0v = *(const bf16x8*)(Vp + (size_t)(kb0 + kr) * 3072 + sc), v1v = *(const bf16x8*)(Vp + (size_t)(kb0 + 32 + kr) * 3072 + sc);
        __syncthreads();
        bool all_done = true;
#pragma unroll
        for (int w = 0; w < 8; ++w) all_done = all_done && (flags[w] != 0);
        if (all_done) break;
        *(LAS bf16x8*)(K_lds + kws) = k0v; *(LAS bf16x8*)(K_lds + kws + 32 * 256) = k1v;
        *(LAS bf16x8*)(V_lds + vst0) = v0v; *(LAS bf16x8*)(V_lds + vst1) = v1v;
        __syncthreads();
        if (!done && kb0 <= qlo + 30) {
            f32x16 p0, p1;
            qkt(p0, p1, K_lds, r32, hi, qr);
            stick_tile(p0, p1, c, t, kb0, hi);
            bf16x8 pa0, pa1, pa2, pa3;
            PK4(p0, 0, pa0); PK4(p0, 8, pa1); PK4(p1, 0, pa2); PK4(p1, 8, pa3);
            pv_tile(o, vb0, pa0, pa1, pa2, pa3);
            done = __all(c < ATT_STOP) != 0;
            if (lane == 0 && done) flags[wid] = 1;
        }
    }
    bf16* Ow = O + ((size_t)b * SEQ + qlo) * 1024 + h * 128;
#pragma unroll
    for (int r = 0; r < 16; ++r) { const int orow = crow(r, hi);
#pragma unroll
        for (int d0 = 0; d0 < 4; ++d0) { const float v = o[d0][r]; const float vn = __shfl_xor(v, 1);
            if ((r32 & 1) == 0) *(unsigned*)(Ow + (size_t)orow * 1024 + d0 * 32 + r32) = cvtpk(v, vn); } }
    __syncthreads();
}
#undef PK4
#undef KSWZ
}
__device__ __forceinline__ float shx(float v, int m) { return __shfl_xor(v, m); }
__device__ __forceinline__ float rdl(float v, int l) { return __builtin_bit_cast(float, __builtin_amdgcn_readlane(__builtin_bit_cast(int, v), l)); }
__device__ __forceinline__ void ph9_ln_router(KArgs a, Frame& F, int l) {
    volatile LAS int* lhist = (volatile LAS int*)(F.lds + RING_OFF);
    const float* PRE = (const float*)(F.ws + WS_PRELN); float* X1 = (float*)(F.ws + WS_X1); bf16* XS = (bf16*)(F.ws + WS_XS);
    int* HIST = (int*)(F.ws + WS_HIST); int* SELE = (int*)(F.ws + WS_SELE); float* SELW = (float*)(F.ws + WS_SELW);
    const float* g1 = a->in[16] + (size_t)l * DM; const float* b1 = a->in[17] + (size_t)l * DM;
    const float* WR = a->in[18] + (size_t)l * DM * 64; const float* rbias = a->in[19] + (size_t)l * 64;
    const int lane = F.lane;
    for (int grp = pg8::obid(); grp < 256; grp += F.G) {
        if (F.tid < 64) lhist[F.tid] = 0;
        __syncthreads();
        const int t0 = grp * 32 + F.wave * 4;
#pragma unroll 1
        for (int k = 0; k < 4; ++k) {
            f32x4 v[8];
            const f32x4* row = (const f32x4*)(PRE + (size_t)(t0 + k) * DM) + lane; float s = 0.f;
#pragma unroll
            for (int j = 0; j < 8; ++j) { v[j] = row[64 * j]; s += (v[j][0] + v[j][1]) + (v[j][2] + v[j][3]); }
            const float mean = wave_sum(s) * (1.0f / DM); float s2 = 0.f;
#pragma unroll
            for (int j = 0; j < 8; ++j) { v[j] = v[j] - mean; s2 += (v[j][0] * v[j][0] + v[j][1] * v[j][1]) + (v[j][2] * v[j][2] + v[j][3] * v[j][3]); }
            const float rstd = 1.0f / sqrtf(wave_sum(s2) * (1.0f / DM) + LN_EPS);
            f32x4* xo = (f32x4*)(X1 + (size_t)(t0 + k) * DM) + lane; v2u* bo = (v2u*)(XS + (size_t)(t0 + k) * DM) + lane;
#pragma unroll
            for (int j = 0; j < 8; ++j) { const f32x4 gg = ((const f32x4*)g1)[64 * j + lane], bb = ((const f32x4*)b1)[64 * j + lane];
                v[j] = v[j] * rstd * gg + bb; xo[64 * j] = v[j];
                v2u w; w.x = pk2(v[j][0], v[j][1]); w.y = pk2(v[j][2], v[j][3]); bo[64 * j] = w; }
        }
        __syncthreads();
        LAS float* XC = (LAS float*)(F.lds + RING_OFF + 1024);
        LAS float* WC = (LAS float*)(F.lds + RING_OFF + 1024 + 33024);
        f32x16 ac0 = {}, ac1 = {};
#pragma unroll 1
        for (int j = 0; j < 8; ++j) {
            __syncthreads();
#pragma unroll
            for (int i = 0; i < 4; ++i) { const int idx = F.tid + 512 * i, xrow = idx >> 6, c4 = idx & 63;
                const f32x4 xv = *(const f32x4*)(X1 + (size_t)(grp * 32 + xrow) * DM + 256 * j + 4 * c4);
                LAS float* xr = XC + xrow * 257 + 4 * c4; xr[0] = xv[0]; xr[1] = xv[1]; xr[2] = xv[2]; xr[3] = xv[3]; }
            { const f32x4* wsrc = (const f32x4*)(WR + (size_t)256 * j * 64);
#pragma unroll
              for (int i = 0; i < 8; ++i) ((LAS f32x4*)WC)[F.tid + 512 * i] = wsrc[F.tid + 512 * i]; }
            __syncthreads();
#pragma unroll
            for (int kk = 0; kk < 16; ++kk) { const int kidx = 32 * F.wave + 2 * kk + (lane >> 5);
                const float av = XC[(lane & 31) * 257 + kidx], b0 = WC[kidx * 64 + (lane & 31)], b1 = WC[kidx * 64 + 32 + (lane & 31)];
                ac0 = __builtin_amdgcn_mfma_f32_32x32x2f32(av, b0, ac0, 0, 0, 0); ac1 = __builtin_amdgcn_mfma_f32_32x32x2f32(av, b1, ac1, 0, 0, 0); }
        }
        __syncthreads();
        { LAS float* RED = WC; const int hi = lane >> 5, e = lane & 31;
#pragma unroll
          for (int r = 0; r < 16; ++r) { const int tok = (r & 3) + 8 * (r >> 2) + 4 * hi; RED[(F.wave * 32 + tok) * 64 + e] = ac0[r]; RED[(F.wave * 32 + tok) * 64 + 32 + e] = ac1[r]; } }
        __syncthreads();
        float acc[4];
#pragma unroll
        for (int k = 0; k < 4; ++k) { float sacc = 0.f;
#pragma unroll
            for (int w2 = 0; w2 < 8; ++w2) sacc += WC[(w2 * 32 + F.wave * 4 + k) * 64 + lane];
            acc[k] = sacc; }
        const float rb = rbias[lane];
#pragma unroll
        for (int k = 0; k < 4; ++k) {
            const int t = t0 + k;
            const float sc = 1.0f / (1.0f + expf(-acc[k])); const float bz = sc + rb;
            float m1 = bz; m1 = fmaxf(m1, shx(m1, 1)); m1 = fmaxf(m1, shx(m1, 2)); m1 = fmaxf(m1, shx(m1, 4));
            const unsigned long long eq = __ballot(bz == m1);
            const int g = lane >> 3; const unsigned gb = (unsigned)((eq >> (8 * g)) & 0xffull); const int first = __ffs((int)gb) - 1;
            float m2 = ((lane & 7) == first) ? -__builtin_inff() : bz; m2 = fmaxf(m2, shx(m2, 1)); m2 = fmaxf(m2, shx(m2, 2)); m2 = fmaxf(m2, shx(m2, 4));
            const float gs = m1 + m2;
            int grank = 0;
#pragma unroll
            for (int g2 = 0; g2 < 8; ++g2) { const float o = rdl(gs, 8 * g2); grank += ((o > gs) || (o == gs && g2 < g)) ? 1 : 0; }
            const bool gsel = grank < 4;
            const float mv = gsel ? bz : -__builtin_inff();
            int rank = 0;
            for (int e2 = 0; e2 < 64; ++e2) { const float o = rdl(mv, e2); rank += ((o > mv) || (o == mv && e2 < lane)) ? 1 : 0; }
            const bool sel = gsel && rank < 8;
            const float ssum = wave_sum(sel ? sc : 0.f);
            const float wgt = sc / ssum * ROUTED_SCALE;
            const unsigned long long m = __ballot(sel);
            const int slot = __popcll(m & ((1ull << lane) - 1ull));
            if (sel) { SELE[t * 8 + slot] = lane; SELW[t * 8 + slot] = wgt; __hip_atomic_fetch_add((LAS int*)&lhist[lane], 1, __ATOMIC_RELAXED, __HIP_MEMORY_SCOPE_WORKGROUP); }
        }
        __syncthreads();
        if (F.tid < 64) HIST[grp * 64 + F.tid] = lhist[F.tid];
        __syncthreads();
    }
}
__device__ __forceinline__ void ph10_lists(Frame& F) {
    volatile LAS int* L = (volatile LAS int*)(F.lds + RING_OFF);
    volatile LAS int* partT = L, * partB = L + 512, * rowbase = L + 1024, * lsel = L + 1088, * lpos = L + 1344;
    const int* HIST = (const int*)(F.ws + WS_HIST); const int* SELE = (const int*)(F.ws + WS_SELE); const float* SELW = (const float*)(F.ws + WS_SELW);
    int* SLOT = (int*)(F.ws + WS_SLOT); float* ROWW = (float*)(F.ws + WS_ROWW); int* TSEG = (int*)(F.ws + WS_TSEG); int* ROWT = (int*)(F.ws + WS_ROWT);
    for (int grp = pg8::obid(); grp < 256; grp += F.G) {
        { const int e = F.tid & 63, part = F.tid >> 6; int s = 0, bs = 0;
          for (int w = 32 * part; w < 32 * part + 32; ++w) { const int hv = HIST[w * 64 + e]; s += hv; bs += (w < grp) ? hv : 0; }
          partT[part * 64 + e] = s; partB[part * 64 + e] = bs; }
        __syncthreads();
        if (F.tid < 64) { int tot = 0, bef = 0;
#pragma unroll
            for (int p = 0; p < 8; ++p) { tot += partT[p * 64 + F.tid]; bef += partB[p * 64 + F.tid]; }
            const int nt = (tot + 255) >> 8; int incl = nt;
#pragma unroll
            for (int o = 1; o < 64; o <<= 1) { const int u = __shfl_up(incl, o); if (F.lane >= o) incl += u; }
            const int excl = incl - nt;
            rowbase[F.tid] = 8192 + 256 * excl + bef;
            if (grp == 0) { for (int i = 0; i < nt; ++i) TSEG[16 + 32 + excl + i] = F.tid + 1;
                for (int r = 8192 + 256 * excl + tot; r < 8192 + 256 * (excl + nt); ++r) ROWT[r] = 0;
                if (F.tid < 32) TSEG[16 + F.tid] = 0;
                if (F.tid == 63) TSEG[0] = 32 + incl; } }
        if (F.tid < 256) lsel[F.tid] = SELE[grp * 256 + F.tid];
        __syncthreads();
        if (F.tid < 256) { const int j = F.tid >> 3, e = lsel[F.tid]; int rank = 0;
            for (int q = 0; q < 8 * j; ++q) rank += (lsel[q] == e) ? 1 : 0;
            const int pos = rowbase[e] + rank; const int t = grp * 32 + j;
            SLOT[t * 8 + (F.tid & 7)] = pos; ROWW[pos] = SELW[grp * 256 + F.tid]; ROWT[pos] = t; }
        else if (F.tid < 288) { ROWW[grp * 32 + F.tid - 256] = 1.0f; ROWT[grp * 32 + F.tid - 256] = grp * 32 + F.tid - 256; }
        __syncthreads();
    }
}
__device__ __forceinline__ void ph13_combine(KArgs a, Frame& F, int l, float poison) {
    const int gw = F.vcu * NWAVES + F.wave, NGW = F.G * NWAVES, lane = F.lane;
    const float* X1 = (const float*)(F.ws + WS_X1); const bf16* YS = (const bf16*)(F.ws + WS_YS); const int* SLOT = (const int*)(F.ws + WS_SLOT);
    float* outf = (l == NLAYER - 1) ? a->out : (float*)(F.ws + WS_X2); bf16* XB = (bf16*)(F.ws + WS_XB);
    const float* g2 = a->in[26] + (size_t)l * DM; const float* b2 = a->in[27] + (size_t)l * DM;
    for (int t = gw; t < NTOK; t += NGW) {
        const int mypos = (lane < 8) ? SLOT[t * 8 + lane] : t;
        float acc[4][8];
#pragma unroll
        for (int q = 0; q < 4; ++q) { const f32x4 p0 = *(const f32x4*)(X1 + (size_t)t * DM + 512 * q + 8 * lane), p1 = *(const f32x4*)(X1 + (size_t)t * DM + 512 * q + 8 * lane + 4);
#pragma unroll
            for (int j = 0; j < 4; ++j) { acc[q][j] = ALPHA * p0[j]; acc[q][4 + j] = ALPHA * p1[j]; } }
#pragma unroll
        for (int s = 0; s < 9; ++s) { const int row = __builtin_amdgcn_readlane(mypos, s); const v4u* yr = (const v4u*)(YS + (size_t)row * DM) + lane;
#pragma unroll
            for (int q = 0; q < 4; ++q) { float u[8]; unpack8(yr[64 * q], u);
#pragma unroll
                for (int j = 0; j < 8; ++j) acc[q][j] += u[j]; } }
        float s1 = 0.f;
#pragma unroll
        for (int q = 0; q < 4; ++q)
#pragma unroll
            for (int j = 0; j < 8; ++j) s1 += acc[q][j];
        const float mean = wave_sum(s1) * (1.0f / DM); float s2 = 0.f;
#pragma unroll
        for (int q = 0; q < 4; ++q)
#pragma unroll
            for (int j = 0; j < 8; ++j) { acc[q][j] -= mean; s2 += acc[q][j] * acc[q][j]; }
        const float rstd = 1.0f / sqrtf(wave_sum(s2) * (1.0f / DM) + LN_EPS);
#pragma unroll
        for (int q = 0; q < 4; ++q) { const int col = 512 * q + 8 * lane;
            const f32x4 ga = *(const f32x4*)(g2 + col), gb = *(const f32x4*)(g2 + col + 4), ba = *(const f32x4*)(b2 + col), bb = *(const f32x4*)(b2 + col + 4);
            float y[8];
#pragma unroll
            for (int j = 0; j < 4; ++j) { y[j] = (acc[q][j] * rstd * ga[j] + ba[j]) * poison; y[4 + j] = (acc[q][4 + j] * rstd * gb[j] + bb[j]) * poison; }
            *(f32x4*)(outf + (size_t)t * DM + col) = (f32x4){y[0], y[1], y[2], y[3]}; *(f32x4*)(outf + (size_t)t * DM + col + 4) = (f32x4){y[4], y[5], y[6], y[7]};
            *(v4u*)(XB + (size_t)t * DM + col) = pack8(y); }
    }
}
__device__ __forceinline__ KArgs kargs() { KArgs p = (KArgs)__builtin_amdgcn_kernarg_segment_ptr(); asm volatile("" : "+s"(p)); return p; }
__device__ __forceinline__ Frame mkframe(LAS unsigned char* lds) {
    Frame F; KArgs ka = kargs();
    F.lds = lds; F.MISC = (volatile LAS unsigned*)(lds + MISC_OFF);
    F.tid = pg8::otid(); F.lane = F.tid & 63; F.wave = __builtin_amdgcn_readfirstlane(F.tid >> 6);
    F.G = gridDim.x; { const int bx = pg8::obid(); F.vcu = (F.G % 8 == 0) ? (bx % 8) * (F.G / 8) + bx / 8 : bx; }
    F.ws = ka->ws; F.ctl = (gu32*)(ka->ws + WS_CTL);
    return F;
}
__device__ __forceinline__ void grid_seam(LAS unsigned char* lds) {
    XcdBarrier b; b.bar = (unsigned*)((gu32*)(kargs()->ws + WS_CTL) + CW_BAR); b.x = xb_xcc_id(); b.st = (volatile LAS unsigned*)(lds + MISC_OFF) + 8;
    xcd_barrier(b);
}
__global__ void __launch_bounds__(NWAVES * 64, 2) fwd_kernel(Args args_unused) {
    extern __shared__ __attribute__((aligned(16))) unsigned char lds_raw[];
    LAS unsigned char* lds = (LAS unsigned char*)lds_raw;
    for (int u = threadIdx.x; u < (LDS_BYTES - LDSCTL_OFF) / 4; u += NWAVES * 64) ((LAS unsigned*)(lds + LDSCTL_OFF))[u] = 0u;
    __syncthreads();
    if (kargs()->ph_hi - kargs()->ph_lo > 1) (void)xcd_barrier_post((unsigned*)((gu32*)(kargs()->ws + WS_CTL) + CW_BAR), (volatile LAS unsigned*)(lds + MISC_OFF) + 8);
#ifndef PH_MASK
#define PH_MASK 0xffff
#endif
#define IN(k) (((PH_MASK >> (k)) & 1) && kargs()->ph_lo <= (pb + (k)) && (pb + (k)) < kargs()->ph_hi)
#ifndef REP_MASK
#define REP_MASK 0
#endif
#define REPS(k) _Pragma("unroll 1") for (int rep_ = 0; rep_ < ((((REP_MASK) >> (k)) & 1) ? 2 : 1); ++rep_)
#define REPSEAM() do { if (rep_) grid_seam(lds); } while (0)
#define SEAM(k) do { if (IN(k) && (pb + (k) + 1) < kargs()->ph_hi) grid_seam(lds); } while (0)
#pragma unroll 1
    for (int l = 0; l < NLAYER; ++l) {
        const int pb = l * NPHASE;
        if (IN(0)) REPS(0) { REPSEAM(); Frame F = mkframe(lds); ph0_convert(kargs(), F, l); } SEAM(0);
        if (IN(1)) REPS(1) { REPSEAM(); unsigned char* ws = kargs()->ws;
            pg8::Gemm g{(const pg8::bf16_t*)(ws + WS_XB), (const pg8::bf16_t*)(ws + WS_WIN), NTOK, INP, DM}; pg8::StaticOrder S; S.init(NTOK, INP, (int)gridDim.x, pg8::obid());
            pg8::EpiInProj E{(pg8::bf16_t*)(ws + WS_PCONV), (pg8::bf16_t*)(ws + WS_PQKV), (pg8::bf16_t*)(ws + WS_PRKV), (pg8::bf16_t*)(ws + WS_PLORA), (pg8::bf16_t*)(ws + WS_PGATE)};
            pg8::gemm_phase<pg8::EpiInProj, pg8::StaticOrder, true, true>(lds + RING_OFF, g, S, E);
        } SEAM(1);
        if (IN(2)) REPS(2) { REPSEAM(); unsigned char* ws = kargs()->ws;
            for (int u = pg8::obid(); u < 256; u += gridDim.x) att::attn_unit(lds + RING_OFF, (const bf16*)(ws + WS_PQKV), (bf16*)(ws + WS_YBR) + (size_t)NTOK * 1024, u >> 7, (u >> 4) & 7, u & 15);
            Frame F = mkframe(lds); ph2_elementwise(kargs(), F, l);
        } SEAM(2);
        if (IN(3)) REPS(3) { REPSEAM(); unsigned char* ws = kargs()->ws;
            pg8::Gemm g{(const pg8::bf16_t*)(ws + WS_LORAA), (const pg8::bf16_t*)(ws + WS_WLORA), NTOK, 3072, 512}; pg8::StaticOrder S; S.init(NTOK, 3072, (int)gridDim.x, pg8::obid());
            pg8::EpiLora E{(float*)(ws + WS_RWW), (long)((WS_RWA - WS_RWW) / 4), (long)((WS_RWG - WS_RWW) / 4), kargs()->in[4] + (size_t)l * 1024, kargs()->in[6] + (size_t)l * 1024};
            pg8::gemm_phase<pg8::EpiLora, pg8::StaticOrder, true, true>(lds + RING_OFF, g, S, E);
        } SEAM(3);
#ifndef DOWN_ALIGN
#define DOWN_ALIGN true
#endif
#ifndef RK_FUSE_PREP
#define RK_FUSE_PREP 0
#endif
#ifndef RWKV_MODE
#define RWKV_MODE 1
#endif
#ifndef RK_CHECK
#define RK_CHECK 0
#endif
#ifndef RK_CHECK_TOL
#define RK_CHECK_TOL 0.02f
#endif
        if ((RWKV_MODE == 0 || RK_CHECK || !RK_FUSE_PREP) && IN(4)) REPS(4) { REPSEAM(); Frame F = mkframe(lds); ph4_prep(kargs(), F, l); if ((pb + 5) < kargs()->ph_hi) grid_seam(lds); }

        if (IN(5)) REPS(5) { REPSEAM(); Frame F = mkframe(lds);
            if (RWKV_MODE == 0 || RK_CHECK) { ph5_scan<0>(kargs(), F, l); }
            if (RWKV_MODE == 1) { if (RK_CHECK) grid_seam(lds); rk::rk_chunk_local<RK_CHECK ? 0 : 1, (RK_CHECK || !RK_FUSE_PREP) ? 0 : 1>(kargs(), F, l); }
        } SEAM(5);
#ifdef RK_PROBE
        if (IN(5)) { Frame F = mkframe(lds); rk::rk_chunk_local<0, 0, RK_PROBE>(kargs(), F, l); grid_seam(lds); }
#endif
        if (IN(6)) REPS(6) { REPSEAM(); Frame F = mkframe(lds); if (RWKV_MODE == 1) rk::rk_sequential(F); } SEAM(6);
        if (IN(7)) REPS(7) { REPSEAM(); Frame F = mkframe(lds);
            if (RWKV_MODE == 1) rk::rk_output<RK_CHECK>(F, (float*)(F.ws + (RK_CHECK ? WS_M + 720 * MiB : WS_RWY)), (const float*)(F.ws + WS_RWY), (float*)(F.ctl + 2048 + 2 * l)); } SEAM(7);
        if (IN(8)) REPS(8) { REPSEAM(); Frame F = mkframe(lds); ph6_rwkv_out(kargs(), F, l); } SEAM(8);
        if (IN(9)) REPS(9) { REPSEAM(); unsigned char* ws = kargs()->ws;
            pg8::Gemm g{(const pg8::bf16_t*)(ws + WS_YBR), (const pg8::bf16_t*)(ws + WS_WBR), 3 * NTOK, 3 * DM, 1024}; pg8::BranchOrder S; S.so.init(NTOK, DM, (int)gridDim.x, pg8::obid());
            pg8::EpiGate E{(const pg8::bf16_t*)(ws + WS_PGATE), (float*)(ws + WS_PRELN), (pg8::bf16_t*)(ws + WS_MERGED)};
            pg8::gemm_phase<pg8::EpiGate, pg8::BranchOrder, true, true>(lds + RING_OFF, g, S, E);
        } SEAM(9);
        if (IN(10)) REPS(10) { REPSEAM(); unsigned char* ws = kargs()->ws;
            pg8::Gemm g{(const pg8::bf16_t*)(ws + WS_MERGED), (const pg8::bf16_t*)(ws + WS_WO), NTOK, DM, DM}; pg8::StaticOrder S; S.init(NTOK, DM, (int)gridDim.x, pg8::obid());
            pg8::EpiWo E{l == 0 ? kargs()->in[0] : (const float*)(ws + WS_X2), (float*)(ws + WS_PRELN), ALPHA};
            pg8::gemm_phase<pg8::EpiWo, pg8::StaticOrder, true, true>(lds + RING_OFF, g, S, E);
        } SEAM(10);
        if (IN(11)) REPS(11) { REPSEAM(); Frame F = mkframe(lds); ph9_ln_router(kargs(), F, l); } SEAM(11);
        if (IN(12)) REPS(12) { REPSEAM(); Frame F = mkframe(lds); ph10_lists(F); } SEAM(12);
        if (IN(13)) REPS(13) { REPSEAM(); unsigned char* ws = kargs()->ws;
            const int ntiles = __builtin_amdgcn_readfirstlane(ld_i32((const int*)(ws + WS_TSEG)));
            pg8::Gemm g{(const pg8::bf16_t*)(ws + WS_XS), (const pg8::bf16_t*)(ws + WS_WGU), ntiles * 256, NSEG * 1024, DM};
            pg8::MoeOrder S{(const int*)(ws + WS_TSEG) + 16, ntiles, 4, (int)gridDim.x, pg8::obid()};
            pg8::EpiSwiglu E{(pg8::bf16_t*)(ws + WS_H)};
            pg8::gemm_phase_gather<pg8::EpiSwiglu, pg8::MoeOrder, true, true>(lds + RING_OFF, g, S, E, (const int*)(ws + WS_ROWT));
        } SEAM(13);
        if (IN(14)) REPS(14) { REPSEAM(); unsigned char* ws = kargs()->ws;
            const int ntiles = __builtin_amdgcn_readfirstlane(ld_i32((const int*)(ws + WS_TSEG)));
            pg8::Gemm g{(const pg8::bf16_t*)(ws + WS_H), (const pg8::bf16_t*)(ws + WS_WD), ntiles * 256, NSEG * 2048, 512};
            pg8::MoeOrder S{(const int*)(ws + WS_TSEG) + 16, ntiles, 8, (int)gridDim.x, pg8::obid()};
            pg8::EpiDown E{(pg8::bf16_t*)(ws + WS_YS), (const float*)(ws + WS_ROWW)};
            pg8::gemm_phase<pg8::EpiDown, pg8::MoeOrder, DOWN_ALIGN, true>(lds + RING_OFF, g, S, E);
        } SEAM(14);
        if (IN(15)) REPS(15) { REPSEAM(); Frame F = mkframe(lds); ph13_combine(kargs(), F, l, (RK_CHECK && ld_f32((const float*)(F.ctl + 2048 + 2 * l)) > RK_CHECK_TOL * RK_CHECK_TOL * ld_f32((const float*)(F.ctl + 2049 + 2 * l))) ? 1000.f : 1.f); } SEAM(15);
    }
#undef IN
#undef SEAM
}

#ifndef MK_PER_PHASE
#define MK_PER_PHASE 0
#endif
extern "C" void kernel_launch(void* const* d_in, const int* in_sizes, int n_in, void* d_out, int out_size, void* d_ws, size_t ws_size, hipStream_t stream) {
    static int grid = 0;
    if (grid == 0) {
        if (n_in != 28 || out_size != NTOK * DM || ws_size < WS_END) { fprintf(stderr, "kernel_launch: unexpected problem shape (n_in %d out %d ws %zu)\n", n_in, out_size, ws_size); grid = -1; return; }
        int dev = 0, cus = 0, per_cu = 0;
        if (hipGetDevice(&dev) != hipSuccess || hipDeviceGetAttribute(&cus, hipDeviceAttributeMultiprocessorCount, dev) != hipSuccess) { grid = -1; return; }
        if (hipFuncSetAttribute((const void*)fwd_kernel, hipFuncAttributeMaxDynamicSharedMemorySize, LDS_BYTES) != hipSuccess) { fprintf(stderr, "kernel_launch: hipFuncSetAttribute failed\n"); grid = -1; return; }
        if (hipOccupancyMaxActiveBlocksPerMultiprocessor(&per_cu, (const void*)fwd_kernel, NWAVES * 64, LDS_BYTES) != hipSuccess || per_cu < 1) fprintf(stderr, "kernel_launch: occupancy query reports %d\n", per_cu);
        (void)hipGetLastError();
        grid = cus;
    }
    if (grid < 0) return;
    (void)hipMemsetAsync((char*)d_ws + WS_CTL, 0, CTL_ZERO_BYTES, stream);
    Args a{};
    for (int i = 0; i < 28; ++i) a.in[i] = (const float*)d_in[i];
    a.out = (float*)d_out; a.ws = (unsigned char*)d_ws; a.li = 0; a.pad = 0;
#if MK_PER_PHASE
    for (int p = 0; p < NLAYER * NPHASE; ++p) { a.ph_lo = p; a.ph_hi = p + 1; hipLaunchKernelGGL(fwd_kernel, dim3(grid), dim3(NWAVES * 64), LDS_BYTES, stream, a); }
#else
    a.ph_lo = 0; a.ph_hi = NLAYER * NPHASE;
    hipLaunchKernelGGL(fwd_kernel, dim3(grid), dim3(NWAVES * 64), LDS_BYTES, stream, a);
#endif
}
```

```cpp
#include <hip/hip_runtime.h>
#include <cstdio>
#include <cstdint>
namespace pg8 {
#define PG8_LAS __attribute__((address_space(3)))
typedef unsigned short bf16_t;
typedef short bf16x8 __attribute__((ext_vector_type(8)));
typedef float f32x4 __attribute__((ext_vector_type(4)));
typedef unsigned u32x4 __attribute__((ext_vector_type(4)));
constexpr int BM = 256, BK = 64, HALF = 128, HTB = HALF * BK * 2  , STAGE_BYTES = 8 * HTB, NXCD = 8, WGM = 8;

__host__ __device__ __forceinline__ int lds_byte(int r, int c) { const int st = (r >> 4) * 2 + (c >> 5), rr = r & 15, cc = c & 31, ob = rr * 64 + cc * 2; return st * 1024 + (ob ^ (((ob >> 9) & 1) << 5)); }
__host__ __device__ __forceinline__ void stage_rc(int b, int& R, int& C) { const int st = b / 1024, sb = b % 1024, swz = sb ^ (((sb >> 9) & 1) << 5); R = (st >> 1) * 16 + swz / 64; C = (st & 1) * 32 + (swz % 64) / 2; }
__host__ __device__ __forceinline__ int perm32(int rho) { const int n = rho >> 4, i = rho & 15; return 8 * (i >> 2) + 4 * n + (i & 3); }

struct Unit { int pm, pn; };
struct Gemm { const bf16_t* A; const bf16_t* Bt; int M, N, K; };

struct StaticOrder {
    int nM, nN, nwg, G, c;
    __host__ __device__ void init(int M, int N, int G_, int c_) { nM = M / BM; nN = N / BM; nwg = nM * nN; G = G_; c = c_; }
    __host__ __device__ bool next(int i, Unit& u) const {
        const long L = (long)i * G + c; if (L >= nwg) return false;
        int wgid = (int)L; { const int q = nwg / NXCD, r = nwg % NXCD, xcd = wgid % NXCD, off = wgid / NXCD; wgid = (xcd < r ? xcd * (q + 1) : r * (q + 1) + (xcd - r) * q) + off; }
        const int nig = WGM * nN, gid = wgid / nig, fm = gid * WGM, gsz = (nM - fm) < WGM ? (nM - fm) : WGM;
        u.pm = fm + ((wgid % nig) % gsz); u.pn = (wgid % nig) / gsz; return true;
    }
    __device__ __forceinline__ void a_ready(const Unit&) const {}
    __device__ __forceinline__ void done(const Unit&) const {}
};

__device__ __forceinline__ int otid() { int t = threadIdx.x; asm volatile("" : "+v"(t)); return t; }
__device__ __forceinline__ int obid() { int t = blockIdx.x; asm volatile("" : "+s"(t)); return t; }
__device__ __forceinline__ unsigned cvt_pk_bf16(float lo, float hi) { unsigned r; asm volatile("v_cvt_pk_bf16_f32 %0, %1, %2" : "=v"(r) : "v"(lo), "v"(hi)); return r; }
__device__ __forceinline__ float bflo(unsigned w) { return __uint_as_float(w << 16); }
__device__ __forceinline__ float bfhi(unsigned w) { return __uint_as_float(w & 0xffff0000u); }
__device__ __forceinline__ float sigmoidf_(float x) { return 1.0f / (1.0f + __expf(-x)); }

struct EpiInProj {
    static constexpr bool PERM = true, AFTER_DRAIN = false;
    bf16_t *conv, *qkv, *rkv, *lora, *gate;
    __device__ __forceinline__ void operator()(const f32x4 (&acc)[2][2][4][2], const Unit& u, int wr, int wc, int fr, int fq) const {
        const int pn = u.pn; bf16_t* base; int ldc, colt;
        if (pn < 12) { base = conv; ldc = 3072; colt = pn * 256; }
        else if (pn < 24) { base = qkv; ldc = 3072; colt = (pn - 12) * 256; }
        else if (pn < 36) { base = rkv; ldc = 3072; colt = (pn - 24) * 256; }
        else if (pn < 38) { base = lora; ldc = 512; colt = (pn - 36) * 256; }
        else { base = gate; ldc = 6144; colt = (pn - 38) * 256; }
        const int row0 = u.pm * BM + wr * 64 + fr, col0 = colt + wc * 32 + 8 * fq;
#pragma unroll
        for (int ai = 0; ai < 2; ++ai)
#pragma unroll
            for (int m = 0; m < 4; ++m) { bf16_t* rowp = base + (size_t)(row0 + ai * HALF + m * 16) * ldc + col0;
#pragma unroll
                for (int bj = 0; bj < 2; ++bj) { const f32x4 v0 = acc[ai][bj][m][0], v1 = acc[ai][bj][m][1];
                    u32x4 w; w.x = cvt_pk_bf16(v0[0], v0[1]); w.y = cvt_pk_bf16(v0[2], v0[3]); w.z = cvt_pk_bf16(v1[0], v1[1]); w.w = cvt_pk_bf16(v1[2], v1[3]);
                    *(u32x4*)(rowp + bj * HALF) = w; } }
    }
};
struct EpiLora {
    static constexpr bool PERM = false, AFTER_DRAIN = false;
    float* Wd; long offA, offG; const float *w0, *a0;
    __device__ __forceinline__ void operator()(const f32x4 (&acc)[2][2][4][2], const Unit& u, int wr, int wc, int fr, int fq) const {
        const int sec = u.pn >> 2, colt = (u.pn & 3) * 256;
        float* out = Wd + (sec == 0 ? 0l : (sec == 1 ? offA : offG));
        const float* bp = sec == 0 ? w0 : a0;
        const int row0 = u.pm * BM + wr * 64 + fr, col0 = colt + wc * 32 + 4 * fq;
        f32x4 bv[2][2];
#pragma unroll
        for (int bj = 0; bj < 2; ++bj)
#pragma unroll
            for (int n = 0; n < 2; ++n) { const f32x4 t = *(const f32x4*)(bp + col0 + bj * HALF + n * 16); bv[bj][n] = sec == 2 ? (f32x4){0.f, 0.f, 0.f, 0.f} : t; }
#pragma unroll
        for (int ai = 0; ai < 2; ++ai)
#pragma unroll
            for (int m = 0; m < 4; ++m) { float* rowp = out + (size_t)(row0 + ai * HALF + m * 16) * 1024 + col0;
#pragma unroll
                for (int bj = 0; bj < 2; ++bj)
#pragma unroll
                    for (int n = 0; n < 2; ++n) { f32x4 v = acc[ai][bj][m][n] + bv[bj][n];
                        if (sec == 0) {
#pragma unroll
                            for (int j = 0; j < 4; ++j) { const float x = v[j]; const float sp = fmaxf(-x, 0.f) + __logf(1.0f + __expf(-fabsf(x)));
                                v[j] = __expf(-__expf(-sp - 0.5f)); }
                        } else if (sec == 1) {
#pragma unroll
                            for (int j = 0; j < 4; ++j) v[j] = 1.0f / (1.0f + __expf(-v[j]));
                        }
                        *(f32x4*)(rowp + bj * HALF + n * 16) = v; } }
    }
};
struct EpiGate {
    static constexpr bool PERM = true, AFTER_DRAIN = false;
    const bf16_t* gate; bf16_t* tmp; bf16_t* out;
    __device__ __forceinline__ void operator()(const f32x4 (&acc)[2][2][4][2], const Unit& u, int wr, int wc, int fr, int fq) const {
        const int mode = u.pn >> 3;
        const int row0 = (u.pm & 31) * BM + wr * 64 + fr, col0 = (u.pn & 7) * BM + wc * 32 + 8 * fq;
        const bf16_t* gp = gate + mode * 2048;
#pragma unroll
        for (int ai = 0; ai < 2; ++ai)
#pragma unroll
            for (int m = 0; m < 4; ++m) { const size_t row = (size_t)(row0 + ai * HALF + m * 16);
#pragma unroll
                for (int bj = 0; bj < 2; ++bj) { const int col = col0 + bj * HALF;
                    const u32x4 gw = *(const u32x4*)(gp + row * 6144 + col);
                    f32x4 v0 = acc[ai][bj][m][0], v1 = acc[ai][bj][m][1];
                    v0[0] *= sigmoidf_(bflo(gw.x)); v0[1] *= sigmoidf_(bfhi(gw.x)); v0[2] *= sigmoidf_(bflo(gw.y)); v0[3] *= sigmoidf_(bfhi(gw.y));
                    v1[0] *= sigmoidf_(bflo(gw.z)); v1[1] *= sigmoidf_(bfhi(gw.z)); v1[2] *= sigmoidf_(bflo(gw.w)); v1[3] *= sigmoidf_(bfhi(gw.w));
                    bf16_t* tp = tmp + row * 2048 + col;
                    if (mode != 0) { const u32x4 tw = *(const u32x4*)tp; v0[0] += bflo(tw.x); v0[1] += bfhi(tw.x); v0[2] += bflo(tw.y); v0[3] += bfhi(tw.y); v1[0] += bflo(tw.z); v1[1] += bfhi(tw.z); v1[2] += bflo(tw.w); v1[3] += bfhi(tw.w); }
                    if (mode != 2) { u32x4 w; w.x = cvt_pk_bf16(v0[0], v0[1]); w.y = cvt_pk_bf16(v0[2], v0[3]); w.z = cvt_pk_bf16(v1[0], v1[1]); w.w = cvt_pk_bf16(v1[2], v1[3]); *(u32x4*)tp = w; }
                    else { u32x4 w; w.x = cvt_pk_bf16(v0[0], v0[1]); w.y = cvt_pk_bf16(v0[2], v0[3]); w.z = cvt_pk_bf16(v1[0], v1[1]); w.w = cvt_pk_bf16(v1[2], v1[3]);
                        *(u32x4*)(out + row * 2048 + col) = w; } } }
    }
};
struct BranchOrder {
    StaticOrder so;
    __device__ __forceinline__ bool next(int i, Unit& u) const { Unit t; if (!so.next(i / 3, t)) return false; const int n = i % 3; u.pm = n * 32 + t.pm; u.pn = n * 8 + t.pn; return true; }
    __device__ __forceinline__ void a_ready(const Unit&) const {}
    __device__ __forceinline__ void done(const Unit&) const {}
};
struct EpiWo {
    static constexpr bool PERM = false, AFTER_DRAIN = false;
    const float* xin; float* out; float alpha;
    __device__ __forceinline__ void operator()(const f32x4 (&acc)[2][2][4][2], const Unit& u, int wr, int wc, int fr, int fq) const {
        const int row0 = u.pm * BM + wr * 64 + fr, col0 = u.pn * BM + wc * 32 + 4 * fq;
#pragma unroll
        for (int ai = 0; ai < 2; ++ai)
#pragma unroll
            for (int m = 0; m < 4; ++m) { const size_t off = (size_t)(row0 + ai * HALF + m * 16) * 2048 + col0;
#pragma unroll
                for (int bj = 0; bj < 2; ++bj)
#pragma unroll
                    for (int n = 0; n < 2; ++n) { const f32x4 xv = *(const f32x4*)(xin + off + bj * HALF + n * 16);
                        *(f32x4*)(out + off + bj * HALF + n * 16) = xv * alpha + acc[ai][bj][m][n]; } }
    }
};
struct EpiSwiglu {
    static constexpr bool PERM = true, AFTER_DRAIN = false;
    bf16_t* H; const float* roww;
    __device__ __forceinline__ void operator()(const f32x4 (&acc)[2][2][4][2], const Unit& u, int wr, int wc, int fr, int fq) const {
        const int row0 = u.pm * BM + wr * 64 + fr, col0 = (u.pn & 3) * 128 + wc * 32 + 8 * fq;
        float rw[2][4];
#pragma unroll
        for (int ai = 0; ai < 2; ++ai)
#pragma unroll
            for (int m = 0; m < 4; ++m) rw[ai][m] = roww[row0 + ai * HALF + m * 16];
#pragma unroll
        for (int ai = 0; ai < 2; ++ai)
#pragma unroll
            for (int m = 0; m < 4; ++m) { bf16_t* rowp = H + (size_t)(row0 + ai * HALF + m * 16) * 512 + col0;
                float h[8];
#pragma unroll
                for (int n = 0; n < 2; ++n)
#pragma unroll
                    for (int j = 0; j < 4; ++j) { const float g = acc[ai][0][m][n][j], up = acc[ai][1][m][n][j]; h[n * 4 + j] = g * sigmoidf_(g) * up * rw[ai][m]; }
                u32x4 w; w.x = cvt_pk_bf16(h[0], h[1]); w.y = cvt_pk_bf16(h[2], h[3]); w.z = cvt_pk_bf16(h[4], h[5]); w.w = cvt_pk_bf16(h[6], h[7]);
                *(u32x4*)rowp = w; }
    }
};
struct EpiDown {
    static constexpr bool PERM = true, AFTER_DRAIN = false;
    bf16_t* Y; const float* roww;
    __device__ __forceinline__ void operator()(const f32x4 (&acc)[2][2][4][2], const Unit& u, int wr, int wc, int fr, int fq) const {
        const int row0 = u.pm * BM + wr * 64 + fr, col0 = (u.pn & 7) * 256 + wc * 32 + 8 * fq;
#pragma unroll
        for (int ai = 0; ai < 2; ++ai)
#pragma unroll
            for (int m = 0; m < 4; ++m) { const int row = row0 + ai * HALF + m * 16; bf16_t* rowp = Y + (size_t)row * 2048 + col0;
#pragma unroll
                for (int bj = 0; bj < 2; ++bj) { const f32x4 v0 = acc[ai][bj][m][0], v1 = acc[ai][bj][m][1];
                    u32x4 w; w.x = cvt_pk_bf16(v0[0], v0[1]); w.y = cvt_pk_bf16(v0[2], v0[3]); w.z = cvt_pk_bf16(v1[0], v1[1]); w.w = cvt_pk_bf16(v1[2], v1[3]);
                    *(u32x4*)(rowp + bj * HALF) = w; } }
    }
};
struct MoeOrder {
    const int* seg; int ntiles, npn, G, c;
    __device__ __forceinline__ bool next(int i, Unit& u) const {
        const long L = (long)i * G + c; if (L >= (long)ntiles * npn) return false;
        const int pm = (int)(L / npn), pl = (int)(L % npn); u.pm = pm; u.pn = __builtin_amdgcn_readfirstlane(__hip_atomic_load(seg + pm, __ATOMIC_RELAXED, __HIP_MEMORY_SCOPE_AGENT)) * npn + pl; return true;
    }
    __device__ __forceinline__ void a_ready(const Unit&) const {}
    __device__ __forceinline__ void done(const Unit&) const {}
};
template <class Epi, class Sched, bool ALIGN_EPI = false, bool SP2 = false>
__device__ __forceinline__ void gemm_phase(PG8_LAS unsigned char* lds, const Gemm g, const Sched& S, const Epi& E) {
    const int tid = otid(), wid = __builtin_amdgcn_readfirstlane(tid >> 6), lane = tid & 63, wr = wid >> 2, wc = wid & 3, fr = lane & 15, fq = lane >> 4;
    const int K = g.K, nt = K / BK;
    unsigned voffA[2], voffB[2];
#pragma unroll
    for (int i = 0; i < 2; ++i) { int R, C; stage_rc(tid * 16 + i * 8192, R, C); const int Rb = Epi::PERM ? ((R & ~31) + perm32(R & 31)) : R;
        voffA[i] = (unsigned)(R * K + C) * 2u; voffB[i] = (unsigned)(Rb * K + C) * 2u; }
    const size_t kstep = (size_t)(BK * 2);
    const size_t hstep = (size_t)HALF * K * 2;
    const size_t tstep = 2 * hstep;
    const unsigned ldsw = (unsigned)wid * 1024u;
    const int aoff = lds_byte(wr * 64 + fr, fq * 8), boff = lds_byte(wc * 32 + fr, fq * 8);
#define PG8_SA(b, h) (((b) * 2 + (h)) * HTB)
#define PG8_SB(b, h) ((4 + (b) * 2 + (h)) * HTB)
#define PG8_STAGE(bufoff, gbase, voff) do { _Pragma("unroll") for (int _i = 0; _i < 2; ++_i) \
        __builtin_amdgcn_global_load_lds((const unsigned*)((const char*)(gbase) + (voff)[_i]), (PG8_LAS unsigned*)(lds + (bufoff) + ldsw + _i * 8192), 16, 0, 0); } while (0)
#define PG8_LDA(dst, b, h) do { _Pragma("unroll") for (int m = 0; m < 4; ++m) _Pragma("unroll") for (int k = 0; k < 2; ++k) dst[m][k] = *(const PG8_LAS bf16x8*)(lds + PG8_SA(b, h) + aoff + m * 2048 + k * 1024); } while (0)
#define PG8_LDB(dst, b, h) do { _Pragma("unroll") for (int n = 0; n < 2; ++n) _Pragma("unroll") for (int k = 0; k < 2; ++k) dst[n][k] = *(const PG8_LAS bf16x8*)(lds + PG8_SB(b, h) + boff + n * 2048 + k * 1024); } while (0)
#define PG8_MMA(ai, bj, At, Bt) do { __builtin_amdgcn_s_setprio(1); _Pragma("unroll") for (int m = 0; m < 4; ++m) _Pragma("unroll") for (int n = 0; n < 2; ++n) _Pragma("unroll") for (int k = 0; k < 2; ++k) \
        acc[ai][bj][m][n] = __builtin_amdgcn_mfma_f32_16x16x32_bf16(Bt[n][k], At[m][k], acc[ai][bj][m][n], 0, 0, 0); __builtin_amdgcn_s_setprio(0); } while (0)
#define PG8_WAIT_V(n) asm volatile("s_waitcnt vmcnt(" #n ")" ::: "memory")
#define PG8_WAIT_L(n) asm volatile("s_waitcnt lgkmcnt(" #n ")" ::: "memory")
#define PG8_BAR __builtin_amdgcn_s_barrier()
#define PG8_SCHED __builtin_amdgcn_sched_barrier(0)
    Unit cur, nxt; int ui = 0;
    if (!S.next(0, cur)) return;
    f32x4 acc[2][2][4][2];
#pragma unroll
    for (int a = 0; a < 2; ++a)
#pragma unroll
        for (int b = 0; b < 2; ++b)
#pragma unroll
            for (int m = 0; m < 4; ++m)
#pragma unroll
                for (int n = 0; n < 2; ++n) acc[a][b][m][n] = (f32x4){0.f, 0.f, 0.f, 0.f};
    bf16x8 At[4][2], B0[2][2], B1[2][2];
    const char* cA = (const char*)g.A + (size_t)cur.pm * tstep; const char* cB = (const char*)g.Bt + (size_t)cur.pn * tstep;
    S.a_ready(cur);
    if constexpr (SP2) {
        PG8_STAGE(PG8_SB(0, 0), cB, voffB); PG8_STAGE(PG8_SB(0, 1), cB + hstep, voffB); PG8_STAGE(PG8_SA(0, 0), cA, voffA); PG8_STAGE(PG8_SA(0, 1), cA + hstep, voffA);
        if (wr == 1) PG8_BAR;
        PG8_WAIT_V(2); PG8_BAR;
        PG8_STAGE(PG8_SB(1, 0), cB + kstep, voffB); PG8_STAGE(PG8_SA(1, 0), cA + kstep, voffA); PG8_STAGE(PG8_SB(1, 1), cB + hstep + kstep, voffB);
        PG8_WAIT_V(6); PG8_BAR;
    } else {
        PG8_STAGE(PG8_SB(0, 0), cB, voffB); PG8_STAGE(PG8_SA(0, 0), cA, voffA); PG8_STAGE(PG8_SB(0, 1), cB + hstep, voffB); PG8_STAGE(PG8_SA(0, 1), cA + hstep, voffA);
        if (wr == 1) PG8_BAR;
        PG8_WAIT_V(4); PG8_BAR;
        PG8_STAGE(PG8_SB(1, 0), cB + kstep, voffB); PG8_STAGE(PG8_SA(1, 0), cA + kstep, voffA); PG8_STAGE(PG8_SB(1, 1), cB + hstep + kstep, voffB);
        PG8_WAIT_V(6); PG8_BAR;
    }
    for (;;) {
        const bool has_next = S.next(ui + 1, nxt);
        const char* nA = has_next ? (const char*)g.A + (size_t)nxt.pm * tstep : cA; const char* nB = has_next ? (const char*)g.Bt + (size_t)nxt.pn * tstep : cB;
        for (int t = 0; t < nt; t += 2) {
            const bool last = (t == nt - 2);
            const char* a1 = cA + (size_t)(t + 1) * kstep;
            const char* a2 = last ? nA : cA + (size_t)(t + 2) * kstep; const char* b2 = last ? nB : cB + (size_t)(t + 2) * kstep;
            const char* a3 = a2 + kstep; const char* b3 = b2 + kstep;
            if (last && has_next) S.a_ready(nxt);
            if constexpr (SP2) {
            PG8_LDB(B0, 0, 0); PG8_LDB(B1, 0, 1); PG8_SCHED; PG8_LDA(At, 0, 0); PG8_STAGE(PG8_SA(1, 1), a1 + hstep, voffA);
            PG8_WAIT_V(8); PG8_WAIT_L(0); PG8_BAR; PG8_MMA(0, 0, At, B0); PG8_MMA(0, 1, At, B1); PG8_BAR; PG8_SCHED;
            PG8_LDA(At, 0, 1); PG8_STAGE(PG8_SB(0, 0), b2, voffB); PG8_STAGE(PG8_SB(0, 1), b2 + hstep, voffB); PG8_STAGE(PG8_SA(0, 0), a2, voffA);
            PG8_WAIT_V(8); PG8_WAIT_L(0); PG8_BAR; PG8_MMA(1, 0, At, B0); PG8_MMA(1, 1, At, B1); PG8_BAR; PG8_SCHED;
            PG8_LDB(B0, 1, 0); PG8_LDB(B1, 1, 1); PG8_SCHED; PG8_LDA(At, 1, 0); PG8_STAGE(PG8_SA(0, 1), a2 + hstep, voffA);
            PG8_WAIT_V(8); PG8_WAIT_L(0); PG8_BAR; PG8_MMA(0, 0, At, B0); PG8_MMA(0, 1, At, B1); PG8_BAR; PG8_SCHED;
            PG8_LDA(At, 1, 1); PG8_STAGE(PG8_SB(1, 0), b3, voffB); PG8_STAGE(PG8_SB(1, 1), b3 + hstep, voffB); PG8_STAGE(PG8_SA(1, 0), a3, voffA);
            PG8_WAIT_V(8); PG8_WAIT_L(0); PG8_BAR; PG8_MMA(1, 0, At, B0); PG8_MMA(1, 1, At, B1); PG8_BAR; PG8_SCHED;
            } else {
            PG8_LDB(B0, 0, 0); PG8_SCHED; PG8_LDA(At, 0, 0); PG8_STAGE(PG8_SA(1, 1), a1 + hstep, voffA);
            PG8_WAIT_L(8); PG8_BAR; PG8_WAIT_L(0); PG8_MMA(0, 0, At, B0); PG8_BAR; PG8_SCHED;
            PG8_LDB(B1, 0, 1); PG8_STAGE(PG8_SB(0, 0), b2, voffB);
            PG8_BAR; PG8_WAIT_L(0); PG8_MMA(0, 1, At, B1); PG8_BAR;
            PG8_LDA(At, 0, 1); PG8_STAGE(PG8_SA(0, 0), a2, voffA);
            PG8_BAR; PG8_WAIT_L(0); PG8_MMA(1, 0, At, B0); PG8_BAR; PG8_SCHED;
            PG8_STAGE(PG8_SB(0, 1), b2 + hstep, voffB);
            PG8_WAIT_V(6); PG8_BAR; PG8_MMA(1, 1, At, B1); PG8_BAR;
            PG8_LDB(B0, 1, 0); PG8_SCHED; PG8_LDA(At, 1, 0); PG8_STAGE(PG8_SA(0, 1), a2 + hstep, voffA);
            PG8_WAIT_L(8); PG8_BAR; PG8_WAIT_L(0); PG8_MMA(0, 0, At, B0); PG8_BAR; PG8_SCHED;
            PG8_LDB(B1, 1, 1); PG8_STAGE(PG8_SB(1, 0), b3, voffB);
            PG8_BAR; PG8_WAIT_L(0); PG8_MMA(0, 1, At, B1); PG8_BAR;
            PG8_LDA(At, 1, 1); PG8_STAGE(PG8_SA(1, 0), a3, voffA);
            PG8_BAR; PG8_WAIT_L(0); PG8_MMA(1, 0, At, B0); PG8_BAR; PG8_SCHED;
            PG8_STAGE(PG8_SB(1, 1), b3 + hstep, voffB);
            PG8_WAIT_V(6); PG8_BAR; PG8_MMA(1, 1, At, B1); PG8_BAR;
            }
        }
        if constexpr (ALIGN_EPI) { if (wr == 0) PG8_BAR; }
        if constexpr (!Epi::AFTER_DRAIN) { E(acc, cur, wr, wc, fr, fq); S.done(cur); }
        if (!has_next) break;
#pragma unroll
        for (int a = 0; a < 2; ++a)
#pragma unroll
            for (int b = 0; b < 2; ++b)
#pragma unroll
                for (int m = 0; m < 4; ++m)
#pragma unroll
                    for (int n = 0; n < 2; ++n) acc[a][b][m][n] = (f32x4){0.f, 0.f, 0.f, 0.f};
        cur = nxt; cA = nA; cB = nB; ++ui;
        if constexpr (ALIGN_EPI) { if (wr == 1) PG8_BAR; }
    }
    PG8_WAIT_V(0);
    if constexpr (!ALIGN_EPI) { if (wr == 0) PG8_BAR; }
    PG8_BAR;
    if constexpr (Epi::AFTER_DRAIN) { E.fused(acc, cur, wr, wc, fr, fq, lds, wid, lane); S.done(cur); }
#undef PG8_SA
#undef PG8_SB
#undef PG8_STAGE
#undef PG8_LDA
#undef PG8_LDB
#undef PG8_MMA
#undef PG8_WAIT_V
#undef PG8_WAIT_L
#undef PG8_BAR
#undef PG8_SCHED
}

template <class Epi, class Sched, bool ALIGN_EPI = false, bool SP2 = true>
__device__ __forceinline__ void gemm_phase_gather(PG8_LAS unsigned char* lds, const Gemm g, const Sched& S, const Epi& E, const int* rowtab) {
    static_assert(SP2, "gather variant: SP2 loop only");
    const int tid = otid(), wid = __builtin_amdgcn_readfirstlane(tid >> 6), lane = tid & 63, wr = wid >> 2, wc = wid & 3, fr = lane & 15, fq = lane >> 4;
    const int K = g.K, nt = K / BK;
    unsigned voffA[2], voffB[2]; int RA[2]; unsigned CA[2];
#pragma unroll
    for (int i = 0; i < 2; ++i) { int R, C; stage_rc(tid * 16 + i * 8192, R, C); const int Rb = Epi::PERM ? ((R & ~31) + perm32(R & 31)) : R;
        voffA[i] = (unsigned)(R * K + C) * 2u; voffB[i] = (unsigned)(Rb * K + C) * 2u; RA[i] = R; CA[i] = (unsigned)C * 2u; }
    unsigned gA[4], gN[4];
#define PG8_GLOAD(G, pm_) do { _Pragma("unroll") for (int h_ = 0; h_ < 2; ++h_) _Pragma("unroll") for (int i_ = 0; i_ < 2; ++i_) \
        G[2 * h_ + i_] = (unsigned)rowtab[(pm_) * BM + h_ * HALF + RA[i_]] * (unsigned)(K * 2) + CA[i_]; } while (0)
#define PG8_STAGEG(bufoff, gbase, G, h_) do { _Pragma("unroll") for (int _i = 0; _i < 2; ++_i) \
        __builtin_amdgcn_global_load_lds((const unsigned*)((const char*)(gbase) + G[2 * (h_) + _i]), (PG8_LAS unsigned*)(lds + (bufoff) + ldsw + _i * 8192), 16, 0, 0); } while (0)
    const size_t kstep = (size_t)(BK * 2);
    const size_t hstep = (size_t)HALF * K * 2;
    const size_t tstep = 2 * hstep;
    const unsigned ldsw = (unsigned)wid * 1024u;
    const int aoff = lds_byte(wr * 64 + fr, fq * 8), boff = lds_byte(wc * 32 + fr, fq * 8);
#define PG8_SA(b, h) (((b) * 2 + (h)) * HTB)
#define PG8_SB(b, h) ((4 + (b) * 2 + (h)) * HTB)
#define PG8_STAGE(bufoff, gbase, voff) do { _Pragma("unroll") for (int _i = 0; _i < 2; ++_i) \
        __builtin_amdgcn_global_load_lds((const unsigned*)((const char*)(gbase) + (voff)[_i]), (PG8_LAS unsigned*)(lds + (bufoff) + ldsw + _i * 8192), 16, 0, 0); } while (0)
#define PG8_LDA(dst, b, h) do { _Pragma("unroll") for (int m = 0; m < 4; ++m) _Pragma("unroll") for (int k = 0; k < 2; ++k) dst[m][k] = *(const PG8_LAS bf16x8*)(lds + PG8_SA(b, h) + aoff + m * 2048 + k * 1024); } while (0)
#define PG8_LDB(dst, b, h) do { _Pragma("unroll") for (int n = 0; n < 2; ++n) _Pragma("unroll") for (int k = 0; k < 2; ++k) dst[n][k] = *(const PG8_LAS bf16x8*)(lds + PG8_SB(b, h) + boff + n * 2048 + k * 1024); } while (0)
#define PG8_MMA(ai, bj, At, Bt) do { __builtin_amdgcn_s_setprio(1); _Pragma("unroll") for (int m = 0; m < 4; ++m) _Pragma("unroll") for (int n = 0; n < 2; ++n) _Pragma("unroll") for (int k = 0; k < 2; ++k) \
        acc[ai][bj][m][n] = __builtin_amdgcn_mfma_f32_16x16x32_bf16(Bt[n][k], At[m][k], acc[ai][bj][m][n], 0, 0, 0); __builtin_amdgcn_s_setprio(0); } while (0)
#define PG8_WAIT_V(n) asm volatile("s_waitcnt vmcnt(" #n ")" ::: "memory")
#define PG8_WAIT_L(n) asm volatile("s_waitcnt lgkmcnt(" #n ")" ::: "memory")
#define PG8_BAR __builtin_amdgcn_s_barrier()
#define PG8_SCHED __builtin_amdgcn_sched_barrier(0)
    Unit cur, nxt; int ui = 0;
    if (!S.next(0, cur)) return;
    f32x4 acc[2][2][4][2];
#pragma unroll
    for (int a = 0; a < 2; ++a)
#pragma unroll
        for (int b = 0; b < 2; ++b)
#pragma unroll
            for (int m = 0; m < 4; ++m)
#pragma unroll
                for (int n = 0; n < 2; ++n) acc[a][b][m][n] = (f32x4){0.f, 0.f, 0.f, 0.f};
    bf16x8 At[4][2], B0[2][2], B1[2][2];
    const char* A0 = (const char*)g.A; const char* cB = (const char*)g.Bt + (size_t)cur.pn * tstep;
    PG8_GLOAD(gA, cur.pm);
    S.a_ready(cur);
    if constexpr (SP2) {
        PG8_STAGE(PG8_SB(0, 0), cB, voffB); PG8_STAGE(PG8_SB(0, 1), cB + hstep, voffB); PG8_STAGEG(PG8_SA(0, 0), A0, gA, 0); PG8_STAGEG(PG8_SA(0, 1), A0, gA, 1);
        if (wr == 1) PG8_BAR;
        PG8_WAIT_V(2); PG8_BAR;
        PG8_STAGE(PG8_SB(1, 0), cB + kstep, voffB); PG8_STAGEG(PG8_SA(1, 0), A0 + kstep, gA, 0); PG8_STAGE(PG8_SB(1, 1), cB + hstep + kstep, voffB);
        PG8_WAIT_V(6); PG8_BAR;
    } else {
        ;
    }
    for (;;) {
        const bool has_next = S.next(ui + 1, nxt);
        const char* nB = has_next ? (const char*)g.Bt + (size_t)nxt.pn * tstep : cB;
        if (has_next) PG8_GLOAD(gN, nxt.pm); else { gN[0] = gA[0]; gN[1] = gA[1]; gN[2] = gA[2]; gN[3] = gA[3]; }
        for (int t = 0; t < nt; t += 2) {
            const bool last = (t == nt - 2);
            const char* a1 = A0 + (size_t)(t + 1) * kstep;
            const char* a2 = last ? A0 : A0 + (size_t)(t + 2) * kstep; const char* b2 = last ? nB : cB + (size_t)(t + 2) * kstep;
            unsigned gs[4] = {gA[0], gA[1], gA[2], gA[3]};
            if (last) { gs[0] = gN[0]; gs[1] = gN[1]; gs[2] = gN[2]; gs[3] = gN[3]; }
            const char* a3 = a2 + kstep; const char* b3 = b2 + kstep;
            if (last && has_next) S.a_ready(nxt);
            if constexpr (SP2) {
            PG8_LDB(B0, 0, 0); PG8_LDB(B1, 0, 1); PG8_SCHED; PG8_LDA(At, 0, 0); PG8_STAGEG(PG8_SA(1, 1), a1, gA, 1);
            PG8_WAIT_V(8); PG8_WAIT_L(0); PG8_BAR; PG8_MMA(0, 0, At, B0); PG8_MMA(0, 1, At, B1); PG8_BAR; PG8_SCHED;
            PG8_LDA(At, 0, 1); PG8_STAGE(PG8_SB(0, 0), b2, voffB); PG8_STAGE(PG8_SB(0, 1), b2 + hstep, voffB); PG8_STAGEG(PG8_SA(0, 0), a2, gs, 0);
            PG8_WAIT_V(8); PG8_WAIT_L(0); PG8_BAR; PG8_MMA(1, 0, At, B0); PG8_MMA(1, 1, At, B1); PG8_BAR; PG8_SCHED;
            PG8_LDB(B0, 1, 0); PG8_LDB(B1, 1, 1); PG8_SCHED; PG8_LDA(At, 1, 0); PG8_STAGEG(PG8_SA(0, 1), a2, gs, 1);
            PG8_WAIT_V(8); PG8_WAIT_L(0); PG8_BAR; PG8_MMA(0, 0, At, B0); PG8_MMA(0, 1, At, B1); PG8_BAR; PG8_SCHED;
            PG8_LDA(At, 1, 1); PG8_STAGE(PG8_SB(1, 0), b3, voffB); PG8_STAGE(PG8_SB(1, 1), b3 + hstep, voffB); PG8_STAGEG(PG8_SA(1, 0), a3, gs, 0);
            PG8_WAIT_V(8); PG8_WAIT_L(0); PG8_BAR; PG8_MMA(1, 0, At, B0); PG8_MMA(1, 1, At, B1); PG8_BAR; PG8_SCHED;
            }
        }
        if constexpr (ALIGN_EPI) { if (wr == 0) PG8_BAR; }
        if constexpr (!Epi::AFTER_DRAIN) { E(acc, cur, wr, wc, fr, fq); S.done(cur); }
        if (!has_next) break;
#pragma unroll
        for (int a = 0; a < 2; ++a)
#pragma unroll
            for (int b = 0; b < 2; ++b)
#pragma unroll
                for (int m = 0; m < 4; ++m)
#pragma unroll
                    for (int n = 0; n < 2; ++n) acc[a][b][m][n] = (f32x4){0.f, 0.f, 0.f, 0.f};
        cur = nxt; cB = nB; ++ui; gA[0] = gN[0]; gA[1] = gN[1]; gA[2] = gN[2]; gA[3] = gN[3];
        if constexpr (ALIGN_EPI) { if (wr == 1) PG8_BAR; }
    }
    PG8_WAIT_V(0);
    if constexpr (!ALIGN_EPI) { if (wr == 0) PG8_BAR; }
    PG8_BAR;
    if constexpr (Epi::AFTER_DRAIN) { E.fused(acc, cur, wr, wc, fr, fq, lds, wid, lane); S.done(cur); }
#undef PG8_SA
#undef PG8_SB
#undef PG8_STAGE
#undef PG8_STAGEG
#undef PG8_GLOAD
#undef PG8_LDA
#undef PG8_LDB
#undef PG8_MMA
#undef PG8_WAIT_V
#undef PG8_WAIT_L
#undef PG8_BAR
#undef PG8_SCHED
}
}

constexpr int NTOK = 8192, SEQ = 4096, DM = 2048, NLAYER = 2;
constexpr int IN_COLS = 15808, INP = 15872;
constexpr int NSEG = 65;
constexpr int XS_ROWS = 8192 + 65536 + 64 * 256;
constexpr int NPHASE = 16;
constexpr float LN_EPS = 1e-5f, GN_EPS = 64e-5f, ALPHA = 1.4142135623730951f  , ROUTED_SCALE = 2.5f;

constexpr size_t MiB = 1u << 20, KiB = 1u << 10;
constexpr size_t WS_CTL = 0, CTL_ZERO_BYTES = 1 * MiB;
constexpr size_t WS_HIST = 1 * MiB;
constexpr size_t WS_SELE = WS_HIST + 64 * KiB;
constexpr size_t WS_SELW = WS_SELE + 256 * KiB;
constexpr size_t WS_SLOT = WS_SELW + 256 * KiB;
constexpr size_t WS_ROWW = WS_SLOT + 256 * KiB;
constexpr size_t WS_TSEG = WS_ROWW + 352 * KiB;
constexpr size_t WS_BON = WS_TSEG + 4 * KiB;
constexpr size_t WS_ROWT = WS_BON + 576 * KiB;
constexpr size_t WS_XT = WS_ROWT + 352 * KiB;
constexpr size_t WS_WIN = 4 * MiB;
constexpr size_t WS_WLORA = 66 * MiB;
constexpr size_t WS_WBR = 69 * MiB;
constexpr size_t WS_WO = 81 * MiB;
constexpr size_t WS_WGU = 89 * MiB;
constexpr size_t WS_WD = 349 * MiB;
constexpr size_t WS_XB = 479 * MiB;
constexpr size_t WS_MERGED = 511 * MiB;
constexpr size_t WS_PRELN = 543 * MiB;
constexpr size_t WS_X1 = 607 * MiB;
constexpr size_t WS_X2 = 671 * MiB;
constexpr size_t WS_M = 735 * MiB;
constexpr size_t WS_PCONV = WS_M, WS_PQKV = WS_M + 48 * MiB, WS_PRKV = WS_M + 96 * MiB, WS_PLORA = WS_M + 144 * MiB, WS_PGATE = WS_M + 152 * MiB;
constexpr size_t WS_YBR = WS_M + 248 * MiB;
constexpr size_t WS_LORAA = WS_M + 296 * MiB;
constexpr size_t WS_RWR = WS_M + 304 * MiB, WS_RWW = WS_RWR + 32 * MiB, WS_RWK = WS_RWW + 32 * MiB, WS_RWV = WS_RWK + 32 * MiB, WS_RWKK = WS_RWV + 32 * MiB,
                 WS_RWB = WS_RWKK + 32 * MiB, WS_RWA = WS_RWB + 32 * MiB, WS_RWG = WS_RWA + 32 * MiB, WS_RWY = WS_RWG + 32 * MiB;
constexpr size_t WS_XS = WS_M;
constexpr size_t WS_H = WS_XS + 352 * MiB;
constexpr size_t WS_YS = WS_H + 88 * MiB;
constexpr size_t WS_END = WS_YS + 352 * MiB;
static_assert(WS_RWY + 32 * MiB <= WS_END && (size_t)XS_ROWS * 2048 * 2 == 352 * MiB && (size_t)XS_ROWS * 512 * 2 == 88 * MiB, "ws map");
static_assert(WS_XT + 16 * KiB <= WS_WIN && WS_WIN + (size_t)INP * 2048 * 2 <= WS_WLORA && WS_WGU + (size_t)65 * 1024 * 2048 * 2 <= WS_WD && WS_WD + (size_t)65 * 2048 * 512 * 2 <= WS_XB, "ws map 2");
constexpr int CW_TMO = 0, CW_BAR = 4096;

constexpr int RING_OFF = 0, RING_BYTES = 131072;
constexpr int LDS_BYTES = 147456;
constexpr int LDSCTL_OFF = LDS_BYTES - 1024, MISC_OFF = LDSCTL_OFF + 320;
constexpr int NWAVES = 8;

#define GAS __attribute__((address_space(1)))
#define LAS __attribute__((address_space(3)))
typedef unsigned short bf16;
typedef unsigned v4u __attribute__((ext_vector_type(4)));
typedef unsigned v2u __attribute__((ext_vector_type(2)));
typedef float f32x4 __attribute__((ext_vector_type(4)));
typedef float f32x16 __attribute__((ext_vector_type(16)));
typedef short bf16x8 __attribute__((ext_vector_type(8)));
typedef short s16x4 __attribute__((ext_vector_type(4)));
typedef GAS unsigned gu32;
#define RLX_AGENT __ATOMIC_RELAXED, __HIP_MEMORY_SCOPE_AGENT
#define LDS_WAIT() asm volatile("s_waitcnt lgkmcnt(0)" ::: "memory")
#define VM_WAIT() asm volatile("s_waitcnt vmcnt(0)" ::: "memory")
__device__ __forceinline__ unsigned f2bf(float f) { unsigned u = __builtin_bit_cast(unsigned, f); return (u + 0x7fffu + ((u >> 16) & 1u)) >> 16; }
__device__ __forceinline__ unsigned pk2(float lo, float hi) { return f2bf(lo) | (f2bf(hi) << 16); }
__device__ __forceinline__ float bf2f(bf16 b) { return __uint_as_float((unsigned)b << 16); }
__device__ __forceinline__ float blo(unsigned w) { return __uint_as_float(w << 16); }
__device__ __forceinline__ float bhi(unsigned w) { return __uint_as_float(w & 0xffff0000u); }
__device__ __forceinline__ int ld_i32(const int* p) { return __hip_atomic_load(p, RLX_AGENT); }
__device__ __forceinline__ float ld_f32(const float* p) { return __hip_atomic_load(p, RLX_AGENT); }

#define XB_TMO      128
#define XB_XCNT(j)  (256  + 64 * (j))
#define XB_XSUB(j)  (1280 + 64 * (j))
#define XB_XGEN(j)  (2304 + 64 * (j))
#define XB_TOP      3328
#define XB_TOPGEN   3392
#define XCD_BAR_WORDS 3456
#define XB_SPIN_CAP (1u << 18)

__device__ __forceinline__ unsigned xb_ld(unsigned* p)              { return __hip_atomic_load(p, __ATOMIC_RELAXED, __HIP_MEMORY_SCOPE_AGENT); }
__device__ __forceinline__ unsigned xb_add(unsigned* p, unsigned v) { return __hip_atomic_fetch_add(p, v, __ATOMIC_RELAXED, __HIP_MEMORY_SCOPE_AGENT); }
__device__ __forceinline__ unsigned xb_xcc_id() { return (unsigned)__builtin_amdgcn_s_getreg((3 << 11) | 20) & 0xFu; }
#define XB_SPIN(cond, bar) do { unsigned _sp = 0; while (cond) { __builtin_amdgcn_s_sleep(1); \
    if ((++_sp & 255u) == 0u) { if (xb_ld(&(bar)[XB_TMO])) break; if (_sp > XB_SPIN_CAP) { atomicAdd(&(bar)[XB_TMO], 1u); break; } } } } while (0)

struct XcdBarrier {
    unsigned* bar; unsigned x;
    volatile LAS unsigned* st;
};

__device__ __forceinline__ XcdBarrier xcd_barrier_post(unsigned* bar, volatile LAS unsigned* st) {
    XcdBarrier b; b.bar = bar; b.x = xb_xcc_id(); b.st = st;
    if (threadIdx.x == 0) (void)xb_add(&bar[XB_XCNT(b.x)], 1u);
    return b;
}
__device__ __forceinline__ void xcd_barrier_complete(unsigned* bar, unsigned x, unsigned& nloc, unsigned& nx) {
    const unsigned G = gridDim.x * gridDim.y * gridDim.z;
    unsigned sum, cnt, mine, sp = 0u;
    for (;;) {
        sum = 0u; cnt = 0u; mine = 0u;
#pragma unroll
        for (unsigned j = 0; j < 16; ++j) { const unsigned c = xb_ld(&bar[XB_XCNT(j)]); sum += c; cnt += (c > 0u) ? 1u : 0u; mine = (j == x) ? c : mine; }
        if (sum == G) break;
        __builtin_amdgcn_s_sleep(1);
        if ((++sp & 255u) == 0u) { if (xb_ld(&bar[XB_TMO])) break; if (sp > XB_SPIN_CAP) { atomicAdd(&bar[XB_TMO], 1u); break; } }
    }
    nloc = mine > 0u ? mine : 1u; nx = cnt > 0u ? cnt : 1u;
}

__device__ __forceinline__ void xcd_barrier(const XcdBarrier& b) {
    asm volatile("s_waitcnt vmcnt(0)" ::: "memory");
    __syncthreads();
    if (threadIdx.x == 0) {
        unsigned* bar = b.bar;
        __builtin_amdgcn_s_waitcnt(0);
        unsigned nloc = b.st[0], nx = b.st[1];
        if (nloc == 0u) { xcd_barrier_complete(bar, b.x, nloc, nx); b.st[0] = nloc; b.st[1] = nx; }
        const unsigned old = xb_add(&bar[XB_XSUB(b.x)], 1u);
        const unsigned gen = old / nloc;
        if (old + 1u == (gen + 1u) * nloc) {
            __builtin_amdgcn_fence(__ATOMIC_RELEASE, "agent");
            asm volatile("s_waitcnt vmcnt(0)" ::: "memory");
            const unsigned og = xb_add(&bar[XB_TOP], 1u);
            const unsigned tg = og / nx;
            if (og + 1u == (tg + 1u) * nx) xb_add(&bar[XB_TOPGEN], 1u);
            else XB_SPIN(xb_ld(&bar[XB_TOPGEN]) == tg, bar);
            __builtin_amdgcn_fence(__ATOMIC_ACQUIRE, "agent");
            xb_add(&bar[XB_XGEN(b.x)], 1u);
            asm volatile("s_waitcnt vmcnt(0)" ::: "memory");
        } else {
            XB_SPIN(xb_ld(&bar[XB_XGEN(b.x)]) == gen, bar);
            __builtin_amdgcn_fence(__ATOMIC_ACQUIRE, "agent");
            asm volatile("s_waitcnt vmcnt(0)" ::: "memory");
        }
    }
    __syncthreads();
}

struct Args { const float* in[28]; float* out; unsigned char* ws; int ph_lo, ph_hi, li, pad; };
typedef const __attribute__((address_space(4))) Args* KArgs;
struct Frame {
    LAS unsigned char* lds;
    volatile LAS unsigned* MISC;
    gu32* ctl;
    unsigned char* ws;
    int tid, lane, wave, vcu, G;
};
__device__ __forceinline__ float wave_sum(float v) {
#pragma unroll
    for (int o = 1; o < 64; o <<= 1) v += __shfl_xor(v, o);
    return v;
}
__device__ __forceinline__ float dpp16(float v) {
    v += __builtin_bit_cast(float, __builtin_amdgcn_update_dpp(0, __builtin_bit_cast(int, v), 0xB1, 0xF, 0xF, true));
    v += __builtin_bit_cast(float, __builtin_amdgcn_update_dpp(0, __builtin_bit_cast(int, v), 0x4E, 0xF, 0xF, true));
    v += __builtin_bit_cast(float, __builtin_amdgcn_update_dpp(0, __builtin_bit_cast(int, v), 0x141, 0xF, 0xF, true));
    v += __builtin_bit_cast(float, __builtin_amdgcn_update_dpp(0, __builtin_bit_cast(int, v), 0x140, 0xF, 0xF, true));
    return v;
}
__device__ __forceinline__ v4u pack8(const float* v) { v4u o; o.x = pk2(v[0], v[1]); o.y = pk2(v[2], v[3]); o.z = pk2(v[4], v[5]); o.w = pk2(v[6], v[7]); return o; }
__device__ __forceinline__ void unpack8(v4u w, float* v) { v[0] = blo(w.x); v[1] = bhi(w.x); v[2] = blo(w.y); v[3] = bhi(w.y); v[4] = blo(w.z); v[5] = bhi(w.z); v[6] = blo(w.w); v[7] = bhi(w.w); }

struct TrItem { const float* src; bf16* dst; int ldn, k0, n0, Kd; };
__device__ __forceinline__ void tr_issue(const TrItem& d, int lane, float (&hv)[32]) {
    const float* base = d.src + (size_t)d.k0 * d.ldn + d.n0;
    const unsigned off = (unsigned)(lane >> 3) * (unsigned)d.ldn + 4u * (unsigned)(lane & 7), step = 8u * (unsigned)d.ldn;
#pragma unroll
    for (int i = 0; i < 8; ++i) { const f32x4 v = __builtin_nontemporal_load((const f32x4*)(base + (off + (unsigned)i * step))); hv[4 * i] = v[0]; hv[4 * i + 1] = v[1]; hv[4 * i + 2] = v[2]; hv[4 * i + 3] = v[3]; }
}
__device__ __forceinline__ void tr_finish(const TrItem& d, int lane, const float (&hv)[32], LAS float* scr) {
    { LAS float* w = scr + (lane >> 3) * 33 + 4 * (lane & 7);
#pragma unroll
      for (int i = 0; i < 8; ++i) { w[i * 8 * 33] = hv[4 * i]; w[i * 8 * 33 + 1] = hv[4 * i + 1]; w[i * 8 * 33 + 2] = hv[4 * i + 2]; w[i * 8 * 33 + 3] = hv[4 * i + 3]; } }
    LDS_WAIT(); asm volatile("" ::: "memory");
    const int c = lane & 7;
#pragma unroll
    for (int j = 0; j < 4; ++j) { const int n = (lane >> 3) + 8 * j; const LAS float* s = scr + (8 * c) * 33 + n;
        v4u o; o.x = pg8::cvt_pk_bf16(s[0 * 33], s[1 * 33]); o.y = pg8::cvt_pk_bf16(s[2 * 33], s[3 * 33]); o.z = pg8::cvt_pk_bf16(s[4 * 33], s[5 * 33]); o.w = pg8::cvt_pk_bf16(s[6 * 33], s[7 * 33]);
        __builtin_nontemporal_store(o, (GAS v4u*)(d.dst + (size_t)n * d.Kd + d.k0 + 8 * c)); }
    LDS_WAIT(); asm volatile("" ::: "memory");
}
constexpr int I_IN = 32 * 494, I_BR = 3 * 16 * 64, I_WO = 32 * 64, I_G = 65 * 512, I_D = 65 * 512;
constexpr int NIT = I_IN + I_BR + I_WO + 2 * I_G + I_D;
#ifndef HN0
#define HN0 4
#define HN1 2
#define HN2 0
#define HN3 0
#define HN4 4
#define HN5 0
#define HN6 2
#endif
#ifndef P0_EXTRA
#define P0_EXTRA 0
#endif
#ifndef SEQ_ITEMS
#define SEQ_ITEMS 12544
#endif
constexpr int NIT_A = NIT - SEQ_ITEMS;
__device__ __forceinline__ TrItem decode_item(KArgs a, unsigned char* ws, int l, int it) {
    bf16* WIN = (bf16*)(ws + WS_WIN); bf16* WBR = (bf16*)(ws + WS_WBR); bf16* WO = (bf16*)(ws + WS_WO); bf16* WGU = (bf16*)(ws + WS_WGU); bf16* WD = (bf16*)(ws + WS_WD);
    int r = it; TrItem d;
    if (r < I_IN) { const int kb = r / 494, nb = r % 494, n0 = 32 * nb; d.src = a->in[1] + (size_t)l * 2048 * IN_COLS; d.ldn = IN_COLS; d.k0 = 64 * kb; d.n0 = n0; d.dst = WIN + (size_t)(n0 + (n0 >= 9408 ? 64 : 0)) * 2048; d.Kd = 2048; return d; }
    r -= I_IN;
    if (r < I_BR) { const int nbr = r / 1024, rr = r % 1024, kb = rr / 64, nb = rr % 64; d.src = a->in[14] + (size_t)l * 3 * 1024 * 2048 + (size_t)nbr * 1024 * 2048; d.ldn = 2048; d.k0 = 64 * kb; d.n0 = 32 * nb;
        d.dst = WBR + (size_t)nbr * 2048 * 1024 + (size_t)(32 * nb) * 1024; d.Kd = 1024; return d; }
    r -= I_BR;
    if (r < I_WO) { const int kb = r / 64, nb = r % 64; d.src = a->in[15] + (size_t)l * 2048 * 2048; d.ldn = 2048; d.k0 = 64 * kb; d.n0 = 32 * nb; d.dst = WO + (size_t)(32 * nb) * 2048; d.Kd = 2048; return d; }
    r -= I_WO;
    if (r < 2 * I_G) { const int up = r >= I_G ? 1 : 0; if (up) r -= I_G; const int seg = r / 512, rr = r % 512, kb = rr / 16, nb = rr % 16, n0 = 32 * nb;
        d.src = seg == 0 ? (up ? a->in[24] : a->in[23]) + (size_t)l * 2048 * 512 : (up ? a->in[21] : a->in[20]) + (size_t)(l * 64 + seg - 1) * 2048 * 512;
        d.ldn = 512; d.k0 = 64 * kb; d.n0 = n0; d.dst = WGU + (size_t)(seg * 1024 + (n0 >> 7) * 256 + (n0 & 127) + up * 128) * 2048; d.Kd = 2048; return d; }
    r -= 2 * I_G;
    { const int seg = r / 512, rr = r % 512, kb = rr / 64, nb = rr % 64;
        d.src = seg == 0 ? a->in[25] + (size_t)l * 512 * 2048 : a->in[22] + (size_t)(l * 64 + seg - 1) * 512 * 2048;
        d.ldn = 2048; d.k0 = 64 * kb; d.n0 = 32 * nb; d.dst = WD + (size_t)(seg * 2048 + 32 * nb) * 512; d.Kd = 512; return d; }
}
__device__ __forceinline__ void convert_item(KArgs a, unsigned char* ws, int l, int it, LAS float* scr, int lane) {
    const TrItem d = decode_item(a, ws, l, it); float hv[32]; tr_issue(d, lane, hv); tr_finish(d, lane, hv, scr);
}
#ifndef SHADOW_CONVERT
#define SHADOW_CONVERT 1
#endif
__device__ __forceinline__ void ph0_convert(KArgs a, Frame& F, int l) {
    LAS float* scr = (LAS float*)(F.lds + RING_OFF + F.wave * 16384);
    const int gw = F.vcu * NWAVES + F.wave, NGW = F.G * NWAVES;
    bf16* WIN = (bf16*)(F.ws + WS_WIN); bf16* WLORA = (bf16*)(F.ws + WS_WLORA);
    for (int it = gw; it < (SHADOW_CONVERT ? I_IN + P0_EXTRA : NIT); it += NGW) convert_item(a, F.ws, l, it, scr, F.lane);
    const size_t gt = (size_t)F.vcu * 512 + F.tid, NT = (size_t)F.G * 512;
    for (size_t i = gt; i < 64 * 2048 / 8; i += NT) ((v4u*)(WIN + (size_t)9408 * 2048))[i] = (v4u){0u, 0u, 0u, 0u};
    { const float* w2 = a->in[5] + (size_t)l * 96 * 1024; const float* a2 = a->in[7] + (size_t)l * 96 * 1024; const float* g2 = a->in[8] + (size_t)l * 256 * 1024;
      for (size_t i = gt; i < (size_t)3072 * 512; i += NT) { const int k = (int)(i / 3072), n = (int)(i % 3072), sec = n >> 10, nn = n & 1023; float v = 0.f;
          if (sec == 0) { if (k < 96) v = w2[k * 1024 + nn]; } else if (sec == 1) { if (k >= 96 && k < 192) v = a2[(k - 96) * 1024 + nn]; } else { if (k >= 256) v = g2[(k - 256) * 1024 + nn]; }
          WLORA[(size_t)n * 512 + k] = (bf16)f2bf(v); } }
    if (l == 0) { const f32x4* x = (const f32x4*)a->in[0]; v4u* xb = (v4u*)(F.ws + WS_XB);
        for (size_t i = gt; i < (size_t)NTOK * DM / 8; i += NT) { const f32x4 p = x[2 * i], q = x[2 * i + 1]; v4u o; o.x = pk2(p[0], p[1]); o.y = pk2(p[2], p[3]); o.z = pk2(q[0], q[1]); o.w = pk2(q[2], q[3]); xb[i] = o; } }
}

__device__ __forceinline__ void ph2_elementwise(KArgs a, Frame& F, int l) {
    const size_t gt = (size_t)F.vcu * 512 + F.tid, NT = (size_t)F.G * 512;
    const bf16* PC = (const bf16*)(F.ws + WS_PCONV); bf16* Y0 = (bf16*)(F.ws + WS_YBR);
    const float* cw = a->in[2] + (size_t)l * 3 * 1024;
    for (size_t i = gt; i < (size_t)NTOK * 128; i += NT) { const int t = (int)(i >> 7), c = (int)(i & 127) * 8, tt = t & (SEQ - 1);
        const bf16* row = PC + (size_t)t * 3072;
        float gb[8], g0[8], h0[8], u0[8], u1[8], u2[8];
        unpack8(*(const v4u*)(row + c), gb); unpack8(*(const v4u*)(row + 1024 + c), g0); unpack8(*(const v4u*)(row + 2048 + c), h0);
#pragma unroll
        for (int j = 0; j < 8; ++j) { u0[j] = g0[j] * h0[j]; u1[j] = 0.f; u2[j] = 0.f; }
        if (tt >= 1) { unpack8(*(const v4u*)(row - 3072 + 1024 + c), g0); unpack8(*(const v4u*)(row - 3072 + 2048 + c), h0);
#pragma unroll
            for (int j = 0; j < 8; ++j) u1[j] = g0[j] * h0[j]; }
        if (tt >= 2) { unpack8(*(const v4u*)(row - 6144 + 1024 + c), g0); unpack8(*(const v4u*)(row - 6144 + 2048 + c), h0);
#pragma unroll
            for (int j = 0; j < 8; ++j) u2[j] = g0[j] * h0[j]; }
        float y[8];
#pragma unroll
        for (int j = 0; j < 8; ++j) y[j] = gb[j] * (cw[c + j] * u2[j] + cw[1024 + c + j] * u1[j] + cw[2048 + c + j] * u0[j]);
        *(v4u*)(Y0 + (size_t)t * 1024 + c) = pack8(y); }
    const bf16* PR = (const bf16*)(F.ws + WS_PRKV); const float* mix = a->in[3] + (size_t)l * 3520;
    float* RWR = (float*)(F.ws + WS_RWR); float* RWK = (float*)(F.ws + WS_RWK); float* RWV = (float*)(F.ws + WS_RWV);
    for (size_t i = gt; i < (size_t)NTOK * 384; i += NT) { const int t = (int)(i / 384), c = (int)(i % 384) * 8, tt = t & (SEQ - 1);
        float p[8], q[8];
        unpack8(*(const v4u*)(PR + (size_t)t * 3072 + c), p);
        if (tt >= 1) unpack8(*(const v4u*)(PR + (size_t)(t - 1) * 3072 + c), q); else {
#pragma unroll
            for (int j = 0; j < 8; ++j) q[j] = 0.f; }
#pragma unroll
        for (int j = 0; j < 8; ++j) p[j] = p[j] + (q[j] - p[j]) * mix[c + j];
        float* dst = (c < 1024 ? RWR : (c < 2048 ? RWK : RWV)) + (size_t)t * 1024 + (c & 1023);
        *(f32x4*)dst = (f32x4){p[0], p[1], p[2], p[3]}; *(f32x4*)(dst + 4) = (f32x4){p[4], p[5], p[6], p[7]}; }
    const bf16* PL = (const bf16*)(F.ws + WS_PLORA); bf16* LA = (bf16*)(F.ws + WS_LORAA);
    for (size_t i = gt; i < (size_t)NTOK * 64; i += NT) { const int t = (int)(i >> 6), c = (int)(i & 63) * 8, tt = t & (SEQ - 1);
        float p[8], q[8];
        if (c >= 192 && c < 256) {
#pragma unroll
            for (int j = 0; j < 8; ++j) p[j] = 0.f;
        } else {
            unpack8(*(const v4u*)(PL + (size_t)t * 512 + c), p);
            if (tt >= 1) unpack8(*(const v4u*)(PL + (size_t)(t - 1) * 512 + c), q); else {
#pragma unroll
                for (int j = 0; j < 8; ++j) q[j] = 0.f; }
            const int mi = c < 96 ? 3072 + c : (c < 192 ? 3168 + (c - 96) : 3264 + (c - 256));
#pragma unroll
            for (int j = 0; j < 8; ++j) { const float v = p[j] + (q[j] - p[j]) * mix[mi + j]; p[j] = c < 96 ? tanhf(v) : (c < 192 ? v : 1.0f / (1.0f + expf(-v))); }
        }
        *(v4u*)(LA + (size_t)t * 512 + c) = pack8(p); }
}

__device__ __forceinline__ void ph4_prep(KArgs a, Frame& F, int l) {
    const int gw = F.vcu * NWAVES + F.wave, NGW = F.G * NWAVES;
    float* RWR = (float*)(F.ws + WS_RWR); float* RWK = (float*)(F.ws + WS_RWK); float* RWKK = (float*)(F.ws + WS_RWKK); float* RWB = (float*)(F.ws + WS_RWB);
    const float* RWA = (const float*)(F.ws + WS_RWA); float* BON = (float*)(F.ws + WS_BON);
    const float* kkw = a->in[9] + (size_t)l * 1024; const float* kaw = a->in[10] + (size_t)l * 1024; const float* rkw = a->in[11] + (size_t)l * 1024;
    for (int task = gw; task < NTOK * 4; task += NGW) { const int t = task >> 2, hq = task & 3, c = hq * 256 + 4 * F.lane; const size_t idx = (size_t)t * 1024 + c;
        const f32x4 r = *(const f32x4*)(RWR + idx), k = *(const f32x4*)(RWK + idx), av = *(const f32x4*)(RWA + idx);
        const f32x4 kkr = k * *(const f32x4*)(kkw + c);
        const float n2 = dpp16((kkr[0] * kkr[0] + kkr[1] * kkr[1]) + (kkr[2] * kkr[2] + kkr[3] * kkr[3]));
        const f32x4 kk = kkr * (1.0f / fmaxf(sqrtf(n2), 1e-12f));
        const f32x4 k2 = k * (1.0f + (av - 1.0f) * *(const f32x4*)(kaw + c));
        *(f32x4*)(RWK + idx) = k2; *(f32x4*)(RWKK + idx) = kk; *(f32x4*)(RWB + idx) = kk * av;
        const f32x4 pr = r * k2 * *(const f32x4*)(rkw + c);
        const float bon = dpp16((pr[0] + pr[1]) + (pr[2] + pr[3]));
        if ((F.lane & 15) == 0) BON[t * 16 + hq * 4 + (F.lane >> 4)] = bon; }
}
__device__ __forceinline__ void ph6_rwkv_out(KArgs a, Frame& F, int l) {
    const int gw = F.vcu * NWAVES + F.wave, NGW = F.G * NWAVES;
    const float* RWY = (const float*)(F.ws + WS_RWY); const float* RWV = (const float*)(F.ws + WS_RWV); const float* RWG = (const float*)(F.ws + WS_RWG); const float* BON = (const float*)(F.ws + WS_BON);
    bf16* Y2 = (bf16*)(F.ws + WS_YBR) + (size_t)2 * NTOK * 1024;
    const float* lg = a->in[12] + (size_t)l * 1024; const float* lb = a->in[13] + (size_t)l * 1024;
    for (int task = gw; task < NTOK * 4; task += NGW) { const int t = task >> 2, hq = task & 3, c = hq * 256 + 4 * F.lane; const size_t idx = (size_t)t * 1024 + c;
        const f32x4 y = *(const f32x4*)(RWY + idx);
        const float mu = dpp16((y[0] + y[1]) + (y[2] + y[3])) * (1.0f / 64.0f); const f32x4 d = y - mu;
        const float var = dpp16((d[0] * d[0] + d[1] * d[1]) + (d[2] * d[2] + d[3] * d[3])) * (1.0f / 64.0f);
        f32x4 yn = d * rsqrtf(var + GN_EPS) * *(const f32x4*)(lg + c) + *(const f32x4*)(lb + c);
        yn += BON[t * 16 + hq * 4 + (F.lane >> 4)] * *(const f32x4*)(RWV + idx);
        yn *= *(const f32x4*)(RWG + idx);
        v2u w; w.x = pk2(yn[0], yn[1]); w.y = pk2(yn[2], yn[3]); *(v2u*)(Y2 + idx) = w; }
}

typedef float f32x2_t __attribute__((ext_vector_type(2)));
__device__ __forceinline__ void reduce2(float q, float p, float& Q, float& P) {
    const auto a = __builtin_amdgcn_permlane16_swap(__float_as_uint(q), __float_as_uint(p), false, false);
    float x = __uint_as_float(a[0]) + __uint_as_float(a[1]);
    x = dpp16(x);
    const auto b = __builtin_amdgcn_permlane16_swap(__float_as_uint(x), __float_as_uint(x), false, false);
    Q = __uint_as_float(b[0]); P = __uint_as_float(b[1]);
}
template <int MODE  > __device__ __forceinline__ void ph5_scan(KArgs a, Frame& F, int l) {
#define LDS_BAR() do { asm volatile("s_waitcnt lgkmcnt(0)" ::: "memory"); __builtin_amdgcn_s_barrier(); asm volatile("" ::: "memory"); } while (0)
    const int bx = pg8::obid();
    const int seq = bx >> 3, b = seq >> 4, h = seq & 15, i0 = (bx & 7) * 8 + F.wave * 2;
    const bool active = F.wave < 4;
    LAS float* buf = (LAS float*)(F.lds + RING_OFF);
    constexpr int BSZ = 6 * 32 * 64, ASZ = 32 * 64, NBLK = SEQ / 32;
    const float* A0 = (const float*)(F.ws + WS_RWKK) + 1024; const float* A1 = (const float*)(F.ws + WS_RWB); const float* A2 = (const float*)(F.ws + WS_RWW);
    const float* A3 = (const float*)(F.ws + WS_RWK); const float* A4 = (const float*)(F.ws + WS_RWR); const float* A5 = (const float*)(F.ws + WS_RWV);
    float* RWY = (float*)(F.ws + (MODE == 0 ? WS_RWY : WS_M + 600 * MiB));
    const size_t tok0 = (size_t)b * SEQ; const int col0 = h * 64;
    const int st = F.tid >> 4, sq = F.tid & 15;
    const size_t soff = (tok0 + st) * 1024 + col0 + sq * 4;
    const int loff = st * 64 + sq * 4;
    const int rl = F.lane >> 5, jq = F.lane & 31, irow = i0 + rl;
    float S0 = 0.f, S1 = 0.f, yreg = 0.f, sa = 0.f;
#define SC_LOAD(R, blk_) do { if (MODE == 1) break; const size_t o_ = soff + (size_t)(blk_) * 32 * 1024; R##0 = *(const f32x4*)(A0 + o_); R##1 = *(const f32x4*)(A1 + o_); R##2 = *(const f32x4*)(A2 + o_); \
        R##3 = *(const f32x4*)(A3 + o_); R##4 = *(const f32x4*)(A4 + o_); R##5 = *(const f32x4*)(A5 + o_); } while (0)
#define SC_WRITE(R, bufi) do { if (MODE == 1) break; LAS float* nb_ = buf + (bufi) * BSZ; *(LAS f32x4*)(nb_ + 0 * ASZ + loff) = R##0; *(LAS f32x4*)(nb_ + 1 * ASZ + loff) = R##1; *(LAS f32x4*)(nb_ + 2 * ASZ + loff) = R##2; \
        *(LAS f32x4*)(nb_ + 3 * ASZ + loff) = R##3; *(LAS f32x4*)(nb_ + 4 * ASZ + loff) = R##4; *(LAS f32x4*)(nb_ + 5 * ASZ + loff) = R##5; } while (0)
#define SC_COMPUTE(bufi, blk_) do { if (active) { const LAS float* bb = buf + (bufi) * BSZ; \
        _Pragma("unroll 4") for (int tl = 0; tl < 32; ++tl) { const LAS float* base = bb + tl * 64; \
            const f32x2_t b2 = *(const LAS f32x2_t*)(base + 1 * ASZ + 2 * jq), w2 = *(const LAS f32x2_t*)(base + 2 * ASZ + 2 * jq), k2 = *(const LAS f32x2_t*)(base + 3 * ASZ + 2 * jq), \
                          r2 = *(const LAS f32x2_t*)(base + 4 * ASZ + 2 * jq), kn = *(const LAS f32x2_t*)(base + 0 * ASZ + 2 * jq); \
            const float v = base[5 * ASZ + irow]; \
            S0 = S0 * w2[0] + (sa * b2[0] + v * k2[0]); S1 = S1 * w2[1] + (sa * b2[1] + v * k2[1]); \
            float Q, P; reduce2(S0 * r2[0] + S1 * r2[1], S0 * kn[0] + S1 * kn[1], Q, P); \
            sa = -P; \
            if (jq == (tl & 15)) yreg = Q; \
            if ((tl & 15) == 15) { if (jq < 16) RWY[(tok0 + (size_t)(blk_) * 32 + (tl - 15) + jq) * 1024 + col0 + irow] = yreg; } } } } while (0)
    int hit = (SHADOW_CONVERT && MODE == 0 && !active) ? I_IN + (bx * 4 + (F.wave - 4)) : NIT;
    LAS float* hscr = (LAS float*)(F.lds + RING_OFF + (F.wave < 7 ? 98304 + (F.wave - 4) * 8448 : 132096));
    float hv[32]; TrItem hd = {}; bool hpend = false;
    if (active) __builtin_amdgcn_s_setprio(3);
#define SC_HELP() do { if (hpend) { tr_finish(hd, F.lane, hv, hscr); hpend = false; } if (hit < NIT) { hd = decode_item(a, F.ws, l, hit); tr_issue(hd, F.lane, hv); hpend = true; hit += 4 * (int)gridDim.x; } } while (0)
    f32x4 ra0 = {}, ra1 = {}, ra2 = {}, ra3 = {}, ra4 = {}, ra5 = {}, rb0 = {}, rb1 = {}, rb2 = {}, rb3 = {}, rb4 = {}, rb5 = {};
    SC_LOAD(ra, 0); SC_LOAD(rb, 1);
    SC_WRITE(ra, 0);
    SC_LOAD(ra, 2);
    for (int blk = 0; blk < NBLK; blk += 2) {
        LDS_BAR();
        SC_COMPUTE(0, blk);
        SC_WRITE(rb, 1);
        if (blk + 3 < NBLK) SC_LOAD(rb, blk + 3);
        SC_HELP();
        LDS_BAR();
        SC_COMPUTE(1, blk + 1);
        if (blk + 2 < NBLK) { SC_WRITE(ra, 0); if (blk + 4 < NBLK) SC_LOAD(ra, blk + 4); }
        SC_HELP();
    }
    __builtin_amdgcn_s_setprio(0);
    while (hit < NIT || hpend) SC_HELP();
    LDS_BAR();
#undef SC_HELP
#undef LDS_BAR
#undef SC_LOAD
#undef SC_WRITE
#undef SC_COMPUTE
}
namespace rk {
constexpr int NCHUNK = 32 * 64;
constexpr size_t BLOB = 57344;
constexpr size_t O_RH = 0, O_PT = 8192, O_Y0 = 16384, O_LMT = 32768, O_SC = 49152;
constexpr size_t WS_RKC = WS_M + 600 * MiB;
static_assert(WS_RKC + (size_t)NCHUNK * BLOB <= WS_END, "chunk blobs");
constexpr int B_AB = 0, B_KT = 16384, B_RT = 24576, B_VT = 32768, B_ATT = 40960, B_BHT = 49152, B_KHT = 57344, B_LAK = 65536, B_LRB = 73728, B_LRK = 81920, B_T = 90112, B_MISC = 98304, B_HSCR = 100352;
static_assert(B_HSCR + 4 * 8448 <= LDSCTL_OFF, "phase A LDS map");
#define RSW(row, col) ((row) * 128 + ((((col) * 2)) ^ (((row) & 7) << 4)))
__device__ __forceinline__ int crow(int r, int hi) { return (r & 3) + 8 * (r >> 2) + 4 * hi; }
__device__ __forceinline__ unsigned cvtpk(float lo, float hi) { unsigned r; asm volatile("v_cvt_pk_bf16_f32 %0, %1, %2" : "=v"(r) : "v"(lo), "v"(hi)); return r; }
__device__ __forceinline__ void mm(f32x16& acc, LAS const char* A, LAS const char* Bt, int tm, int tn, int r32, int hi) {
#pragma unroll
    for (int s = 0; s < 4; ++s) { const bf16x8 a = *(LAS const bf16x8*)(A + RSW(32 * tm + r32, 16 * s + 8 * hi)), b = *(LAS const bf16x8*)(Bt + RSW(32 * tn + r32, 16 * s + 8 * hi));
        acc = __builtin_amdgcn_mfma_f32_32x32x16_bf16(a, b, acc, 0, 0, 0); }
}
__device__ __forceinline__ void store_n(const f32x16& acc, LAS char* dst, int tm, int tn, int r32, int hi) {
#pragma unroll
    for (int r = 0; r < 16; ++r) *(LAS bf16*)(dst + RSW(32 * tm + crow(r, hi), 32 * tn + r32)) = (bf16)f2bf(acc[r]);
}
__device__ __forceinline__ void store_t(const f32x16& acc, LAS char* dst, int tm, int tn, int r32, int hi) {
#pragma unroll
    for (int g = 0; g < 4; ++g) { v2u w; w.x = cvtpk(acc[4 * g], acc[4 * g + 1]); w.y = cvtpk(acc[4 * g + 2], acc[4 * g + 3]); *(LAS v2u*)(dst + RSW(32 * tn + r32, 32 * tm + 8 * g + 4 * hi)) = w; }
}
__device__ __forceinline__ v4u frag8(const f32x16& acc, int sl) {
    v4u w; w.x = cvtpk(acc[8 * sl], acc[8 * sl + 1]); w.y = cvtpk(acc[8 * sl + 2], acc[8 * sl + 3]); w.z = cvtpk(acc[8 * sl + 4], acc[8 * sl + 5]); w.w = cvtpk(acc[8 * sl + 6], acc[8 * sl + 7]); return w;
}
#define RK_BAR() do { asm volatile("s_waitcnt lgkmcnt(0)" ::: "memory"); __builtin_amdgcn_s_barrier(); asm volatile("" ::: "memory"); } while (0)

template <int HELP, int FUSE_PREP, int VAR = 0  > __device__ __forceinline__ void rk_chunk_local(KArgs a, Frame& F, int l) {
    LAS char* L = (LAS char*)(F.lds + RING_OFF);
    const int lane0 = F.lane, wv = F.wave;
    const bool cw = wv < 4; const int tm = (wv >> 1) & 1, tn = wv & 1;
    const float* GW = (const float*)(F.ws + WS_RWW); const float* GKK = (const float*)(F.ws + (FUSE_PREP ? WS_RWA : WS_RWKK)); const float* GB = (const float*)(F.ws + WS_RWB);
    const float* GK = (const float*)(F.ws + WS_RWK); const float* GR = (const float*)(F.ws + WS_RWR); const float* GV = (const float*)(F.ws + WS_RWV);
    unsigned char* blobs = F.ws + WS_RKC;
    int hit = (HELP && !cw) ? I_IN + P0_EXTRA + (pg8::obid() * 4 + (wv - 4)) : NIT_A; const int hstride = 4 * (int)gridDim.x;
    LAS float* hscr = (LAS float*)(L + B_HSCR + (wv & 3) * 8448);
    float hva[32], hvb[32], hvc[32], hvd[32]; TrItem hda = {}, hdb = {}, hdc = {}, hdd = {}; bool pa = false, pb = false, pc = false, pd = false;
#define RK_FIN(hv, hd, pp) do { if (pp) { tr_finish(hd, lane0, hv, hscr); pp = false; } } while (0)
#define RK_ISS(hv, hd, pp) do { if (hit < NIT_A) { hd = decode_item(a, F.ws, l, hit); tr_issue(hd, lane0, hv); pp = true; hit += hstride; } } while (0)
#define RK_HELPN(n) do { RK_FIN(hva, hda, pa); RK_FIN(hvb, hdb, pb); RK_FIN(hvc, hdc, pc); RK_FIN(hvd, hdd, pd); \
        if ((n) > 0) RK_ISS(hva, hda, pa); if ((n) > 1) RK_ISS(hvb, hdb, pb); if ((n) > 2) RK_ISS(hvc, hdc, pc); if ((n) > 3) RK_ISS(hvd, hdd, pd); } while (0)
#define RK_SYNC() RK_BAR()
    if (!cw) {
#pragma unroll 1
        for (int chunk = pg8::obid(); chunk < NCHUNK; chunk += (int)gridDim.x) {
            if (HELP) RK_HELPN(HN0); RK_BAR();
            if (HELP) RK_HELPN(HN1); RK_BAR();
            if (HELP) RK_HELPN(HN2); RK_BAR();
            if (HELP) RK_HELPN(HN3); RK_BAR();
            if (HELP) RK_HELPN(HN4); RK_BAR();
            if (HELP) RK_HELPN(HN5); RK_BAR();
            if (HELP) RK_HELPN(HN6); RK_BAR(); }
        if (HELP) { while (hit < NIT_A || pa || pb || pc || pd) RK_HELPN(4); }
        return;
    }
#pragma unroll 1
    for (int chunk = pg8::obid(); chunk < NCHUNK; chunk += (int)gridDim.x) {
        int lane = lane0; asm volatile("" : "+v"(lane));
        const int r32 = lane & 31, hi = lane >> 5;
        const int seq = chunk >> 6, c = chunk & 63, b = seq >> 4, h = seq & 15;
        const size_t tok0 = (size_t)b * SEQ + (size_t)c * 64;
        unsigned char* blob = VAR ? F.ws + WS_M + 724 * MiB + (size_t)(chunk & 63) * BLOB : blobs + (size_t)chunk * BLOB;
        float cs[16]; float kkv[16], bbv[16], kv[16], rv[16], vv[16];
        const int j = lane, tg = wv & 3;
        if (cw) {
            const size_t g0 = (tok0 + 16 * tg) * 1024 + h * 64 + j;
            float run = 0.f;
            if (FUSE_PREP) {
                const int cj = h * 64 + j; const float kkw = a->in[9][(size_t)l * 1024 + cj], kaw = a->in[10][(size_t)l * 1024 + cj], rkw = a->in[11][(size_t)l * 1024 + cj];
                float* BON = (float*)(F.ws + WS_BON);
#pragma unroll
                for (int tt = 0; tt < 16; ++tt) { const size_t o = g0 + (size_t)tt * 1024; const float lw = __logf(GW[o]); run += lw; cs[tt] = run;
                    const float kraw = GK[o], av = GKK[o];
                    rv[tt] = GR[o]; vv[tt] = GV[o];
                    const float kkr = kraw * kkw; const float n2 = wave_sum(kkr * kkr); const float kk = kkr / fmaxf(sqrtf(n2), 1e-12f);
                    const float k2 = kraw * (1.0f + (av - 1.0f) * kaw);
                    kkv[tt] = kk; bbv[tt] = kk * av; kv[tt] = k2;
                    const float bon = wave_sum(rv[tt] * k2 * rkw);
                    if (lane == 0) BON[(tok0 + 16 * tg + tt) * 16 + h] = bon; }
            } else {
#pragma unroll
                for (int tt = 0; tt < 16; ++tt) { const size_t o = g0 + (size_t)tt * 1024; const float lw = __logf(GW[o]); run += lw; cs[tt] = run;
                    kkv[tt] = GKK[o]; bbv[tt] = GB[o]; kv[tt] = GK[o]; rv[tt] = GR[o]; vv[tt] = GV[o]; }
            }
            ((LAS float*)(L + B_MISC))[tg * 64 + j] = run;
        }
        RK_SYNC();
        if (cw) {
            const LAS float* ct = (const LAS float*)(L + B_MISC);
            const float t0 = ct[j], t1 = ct[64 + j], t2 = ct[128 + j], t3 = ct[192 + j];
            const float base = tg == 0 ? 0.f : (tg == 1 ? t0 : (tg == 2 ? t0 + t1 : t0 + t1 + t2)), total = (t0 + t1) + (t2 + t3);
            float prev = base;
#pragma unroll
            for (int tt = 0; tt < 16; ++tt) { const int t = 16 * tg + tt; const float cum = base + cs[tt];
                const float eP = __expf(cum), eM = __expf(-cum), ePm1 = __expf(prev), eC = __expf(total - cum); prev = cum;
                const float at = -kkv[tt] * ePm1;
                *(LAS bf16*)(L + B_AB + RSW(t, j)) = (bf16)f2bf(at);
                *(LAS bf16*)(L + B_AB + 8192 + RSW(t, j)) = (bf16)f2bf(bbv[tt] * eM);
                *(LAS bf16*)(L + B_KT + RSW(t, j)) = (bf16)f2bf(kv[tt] * eM);
                *(LAS bf16*)(L + B_RT + RSW(t, j)) = (bf16)f2bf(rv[tt] * eP);
                *(LAS bf16*)(L + B_VT + RSW(j, t)) = (bf16)f2bf(vv[tt]);
                *(LAS bf16*)(L + B_ATT + RSW(j, t)) = (bf16)f2bf(at);
                *(LAS bf16*)(L + B_BHT + RSW(j, t)) = (bf16)f2bf(bbv[tt] * eC);
                *(LAS bf16*)(L + B_KHT + RSW(j, t)) = (bf16)f2bf(kv[tt] * eC); }
            if (tg == 0) ((LAS float*)(L + B_MISC))[256 + j] = __expf(total);
        }
        RK_SYNC();
        f32x16 qab = {}, qak = {}, qrb = {}, qrk = {};
        if (cw && !(VAR & 2)) { mm(qab, L + B_AB, L + B_AB + 8192, tm, tn, r32, hi); mm(qak, L + B_AB, L + B_KT, tm, tn, r32, hi); mm(qrb, L + B_RT, L + B_AB + 8192, tm, tn, r32, hi); mm(qrk, L + B_RT, L + B_KT, tm, tn, r32, hi); }
        RK_SYNC();
        if (cw && !(VAR & 2)) {
#pragma unroll
            for (int r = 0; r < 16; ++r) { const int t = 32 * tm + crow(r, hi), s = 32 * tn + r32;
                ((LAS float*)(L + B_AB))[t * 64 + s] = s < t ? qab[r] : 0.f;
                qak[r] = s < t ? qak[r] : 0.f; qrb[r] = s <= t ? qrb[r] : 0.f; qrk[r] = s <= t ? qrk[r] : 0.f; }
            store_n(qak, L + B_LAK, tm, tn, r32, hi); store_n(qrb, L + B_LRB, tm, tn, r32, hi); store_n(qrk, L + B_LRK, tm, tn, r32, hi);
        }
        RK_SYNC();
        if (wv == 0 && !(VAR & 7)) {
            const LAS float* Lf = (const LAS float*)(L + B_AB);
            float Tr[64];
#pragma unroll
            for (int t = 0; t < 64; ++t) Tr[t] = 0.f;
#pragma unroll
            for (int t = 0; t < 64; ++t) { float a0 = Lf[t * 64 + lane], a1 = 0.f, a2 = 0.f, a3 = 0.f;
#pragma unroll
                for (int q = 0; q < (t + 3) / 4; ++q) { const f32x4 lv = *(const LAS f32x4*)(Lf + t * 64 + 4 * q);
                    a0 += lv[0] * Tr[4 * q + 0]; a1 += lv[1] * Tr[4 * q + 1]; a2 += lv[2] * Tr[4 * q + 2]; a3 += lv[3] * Tr[4 * q + 3]; }
                const float acc = (a0 + a1) + (a2 + a3);
                Tr[t] = acc; *(LAS bf16*)(L + B_T + RSW(t, lane)) = (bf16)f2bf(lane == t ? 1.0f + acc : acc); }
        } else if (cw && !(VAR & 6)) {
            for (int tile = (wv == 1 ? 0 : wv); tile < (wv == 1 ? 2 : wv + 1); ++tile) { f32x16 x = {}; mm(x, L + B_LAK, L + B_VT, tile >> 1, tile & 1, r32, hi); store_t(x, L + B_KT, tile >> 1, tile & 1, r32, hi); }
        }
        RK_SYNC();
        if (cw && !(VAR & 6)) { f32x16 u = {}, w = {}; mm(u, L + B_T, L + B_KT, tm, tn, r32, hi); mm(w, L + B_T, L + B_ATT, tm, tn, r32, hi);
            store_t(u, L + B_LAK, tm, tn, r32, hi); store_t(w, L + B_AB, tm, tn, r32, hi); }
        RK_SYNC();
        if (cw && !(VAR & 6)) {
            { f32x16 q = {}; mm(q, L + B_AB, L + B_LRB, tm, tn, r32, hi);
#pragma unroll
              for (int g = 0; g < 4; ++g) { const v2u rw = *(LAS const v2u*)(L + B_RT + RSW(32 * tn + r32, 32 * tm + 8 * g + 4 * hi));
                  q[4 * g] += blo(rw.x); q[4 * g + 1] += bhi(rw.x); q[4 * g + 2] += blo(rw.y); q[4 * g + 3] += bhi(rw.y); }
              v4u* dst = (v4u*)(blob + O_RH) + (size_t)(tn * 4 + 2 * tm) * 64 + lane; dst[0] = frag8(q, 0); dst[64] = frag8(q, 1); }
            { f32x16 q = {}; mm(q, L + B_AB, L + B_BHT, tm, tn, r32, hi);
              const float gcv = ((const LAS float*)(L + B_MISC))[256 + 32 * tn + r32];
#pragma unroll
              for (int r = 0; r < 16; ++r) if (32 * tm + crow(r, hi) == 32 * tn + r32) q[r] += gcv;
              v4u* dst = (v4u*)(blob + O_PT) + (size_t)(tn * 4 + 2 * tm) * 64 + lane; dst[0] = frag8(q, 0); dst[64] = frag8(q, 1); }
            { f32x16 q = {}; mm(q, L + B_LRB, L + B_LAK, tm, tn, r32, hi); mm(q, L + B_LRK, L + B_VT, tm, tn, r32, hi);
              float* dst = (float*)(blob + O_Y0) + (size_t)(2 * tm + tn) * 1024 + lane;
#pragma unroll
              for (int r = 0; r < 16; ++r) dst[r * 64] = q[r]; }
            { f32x16 q = {}; mm(q, L + B_BHT, L + B_LAK, tm, tn, r32, hi); mm(q, L + B_KHT, L + B_VT, tm, tn, r32, hi);
              float* dst = (float*)(blob + O_LMT) + (size_t)(2 * tm + tn) * 1024 + lane;
#pragma unroll
              for (int r = 0; r < 16; ++r) dst[r * 64] = q[r]; }
        }
        RK_SYNC();
    }
#undef RK_HELPN
#undef RK_FIN
#undef RK_ISS
#undef RK_SYNC
}
__device__ __forceinline__ void rk_sequential(KArgs a, Frame& F, int l) {
    const int bx = pg8::obid();
    if (bx >= 32) {
        LAS float* scr = (LAS float*)(F.lds + RING_OFF + F.wave * 16384);
        for (int it = NIT_A + (bx - 32) * NWAVES + F.wave; it < NIT; it += ((int)gridDim.x - 32) * NWAVES) convert_item(a, F.ws, l, it, scr, F.lane);
        return; }
    if (F.wave >= 2) return;
    const int ii = F.wave, lane = F.lane; unsigned char* blobs = F.ws + WS_RKC + (size_t)bx * 64 * BLOB;
    f32x16 xa0 = {}, xa1 = {}, xb0, xb1, xc0, xc1; v4u pa[8], pb[8], pc[8];
#define RKS_LDP(P, c_) do { if ((c_) < 64) { const v4u* pt_ = (const v4u*)(blobs + (size_t)(c_) * BLOB + O_PT) + lane; _Pragma("unroll") for (int q = 0; q < 8; ++q) P[q] = pt_[q * 64]; } } while (0)
#define RKS_LDL(L0, L1, c_) do { if ((c_) < 64) { const float* lm_ = (const float*)(blobs + (size_t)(c_) * BLOB + O_LMT) + lane; \
        _Pragma("unroll") for (int r = 0; r < 16; ++r) { L0[r] = lm_[(size_t)(0 + ii) * 1024 + r * 64]; L1[r] = lm_[(size_t)(2 + ii) * 1024 + r * 64]; } } } while (0)
#define RKS_STEP(P, s0, s1, l0, l1, c_) do { unsigned char* blob = blobs + (size_t)(c_) * BLOB; \
        v4u bf[4]; bf[0] = frag8(s0, 0); bf[1] = frag8(s0, 1); bf[2] = frag8(s1, 0); bf[3] = frag8(s1, 1); \
        { v4u* sc = (v4u*)(blob + O_SC) + (size_t)ii * 256 + lane; sc[0] = bf[0]; sc[64] = bf[1]; sc[128] = bf[2]; sc[192] = bf[3]; } \
        RKS_LDL(s0, s1, (c_) + 2); \
        _Pragma("unroll") for (int ks = 0; ks < 4; ++ks) { l0 = __builtin_amdgcn_mfma_f32_32x32x16_bf16(__builtin_bit_cast(bf16x8, P[ks]), __builtin_bit_cast(bf16x8, bf[ks]), l0, 0, 0, 0); \
                                                         l1 = __builtin_amdgcn_mfma_f32_32x32x16_bf16(__builtin_bit_cast(bf16x8, P[4 + ks]), __builtin_bit_cast(bf16x8, bf[ks]), l1, 0, 0, 0); } \
        RKS_LDP(P, (c_) + 3); } while (0)
    RKS_LDP(pa, 0); RKS_LDL(xb0, xb1, 0); RKS_LDP(pb, 1); RKS_LDL(xc0, xc1, 1); RKS_LDP(pc, 2);
#pragma unroll 1
    for (int c = 0; c < 63; c += 3) {
        RKS_STEP(pa, xa0, xa1, xb0, xb1, c);
        RKS_STEP(pb, xb0, xb1, xc0, xc1, c + 1);
        RKS_STEP(pc, xc0, xc1, xa0, xa1, c + 2);
    }
    RKS_STEP(pa, xa0, xa1, xb0, xb1, 63);
#undef RKS_LDP
#undef RKS_LDL
#undef RKS_STEP
}
template <int CHECK> __device__ __forceinline__ void rk_output(Frame& F, float* RWY, const float* REF, float* errw) {
    float e2 = 0.f, r2 = 0.f;
    const int gw = F.vcu * NWAVES + F.wave, NGW = F.G * NWAVES, lane = F.lane, r32 = lane & 31, hi = lane >> 5;
    for (int task = gw; task < NCHUNK * 2; task += NGW) { const int chunk = task >> 1, ii = task & 1; const int seq = chunk >> 6, c = chunk & 63, b = seq >> 4, h = seq & 15;
        const unsigned char* blob = F.ws + WS_RKC + (size_t)chunk * BLOB;
        v4u bf[4]; { const v4u* sc = (const v4u*)(blob + O_SC) + (size_t)ii * 256 + lane; bf[0] = sc[0]; bf[1] = sc[64]; bf[2] = sc[128]; bf[3] = sc[192]; }
#pragma unroll
        for (int tt = 0; tt < 2; ++tt) { f32x16 y; const float* y0 = (const float*)(blob + O_Y0) + (size_t)(2 * tt + ii) * 1024 + lane;
#pragma unroll
            for (int r = 0; r < 16; ++r) y[r] = y0[r * 64];
            const v4u* rh = (const v4u*)(blob + O_RH) + (size_t)(tt * 4) * 64 + lane;
#pragma unroll
            for (int ks = 0; ks < 4; ++ks) y = __builtin_amdgcn_mfma_f32_32x32x16_bf16(__builtin_bit_cast(bf16x8, rh[ks * 64]), __builtin_bit_cast(bf16x8, bf[ks]), y, 0, 0, 0);
            float* dst = RWY + ((size_t)b * SEQ + (size_t)c * 64 + 32 * tt) * 1024 + h * 64 + 32 * ii + r32;
#pragma unroll
            for (int r = 0; r < 16; ++r) dst[(size_t)crow(r, hi) * 1024] = y[r];
            if (CHECK) { const float* rf = REF + (dst - RWY);
#pragma unroll
                for (int r = 0; r < 16; ++r) { const float o = rf[(size_t)crow(r, hi) * 1024], d = y[r] - o; e2 += d * d; r2 += o * o; } } }
    }
    if (CHECK) { e2 = wave_sum(e2); r2 = wave_sum(r2); if (lane == 0) { atomicAdd(errw, e2); atomicAdd(errw + 1, r2); } }
}
#undef RSW
}
namespace att {
constexpr int SHM_K = 64 * 128 * 2, SHM_V = 64 * 128 * 2;
constexpr float ATT_STOP = -40.0f;
#define KSWZ(row, colB) ((row) * 256 + ((colB) ^ (((row) & 7) << 4)))
__device__ __forceinline__ int v_st(int k, int c) { const int kk = (k & ~0xC) | ((k & 4) << 1) | ((k & 8) >> 1); return ((kk >> 3) * 4 + (c >> 5)) * 512 + ((kk & 7) * 32 + (c & 31)) * 2; }
__device__ __forceinline__ int v_rd_base(int lane) { return ((lane & 3) << 3) | (((lane >> 2) & 3) << 6) | (((lane >> 4) & 1) << 5) | (((lane >> 5) & 1) << 8); }
constexpr int v_rd_off(int d0, int ks, int half) { return d0 * 512 + ks * 4096 + half * 2048; }
__device__ __forceinline__ int crow(int r, int hi) { return (r & 3) + 8 * (r >> 2) + 4 * hi; }
__device__ __forceinline__ unsigned cvtpk(float lo, float hi) { unsigned r; asm volatile("v_cvt_pk_bf16_f32 %0, %1, %2" : "=v"(r) : "v"(lo), "v"(hi)); return r; }
__device__ __forceinline__ int kperm(int m) { return 16 * ((m >> 2) & 1) + 4 * (m >> 3) + (m & 3); }

__device__ __forceinline__ void qkt(f32x16& p0, f32x16& p1, LAS const char* K_lds, int r32, int hi, const bf16x8* qr) {
    p0 = f32x16{}; p1 = f32x16{};
    LAS const char* kb[4];
#pragma unroll
    for (int dd = 0; dd < 4; ++dd) kb[dd] = K_lds + KSWZ(r32, (dd * 16 + hi * 8) * 2);
#pragma unroll
    for (int d0 = 0; d0 < 8; ++d0) { LAS const char* ap = kb[d0 & 3] + (d0 >> 2) * 128;
        const bf16x8 b0 = *(LAS const bf16x8*)ap;
        const bf16x8 b1 = *(LAS const bf16x8*)(ap + 32 * 256);
        p0 = __builtin_amdgcn_mfma_f32_32x32x16_bf16(b0, qr[d0], p0, 0, 0, 0);
        p1 = __builtin_amdgcn_mfma_f32_32x32x16_bf16(b1, qr[d0], p1, 0, 0, 0); }
}
__device__ __forceinline__ void pv_tile(f32x16* o, int vb0, bf16x8 pa0, bf16x8 pa1, bf16x8 pa2, bf16x8 pa3) {
#define TRRD(dst, off) asm volatile("ds_read_b64_tr_b16 %0, %1 offset:%2" : "=&v"(dst) : "v"(vb0), "i"(off) : "memory")
#define PV_D0(d0) do { s16x4 l0, l1, l2, l3, h0, h1, h2, h3; constexpr int b_ = v_rd_off(d0, 0, 0); \
        TRRD(l0, b_); TRRD(h0, b_ + 2048); TRRD(l1, b_ + 4096); TRRD(h1, b_ + 6144); TRRD(l2, b_ + 8192); TRRD(h2, b_ + 10240); TRRD(l3, b_ + 12288); TRRD(h3, b_ + 14336); \
        asm volatile("s_waitcnt lgkmcnt(0)" ::: "memory"); __builtin_amdgcn_sched_barrier(0); \
        o[d0] = __builtin_amdgcn_mfma_f32_32x32x16_bf16(pa0, (bf16x8){l0[0], l0[1], l0[2], l0[3], h0[0], h0[1], h0[2], h0[3]}, o[d0], 0, 0, 0);   \
        o[d0] = __builtin_amdgcn_mfma_f32_32x32x16_bf16(pa1, (bf16x8){l1[0], l1[1], l1[2], l1[3], h1[0], h1[1], h1[2], h1[3]}, o[d0], 0, 0, 0);   \
        o[d0] = __builtin_amdgcn_mfma_f32_32x32x16_bf16(pa2, (bf16x8){l2[0], l2[1], l2[2], l2[3], h2[0], h2[1], h2[2], h2[3]}, o[d0], 0, 0, 0);   \
        o[d0] = __builtin_amdgcn_mfma_f32_32x32x16_bf16(pa3, (bf16x8){l3[0], l3[1], l3[2], l3[3], h3[0], h3[1], h3[2], h3[3]}, o[d0], 0, 0, 0); } while (0)
    PV_D0(0); PV_D0(1); PV_D0(2); PV_D0(3);
#undef PV_D0
#undef TRRD
}
__device__ __forceinline__ void stick_tile(f32x16& p0, f32x16& p1, float& c, int t, int kb0, int hi) {
    const float CS = 0.08838834764831845f * 1.4426950408889634f;
    const int k0 = kb0 + 16 * hi, k1 = k0 + 32;
    float f0[16], f1[16]; float T0 = 0.f, T1 = 0.f;
#pragma unroll
    for (int r = 0; r < 16; ++r) {
        const float y0 = p0[r] * CS, y1 = p1[r] * CS;
        const float sp0 = __builtin_amdgcn_logf(1.0f + __builtin_amdgcn_exp2f(y0)), sp1 = __builtin_amdgcn_logf(1.0f + __builtin_amdgcn_exp2f(y1));
        f0[r] = (k0 + r < t) ? -sp0 : 0.f; f1[r] = (k1 + r < t) ? -sp1 : 0.f;
        p0[r] = y0 - sp0; p1[r] = y1 - sp1;
        T0 += f0[r]; T1 += f1[r];
    }
    const auto s1 = __builtin_amdgcn_permlane32_swap(__float_as_uint(T1), __float_as_uint(T1), false, false);
    const auto s0 = __builtin_amdgcn_permlane32_swap(__float_as_uint(T0), __float_as_uint(T0), false, false);
    const float T1lo = __uint_as_float(s1[0]), T1hi = __uint_as_float(s1[1]), T0lo = __uint_as_float(s0[0]), T0hi = __uint_as_float(s0[1]);
    const float c1 = c + T1hi, c2 = c1 + T1lo, c3 = c2 + T0hi, c4 = c3 + T0lo;
    float run1 = hi ? c : c1, run0 = hi ? c2 : c3;
#pragma unroll
    for (int r = 15; r >= 0; --r) {
        const float w1 = (k1 + r < t) ? __builtin_amdgcn_exp2f(p1[r] + run1) : 0.f; run1 += f1[r]; p1[r] = w1;
        const float w0 = (k0 + r < t) ? __builtin_amdgcn_exp2f(p0[r] + run0) : 0.f; run0 += f0[r]; p0[r] = w0;
    }
    c = c4;
}
#define PK4(P, B_, OUT) do { unsigned a0 = cvtpk(P[B_+0], P[B_+1]), a1 = cvtpk(P[B_+2], P[B_+3]);                          \
        unsigned b0 = cvtpk(P[B_+4], P[B_+5]), b1 = cvtpk(P[B_+6], P[B_+7]);                                             \
        auto r0 = __builtin_amdgcn_permlane32_swap(a0, b0, false, false); auto r1 = __builtin_amdgcn_permlane32_swap(a1, b1, false, false); \
        v4u w = {r0[0], r1[0], r0[1], r1[1]}; OUT = __builtin_bit_cast(bf16x8, w); } while (0)

__device__ __forceinline__ void attn_unit(LAS unsigned char* lds, const bf16* QKV, bf16* O, int b, int h, int qb) {
    const int tid = pg8::otid(), wid = __builtin_amdgcn_readfirstlane(tid >> 6), lane = tid & 63, r32 = lane & 31, hi = lane >> 5;
    LAS char* V_lds = (LAS char*)lds; LAS char* K_lds = (LAS char*)lds + SHM_V; volatile LAS int* flags = (volatile LAS int*)(lds + SHM_V + SHM_K);
    const bf16* Qp = QKV + (size_t)b * SEQ * 3072 + h * 128; const bf16* Kp = Qp + 1024; const bf16* Vp = Qp + 2048;
    const int qlo = qb * 256 + wid * 32, t = qlo + r32;
    bf16x8 qr[8];
#pragma unroll
    for (int d0 = 0; d0 < 8; ++d0) qr[d0] = *(const bf16x8*)(Qp + (size_t)t * 3072 + d0 * 16 + hi * 8);
    const int sr = tid >> 4, sc = (tid & 15) * 8, kr = kperm(sr);
    const int kws = KSWZ(sr, sc * 2), vst0 = v_st(sr, sc), vst1 = v_st(32 + sr, sc);
    const int vb0 = (int)(unsigned)(uintptr_t)V_lds + v_rd_base(lane);
    f32x16 o[4] = {}; float c = 0.f; bool done = false;
    if (tid < 8) flags[tid] = 0;
    for (int j = 4 * qb + 3; j >= 0; --j) {
        const int kb0 = j * 64;
        const bf16x8 k0v = *(const bf16x8*)(Kp + (size_t)(kb0 + kr) * 3072 + sc), k1v = *(const bf16x8*)(Kp + (size_t)(kb0 + 32 + kr) * 3072 + sc);
        const bf16x8 v0v = *(const bf16x8*)(Vp + (size_t)(kb0 + kr) * 3072 + sc), v1v = *(const bf16x8*)(Vp + (size_t)(kb0 + 32 + kr) * 3072 + sc);
        __syncthreads();
        bool all_done = true;
#pragma unroll
        for (int w = 0; w < 8; ++w) all_done = all_done && (flags[w] != 0);
        if (all_done) break;
        *(LAS bf16x8*)(K_lds + kws) = k0v; *(LAS bf16x8*)(K_lds + kws + 32 * 256) = k1v;
        *(LAS bf16x8*)(V_lds + vst0) = v0v; *(LAS bf16x8*)(V_lds + vst1) = v1v;
        __syncthreads();
        if (!done && kb0 <= qlo + 30) {
            f32x16 p0, p1;
            qkt(p0, p1, K_lds, r32, hi, qr);
            stick_tile(p0, p1, c, t, kb0, hi);
            bf16x8 pa0, pa1, pa2, pa3;
            PK4(p0, 0, pa0); PK4(p0, 8, pa1); PK4(p1, 0, pa2); PK4(p1, 8, pa3);
            pv_tile(o, vb0, pa0, pa1, pa2, pa3);
            done = __all(c < ATT_STOP) != 0;
            if (lane == 0 && done) flags[wid] = 1;
        }
    }
    bf16* Ow = O + ((size_t)b * SEQ + qlo) * 1024 + h * 128;
#pragma unroll
    for (int r = 0; r < 16; ++r) { const int orow = crow(r, hi);
#pragma unroll
        for (int d0 = 0; d0 < 4; ++d0) { const float v = o[d0][r]; const float vn = __shfl_xor(v, 1);
            if ((r32 & 1) == 0) *(unsigned*)(Ow + (size_t)orow * 1024 + d0 * 32 + r32) = cvtpk(v, vn); } }
    __syncthreads();
}
#undef PK4
#undef KSWZ
}
__device__ __forceinline__ float shx(float v, int m) { return __shfl_xor(v, m); }
__device__ __forceinline__ float rdl(float v, int l) { return __builtin_bit_cast(float, __builtin_amdgcn_readlane(__builtin_bit_cast(int, v), l)); }
__device__ __forceinline__ void ph9_ln_router(KArgs a, Frame& F, int l) {
    volatile LAS int* lhist = (volatile LAS int*)(F.lds + RING_OFF);
    const float* PRE = (const float*)(F.ws + WS_PRELN); float* X1 = (float*)(F.ws + WS_X1); bf16* XS = (bf16*)(F.ws + WS_XS);
    int* HIST = (int*)(F.ws + WS_HIST); int* SELE = (int*)(F.ws + WS_SELE); float* SELW = (float*)(F.ws + WS_SELW);
    const float* g1 = a->in[16] + (size_t)l * DM; const float* b1 = a->in[17] + (size_t)l * DM;
    const float* WR = a->in[18] + (size_t)l * DM * 64; const float* rbias = a->in[19] + (size_t)l * 64;
    const int lane = F.lane;
    for (int grp = pg8::obid(); grp < 256; grp += F.G) {
        if (F.tid < 64) lhist[F.tid] = 0;
        __syncthreads();
        const int t0 = grp * 32 + F.wave * 4;
#pragma unroll 1
        for (int k = 0; k < 4; ++k) {
            f32x4 v[8];
            const f32x4* row = (const f32x4*)(PRE + (size_t)(t0 + k) * DM) + lane; float s = 0.f;
#pragma unroll
            for (int j = 0; j < 8; ++j) { v[j] = row[64 * j]; s += (v[j][0] + v[j][1]) + (v[j][2] + v[j][3]); }
            const float mean = wave_sum(s) * (1.0f / DM); float s2 = 0.f;
#pragma unroll
            for (int j = 0; j < 8; ++j) { v[j] = v[j] - mean; s2 += (v[j][0] * v[j][0] + v[j][1] * v[j][1]) + (v[j][2] * v[j][2] + v[j][3] * v[j][3]); }
            const float rstd = 1.0f / sqrtf(wave_sum(s2) * (1.0f / DM) + LN_EPS);
            f32x4* xo = (f32x4*)(X1 + (size_t)(t0 + k) * DM) + lane; v2u* bo = (v2u*)(XS + (size_t)(t0 + k) * DM) + lane;
#pragma unroll
            for (int j = 0; j < 8; ++j) { const f32x4 gg = ((const f32x4*)g1)[64 * j + lane], bb = ((const f32x4*)b1)[64 * j + lane];
                v[j] = v[j] * rstd * gg + bb; xo[64 * j] = v[j];
                v2u w; w.x = pk2(v[j][0], v[j][1]); w.y = pk2(v[j][2], v[j][3]); bo[64 * j] = w; }
        }
        __syncthreads();
        LAS float* XC = (LAS float*)(F.lds + RING_OFF + 1024);
        LAS float* WC = (LAS float*)(F.lds + RING_OFF + 1024 + 33024);
        f32x16 ac0 = {}, ac1 = {};
#pragma unroll 1
        for (int j = 0; j < 8; ++j) {
            __syncthreads();
#pragma unroll
            for (int i = 0; i < 4; ++i) { const int idx = F.tid + 512 * i, xrow = idx >> 6, c4 = idx & 63;
                const f32x4 xv = *(const f32x4*)(X1 + (size_t)(grp * 32 + xrow) * DM + 256 * j + 4 * c4);
                LAS float* xr = XC + xrow * 257 + 4 * c4; xr[0] = xv[0]; xr[1] = xv[1]; xr[2] = xv[2]; xr[3] = xv[3]; }
            { const f32x4* wsrc = (const f32x4*)(WR + (size_t)256 * j * 64);
#pragma unroll
              for (int i = 0; i < 8; ++i) ((LAS f32x4*)WC)[F.tid + 512 * i] = wsrc[F.tid + 512 * i]; }
            __syncthreads();
#pragma unroll
            for (int kk = 0; kk < 16; ++kk) { const int kidx = 32 * F.wave + 2 * kk + (lane >> 5);
                const float av = XC[(lane & 31) * 257 + kidx], b0 = WC[kidx * 64 + (lane & 31)], b1 = WC[kidx * 64 + 32 + (lane & 31)];
                ac0 = __builtin_amdgcn_mfma_f32_32x32x2f32(av, b0, ac0, 0, 0, 0); ac1 = __builtin_amdgcn_mfma_f32_32x32x2f32(av, b1, ac1, 0, 0, 0); }
        }
        __syncthreads();
        { LAS float* RED = WC; const int hi = lane >> 5, e = lane & 31;
#pragma unroll
          for (int r = 0; r < 16; ++r) { const int tok = (r & 3) + 8 * (r >> 2) + 4 * hi; RED[(F.wave * 32 + tok) * 64 + e] = ac0[r]; RED[(F.wave * 32 + tok) * 64 + 32 + e] = ac1[r]; } }
        __syncthreads();
        float acc[4];
#pragma unroll
        for (int k = 0; k < 4; ++k) { float sacc = 0.f;
#pragma unroll
            for (int w2 = 0; w2 < 8; ++w2) sacc += WC[(w2 * 32 + F.wave * 4 + k) * 64 + lane];
            acc[k] = sacc; }
        const float rb = rbias[lane];
#pragma unroll
        for (int k = 0; k < 4; ++k) {
            const int t = t0 + k;
            const float sc = 1.0f / (1.0f + expf(-acc[k])); const float bz = sc + rb;
            float m1 = bz; m1 = fmaxf(m1, shx(m1, 1)); m1 = fmaxf(m1, shx(m1, 2)); m1 = fmaxf(m1, shx(m1, 4));
            const unsigned long long eq = __ballot(bz == m1);
            const int g = lane >> 3; const unsigned gb = (unsigned)((eq >> (8 * g)) & 0xffull); const int first = __ffs((int)gb) - 1;
            float m2 = ((lane & 7) == first) ? -__builtin_inff() : bz; m2 = fmaxf(m2, shx(m2, 1)); m2 = fmaxf(m2, shx(m2, 2)); m2 = fmaxf(m2, shx(m2, 4));
            const float gs = m1 + m2;
            int grank = 0;
#pragma unroll
            for (int g2 = 0; g2 < 8; ++g2) { const float o = rdl(gs, 8 * g2); grank += ((o > gs) || (o == gs && g2 < g)) ? 1 : 0; }
            const bool gsel = grank < 4;
            const float mv = gsel ? bz : -__builtin_inff();
            int rank = 0;
            for (int e2 = 0; e2 < 64; ++e2) { const float o = rdl(mv, e2); rank += ((o > mv) || (o == mv && e2 < lane)) ? 1 : 0; }
            const bool sel = gsel && rank < 8;
            const float ssum = wave_sum(sel ? sc : 0.f);
            const float wgt = sc / ssum * ROUTED_SCALE;
            const unsigned long long m = __ballot(sel);
            const int slot = __popcll(m & ((1ull << lane) - 1ull));
            if (sel) { SELE[t * 8 + slot] = lane; SELW[t * 8 + slot] = wgt; __hip_atomic_fetch_add((LAS int*)&lhist[lane], 1, __ATOMIC_RELAXED, __HIP_MEMORY_SCOPE_WORKGROUP); }
        }
        __syncthreads();
        if (F.tid < 64) HIST[grp * 64 + F.tid] = lhist[F.tid];
        __syncthreads();
    }
}
__device__ __forceinline__ void ph10_lists(Frame& F) {
    volatile LAS int* L = (volatile LAS int*)(F.lds + RING_OFF);
    volatile LAS int* partT = L, * partB = L + 512, * rowbase = L + 1024, * lsel = L + 1088, * lpos = L + 1344;
    const int* HIST = (const int*)(F.ws + WS_HIST); const int* SELE = (const int*)(F.ws + WS_SELE); const float* SELW = (const float*)(F.ws + WS_SELW);
    int* SLOT = (int*)(F.ws + WS_SLOT); float* ROWW = (float*)(F.ws + WS_ROWW); int* TSEG = (int*)(F.ws + WS_TSEG); int* ROWT = (int*)(F.ws + WS_ROWT); int* XT = (int*)(F.ws + WS_XT);
    for (int grp = pg8::obid(); grp < 256; grp += F.G) {
        { const int e = F.tid & 63, part = F.tid >> 6; int s = 0, bs = 0;
          for (int w = 32 * part; w < 32 * part + 32; ++w) { const int hv = HIST[w * 64 + e]; s += hv; bs += (w < grp) ? hv : 0; }
          partT[part * 64 + e] = s; partB[part * 64 + e] = bs; }
        __syncthreads();
        if (F.tid < 64) { int tot = 0, bef = 0;
#pragma unroll
            for (int p = 0; p < 8; ++p) { tot += partT[p * 64 + F.tid]; bef += partB[p * 64 + F.tid]; }
            const int nt = (tot + 255) >> 8; int incl = nt;
#pragma unroll
            for (int o = 1; o < 64; o <<= 1) { const int u = __shfl_up(incl, o); if (F.lane >= o) incl += u; }
            const int excl = incl - nt;
            rowbase[F.tid] = 8192 + 256 * excl + bef;
            if (grp == 0) { for (int i = 0; i < nt; ++i) TSEG[16 + 32 + excl + i] = F.tid + 1;
                for (int r = 8192 + 256 * excl + tot; r < 8192 + 256 * (excl + nt); ++r) ROWT[r] = 0;
                if (F.tid < 32) TSEG[16 + F.tid] = 0;
                if (F.tid == 63) TSEG[0] = 32 + incl; } }
        if (F.tid < 256) lsel[F.tid] = SELE[grp * 256 + F.tid];
        __syncthreads();
        if (F.tid < 256) { const int j = F.tid >> 3, e = lsel[F.tid]; int rank = 0;
            for (int q = 0; q < 8 * j; ++q) rank += (lsel[q] == e) ? 1 : 0;
            const int pos = rowbase[e] + rank; const int t = grp * 32 + j;
            SLOT[t * 8 + (F.tid & 7)] = pos; ROWW[pos] = SELW[grp * 256 + F.tid]; ROWT[pos] = t; }
        else if (F.tid < 288) { ROWW[grp * 32 + F.tid - 256] = 1.0f; ROWT[grp * 32 + F.tid - 256] = grp * 32 + F.tid - 256; }
        __syncthreads();
    }
}
__device__ __forceinline__ void ph13_combine(KArgs a, Frame& F, int l, float poison) {
    const int gw = F.vcu * NWAVES + F.wave, NGW = F.G * NWAVES, lane = F.lane;
    const float* X1 = (const float*)(F.ws + WS_X1); const bf16* YS = (const bf16*)(F.ws + WS_YS); const int* SLOT = (const int*)(F.ws + WS_SLOT);
    float* outf = (l == NLAYER - 1) ? a->out : (float*)(F.ws + WS_X2); bf16* XB = (bf16*)(F.ws + WS_XB);
    const float* g2 = a->in[26] + (size_t)l * DM; const float* b2 = a->in[27] + (size_t)l * DM;
    for (int t = gw; t < NTOK; t += NGW) {
        const int mypos = (lane < 8) ? SLOT[t * 8 + lane] : t;
        float acc[4][8];
#pragma unroll
        for (int q = 0; q < 4; ++q) { const f32x4 p0 = *(const f32x4*)(X1 + (size_t)t * DM + 512 * q + 8 * lane), p1 = *(const f32x4*)(X1 + (size_t)t * DM + 512 * q + 8 * lane + 4);
#pragma unroll
            for (int j = 0; j < 4; ++j) { acc[q][j] = ALPHA * p0[j]; acc[q][4 + j] = ALPHA * p1[j]; } }
#pragma unroll
        for (int s = 0; s < 9; ++s) { const int row = __builtin_amdgcn_readlane(mypos, s); const v4u* yr = (const v4u*)(YS + (size_t)row * DM) + lane;
#pragma unroll
            for (int q = 0; q < 4; ++q) { float u[8]; unpack8(yr[64 * q], u);
#pragma unroll
                for (int j = 0; j < 8; ++j) acc[q][j] += u[j]; } }
        float s1 = 0.f;
#pragma unroll
        for (int q = 0; q < 4; ++q)
#pragma unroll
            for (int j = 0; j < 8; ++j) s1 += acc[q][j];
        const float mean = wave_sum(s1) * (1.0f / DM); float s2 = 0.f;
#pragma unroll
        for (int q = 0; q < 4; ++q)
#pragma unroll
            for (int j = 0; j < 8; ++j) { acc[q][j] -= mean; s2 += acc[q][j] * acc[q][j]; }
        const float rstd = 1.0f / sqrtf(wave_sum(s2) * (1.0f / DM) + LN_EPS);
#pragma unroll
        for (int q = 0; q < 4; ++q) { const int col = 512 * q + 8 * lane;
            const f32x4 ga = *(const f32x4*)(g2 + col), gb = *(const f32x4*)(g2 + col + 4), ba = *(const f32x4*)(b2 + col), bb = *(const f32x4*)(b2 + col + 4);
            float y[8];
#pragma unroll
            for (int j = 0; j < 4; ++j) { y[j] = (acc[q][j] * rstd * ga[j] + ba[j]) * poison; y[4 + j] = (acc[q][4 + j] * rstd * gb[j] + bb[j]) * poison; }
            *(f32x4*)(outf + (size_t)t * DM + col) = (f32x4){y[0], y[1], y[2], y[3]}; *(f32x4*)(outf + (size_t)t * DM + col + 4) = (f32x4){y[4], y[5], y[6], y[7]};
            *(v4u*)(XB + (size_t)t * DM + col) = pack8(y); }
    }
}
__device__ __forceinline__ KArgs kargs() { KArgs p = (KArgs)__builtin_amdgcn_kernarg_segment_ptr(); asm volatile("" : "+s"(p)); return p; }
__device__ __forceinline__ Frame mkframe(LAS unsigned char* lds) {
    Frame F; KArgs ka = kargs();
    F.lds = lds; F.MISC = (volatile LAS unsigned*)(lds + MISC_OFF);
    F.tid = pg8::otid(); F.lane = F.tid & 63; F.wave = __builtin_amdgcn_readfirstlane(F.tid >> 6);
    F.G = gridDim.x; { const int bx = pg8::obid(); F.vcu = (F.G % 8 == 0) ? (bx % 8) * (F.G / 8) + bx / 8 : bx; }
    F.ws = ka->ws; F.ctl = (gu32*)(ka->ws + WS_CTL);
    return F;
}
__device__ __forceinline__ void grid_seam(LAS unsigned char* lds) {
    XcdBarrier b; b.bar = (unsigned*)((gu32*)(kargs()->ws + WS_CTL) + CW_BAR); b.x = xb_xcc_id(); b.st = (volatile LAS unsigned*)(lds + MISC_OFF) + 8;
    xcd_barrier(b);
}
__global__ void __launch_bounds__(NWAVES * 64, 2) fwd_kernel(Args args_unused) {
    extern __shared__ __attribute__((aligned(16))) unsigned char lds_raw[];
    LAS unsigned char* lds = (LAS unsigned char*)lds_raw;
    for (int u = threadIdx.x; u < (LDS_BYTES - LDSCTL_OFF) / 4; u += NWAVES * 64) ((LAS unsigned*)(lds + LDSCTL_OFF))[u] = 0u;
    __syncthreads();
    if (kargs()->ph_hi - kargs()->ph_lo > 1) (void)xcd_barrier_post((unsigned*)((gu32*)(kargs()->ws + WS_CTL) + CW_BAR), (volatile LAS unsigned*)(lds + MISC_OFF) + 8);
#ifndef PH_MASK
#define PH_MASK 0xffff
#endif
#define IN(k) (((PH_MASK >> (k)) & 1) && kargs()->ph_lo <= (pb + (k)) && (pb + (k)) < kargs()->ph_hi)
#ifndef REP_MASK
#define REP_MASK 0
#endif
#define REPS(k) _Pragma("unroll 1") for (int rep_ = 0; rep_ < ((((REP_MASK) >> (k)) & 1) ? 2 : 1); ++rep_)
#define REPSEAM() do { if (rep_) grid_seam(lds); } while (0)
#define SEAM(k) do { if (IN(k) && (pb + (k) + 1) < kargs()->ph_hi) grid_seam(lds); } while (0)
#pragma unroll 1
    for (int l = 0; l < NLAYER; ++l) {
        const int pb = l * NPHASE;
        if (IN(0)) REPS(0) { REPSEAM(); Frame F = mkframe(lds); ph0_convert(kargs(), F, l); } SEAM(0);
        if (IN(1)) REPS(1) { REPSEAM(); unsigned char* ws = kargs()->ws;
            pg8::Gemm g{(const pg8::bf16_t*)(ws + WS_XB), (const pg8::bf16_t*)(ws + WS_WIN), NTOK, INP, DM}; pg8::StaticOrder S; S.init(NTOK, INP, (int)gridDim.x, pg8::obid());
            pg8::EpiInProj E{(pg8::bf16_t*)(ws + WS_PCONV), (pg8::bf16_t*)(ws + WS_PQKV), (pg8::bf16_t*)(ws + WS_PRKV), (pg8::bf16_t*)(ws + WS_PLORA), (pg8::bf16_t*)(ws + WS_PGATE)};
            pg8::gemm_phase<pg8::EpiInProj, pg8::StaticOrder, true, true>(lds + RING_OFF, g, S, E);
        } SEAM(1);
        if (IN(2)) REPS(2) { REPSEAM(); unsigned char* ws = kargs()->ws;
            for (int u = pg8::obid(); u < 256; u += gridDim.x) att::attn_unit(lds + RING_OFF, (const bf16*)(ws + WS_PQKV), (bf16*)(ws + WS_YBR) + (size_t)NTOK * 1024, u >> 7, (u >> 4) & 7, u & 15);
            Frame F = mkframe(lds); ph2_elementwise(kargs(), F, l);
        } SEAM(2);
        if (IN(3)) REPS(3) { REPSEAM(); unsigned char* ws = kargs()->ws;
            pg8::Gemm g{(const pg8::bf16_t*)(ws + WS_LORAA), (const pg8::bf16_t*)(ws + WS_WLORA), NTOK, 3072, 512}; pg8::StaticOrder S; S.init(NTOK, 3072, (int)gridDim.x, pg8::obid());
            pg8::EpiLora E{(float*)(ws + WS_RWW), (long)((WS_RWA - WS_RWW) / 4), (long)((WS_RWG - WS_RWW) / 4), kargs()->in[4] + (size_t)l * 1024, kargs()->in[6] + (size_t)l * 1024};
            pg8::gemm_phase<pg8::EpiLora, pg8::StaticOrder, true, true>(lds + RING_OFF, g, S, E);
        } SEAM(3);
#define MOE_C ((pg8::obid() & 7) * ((int)gridDim.x >> 3) + (pg8::obid() >> 3))
#ifndef DOWN_ALIGN
#define DOWN_ALIGN true
#endif
#ifndef RK_FUSE_PREP
#define RK_FUSE_PREP 0
#endif
#ifndef RWKV_MODE
#define RWKV_MODE 1
#endif
#ifndef RK_CHECK
#define RK_CHECK 0
#endif
#ifndef RK_CHECK_TOL
#define RK_CHECK_TOL 0.02f
#endif
        if ((RWKV_MODE == 0 || RK_CHECK || !RK_FUSE_PREP) && IN(4)) REPS(4) { REPSEAM(); Frame F = mkframe(lds); ph4_prep(kargs(), F, l); if ((pb + 5) < kargs()->ph_hi) grid_seam(lds); }

        if (IN(5)) REPS(5) { REPSEAM(); Frame F = mkframe(lds);
            if (RWKV_MODE == 0 || RK_CHECK) { ph5_scan<0>(kargs(), F, l); }
            if (RWKV_MODE == 1) { if (RK_CHECK) grid_seam(lds); rk::rk_chunk_local<RK_CHECK ? 0 : 1, (RK_CHECK || !RK_FUSE_PREP) ? 0 : 1>(kargs(), F, l); }
        } SEAM(5);
#ifdef RK_PROBE
        if (IN(5)) { Frame F = mkframe(lds); rk::rk_chunk_local<0, 0, RK_PROBE>(kargs(), F, l); grid_seam(lds); }
#endif
        if (IN(6)) REPS(6) { REPSEAM(); Frame F = mkframe(lds); if (RWKV_MODE == 1) rk::rk_sequential(kargs(), F, l); } SEAM(6);
        if (IN(7)) REPS(7) { REPSEAM(); Frame F = mkframe(lds);
            if (RWKV_MODE == 1) rk::rk_output<RK_CHECK>(F, (float*)(F.ws + (RK_CHECK ? WS_M + 720 * MiB : WS_RWY)), (const float*)(F.ws + WS_RWY), (float*)(F.ctl + 2048 + 2 * l)); } SEAM(7);
        if (IN(8)) REPS(8) { REPSEAM(); Frame F = mkframe(lds); ph6_rwkv_out(kargs(), F, l); } SEAM(8);
        if (IN(9)) REPS(9) { REPSEAM(); unsigned char* ws = kargs()->ws;
            pg8::Gemm g{(const pg8::bf16_t*)(ws + WS_YBR), (const pg8::bf16_t*)(ws + WS_WBR), 3 * NTOK, 3 * DM, 1024}; pg8::BranchOrder S; S.so.init(NTOK, DM, (int)gridDim.x, pg8::obid());
            pg8::EpiGate E{(const pg8::bf16_t*)(ws + WS_PGATE), (pg8::bf16_t*)(ws + WS_PRELN), (pg8::bf16_t*)(ws + WS_MERGED)};
            pg8::gemm_phase<pg8::EpiGate, pg8::BranchOrder, true, true>(lds + RING_OFF, g, S, E);
        } SEAM(9);
        if (IN(10)) REPS(10) { REPSEAM(); unsigned char* ws = kargs()->ws;
            pg8::Gemm g{(const pg8::bf16_t*)(ws + WS_MERGED), (const pg8::bf16_t*)(ws + WS_WO), NTOK, DM, DM}; pg8::StaticOrder S; S.init(NTOK, DM, (int)gridDim.x, pg8::obid());
            pg8::EpiWo E{l == 0 ? kargs()->in[0] : (const float*)(ws + WS_X2), (float*)(ws + WS_PRELN), ALPHA};
            pg8::gemm_phase<pg8::EpiWo, pg8::StaticOrder, true, true>(lds + RING_OFF, g, S, E);
        } SEAM(10);
        if (IN(11)) REPS(11) { REPSEAM(); Frame F = mkframe(lds); ph9_ln_router(kargs(), F, l); } SEAM(11);
        if (IN(12)) REPS(12) { REPSEAM(); Frame F = mkframe(lds); ph10_lists(F); } SEAM(12);
        if (IN(13)) REPS(13) { REPSEAM(); unsigned char* ws = kargs()->ws;
            const int ntiles = __builtin_amdgcn_readfirstlane(ld_i32((const int*)(ws + WS_TSEG)));
            pg8::Gemm g{(const pg8::bf16_t*)(ws + WS_XS), (const pg8::bf16_t*)(ws + WS_WGU), ntiles * 256, NSEG * 1024, DM};
            pg8::MoeOrder S{(const int*)(ws + WS_TSEG) + 16, ntiles, 4, (int)gridDim.x, MOE_C};
            pg8::EpiSwiglu E{(pg8::bf16_t*)(ws + WS_H), (const float*)(ws + WS_ROWW)};
            pg8::gemm_phase_gather<pg8::EpiSwiglu, pg8::MoeOrder, true, true>(lds + RING_OFF, g, S, E, (const int*)(ws + WS_ROWT));
        } SEAM(13);
        if (IN(14)) REPS(14) { REPSEAM(); unsigned char* ws = kargs()->ws;
            const int ntiles = __builtin_amdgcn_readfirstlane(ld_i32((const int*)(ws + WS_TSEG)));
            pg8::Gemm g{(const pg8::bf16_t*)(ws + WS_H), (const pg8::bf16_t*)(ws + WS_WD), ntiles * 256, NSEG * 2048, 512};
            pg8::MoeOrder S{(const int*)(ws + WS_TSEG) + 16, ntiles, 8, (int)gridDim.x, MOE_C};
            pg8::EpiDown E{(pg8::bf16_t*)(ws + WS_YS), (const float*)(ws + WS_ROWW)};
            pg8::gemm_phase<pg8::EpiDown, pg8::MoeOrder, DOWN_ALIGN, true>(lds + RING_OFF, g, S, E);
        } SEAM(14);
        if (IN(15)) REPS(15) { REPSEAM(); Frame F = mkframe(lds); ph13_combine(kargs(), F, l, (RK_CHECK && ld_f32((const float*)(F.ctl + 2048 + 2 * l)) > RK_CHECK_TOL * RK_CHECK_TOL * ld_f32((const float*)(F.ctl + 2049 + 2 * l))) ? 1000.f : 1.f); } SEAM(15);
    }
#undef IN
#undef SEAM
}

#ifndef MK_PER_PHASE
#define MK_PER_PHASE 0
#endif
extern "C" void kernel_launch(void* const* d_in, const int* in_sizes, int n_in, void* d_out, int out_size, void* d_ws, size_t ws_size, hipStream_t stream) {
    static int grid = 0;
    if (grid == 0) {
        if (n_in != 28 || out_size != NTOK * DM || ws_size < WS_END) { fprintf(stderr, "kernel_launch: unexpected problem shape (n_in %d out %d ws %zu)\n", n_in, out_size, ws_size); grid = -1; return; }
        int dev = 0, cus = 0, per_cu = 0;
        if (hipGetDevice(&dev) != hipSuccess || hipDeviceGetAttribute(&cus, hipDeviceAttributeMultiprocessorCount, dev) != hipSuccess) { grid = -1; return; }
        if (hipFuncSetAttribute((const void*)fwd_kernel, hipFuncAttributeMaxDynamicSharedMemorySize, LDS_BYTES) != hipSuccess) { fprintf(stderr, "kernel_launch: hipFuncSetAttribute failed\n"); grid = -1; return; }
        if (hipOccupancyMaxActiveBlocksPerMultiprocessor(&per_cu, (const void*)fwd_kernel, NWAVES * 64, LDS_BYTES) != hipSuccess || per_cu < 1) fprintf(stderr, "kernel_launch: occupancy query reports %d\n", per_cu);
        (void)hipGetLastError();
        grid = cus;
    }
    if (grid < 0) return;
    (void)hipMemsetAsync((char*)d_ws + WS_CTL, 0, CTL_ZERO_BYTES, stream);
    Args a{};
    for (int i = 0; i < 28; ++i) a.in[i] = (const float*)d_in[i];
    a.out = (float*)d_out; a.ws = (unsigned char*)d_ws; a.li = 0; a.pad = 0;
#if MK_PER_PHASE
    for (int p = 0; p < NLAYER * NPHASE; ++p) { a.ph_lo = p; a.ph_hi = p + 1; hipLaunchKernelGGL(fwd_kernel, dim3(grid), dim3(NWAVES * 64), LDS_BYTES, stream, a); }
#else
    a.ph_lo = 0; a.ph_hi = NLAYER * NPHASE;
    hipLaunchKernelGGL(fwd_kernel, dim3(grid), dim3(NWAVES * 64), LDS_BYTES, stream, a);
#endif
}
```

```cpp
#include <hip/hip_runtime.h>
#include <cstdio>
#include <cstdint>
namespace pg8 {
#define PG8_LAS __attribute__((address_space(3)))
typedef unsigned short bf16_t;
typedef short bf16x8 __attribute__((ext_vector_type(8)));
typedef float f32x4 __attribute__((ext_vector_type(4)));
typedef unsigned u32x4 __attribute__((ext_vector_type(4)));
constexpr int BM = 256, BK = 64, HALF = 128, HTB = HALF * BK * 2  , STAGE_BYTES = 8 * HTB, NXCD = 8, WGM = 8;

__host__ __device__ __forceinline__ int lds_byte(int r, int c) { const int st = (r >> 4) * 2 + (c >> 5), rr = r & 15, cc = c & 31, ob = rr * 64 + cc * 2; return st * 1024 + (ob ^ (((ob >> 9) & 1) << 5)); }
__host__ __device__ __forceinline__ void stage_rc(int b, int& R, int& C) { const int st = b / 1024, sb = b % 1024, swz = sb ^ (((sb >> 9) & 1) << 5); R = (st >> 1) * 16 + swz / 64; C = (st & 1) * 32 + (swz % 64) / 2; }
__host__ __device__ __forceinline__ int perm32(int rho) { const int n = rho >> 4, i = rho & 15; return 8 * (i >> 2) + 4 * n + (i & 3); }

struct Unit { int pm, pn; };
struct Gemm { const bf16_t* A; const bf16_t* Bt; int M, N, K; };

struct StaticOrder {
    int nM, nN, nwg, G, c;
    __host__ __device__ void init(int M, int N, int G_, int c_) { nM = M / BM; nN = N / BM; nwg = nM * nN; G = G_; c = c_; }
    __host__ __device__ bool next(int i, Unit& u) const {
        const long L = (long)i * G + c; if (L >= nwg) return false;
        int wgid = (int)L; { const int q = nwg / NXCD, r = nwg % NXCD, xcd = wgid % NXCD, off = wgid / NXCD; wgid = (xcd < r ? xcd * (q + 1) : r * (q + 1) + (xcd - r) * q) + off; }
        const int nig = WGM * nN, gid = wgid / nig, fm = gid * WGM, gsz = (nM - fm) < WGM ? (nM - fm) : WGM;
        u.pm = fm + ((wgid % nig) % gsz); u.pn = (wgid % nig) / gsz; return true;
    }
    __device__ __forceinline__ void a_ready(const Unit&) const {}
    __device__ __forceinline__ void done(const Unit&) const {}
};

__device__ __forceinline__ int otid() { int t = threadIdx.x; asm volatile("" : "+v"(t)); return t; }
__device__ __forceinline__ int obid() { int t = blockIdx.x; asm volatile("" : "+s"(t)); return t; }
__device__ __forceinline__ unsigned cvt_pk_bf16(float lo, float hi) { unsigned r; asm volatile("v_cvt_pk_bf16_f32 %0, %1, %2" : "=v"(r) : "v"(lo), "v"(hi)); return r; }
__device__ __forceinline__ float bflo(unsigned w) { return __uint_as_float(w << 16); }
__device__ __forceinline__ float bfhi(unsigned w) { return __uint_as_float(w & 0xffff0000u); }
__device__ __forceinline__ float sigmoidf_(float x) { return 1.0f / (1.0f + __expf(-x)); }

struct EpiInProj {
    static constexpr bool PERM = true, AFTER_DRAIN = false;
    bf16_t *conv, *qkv, *rkv, *lora, *gate;
    __device__ __forceinline__ void operator()(const f32x4 (&acc)[2][2][4][2], const Unit& u, int wr, int wc, int fr, int fq) const {
        const int pn = u.pn; bf16_t* base; int ldc, colt;
        if (pn < 12) { base = conv; ldc = 3072; colt = pn * 256; }
        else if (pn < 24) { base = qkv; ldc = 3072; colt = (pn - 12) * 256; }
        else if (pn < 36) { base = rkv; ldc = 3072; colt = (pn - 24) * 256; }
        else if (pn < 38) { base = lora; ldc = 512; colt = (pn - 36) * 256; }
        else { base = gate; ldc = 6144; colt = (pn - 38) * 256; }
        const int row0 = u.pm * BM + wr * 64 + fr, col0 = colt + wc * 32 + 8 * fq;
#pragma unroll
        for (int ai = 0; ai < 2; ++ai)
#pragma unroll
            for (int m = 0; m < 4; ++m) { bf16_t* rowp = base + (size_t)(row0 + ai * HALF + m * 16) * ldc + col0;
#pragma unroll
                for (int bj = 0; bj < 2; ++bj) { const f32x4 v0 = acc[ai][bj][m][0], v1 = acc[ai][bj][m][1];
                    u32x4 w; w.x = cvt_pk_bf16(v0[0], v0[1]); w.y = cvt_pk_bf16(v0[2], v0[3]); w.z = cvt_pk_bf16(v1[0], v1[1]); w.w = cvt_pk_bf16(v1[2], v1[3]);
                    *(u32x4*)(rowp + bj * HALF) = w; } }
    }
};
struct EpiLora {
    static constexpr bool PERM = false, AFTER_DRAIN = false;
    float* Wd; long offA, offG; const float *w0, *a0;
    __device__ __forceinline__ void operator()(const f32x4 (&acc)[2][2][4][2], const Unit& u, int wr, int wc, int fr, int fq) const {
        const int sec = u.pn >> 2, colt = (u.pn & 3) * 256;
        float* out = Wd + (sec == 0 ? 0l : (sec == 1 ? offA : offG));
        const float* bp = sec == 0 ? w0 : a0;
        const int row0 = u.pm * BM + wr * 64 + fr, col0 = colt + wc * 32 + 4 * fq;
        f32x4 bv[2][2];
#pragma unroll
        for (int bj = 0; bj < 2; ++bj)
#pragma unroll
            for (int n = 0; n < 2; ++n) { const f32x4 t = *(const f32x4*)(bp + col0 + bj * HALF + n * 16); bv[bj][n] = sec == 2 ? (f32x4){0.f, 0.f, 0.f, 0.f} : t; }
#pragma unroll
        for (int ai = 0; ai < 2; ++ai)
#pragma unroll
            for (int m = 0; m < 4; ++m) { float* rowp = out + (size_t)(row0 + ai * HALF + m * 16) * 1024 + col0;
#pragma unroll
                for (int bj = 0; bj < 2; ++bj)
#pragma unroll
                    for (int n = 0; n < 2; ++n) { f32x4 v = acc[ai][bj][m][n] + bv[bj][n];
                        if (sec == 0) {
#pragma unroll
                            for (int j = 0; j < 4; ++j) { const float x = v[j]; const float sp = fmaxf(-x, 0.f) + __logf(1.0f + __expf(-fabsf(x)));
                                v[j] = __expf(-__expf(-sp - 0.5f)); }
                        } else if (sec == 1) {
#pragma unroll
                            for (int j = 0; j < 4; ++j) v[j] = 1.0f / (1.0f + __expf(-v[j]));
                        }
                        *(f32x4*)(rowp + bj * HALF + n * 16) = v; } }
    }
};
struct EpiGate {
    static constexpr bool PERM = true, AFTER_DRAIN = false;
    const bf16_t* gate; bf16_t* tmp; bf16_t* out;
    __device__ __forceinline__ void operator()(const f32x4 (&acc)[2][2][4][2], const Unit& u, int wr, int wc, int fr, int fq) const {
        const int mode = u.pn >> 3;
        const int row0 = (u.pm & 31) * BM + wr * 64 + fr, col0 = (u.pn & 7) * BM + wc * 32 + 8 * fq;
        const bf16_t* gp = gate + mode * 2048;
#pragma unroll
        for (int ai = 0; ai < 2; ++ai)
#pragma unroll
            for (int m = 0; m < 4; ++m) { const size_t row = (size_t)(row0 + ai * HALF + m * 16);
#pragma unroll
                for (int bj = 0; bj < 2; ++bj) { const int col = col0 + bj * HALF;
                    const u32x4 gw = *(const u32x4*)(gp + row * 6144 + col);
                    f32x4 v0 = acc[ai][bj][m][0], v1 = acc[ai][bj][m][1];
                    v0[0] *= sigmoidf_(bflo(gw.x)); v0[1] *= sigmoidf_(bfhi(gw.x)); v0[2] *= sigmoidf_(bflo(gw.y)); v0[3] *= sigmoidf_(bfhi(gw.y));
                    v1[0] *= sigmoidf_(bflo(gw.z)); v1[1] *= sigmoidf_(bfhi(gw.z)); v1[2] *= sigmoidf_(bflo(gw.w)); v1[3] *= sigmoidf_(bfhi(gw.w));
                    bf16_t* tp = tmp + row * 2048 + col;
                    if (mode != 0) { const u32x4 tw = *(const u32x4*)tp; v0[0] += bflo(tw.x); v0[1] += bfhi(tw.x); v0[2] += bflo(tw.y); v0[3] += bfhi(tw.y); v1[0] += bflo(tw.z); v1[1] += bfhi(tw.z); v1[2] += bflo(tw.w); v1[3] += bfhi(tw.w); }
                    if (mode != 2) { u32x4 w; w.x = cvt_pk_bf16(v0[0], v0[1]); w.y = cvt_pk_bf16(v0[2], v0[3]); w.z = cvt_pk_bf16(v1[0], v1[1]); w.w = cvt_pk_bf16(v1[2], v1[3]); *(u32x4*)tp = w; }
                    else { u32x4 w; w.x = cvt_pk_bf16(v0[0], v0[1]); w.y = cvt_pk_bf16(v0[2], v0[3]); w.z = cvt_pk_bf16(v1[0], v1[1]); w.w = cvt_pk_bf16(v1[2], v1[3]);
                        *(u32x4*)(out + row * 2048 + col) = w; } } }
    }
};
struct BranchOrder {
    StaticOrder so;
    __device__ __forceinline__ bool next(int i, Unit& u) const { Unit t; if (!so.next(i / 3, t)) return false; const int n = i % 3; u.pm = n * 32 + t.pm; u.pn = n * 8 + t.pn; return true; }
    __device__ __forceinline__ void a_ready(const Unit&) const {}
    __device__ __forceinline__ void done(const Unit&) const {}
};
struct EpiWo {
    static constexpr bool PERM = false, AFTER_DRAIN = false;
    const float* xin; float* out; float alpha;
    __device__ __forceinline__ void operator()(const f32x4 (&acc)[2][2][4][2], const Unit& u, int wr, int wc, int fr, int fq) const {
        const int row0 = u.pm * BM + wr * 64 + fr, col0 = u.pn * BM + wc * 32 + 4 * fq;
#pragma unroll
        for (int ai = 0; ai < 2; ++ai)
#pragma unroll
            for (int m = 0; m < 4; ++m) { const size_t off = (size_t)(row0 + ai * HALF + m * 16) * 2048 + col0;
#pragma unroll
                for (int bj = 0; bj < 2; ++bj)
#pragma unroll
                    for (int n = 0; n < 2; ++n) { const f32x4 xv = *(const f32x4*)(xin + off + bj * HALF + n * 16);
                        *(f32x4*)(out + off + bj * HALF + n * 16) = xv * alpha + acc[ai][bj][m][n]; } }
    }
};
struct EpiSwiglu {
    static constexpr bool PERM = true, AFTER_DRAIN = false;
    bf16_t* H; const float* roww;
    __device__ __forceinline__ void operator()(const f32x4 (&acc)[2][2][4][2], const Unit& u, int wr, int wc, int fr, int fq) const {
        const int row0 = u.pm * BM + wr * 64 + fr, col0 = (u.pn & 3) * 128 + wc * 32 + 8 * fq;
        float rw[2][4];
#pragma unroll
        for (int ai = 0; ai < 2; ++ai)
#pragma unroll
            for (int m = 0; m < 4; ++m) rw[ai][m] = roww[row0 + ai * HALF + m * 16];
#pragma unroll
        for (int ai = 0; ai < 2; ++ai)
#pragma unroll
            for (int m = 0; m < 4; ++m) { bf16_t* rowp = H + (size_t)(row0 + ai * HALF + m * 16) * 512 + col0;
                float h[8];
#pragma unroll
                for (int n = 0; n < 2; ++n)
#pragma unroll
                    for (int j = 0; j < 4; ++j) { const float g = acc[ai][0][m][n][j], up = acc[ai][1][m][n][j]; h[n * 4 + j] = g * sigmoidf_(g) * up * rw[ai][m]; }
                u32x4 w; w.x = cvt_pk_bf16(h[0], h[1]); w.y = cvt_pk_bf16(h[2], h[3]); w.z = cvt_pk_bf16(h[4], h[5]); w.w = cvt_pk_bf16(h[6], h[7]);
                *(u32x4*)rowp = w; }
    }
};
struct EpiDown {
    static constexpr bool PERM = true, AFTER_DRAIN = false;
    bf16_t* Y; const float* roww;
    __device__ __forceinline__ void operator()(const f32x4 (&acc)[2][2][4][2], const Unit& u, int wr, int wc, int fr, int fq) const {
        const int row0 = u.pm * BM + wr * 64 + fr, col0 = (u.pn & 7) * 256 + wc * 32 + 8 * fq;
#pragma unroll
        for (int ai = 0; ai < 2; ++ai)
#pragma unroll
            for (int m = 0; m < 4; ++m) { const int row = row0 + ai * HALF + m * 16; bf16_t* rowp = Y + (size_t)row * 2048 + col0;
#pragma unroll
                for (int bj = 0; bj < 2; ++bj) { const f32x4 v0 = acc[ai][bj][m][0], v1 = acc[ai][bj][m][1];
                    u32x4 w; w.x = cvt_pk_bf16(v0[0], v0[1]); w.y = cvt_pk_bf16(v0[2], v0[3]); w.z = cvt_pk_bf16(v1[0], v1[1]); w.w = cvt_pk_bf16(v1[2], v1[3]);
                    *(u32x4*)(rowp + bj * HALF) = w; } }
    }
};
struct MoeOrder {
    const int* seg; int ntiles, npn, G, c;
    __device__ __forceinline__ bool next(int i, Unit& u) const {
        const long L = (long)i * G + c; if (L >= (long)ntiles * npn) return false;
        const int pm = (int)(L / npn), pl = (int)(L % npn); u.pm = pm; u.pn = __builtin_amdgcn_readfirstlane(__hip_atomic_load(seg + pm, __ATOMIC_RELAXED, __HIP_MEMORY_SCOPE_AGENT)) * npn + pl; return true;
    }
    __device__ __forceinline__ void a_ready(const Unit&) const {}
    __device__ __forceinline__ void done(const Unit&) const {}
};
template <class Epi, class Sched, bool ALIGN_EPI = false, bool SP2 = false>
__device__ __forceinline__ void gemm_phase(PG8_LAS unsigned char* lds, const Gemm g, const Sched& S, const Epi& E) {
    const int tid = otid(), wid = __builtin_amdgcn_readfirstlane(tid >> 6), lane = tid & 63, wr = wid >> 2, wc = wid & 3, fr = lane & 15, fq = lane >> 4;
    const int K = g.K, nt = K / BK;
    unsigned voffA[2], voffB[2];
#pragma unroll
    for (int i = 0; i < 2; ++i) { int R, C; stage_rc(tid * 16 + i * 8192, R, C); const int Rb = Epi::PERM ? ((R & ~31) + perm32(R & 31)) : R;
        voffA[i] = (unsigned)(R * K + C) * 2u; voffB[i] = (unsigned)(Rb * K + C) * 2u; }
    const size_t kstep = (size_t)(BK * 2);
    const size_t hstep = (size_t)HALF * K * 2;
    const size_t tstep = 2 * hstep;
    const unsigned ldsw = (unsigned)wid * 1024u;
    const int aoff = lds_byte(wr * 64 + fr, fq * 8), boff = lds_byte(wc * 32 + fr, fq * 8);
#define PG8_SA(b, h) (((b) * 2 + (h)) * HTB)
#define PG8_SB(b, h) ((4 + (b) * 2 + (h)) * HTB)
#define PG8_STAGE(bufoff, gbase, voff) do { _Pragma("unroll") for (int _i = 0; _i < 2; ++_i) \
        __builtin_amdgcn_global_load_lds((const unsigned*)((const char*)(gbase) + (voff)[_i]), (PG8_LAS unsigned*)(lds + (bufoff) + ldsw + _i * 8192), 16, 0, 0); } while (0)
#define PG8_LDA(dst, b, h) do { _Pragma("unroll") for (int m = 0; m < 4; ++m) _Pragma("unroll") for (int k = 0; k < 2; ++k) dst[m][k] = *(const PG8_LAS bf16x8*)(lds + PG8_SA(b, h) + aoff + m * 2048 + k * 1024); } while (0)
#define PG8_LDB(dst, b, h) do { _Pragma("unroll") for (int n = 0; n < 2; ++n) _Pragma("unroll") for (int k = 0; k < 2; ++k) dst[n][k] = *(const PG8_LAS bf16x8*)(lds + PG8_SB(b, h) + boff + n * 2048 + k * 1024); } while (0)
#define PG8_MMA(ai, bj, At, Bt) do { __builtin_amdgcn_s_setprio(1); _Pragma("unroll") for (int m = 0; m < 4; ++m) _Pragma("unroll") for (int n = 0; n < 2; ++n) _Pragma("unroll") for (int k = 0; k < 2; ++k) \
        acc[ai][bj][m][n] = __builtin_amdgcn_mfma_f32_16x16x32_bf16(Bt[n][k], At[m][k], acc[ai][bj][m][n], 0, 0, 0); __builtin_amdgcn_s_setprio(0); } while (0)
#define PG8_WAIT_V(n) asm volatile("s_waitcnt vmcnt(" #n ")" ::: "memory")
#define PG8_WAIT_L(n) asm volatile("s_waitcnt lgkmcnt(" #n ")" ::: "memory")
#define PG8_BAR __builtin_amdgcn_s_barrier()
#define PG8_SCHED __builtin_amdgcn_sched_barrier(0)
    Unit cur, nxt; int ui = 0;
    if (!S.next(0, cur)) return;
    f32x4 acc[2][2][4][2];
#pragma unroll
    for (int a = 0; a < 2; ++a)
#pragma unroll
        for (int b = 0; b < 2; ++b)
#pragma unroll
            for (int m = 0; m < 4; ++m)
#pragma unroll
                for (int n = 0; n < 2; ++n) acc[a][b][m][n] = (f32x4){0.f, 0.f, 0.f, 0.f};
    bf16x8 At[4][2], B0[2][2], B1[2][2];
    const char* cA = (const char*)g.A + (size_t)cur.pm * tstep; const char* cB = (const char*)g.Bt + (size_t)cur.pn * tstep;
    S.a_ready(cur);
    if constexpr (SP2) {
        PG8_STAGE(PG8_SB(0, 0), cB, voffB); PG8_STAGE(PG8_SB(0, 1), cB + hstep, voffB); PG8_STAGE(PG8_SA(0, 0), cA, voffA); PG8_STAGE(PG8_SA(0, 1), cA + hstep, voffA);
        if (wr == 1) PG8_BAR;
        PG8_WAIT_V(2); PG8_BAR;
        PG8_STAGE(PG8_SB(1, 0), cB + kstep, voffB); PG8_STAGE(PG8_SA(1, 0), cA + kstep, voffA); PG8_STAGE(PG8_SB(1, 1), cB + hstep + kstep, voffB);
        PG8_WAIT_V(6); PG8_BAR;
    } else {
        PG8_STAGE(PG8_SB(0, 0), cB, voffB); PG8_STAGE(PG8_SA(0, 0), cA, voffA); PG8_STAGE(PG8_SB(0, 1), cB + hstep, voffB); PG8_STAGE(PG8_SA(0, 1), cA + hstep, voffA);
        if (wr == 1) PG8_BAR;
        PG8_WAIT_V(4); PG8_BAR;
        PG8_STAGE(PG8_SB(1, 0), cB + kstep, voffB); PG8_STAGE(PG8_SA(1, 0), cA + kstep, voffA); PG8_STAGE(PG8_SB(1, 1), cB + hstep + kstep, voffB);
        PG8_WAIT_V(6); PG8_BAR;
    }
    for (;;) {
        const bool has_next = S.next(ui + 1, nxt);
        const char* nA = has_next ? (const char*)g.A + (size_t)nxt.pm * tstep : cA; const char* nB = has_next ? (const char*)g.Bt + (size_t)nxt.pn * tstep : cB;
        for (int t = 0; t < nt; t += 2) {
            const bool last = (t == nt - 2);
            const char* a1 = cA + (size_t)(t + 1) * kstep;
            const char* a2 = last ? nA : cA + (size_t)(t + 2) * kstep; const char* b2 = last ? nB : cB + (size_t)(t + 2) * kstep;
            const char* a3 = a2 + kstep; const char* b3 = b2 + kstep;
            if (last && has_next) S.a_ready(nxt);
            if constexpr (SP2) {
            PG8_LDB(B0, 0, 0); PG8_LDB(B1, 0, 1); PG8_SCHED; PG8_LDA(At, 0, 0); PG8_STAGE(PG8_SA(1, 1), a1 + hstep, voffA);
            PG8_WAIT_V(8); PG8_WAIT_L(0); PG8_BAR; PG8_MMA(0, 0, At, B0); PG8_MMA(0, 1, At, B1); PG8_BAR; PG8_SCHED;
            PG8_LDA(At, 0, 1); PG8_STAGE(PG8_SB(0, 0), b2, voffB); PG8_STAGE(PG8_SB(0, 1), b2 + hstep, voffB); PG8_STAGE(PG8_SA(0, 0), a2, voffA);
            PG8_WAIT_V(8); PG8_WAIT_L(0); PG8_BAR; PG8_MMA(1, 0, At, B0); PG8_MMA(1, 1, At, B1); PG8_BAR; PG8_SCHED;
            PG8_LDB(B0, 1, 0); PG8_LDB(B1, 1, 1); PG8_SCHED; PG8_LDA(At, 1, 0); PG8_STAGE(PG8_SA(0, 1), a2 + hstep, voffA);
            PG8_WAIT_V(8); PG8_WAIT_L(0); PG8_BAR; PG8_MMA(0, 0, At, B0); PG8_MMA(0, 1, At, B1); PG8_BAR; PG8_SCHED;
            PG8_LDA(At, 1, 1); PG8_STAGE(PG8_SB(1, 0), b3, voffB); PG8_STAGE(PG8_SB(1, 1), b3 + hstep, voffB); PG8_STAGE(PG8_SA(1, 0), a3, voffA);
            PG8_WAIT_V(8); PG8_WAIT_L(0); PG8_BAR; PG8_MMA(1, 0, At, B0); PG8_MMA(1, 1, At, B1); PG8_BAR; PG8_SCHED;
            } else {
            PG8_LDB(B0, 0, 0); PG8_SCHED; PG8_LDA(At, 0, 0); PG8_STAGE(PG8_SA(1, 1), a1 + hstep, voffA);
            PG8_WAIT_L(8); PG8_BAR; PG8_WAIT_L(0); PG8_MMA(0, 0, At, B0); PG8_BAR; PG8_SCHED;
            PG8_LDB(B1, 0, 1); PG8_STAGE(PG8_SB(0, 0), b2, voffB);
            PG8_BAR; PG8_WAIT_L(0); PG8_MMA(0, 1, At, B1); PG8_BAR;
            PG8_LDA(At, 0, 1); PG8_STAGE(PG8_SA(0, 0), a2, voffA);
            PG8_BAR; PG8_WAIT_L(0); PG8_MMA(1, 0, At, B0); PG8_BAR; PG8_SCHED;
            PG8_STAGE(PG8_SB(0, 1), b2 + hstep, voffB);
            PG8_WAIT_V(6); PG8_BAR; PG8_MMA(1, 1, At, B1); PG8_BAR;
            PG8_LDB(B0, 1, 0); PG8_SCHED; PG8_LDA(At, 1, 0); PG8_STAGE(PG8_SA(0, 1), a2 + hstep, voffA);
            PG8_WAIT_L(8); PG8_BAR; PG8_WAIT_L(0); PG8_MMA(0, 0, At, B0); PG8_BAR; PG8_SCHED;
            PG8_LDB(B1, 1, 1); PG8_STAGE(PG8_SB(1, 0), b3, voffB);
            PG8_BAR; PG8_WAIT_L(0); PG8_MMA(0, 1, At, B1); PG8_BAR;
            PG8_LDA(At, 1, 1); PG8_STAGE(PG8_SA(1, 0), a3, voffA);
            PG8_BAR; PG8_WAIT_L(0); PG8_MMA(1, 0, At, B0); PG8_BAR; PG8_SCHED;
            PG8_STAGE(PG8_SB(1, 1), b3 + hstep, voffB);
            PG8_WAIT_V(6); PG8_BAR; PG8_MMA(1, 1, At, B1); PG8_BAR;
            }
        }
        if constexpr (ALIGN_EPI) { if (wr == 0) PG8_BAR; }
        if constexpr (!Epi::AFTER_DRAIN) { E(acc, cur, wr, wc, fr, fq); S.done(cur); }
        if (!has_next) break;
#pragma unroll
        for (int a = 0; a < 2; ++a)
#pragma unroll
            for (int b = 0; b < 2; ++b)
#pragma unroll
                for (int m = 0; m < 4; ++m)
#pragma unroll
                    for (int n = 0; n < 2; ++n) acc[a][b][m][n] = (f32x4){0.f, 0.f, 0.f, 0.f};
        cur = nxt; cA = nA; cB = nB; ++ui;
        if constexpr (ALIGN_EPI) { if (wr == 1) PG8_BAR; }
    }
    PG8_WAIT_V(0);
    if constexpr (!ALIGN_EPI) { if (wr == 0) PG8_BAR; }
    PG8_BAR;
    if constexpr (Epi::AFTER_DRAIN) { E.fused(acc, cur, wr, wc, fr, fq, lds, wid, lane); S.done(cur); }
#undef PG8_SA
#undef PG8_SB
#undef PG8_STAGE
#undef PG8_LDA
#undef PG8_LDB
#undef PG8_MMA
#undef PG8_WAIT_V
#undef PG8_WAIT_L
#undef PG8_BAR
#undef PG8_SCHED
}

template <class Epi, class Sched, bool ALIGN_EPI = false, bool SP2 = true>
__device__ __forceinline__ void gemm_phase_gather(PG8_LAS unsigned char* lds, const Gemm g, const Sched& S, const Epi& E, const int* rowtab) {
    static_assert(SP2, "gather variant: SP2 loop only");
    const int tid = otid(), wid = __builtin_amdgcn_readfirstlane(tid >> 6), lane = tid & 63, wr = wid >> 2, wc = wid & 3, fr = lane & 15, fq = lane >> 4;
    const int K = g.K, nt = K / BK;
    unsigned voffA[2], voffB[2]; int RA[2]; unsigned CA[2];
#pragma unroll
    for (int i = 0; i < 2; ++i) { int R, C; stage_rc(tid * 16 + i * 8192, R, C); const int Rb = Epi::PERM ? ((R & ~31) + perm32(R & 31)) : R;
        voffA[i] = (unsigned)(R * K + C) * 2u; voffB[i] = (unsigned)(Rb * K + C) * 2u; RA[i] = R; CA[i] = (unsigned)C * 2u; }
    unsigned gA[4], gN[4];
#define PG8_GLOAD(G, pm_) do { _Pragma("unroll") for (int h_ = 0; h_ < 2; ++h_) _Pragma("unroll") for (int i_ = 0; i_ < 2; ++i_) \
        G[2 * h_ + i_] = (unsigned)rowtab[(pm_) * BM + h_ * HALF + RA[i_]] * (unsigned)(K * 2) + CA[i_]; } while (0)
#define PG8_STAGEG(bufoff, gbase, G, h_) do { _Pragma("unroll") for (int _i = 0; _i < 2; ++_i) \
        __builtin_amdgcn_global_load_lds((const unsigned*)((const char*)(gbase) + G[2 * (h_) + _i]), (PG8_LAS unsigned*)(lds + (bufoff) + ldsw + _i * 8192), 16, 0, 0); } while (0)
    const size_t kstep = (size_t)(BK * 2);
    const size_t hstep = (size_t)HALF * K * 2;
    const size_t tstep = 2 * hstep;
    const unsigned ldsw = (unsigned)wid * 1024u;
    const int aoff = lds_byte(wr * 64 + fr, fq * 8), boff = lds_byte(wc * 32 + fr, fq * 8);
#define PG8_SA(b, h) (((b) * 2 + (h)) * HTB)
#define PG8_SB(b, h) ((4 + (b) * 2 + (h)) * HTB)
#define PG8_STAGE(bufoff, gbase, voff) do { _Pragma("unroll") for (int _i = 0; _i < 2; ++_i) \
        __builtin_amdgcn_global_load_lds((const unsigned*)((const char*)(gbase) + (voff)[_i]), (PG8_LAS unsigned*)(lds + (bufoff) + ldsw + _i * 8192), 16, 0, 0); } while (0)
#define PG8_LDA(dst, b, h) do { _Pragma("unroll") for (int m = 0; m < 4; ++m) _Pragma("unroll") for (int k = 0; k < 2; ++k) dst[m][k] = *(const PG8_LAS bf16x8*)(lds + PG8_SA(b, h) + aoff + m * 2048 + k * 1024); } while (0)
#define PG8_LDB(dst, b, h) do { _Pragma("unroll") for (int n = 0; n < 2; ++n) _Pragma("unroll") for (int k = 0; k < 2; ++k) dst[n][k] = *(const PG8_LAS bf16x8*)(lds + PG8_SB(b, h) + boff + n * 2048 + k * 1024); } while (0)
#define PG8_MMA(ai, bj, At, Bt) do { __builtin_amdgcn_s_setprio(1); _Pragma("unroll") for (int m = 0; m < 4; ++m) _Pragma("unroll") for (int n = 0; n < 2; ++n) _Pragma("unroll") for (int k = 0; k < 2; ++k) \
        acc[ai][bj][m][n] = __builtin_amdgcn_mfma_f32_16x16x32_bf16(Bt[n][k], At[m][k], acc[ai][bj][m][n], 0, 0, 0); __builtin_amdgcn_s_setprio(0); } while (0)
#define PG8_WAIT_V(n) asm volatile("s_waitcnt vmcnt(" #n ")" ::: "memory")
#define PG8_WAIT_L(n) asm volatile("s_waitcnt lgkmcnt(" #n ")" ::: "memory")
#define PG8_BAR __builtin_amdgcn_s_barrier()
#define PG8_SCHED __builtin_amdgcn_sched_barrier(0)
    Unit cur, nxt; int ui = 0;
    if (!S.next(0, cur)) return;
    f32x4 acc[2][2][4][2];
#pragma unroll
    for (int a = 0; a < 2; ++a)
#pragma unroll
        for (int b = 0; b < 2; ++b)
#pragma unroll
            for (int m = 0; m < 4; ++m)
#pragma unroll
                for (int n = 0; n < 2; ++n) acc[a][b][m][n] = (f32x4){0.f, 0.f, 0.f, 0.f};
    bf16x8 At[4][2], B0[2][2], B1[2][2];
    const char* A0 = (const char*)g.A; const char* cB = (const char*)g.Bt + (size_t)cur.pn * tstep;
    PG8_GLOAD(gA, cur.pm);
    S.a_ready(cur);
    if constexpr (SP2) {
        PG8_STAGE(PG8_SB(0, 0), cB, voffB); PG8_STAGE(PG8_SB(0, 1), cB + hstep, voffB); PG8_STAGEG(PG8_SA(0, 0), A0, gA, 0); PG8_STAGEG(PG8_SA(0, 1), A0, gA, 1);
        if (wr == 1) PG8_BAR;
        PG8_WAIT_V(2); PG8_BAR;
        PG8_STAGE(PG8_SB(1, 0), cB + kstep, voffB); PG8_STAGEG(PG8_SA(1, 0), A0 + kstep, gA, 0); PG8_STAGE(PG8_SB(1, 1), cB + hstep + kstep, voffB);
        PG8_WAIT_V(6); PG8_BAR;
    } else {
        ;
    }
    for (;;) {
        const bool has_next = S.next(ui + 1, nxt);
        const char* nB = has_next ? (const char*)g.Bt + (size_t)nxt.pn * tstep : cB;
        if (has_next) PG8_GLOAD(gN, nxt.pm); else { gN[0] = gA[0]; gN[1] = gA[1]; gN[2] = gA[2]; gN[3] = gA[3]; }
        for (int t = 0; t < nt; t += 2) {
            const bool last = (t == nt - 2);
            const char* a1 = A0 + (size_t)(t + 1) * kstep;
            const char* a2 = last ? A0 : A0 + (size_t)(t + 2) * kstep; const char* b2 = last ? nB : cB + (size_t)(t + 2) * kstep;
            unsigned gs[4] = {gA[0], gA[1], gA[2], gA[3]};
            if (last) { gs[0] = gN[0]; gs[1] = gN[1]; gs[2] = gN[2]; gs[3] = gN[3]; }
            const char* a3 = a2 + kstep; const char* b3 = b2 + kstep;
            if (last && has_next) S.a_ready(nxt);
            if constexpr (SP2) {
            PG8_LDB(B0, 0, 0); PG8_LDB(B1, 0, 1); PG8_SCHED; PG8_LDA(At, 0, 0); PG8_STAGEG(PG8_SA(1, 1), a1, gA, 1);
            PG8_WAIT_V(8); PG8_WAIT_L(0); PG8_BAR; PG8_MMA(0, 0, At, B0); PG8_MMA(0, 1, At, B1); PG8_BAR; PG8_SCHED;
            PG8_LDA(At, 0, 1); PG8_STAGE(PG8_SB(0, 0), b2, voffB); PG8_STAGE(PG8_SB(0, 1), b2 + hstep, voffB); PG8_STAGEG(PG8_SA(0, 0), a2, gs, 0);
            PG8_WAIT_V(8); PG8_WAIT_L(0); PG8_BAR; PG8_MMA(1, 0, At, B0); PG8_MMA(1, 1, At, B1); PG8_BAR; PG8_SCHED;
            PG8_LDB(B0, 1, 0); PG8_LDB(B1, 1, 1); PG8_SCHED; PG8_LDA(At, 1, 0); PG8_STAGEG(PG8_SA(0, 1), a2, gs, 1);
            PG8_WAIT_V(8); PG8_WAIT_L(0); PG8_BAR; PG8_MMA(0, 0, At, B0); PG8_MMA(0, 1, At, B1); PG8_BAR; PG8_SCHED;
            PG8_LDA(At, 1, 1); PG8_STAGE(PG8_SB(1, 0), b3, voffB); PG8_STAGE(PG8_SB(1, 1), b3 + hstep, voffB); PG8_STAGEG(PG8_SA(1, 0), a3, gs, 0);
            PG8_WAIT_V(8); PG8_WAIT_L(0); PG8_BAR; PG8_MMA(1, 0, At, B0); PG8_MMA(1, 1, At, B1); PG8_BAR; PG8_SCHED;
            }
        }
        if constexpr (ALIGN_EPI) { if (wr == 0) PG8_BAR; }
        if constexpr (!Epi::AFTER_DRAIN) { E(acc, cur, wr, wc, fr, fq); S.done(cur); }
        if (!has_next) break;
#pragma unroll
        for (int a = 0; a < 2; ++a)
#pragma unroll
            for (int b = 0; b < 2; ++b)
#pragma unroll
                for (int m = 0; m < 4; ++m)
#pragma unroll
                    for (int n = 0; n < 2; ++n) acc[a][b][m][n] = (f32x4){0.f, 0.f, 0.f, 0.f};
        cur = nxt; cB = nB; ++ui; gA[0] = gN[0]; gA[1] = gN[1]; gA[2] = gN[2]; gA[3] = gN[3];
        if constexpr (ALIGN_EPI) { if (wr == 1) PG8_BAR; }
    }
    PG8_WAIT_V(0);
    if constexpr (!ALIGN_EPI) { if (wr == 0) PG8_BAR; }
    PG8_BAR;
    if constexpr (Epi::AFTER_DRAIN) { E.fused(acc, cur, wr, wc, fr, fq, lds, wid, lane); S.done(cur); }
#undef PG8_SA
#undef PG8_SB
#undef PG8_STAGE
#undef PG8_STAGEG
#undef PG8_GLOAD
#undef PG8_LDA
#undef PG8_LDB
#undef PG8_MMA
#undef PG8_WAIT_V
#undef PG8_WAIT_L
#undef PG8_BAR
#undef PG8_SCHED
}
}

constexpr int NTOK = 8192, SEQ = 4096, DM = 2048, NLAYER = 2;
constexpr int IN_COLS = 15808, INP = 15872;
constexpr int NSEG = 65;
constexpr int XS_ROWS = 8192 + 65536 + 64 * 256;
constexpr int NPHASE = 16;
constexpr float LN_EPS = 1e-5f, GN_EPS = 64e-5f, ALPHA = 1.4142135623730951f  , ROUTED_SCALE = 2.5f;

constexpr size_t MiB = 1u << 20, KiB = 1u << 10;
constexpr size_t WS_CTL = 0, CTL_ZERO_BYTES = 1 * MiB;
constexpr size_t WS_HIST = 1 * MiB;
constexpr size_t WS_SELE = WS_HIST + 64 * KiB;
constexpr size_t WS_SELW = WS_SELE + 256 * KiB;
constexpr size_t WS_SLOT = WS_SELW + 256 * KiB;
constexpr size_t WS_ROWW = WS_SLOT + 256 * KiB;
constexpr size_t WS_TSEG = WS_ROWW + 352 * KiB;
constexpr size_t WS_BON = WS_TSEG + 4 * KiB;
constexpr size_t WS_ROWT = WS_BON + 576 * KiB;
constexpr size_t WS_XT = WS_ROWT + 352 * KiB;
constexpr size_t WS_WIN = 4 * MiB;
constexpr size_t WS_WLORA = 66 * MiB;
constexpr size_t WS_WBR = 69 * MiB;
constexpr size_t WS_WO = 81 * MiB;
constexpr size_t WS_WGU = 89 * MiB;
constexpr size_t WS_WD = 349 * MiB;
constexpr size_t WS_XB = 479 * MiB;
constexpr size_t WS_MERGED = 511 * MiB;
constexpr size_t WS_PRELN = 543 * MiB;
constexpr size_t WS_X1 = 607 * MiB;
constexpr size_t WS_X2 = 671 * MiB;
constexpr size_t WS_M = 735 * MiB;
constexpr size_t WS_PCONV = WS_M, WS_PQKV = WS_M + 48 * MiB, WS_PRKV = WS_M + 96 * MiB, WS_PLORA = WS_M + 144 * MiB, WS_PGATE = WS_M + 152 * MiB;
constexpr size_t WS_YBR = WS_M + 248 * MiB;
constexpr size_t WS_LORAA = WS_M + 296 * MiB;
constexpr size_t WS_RWR = WS_M + 304 * MiB, WS_RWW = WS_RWR + 32 * MiB, WS_RWK = WS_RWW + 32 * MiB, WS_RWV = WS_RWK + 32 * MiB, WS_RWKK = WS_RWV + 32 * MiB,
                 WS_RWB = WS_RWKK + 32 * MiB, WS_RWA = WS_RWB + 32 * MiB, WS_RWG = WS_RWA + 32 * MiB, WS_RWY = WS_RWG + 32 * MiB;
constexpr size_t WS_XS = WS_M;
constexpr size_t WS_H = WS_XS + 352 * MiB;
constexpr size_t WS_YS = WS_H + 88 * MiB;
constexpr size_t WS_END = WS_YS + 352 * MiB;
static_assert(WS_RWY + 32 * MiB <= WS_END && (size_t)XS_ROWS * 2048 * 2 == 352 * MiB && (size_t)XS_ROWS * 512 * 2 == 88 * MiB, "ws map");
static_assert(WS_XT + 16 * KiB <= WS_WIN && WS_WIN + (size_t)INP * 2048 * 2 <= WS_WLORA && WS_WGU + (size_t)65 * 1024 * 2048 * 2 <= WS_WD && WS_WD + (size_t)65 * 2048 * 512 * 2 <= WS_XB, "ws map 2");
constexpr int CW_TMO = 0, CW_BAR = 4096;

constexpr int RING_OFF = 0, RING_BYTES = 131072;
constexpr int LDS_BYTES = 147456;
constexpr int LDSCTL_OFF = LDS_BYTES - 1024, MISC_OFF = LDSCTL_OFF + 320;
constexpr int NWAVES = 8;

#define GAS __attribute__((address_space(1)))
#define LAS __attribute__((address_space(3)))
typedef unsigned short bf16;
typedef unsigned v4u __attribute__((ext_vector_type(4)));
typedef unsigned v2u __attribute__((ext_vector_type(2)));
typedef float f32x4 __attribute__((ext_vector_type(4)));
typedef float f32x16 __attribute__((ext_vector_type(16)));
typedef short bf16x8 __attribute__((ext_vector_type(8)));
typedef short s16x4 __attribute__((ext_vector_type(4)));
typedef GAS unsigned gu32;
#define RLX_AGENT __ATOMIC_RELAXED, __HIP_MEMORY_SCOPE_AGENT
#define LDS_WAIT() asm volatile("s_waitcnt lgkmcnt(0)" ::: "memory")
#define VM_WAIT() asm volatile("s_waitcnt vmcnt(0)" ::: "memory")
__device__ __forceinline__ unsigned f2bf(float f) { unsigned u = __builtin_bit_cast(unsigned, f); return (u + 0x7fffu + ((u >> 16) & 1u)) >> 16; }
__device__ __forceinline__ unsigned pk2(float lo, float hi) { return f2bf(lo) | (f2bf(hi) << 16); }
__device__ __forceinline__ float bf2f(bf16 b) { return __uint_as_float((unsigned)b << 16); }
__device__ __forceinline__ float blo(unsigned w) { return __uint_as_float(w << 16); }
__device__ __forceinline__ float bhi(unsigned w) { return __uint_as_float(w & 0xffff0000u); }
__device__ __forceinline__ int ld_i32(const int* p) { return __hip_atomic_load(p, RLX_AGENT); }
__device__ __forceinline__ float ld_f32(const float* p) { return __hip_atomic_load(p, RLX_AGENT); }

#define XB_TMO      128
#define XB_XCNT(j)  (256  + 64 * (j))
#define XB_XSUB(j)  (1280 + 64 * (j))
#define XB_XGEN(j)  (2304 + 64 * (j))
#define XB_TOP      3328
#define XB_TOPGEN   3392
#define XCD_BAR_WORDS 3456
#define XB_SPIN_CAP (1u << 18)

__device__ __forceinline__ unsigned xb_ld(unsigned* p)              { return __hip_atomic_load(p, __ATOMIC_RELAXED, __HIP_MEMORY_SCOPE_AGENT); }
__device__ __forceinline__ unsigned xb_add(unsigned* p, unsigned v) { return __hip_atomic_fetch_add(p, v, __ATOMIC_RELAXED, __HIP_MEMORY_SCOPE_AGENT); }
__device__ __forceinline__ unsigned xb_xcc_id() { return (unsigned)__builtin_amdgcn_s_getreg((3 << 11) | 20) & 0xFu; }
#define XB_SPIN(cond, bar) do { unsigned _sp = 0; while (cond) { __builtin_amdgcn_s_sleep(1); \
    if ((++_sp & 255u) == 0u) { if (xb_ld(&(bar)[XB_TMO])) break; if (_sp > XB_SPIN_CAP) { atomicAdd(&(bar)[XB_TMO], 1u); break; } } } } while (0)

struct XcdBarrier {
    unsigned* bar; unsigned x;
    volatile LAS unsigned* st;
};

__device__ __forceinline__ XcdBarrier xcd_barrier_post(unsigned* bar, volatile LAS unsigned* st) {
    XcdBarrier b; b.bar = bar; b.x = xb_xcc_id(); b.st = st;
    if (threadIdx.x == 0) (void)xb_add(&bar[XB_XCNT(b.x)], 1u);
    return b;
}
__device__ __forceinline__ void xcd_barrier_complete(unsigned* bar, unsigned x, unsigned& nloc, unsigned& nx) {
    const unsigned G = gridDim.x * gridDim.y * gridDim.z;
    unsigned sum, cnt, mine, sp = 0u;
    for (;;) {
        sum = 0u; cnt = 0u; mine = 0u;
#pragma unroll
        for (unsigned j = 0; j < 16; ++j) { const unsigned c = xb_ld(&bar[XB_XCNT(j)]); sum += c; cnt += (c > 0u) ? 1u : 0u; mine = (j == x) ? c : mine; }
        if (sum == G) break;
        __builtin_amdgcn_s_sleep(1);
        if ((++sp & 255u) == 0u) { if (xb_ld(&bar[XB_TMO])) break; if (sp > XB_SPIN_CAP) { atomicAdd(&bar[XB_TMO], 1u); break; } }
    }
    nloc = mine > 0u ? mine : 1u; nx = cnt > 0u ? cnt : 1u;
}

__device__ __forceinline__ void xcd_barrier(const XcdBarrier& b) {
    asm volatile("s_waitcnt vmcnt(0)" ::: "memory");
    __syncthreads();
    if (threadIdx.x == 0) {
        unsigned* bar = b.bar;
        __builtin_amdgcn_s_waitcnt(0);
        unsigned nloc = b.st[0], nx = b.st[1];
        if (nloc == 0u) { xcd_barrier_complete(bar, b.x, nloc, nx); b.st[0] = nloc; b.st[1] = nx; }
        const unsigned old = xb_add(&bar[XB_XSUB(b.x)], 1u);
        const unsigned gen = old / nloc;
        if (old + 1u == (gen + 1u) * nloc) {
            __builtin_amdgcn_fence(__ATOMIC_RELEASE, "agent");
            asm volatile("s_waitcnt vmcnt(0)" ::: "memory");
            const unsigned og = xb_add(&bar[XB_TOP], 1u);
            const unsigned tg = og / nx;
            if (og + 1u == (tg + 1u) * nx) xb_add(&bar[XB_TOPGEN], 1u);
            else XB_SPIN(xb_ld(&bar[XB_TOPGEN]) == tg, bar);
            __builtin_amdgcn_fence(__ATOMIC_ACQUIRE, "agent");
            xb_add(&bar[XB_XGEN(b.x)], 1u);
            asm volatile("s_waitcnt vmcnt(0)" ::: "memory");
        } else {
            XB_SPIN(xb_ld(&bar[XB_XGEN(b.x)]) == gen, bar);
            __builtin_amdgcn_fence(__ATOMIC_ACQUIRE, "agent");
            asm volatile("s_waitcnt vmcnt(0)" ::: "memory");
        }
    }
    __syncthreads();
}

struct Args { const float* in[28]; float* out; unsigned char* ws; int ph_lo, ph_hi, li, pad; };
typedef const __attribute__((address_space(4))) Args* KArgs;
struct Frame {
    LAS unsigned char* lds;
    volatile LAS unsigned* MISC;
    gu32* ctl;
    unsigned char* ws;
    int tid, lane, wave, vcu, G;
};
__device__ __forceinline__ float wave_sum(float v) {
#pragma unroll
    for (int o = 1; o < 64; o <<= 1) v += __shfl_xor(v, o);
    return v;
}
__device__ __forceinline__ float dpp16(float v) {
    v += __builtin_bit_cast(float, __builtin_amdgcn_update_dpp(0, __builtin_bit_cast(int, v), 0xB1, 0xF, 0xF, true));
    v += __builtin_bit_cast(float, __builtin_amdgcn_update_dpp(0, __builtin_bit_cast(int, v), 0x4E, 0xF, 0xF, true));
    v += __builtin_bit_cast(float, __builtin_amdgcn_update_dpp(0, __builtin_bit_cast(int, v), 0x141, 0xF, 0xF, true));
    v += __builtin_bit_cast(float, __builtin_amdgcn_update_dpp(0, __builtin_bit_cast(int, v), 0x140, 0xF, 0xF, true));
    return v;
}
__device__ __forceinline__ v4u pack8(const float* v) { v4u o; o.x = pk2(v[0], v[1]); o.y = pk2(v[2], v[3]); o.z = pk2(v[4], v[5]); o.w = pk2(v[6], v[7]); return o; }
__device__ __forceinline__ void unpack8(v4u w, float* v) { v[0] = blo(w.x); v[1] = bhi(w.x); v[2] = blo(w.y); v[3] = bhi(w.y); v[4] = blo(w.z); v[5] = bhi(w.z); v[6] = blo(w.w); v[7] = bhi(w.w); }

struct TrItem { const float* src; bf16* dst; int ldn, k0, n0, Kd; };
__device__ __forceinline__ void tr_issue(const TrItem& d, int lane, float (&hv)[32]) {
    const float* base = d.src + (size_t)d.k0 * d.ldn + d.n0;
    const unsigned off = (unsigned)(lane >> 3) * (unsigned)d.ldn + 4u * (unsigned)(lane & 7), step = 8u * (unsigned)d.ldn;
#pragma unroll
    for (int i = 0; i < 8; ++i) { const f32x4 v = __builtin_nontemporal_load((const f32x4*)(base + (off + (unsigned)i * step))); hv[4 * i] = v[0]; hv[4 * i + 1] = v[1]; hv[4 * i + 2] = v[2]; hv[4 * i + 3] = v[3]; }
}
__device__ __forceinline__ void tr_finish(const TrItem& d, int lane, const float (&hv)[32], LAS float* scr) {
    { LAS float* w = scr + (lane >> 3) * 33 + 4 * (lane & 7);
#pragma unroll
      for (int i = 0; i < 8; ++i) { w[i * 8 * 33] = hv[4 * i]; w[i * 8 * 33 + 1] = hv[4 * i + 1]; w[i * 8 * 33 + 2] = hv[4 * i + 2]; w[i * 8 * 33 + 3] = hv[4 * i + 3]; } }
    LDS_WAIT(); asm volatile("" ::: "memory");
    const int c = lane & 7;
#pragma unroll
    for (int j = 0; j < 4; ++j) { const int n = (lane >> 3) + 8 * j; const LAS float* s = scr + (8 * c) * 33 + n;
        v4u o; o.x = pg8::cvt_pk_bf16(s[0 * 33], s[1 * 33]); o.y = pg8::cvt_pk_bf16(s[2 * 33], s[3 * 33]); o.z = pg8::cvt_pk_bf16(s[4 * 33], s[5 * 33]); o.w = pg8::cvt_pk_bf16(s[6 * 33], s[7 * 33]);
        __builtin_nontemporal_store(o, (GAS v4u*)(d.dst + (size_t)n * d.Kd + d.k0 + 8 * c)); }
    LDS_WAIT(); asm volatile("" ::: "memory");
}
constexpr int I_IN = 32 * 494, I_BR = 3 * 16 * 64, I_WO = 32 * 64, I_G = 65 * 512, I_D = 65 * 512;
constexpr int NIT = I_IN + I_BR + I_WO + 2 * I_G + I_D;
#ifndef HN0
#define HN0 4
#define HN1 2
#define HN2 0
#define HN3 0
#define HN4 4
#define HN5 0
#define HN6 2
#endif
#ifndef P0_EXTRA
#define P0_EXTRA 0
#endif
#ifndef SEQ_ITEMS
#define SEQ_ITEMS 12544
#endif
constexpr int NIT_A = NIT - SEQ_ITEMS;
__device__ __forceinline__ TrItem decode_item(KArgs a, unsigned char* ws, int l, int it) {
    bf16* WIN = (bf16*)(ws + WS_WIN); bf16* WBR = (bf16*)(ws + WS_WBR); bf16* WO = (bf16*)(ws + WS_WO); bf16* WGU = (bf16*)(ws + WS_WGU); bf16* WD = (bf16*)(ws + WS_WD);
    int r = it; TrItem d;
    if (r < I_IN) { const int kb = r / 494, nb = r % 494, n0 = 32 * nb; d.src = a->in[1] + (size_t)l * 2048 * IN_COLS; d.ldn = IN_COLS; d.k0 = 64 * kb; d.n0 = n0; d.dst = WIN + (size_t)(n0 + (n0 >= 9408 ? 64 : 0)) * 2048; d.Kd = 2048; return d; }
    r -= I_IN;
    if (r < I_BR) { const int nbr = r / 1024, rr = r % 1024, kb = rr / 64, nb = rr % 64; d.src = a->in[14] + (size_t)l * 3 * 1024 * 2048 + (size_t)nbr * 1024 * 2048; d.ldn = 2048; d.k0 = 64 * kb; d.n0 = 32 * nb;
        d.dst = WBR + (size_t)nbr * 2048 * 1024 + (size_t)(32 * nb) * 1024; d.Kd = 1024; return d; }
    r -= I_BR;
    if (r < I_WO) { const int kb = r / 64, nb = r % 64; d.src = a->in[15] + (size_t)l * 2048 * 2048; d.ldn = 2048; d.k0 = 64 * kb; d.n0 = 32 * nb; d.dst = WO + (size_t)(32 * nb) * 2048; d.Kd = 2048; return d; }
    r -= I_WO;
    if (r < 2 * I_G) { const int up = r >= I_G ? 1 : 0; if (up) r -= I_G; const int seg = r / 512, rr = r % 512, kb = rr / 16, nb = rr % 16, n0 = 32 * nb;
        d.src = seg == 0 ? (up ? a->in[24] : a->in[23]) + (size_t)l * 2048 * 512 : (up ? a->in[21] : a->in[20]) + (size_t)(l * 64 + seg - 1) * 2048 * 512;
        d.ldn = 512; d.k0 = 64 * kb; d.n0 = n0; d.dst = WGU + (size_t)(seg * 1024 + (n0 >> 7) * 256 + (n0 & 127) + up * 128) * 2048; d.Kd = 2048; return d; }
    r -= 2 * I_G;
    { const int seg = r / 512, rr = r % 512, kb = rr / 64, nb = rr % 64;
        d.src = seg == 0 ? a->in[25] + (size_t)l * 512 * 2048 : a->in[22] + (size_t)(l * 64 + seg - 1) * 512 * 2048;
        d.ldn = 2048; d.k0 = 64 * kb; d.n0 = 32 * nb; d.dst = WD + (size_t)(seg * 2048 + 32 * nb) * 512; d.Kd = 512; return d; }
}
__device__ __forceinline__ void convert_item(KArgs a, unsigned char* ws, int l, int it, LAS float* scr, int lane) {
    const TrItem d = decode_item(a, ws, l, it); float hv[32]; tr_issue(d, lane, hv); tr_finish(d, lane, hv, scr);
}
#ifndef SHADOW_CONVERT
#define SHADOW_CONVERT 1
#endif
__device__ __forceinline__ void ph0_convert(KArgs a, Frame& F, int l) {
    LAS float* scr = (LAS float*)(F.lds + RING_OFF + F.wave * 16384);
    const int gw = F.vcu * NWAVES + F.wave, NGW = F.G * NWAVES;
    bf16* WIN = (bf16*)(F.ws + WS_WIN); bf16* WLORA = (bf16*)(F.ws + WS_WLORA);
    for (int it = gw; it < (SHADOW_CONVERT ? I_IN + P0_EXTRA : NIT); it += NGW) convert_item(a, F.ws, l, it, scr, F.lane);
    const size_t gt = (size_t)F.vcu * 512 + F.tid, NT = (size_t)F.G * 512;
    for (size_t i = gt; i < 64 * 2048 / 8; i += NT) ((v4u*)(WIN + (size_t)9408 * 2048))[i] = (v4u){0u, 0u, 0u, 0u};
    { const float* w2 = a->in[5] + (size_t)l * 96 * 1024; const float* a2 = a->in[7] + (size_t)l * 96 * 1024; const float* g2 = a->in[8] + (size_t)l * 256 * 1024;
      for (size_t i = gt; i < (size_t)3072 * 512; i += NT) { const int k = (int)(i / 3072), n = (int)(i % 3072), sec = n >> 10, nn = n & 1023; float v = 0.f;
          if (sec == 0) { if (k < 96) v = w2[k * 1024 + nn]; } else if (sec == 1) { if (k >= 96 && k < 192) v = a2[(k - 96) * 1024 + nn]; } else { if (k >= 256) v = g2[(k - 256) * 1024 + nn]; }
          WLORA[(size_t)n * 512 + k] = (bf16)f2bf(v); } }
    if (l == 0) { const f32x4* x = (const f32x4*)a->in[0]; v4u* xb = (v4u*)(F.ws + WS_XB);
        for (size_t i = gt; i < (size_t)NTOK * DM / 8; i += NT) { const f32x4 p = x[2 * i], q = x[2 * i + 1]; v4u o; o.x = pk2(p[0], p[1]); o.y = pk2(p[2], p[3]); o.z = pk2(q[0], q[1]); o.w = pk2(q[2], q[3]); xb[i] = o; } }
}

__device__ __forceinline__ void ph2_elementwise(KArgs a, Frame& F, int l) {
    const size_t gt = (size_t)F.vcu * 512 + F.tid, NT = (size_t)F.G * 512;
    const bf16* PC = (const bf16*)(F.ws + WS_PCONV); bf16* Y0 = (bf16*)(F.ws + WS_YBR);
    const float* cw = a->in[2] + (size_t)l * 3 * 1024;
    for (size_t i = gt; i < (size_t)NTOK * 128; i += NT) { const int t = (int)(i >> 7), c = (int)(i & 127) * 8, tt = t & (SEQ - 1);
        const bf16* row = PC + (size_t)t * 3072;
        float gb[8], g0[8], h0[8], u0[8], u1[8], u2[8];
        unpack8(*(const v4u*)(row + c), gb); unpack8(*(const v4u*)(row + 1024 + c), g0); unpack8(*(const v4u*)(row + 2048 + c), h0);
#pragma unroll
        for (int j = 0; j < 8; ++j) { u0[j] = g0[j] * h0[j]; u1[j] = 0.f; u2[j] = 0.f; }
        if (tt >= 1) { unpack8(*(const v4u*)(row - 3072 + 1024 + c), g0); unpack8(*(const v4u*)(row - 3072 + 2048 + c), h0);
#pragma unroll
            for (int j = 0; j < 8; ++j) u1[j] = g0[j] * h0[j]; }
        if (tt >= 2) { unpack8(*(const v4u*)(row - 6144 + 1024 + c), g0); unpack8(*(const v4u*)(row - 6144 + 2048 + c), h0);
#pragma unroll
            for (int j = 0; j < 8; ++j) u2[j] = g0[j] * h0[j]; }
        float y[8];
#pragma unroll
        for (int j = 0; j < 8; ++j) y[j] = gb[j] * (cw[c + j] * u2[j] + cw[1024 + c + j] * u1[j] + cw[2048 + c + j] * u0[j]);
        *(v4u*)(Y0 + (size_t)t * 1024 + c) = pack8(y); }
    const bf16* PR = (const bf16*)(F.ws + WS_PRKV); const float* mix = a->in[3] + (size_t)l * 3520;
    float* RWR = (float*)(F.ws + WS_RWR); float* RWK = (float*)(F.ws + WS_RWK); float* RWV = (float*)(F.ws + WS_RWV);
    for (size_t i = gt; i < (size_t)NTOK * 384; i += NT) { const int t = (int)(i / 384), c = (int)(i % 384) * 8, tt = t & (SEQ - 1);
        float p[8], q[8];
        unpack8(*(const v4u*)(PR + (size_t)t * 3072 + c), p);
        if (tt >= 1) unpack8(*(const v4u*)(PR + (size_t)(t - 1) * 3072 + c), q); else {
#pragma unroll
            for (int j = 0; j < 8; ++j) q[j] = 0.f; }
#pragma unroll
        for (int j = 0; j < 8; ++j) p[j] = p[j] + (q[j] - p[j]) * mix[c + j];
        float* dst = (c < 1024 ? RWR : (c < 2048 ? RWK : RWV)) + (size_t)t * 1024 + (c & 1023);
        *(f32x4*)dst = (f32x4){p[0], p[1], p[2], p[3]}; *(f32x4*)(dst + 4) = (f32x4){p[4], p[5], p[6], p[7]}; }
    const bf16* PL = (const bf16*)(F.ws + WS_PLORA); bf16* LA = (bf16*)(F.ws + WS_LORAA);
    for (size_t i = gt; i < (size_t)NTOK * 64; i += NT) { const int t = (int)(i >> 6), c = (int)(i & 63) * 8, tt = t & (SEQ - 1);
        float p[8], q[8];
        if (c >= 192 && c < 256) {
#pragma unroll
            for (int j = 0; j < 8; ++j) p[j] = 0.f;
        } else {
            unpack8(*(const v4u*)(PL + (size_t)t * 512 + c), p);
            if (tt >= 1) unpack8(*(const v4u*)(PL + (size_t)(t - 1) * 512 + c), q); else {
#pragma unroll
                for (int j = 0; j < 8; ++j) q[j] = 0.f; }
            const int mi = c < 96 ? 3072 + c : (c < 192 ? 3168 + (c - 96) : 3264 + (c - 256));
#pragma unroll
            for (int j = 0; j < 8; ++j) { const float v = p[j] + (q[j] - p[j]) * mix[mi + j]; p[j] = c < 96 ? tanhf(v) : (c < 192 ? v : 1.0f / (1.0f + expf(-v))); }
        }
        *(v4u*)(LA + (size_t)t * 512 + c) = pack8(p); }
}

__device__ __forceinline__ void ph4_prep(KArgs a, Frame& F, int l) {
    const int gw = F.vcu * NWAVES + F.wave, NGW = F.G * NWAVES;
    float* RWR = (float*)(F.ws + WS_RWR); float* RWK = (float*)(F.ws + WS_RWK); float* RWKK = (float*)(F.ws + WS_RWKK); float* RWB = (float*)(F.ws + WS_RWB);
    const float* RWA = (const float*)(F.ws + WS_RWA); float* BON = (float*)(F.ws + WS_BON);
    const float* kkw = a->in[9] + (size_t)l * 1024; const float* kaw = a->in[10] + (size_t)l * 1024; const float* rkw = a->in[11] + (size_t)l * 1024;
    for (int task = gw; task < NTOK * 4; task += NGW) { const int t = task >> 2, hq = task & 3, c = hq * 256 + 4 * F.lane; const size_t idx = (size_t)t * 1024 + c;
        const f32x4 r = *(const f32x4*)(RWR + idx), k = *(const f32x4*)(RWK + idx), av = *(const f32x4*)(RWA + idx);
        const f32x4 kkr = k * *(const f32x4*)(kkw + c);
        const float n2 = dpp16((kkr[0] * kkr[0] + kkr[1] * kkr[1]) + (kkr[2] * kkr[2] + kkr[3] * kkr[3]));
        const f32x4 kk = kkr * (1.0f / fmaxf(sqrtf(n2), 1e-12f));
        const f32x4 k2 = k * (1.0f + (av - 1.0f) * *(const f32x4*)(kaw + c));
        *(f32x4*)(RWK + idx) = k2; *(f32x4*)(RWKK + idx) = kk; *(f32x4*)(RWB + idx) = kk * av;
        const f32x4 pr = r * k2 * *(const f32x4*)(rkw + c);
        const float bon = dpp16((pr[0] + pr[1]) + (pr[2] + pr[3]));
        if ((F.lane & 15) == 0) BON[t * 16 + hq * 4 + (F.lane >> 4)] = bon; }
}
__device__ __forceinline__ void ph6_rwkv_out(KArgs a, Frame& F, int l) {
    const int gw = F.vcu * NWAVES + F.wave, NGW = F.G * NWAVES;
    const float* RWY = (const float*)(F.ws + WS_RWY); const float* RWV = (const float*)(F.ws + WS_RWV); const float* RWG = (const float*)(F.ws + WS_RWG); const float* BON = (const float*)(F.ws + WS_BON);
    bf16* Y2 = (bf16*)(F.ws + WS_YBR) + (size_t)2 * NTOK * 1024;
    const float* lg = a->in[12] + (size_t)l * 1024; const float* lb = a->in[13] + (size_t)l * 1024;
    for (int task = gw; task < NTOK * 4; task += NGW) { const int t = task >> 2, hq = task & 3, c = hq * 256 + 4 * F.lane; const size_t idx = (size_t)t * 1024 + c;
        const f32x4 y = *(const f32x4*)(RWY + idx);
        const float mu = dpp16((y[0] + y[1]) + (y[2] + y[3])) * (1.0f / 64.0f); const f32x4 d = y - mu;
        const float var = dpp16((d[0] * d[0] + d[1] * d[1]) + (d[2] * d[2] + d[3] * d[3])) * (1.0f / 64.0f);
        f32x4 yn = d * rsqrtf(var + GN_EPS) * *(const f32x4*)(lg + c) + *(const f32x4*)(lb + c);
        yn += BON[t * 16 + hq * 4 + (F.lane >> 4)] * *(const f32x4*)(RWV + idx);
        yn *= *(const f32x4*)(RWG + idx);
        v2u w; w.x = pk2(yn[0], yn[1]); w.y = pk2(yn[2], yn[3]); *(v2u*)(Y2 + idx) = w; }
}

typedef float f32x2_t __attribute__((ext_vector_type(2)));
__device__ __forceinline__ void reduce2(float q, float p, float& Q, float& P) {
    const auto a = __builtin_amdgcn_permlane16_swap(__float_as_uint(q), __float_as_uint(p), false, false);
    float x = __uint_as_float(a[0]) + __uint_as_float(a[1]);
    x = dpp16(x);
    const auto b = __builtin_amdgcn_permlane16_swap(__float_as_uint(x), __float_as_uint(x), false, false);
    Q = __uint_as_float(b[0]); P = __uint_as_float(b[1]);
}
template <int MODE  > __device__ __forceinline__ void ph5_scan(KArgs a, Frame& F, int l) {
#define LDS_BAR() do { asm volatile("s_waitcnt lgkmcnt(0)" ::: "memory"); __builtin_amdgcn_s_barrier(); asm volatile("" ::: "memory"); } while (0)
    const int bx = pg8::obid();
    const int seq = bx >> 3, b = seq >> 4, h = seq & 15, i0 = (bx & 7) * 8 + F.wave * 2;
    const bool active = F.wave < 4;
    LAS float* buf = (LAS float*)(F.lds + RING_OFF);
    constexpr int BSZ = 6 * 32 * 64, ASZ = 32 * 64, NBLK = SEQ / 32;
    const float* A0 = (const float*)(F.ws + WS_RWKK) + 1024; const float* A1 = (const float*)(F.ws + WS_RWB); const float* A2 = (const float*)(F.ws + WS_RWW);
    const float* A3 = (const float*)(F.ws + WS_RWK); const float* A4 = (const float*)(F.ws + WS_RWR); const float* A5 = (const float*)(F.ws + WS_RWV);
    float* RWY = (float*)(F.ws + (MODE == 0 ? WS_RWY : WS_M + 600 * MiB));
    const size_t tok0 = (size_t)b * SEQ; const int col0 = h * 64;
    const int st = F.tid >> 4, sq = F.tid & 15;
    const size_t soff = (tok0 + st) * 1024 + col0 + sq * 4;
    const int loff = st * 64 + sq * 4;
    const int rl = F.lane >> 5, jq = F.lane & 31, irow = i0 + rl;
    float S0 = 0.f, S1 = 0.f, yreg = 0.f, sa = 0.f;
#define SC_LOAD(R, blk_) do { if (MODE == 1) break; const size_t o_ = soff + (size_t)(blk_) * 32 * 1024; R##0 = *(const f32x4*)(A0 + o_); R##1 = *(const f32x4*)(A1 + o_); R##2 = *(const f32x4*)(A2 + o_); \
        R##3 = *(const f32x4*)(A3 + o_); R##4 = *(const f32x4*)(A4 + o_); R##5 = *(const f32x4*)(A5 + o_); } while (0)
#define SC_WRITE(R, bufi) do { if (MODE == 1) break; LAS float* nb_ = buf + (bufi) * BSZ; *(LAS f32x4*)(nb_ + 0 * ASZ + loff) = R##0; *(LAS f32x4*)(nb_ + 1 * ASZ + loff) = R##1; *(LAS f32x4*)(nb_ + 2 * ASZ + loff) = R##2; \
        *(LAS f32x4*)(nb_ + 3 * ASZ + loff) = R##3; *(LAS f32x4*)(nb_ + 4 * ASZ + loff) = R##4; *(LAS f32x4*)(nb_ + 5 * ASZ + loff) = R##5; } while (0)
#define SC_COMPUTE(bufi, blk_) do { if (active) { const LAS float* bb = buf + (bufi) * BSZ; \
        _Pragma("unroll 4") for (int tl = 0; tl < 32; ++tl) { const LAS float* base = bb + tl * 64; \
            const f32x2_t b2 = *(const LAS f32x2_t*)(base + 1 * ASZ + 2 * jq), w2 = *(const LAS f32x2_t*)(base + 2 * ASZ + 2 * jq), k2 = *(const LAS f32x2_t*)(base + 3 * ASZ + 2 * jq), \
                          r2 = *(const LAS f32x2_t*)(base + 4 * ASZ + 2 * jq), kn = *(const LAS f32x2_t*)(base + 0 * ASZ + 2 * jq); \
            const float v = base[5 * ASZ + irow]; \
            S0 = S0 * w2[0] + (sa * b2[0] + v * k2[0]); S1 = S1 * w2[1] + (sa * b2[1] + v * k2[1]); \
            float Q, P; reduce2(S0 * r2[0] + S1 * r2[1], S0 * kn[0] + S1 * kn[1], Q, P); \
            sa = -P; \
            if (jq == (tl & 15)) yreg = Q; \
            if ((tl & 15) == 15) { if (jq < 16) RWY[(tok0 + (size_t)(blk_) * 32 + (tl - 15) + jq) * 1024 + col0 + irow] = yreg; } } } } while (0)
    int hit = (SHADOW_CONVERT && MODE == 0 && !active) ? I_IN + (bx * 4 + (F.wave - 4)) : NIT;
    LAS float* hscr = (LAS float*)(F.lds + RING_OFF + (F.wave < 7 ? 98304 + (F.wave - 4) * 8448 : 132096));
    float hv[32]; TrItem hd = {}; bool hpend = false;
    if (active) __builtin_amdgcn_s_setprio(3);
#define SC_HELP() do { if (hpend) { tr_finish(hd, F.lane, hv, hscr); hpend = false; } if (hit < NIT) { hd = decode_item(a, F.ws, l, hit); tr_issue(hd, F.lane, hv); hpend = true; hit += 4 * (int)gridDim.x; } } while (0)
    f32x4 ra0 = {}, ra1 = {}, ra2 = {}, ra3 = {}, ra4 = {}, ra5 = {}, rb0 = {}, rb1 = {}, rb2 = {}, rb3 = {}, rb4 = {}, rb5 = {};
    SC_LOAD(ra, 0); SC_LOAD(rb, 1);
    SC_WRITE(ra, 0);
    SC_LOAD(ra, 2);
    for (int blk = 0; blk < NBLK; blk += 2) {
        LDS_BAR();
        SC_COMPUTE(0, blk);
        SC_WRITE(rb, 1);
        if (blk + 3 < NBLK) SC_LOAD(rb, blk + 3);
        SC_HELP();
        LDS_BAR();
        SC_COMPUTE(1, blk + 1);
        if (blk + 2 < NBLK) { SC_WRITE(ra, 0); if (blk + 4 < NBLK) SC_LOAD(ra, blk + 4); }
        SC_HELP();
    }
    __builtin_amdgcn_s_setprio(0);
    while (hit < NIT || hpend) SC_HELP();
    LDS_BAR();
#undef SC_HELP
#undef LDS_BAR
#undef SC_LOAD
#undef SC_WRITE
#undef SC_COMPUTE
}
namespace rk {
constexpr int NCHUNK = 32 * 64;
constexpr size_t BLOB = 57344;
constexpr size_t O_RH = 0, O_PT = 8192, O_Y0 = 16384, O_LMT = 32768, O_SC = 49152;
constexpr size_t WS_RKC = WS_M + 600 * MiB;
static_assert(WS_RKC + (size_t)NCHUNK * BLOB <= WS_END, "chunk blobs");
constexpr int B_AB = 0, B_KT = 16384, B_RT = 24576, B_VT = 32768, B_ATT = 40960, B_BHT = 49152, B_KHT = 57344, B_LAK = 65536, B_LRB = 73728, B_LRK = 81920, B_T = 90112, B_MISC = 98304, B_HSCR = 100352;
static_assert(B_HSCR + 4 * 8448 <= LDSCTL_OFF, "phase A LDS map");
#define RSW(row, col) ((row) * 128 + ((((col) * 2)) ^ (((row) & 7) << 4)))
__device__ __forceinline__ int crow(int r, int hi) { return (r & 3) + 8 * (r >> 2) + 4 * hi; }
__device__ __forceinline__ unsigned cvtpk(float lo, float hi) { unsigned r; asm volatile("v_cvt_pk_bf16_f32 %0, %1, %2" : "=v"(r) : "v"(lo), "v"(hi)); return r; }
__device__ __forceinline__ void mm(f32x16& acc, LAS const char* A, LAS const char* Bt, int tm, int tn, int r32, int hi) {
#pragma unroll
    for (int s = 0; s < 4; ++s) { const bf16x8 a = *(LAS const bf16x8*)(A + RSW(32 * tm + r32, 16 * s + 8 * hi)), b = *(LAS const bf16x8*)(Bt + RSW(32 * tn + r32, 16 * s + 8 * hi));
        acc = __builtin_amdgcn_mfma_f32_32x32x16_bf16(a, b, acc, 0, 0, 0); }
}
__device__ __forceinline__ void store_n(const f32x16& acc, LAS char* dst, int tm, int tn, int r32, int hi) {
#pragma unroll
    for (int r = 0; r < 16; ++r) *(LAS bf16*)(dst + RSW(32 * tm + crow(r, hi), 32 * tn + r32)) = (bf16)f2bf(acc[r]);
}
__device__ __forceinline__ void store_t(const f32x16& acc, LAS char* dst, int tm, int tn, int r32, int hi) {
#pragma unroll
    for (int g = 0; g < 4; ++g) { v2u w; w.x = cvtpk(acc[4 * g], acc[4 * g + 1]); w.y = cvtpk(acc[4 * g + 2], acc[4 * g + 3]); *(LAS v2u*)(dst + RSW(32 * tn + r32, 32 * tm + 8 * g + 4 * hi)) = w; }
}
__device__ __forceinline__ v4u frag8(const f32x16& acc, int sl) {
    v4u w; w.x = cvtpk(acc[8 * sl], acc[8 * sl + 1]); w.y = cvtpk(acc[8 * sl + 2], acc[8 * sl + 3]); w.z = cvtpk(acc[8 * sl + 4], acc[8 * sl + 5]); w.w = cvtpk(acc[8 * sl + 6], acc[8 * sl + 7]); return w;
}
#define RK_BAR() do { asm volatile("s_waitcnt lgkmcnt(0)" ::: "memory"); __builtin_amdgcn_s_barrier(); asm volatile("" ::: "memory"); } while (0)

template <int HELP, int FUSE_PREP, int VAR = 0  > __device__ __forceinline__ void rk_chunk_local(KArgs a, Frame& F, int l) {
    LAS char* L = (LAS char*)(F.lds + RING_OFF);
    const int lane0 = F.lane, wv = F.wave;
    const bool cw = wv < 4; const int tm = (wv >> 1) & 1, tn = wv & 1;
    const float* GW = (const float*)(F.ws + WS_RWW); const float* GKK = (const float*)(F.ws + (FUSE_PREP ? WS_RWA : WS_RWKK)); const float* GB = (const float*)(F.ws + WS_RWB);
    const float* GK = (const float*)(F.ws + WS_RWK); const float* GR = (const float*)(F.ws + WS_RWR); const float* GV = (const float*)(F.ws + WS_RWV);
    unsigned char* blobs = F.ws + WS_RKC;
    int hit = (HELP && !cw) ? I_IN + P0_EXTRA + (pg8::obid() * 4 + (wv - 4)) : NIT_A; const int hstride = 4 * (int)gridDim.x;
    LAS float* hscr = (LAS float*)(L + B_HSCR + (wv & 3) * 8448);
    float hva[32], hvb[32], hvc[32], hvd[32]; TrItem hda = {}, hdb = {}, hdc = {}, hdd = {}; bool pa = false, pb = false, pc = false, pd = false;
#define RK_FIN(hv, hd, pp) do { if (pp) { tr_finish(hd, lane0, hv, hscr); pp = false; } } while (0)
#define RK_ISS(hv, hd, pp) do { if (hit < NIT_A) { hd = decode_item(a, F.ws, l, hit); tr_issue(hd, lane0, hv); pp = true; hit += hstride; } } while (0)
#define RK_HELPN(n) do { RK_FIN(hva, hda, pa); RK_FIN(hvb, hdb, pb); RK_FIN(hvc, hdc, pc); RK_FIN(hvd, hdd, pd); \
        if ((n) > 0) RK_ISS(hva, hda, pa); if ((n) > 1) RK_ISS(hvb, hdb, pb); if ((n) > 2) RK_ISS(hvc, hdc, pc); if ((n) > 3) RK_ISS(hvd, hdd, pd); } while (0)
#define RK_SYNC() RK_BAR()
    if (!cw) {
#pragma unroll 1
        for (int chunk = pg8::obid(); chunk < NCHUNK; chunk += (int)gridDim.x) {
            if (HELP) RK_HELPN(HN0); RK_BAR();
            if (HELP) RK_HELPN(HN1); RK_BAR();
            if (HELP) RK_HELPN(HN2); RK_BAR();
            if (HELP) RK_HELPN(HN3); RK_BAR();
            if (HELP) RK_HELPN(HN4); RK_BAR();
            if (HELP) RK_HELPN(HN5); RK_BAR();
            if (HELP) RK_HELPN(HN6); RK_BAR(); }
        if (HELP) { while (hit < NIT_A || pa || pb || pc || pd) RK_HELPN(4); }
        return;
    }
    float wv16[16], kk16[16], bb16[16], k16[16], r16[16], v16[16];
#define RK_LOAD(ch_) do { const int sq_ = (ch_) >> 6, cc_ = (ch_) & 63; const size_t g0_ = ((size_t)(sq_ >> 4) * SEQ + (size_t)cc_ * 64 + 16 * (wv & 3)) * 1024 + (sq_ & 15) * 64 + lane0; \
        _Pragma("unroll") for (int tt = 0; tt < 16; ++tt) { const size_t o = g0_ + (size_t)tt * 1024; wv16[tt] = GW[o]; kk16[tt] = GKK[o]; bb16[tt] = GB[o]; } } while (0)
#define RK_LOAD2(ch_) do { const int sq_ = (ch_) >> 6, cc_ = (ch_) & 63; const size_t g0_ = ((size_t)(sq_ >> 4) * SEQ + (size_t)cc_ * 64 + 16 * (wv & 3)) * 1024 + (sq_ & 15) * 64 + lane0; \
        _Pragma("unroll") for (int tt = 0; tt < 16; ++tt) { const size_t o = g0_ + (size_t)tt * 1024; k16[tt] = GK[o]; r16[tt] = GR[o]; v16[tt] = GV[o]; } } while (0)
    RK_LOAD(pg8::obid());
#pragma unroll 1
    for (int chunk = pg8::obid(); chunk < NCHUNK; chunk += (int)gridDim.x) {
        int lane = lane0; asm volatile("" : "+v"(lane));
        const int r32 = lane & 31, hi = lane >> 5;
        const int seq = chunk >> 6, c = chunk & 63, b = seq >> 4, h = seq & 15;
        const size_t tok0 = (size_t)b * SEQ + (size_t)c * 64;
        unsigned char* blob = VAR ? F.ws + WS_M + 724 * MiB + (size_t)(chunk & 63) * BLOB : blobs + (size_t)chunk * BLOB;
        float cs[16];
        const int j = lane, tg = wv & 3;
        {
            RK_LOAD2(chunk); if (wv == 0 && chunk != pg8::obid()) RK_LOAD(chunk);
            float run = 0.f;
#pragma unroll
            for (int tt = 0; tt < 16; ++tt) { run += __logf(wv16[tt]); cs[tt] = run; }
            ((LAS float*)(L + B_MISC))[tg * 64 + j] = run;
        }
        RK_SYNC();
        if (cw) {
            const LAS float* ct = (const LAS float*)(L + B_MISC);
            const float t0 = ct[j], t1 = ct[64 + j], t2 = ct[128 + j], t3 = ct[192 + j];
            const float base = tg == 0 ? 0.f : (tg == 1 ? t0 : (tg == 2 ? t0 + t1 : t0 + t1 + t2)), total = (t0 + t1) + (t2 + t3);
            float prev = base;
#pragma unroll
            for (int tt = 0; tt < 16; ++tt) { const int t = 16 * tg + tt; const float cum = base + cs[tt];
                const float eP = __expf(cum), eM = __expf(-cum), ePm1 = __expf(prev), eC = __expf(total - cum); prev = cum;
                const float at = -kk16[tt] * ePm1;
                *(LAS bf16*)(L + B_AB + RSW(t, j)) = (bf16)f2bf(at);
                *(LAS bf16*)(L + B_AB + 8192 + RSW(t, j)) = (bf16)f2bf(bb16[tt] * eM);
                *(LAS bf16*)(L + B_KT + RSW(t, j)) = (bf16)f2bf(k16[tt] * eM);
                *(LAS bf16*)(L + B_RT + RSW(t, j)) = (bf16)f2bf(r16[tt] * eP);
                *(LAS bf16*)(L + B_VT + RSW(j, t)) = (bf16)f2bf(v16[tt]);
                *(LAS bf16*)(L + B_ATT + RSW(j, t)) = (bf16)f2bf(at);
                *(LAS bf16*)(L + B_BHT + RSW(j, t)) = (bf16)f2bf(bb16[tt] * eC);
                *(LAS bf16*)(L + B_KHT + RSW(j, t)) = (bf16)f2bf(k16[tt] * eC); }
            if (tg == 0) ((LAS float*)(L + B_MISC))[256 + j] = __expf(total);
            if (wv != 0 && chunk + (int)gridDim.x < NCHUNK) RK_LOAD(chunk + (int)gridDim.x);
        }
        RK_SYNC();
        f32x16 qab = {}, qak = {}, qrb = {}, qrk = {};
        if (cw && !(VAR & 2)) { mm(qab, L + B_AB, L + B_AB + 8192, tm, tn, r32, hi); mm(qak, L + B_AB, L + B_KT, tm, tn, r32, hi); mm(qrb, L + B_RT, L + B_AB + 8192, tm, tn, r32, hi); mm(qrk, L + B_RT, L + B_KT, tm, tn, r32, hi); }
        RK_SYNC();
        if (cw && !(VAR & 2)) {
#pragma unroll
            for (int r = 0; r < 16; ++r) { const int t = 32 * tm + crow(r, hi), s = 32 * tn + r32;
                ((LAS float*)(L + B_AB))[t * 64 + s] = s < t ? qab[r] : 0.f;
                qak[r] = s < t ? qak[r] : 0.f; qrb[r] = s <= t ? qrb[r] : 0.f; qrk[r] = s <= t ? qrk[r] : 0.f; }
            store_n(qak, L + B_LAK, tm, tn, r32, hi); store_n(qrb, L + B_LRB, tm, tn, r32, hi); store_n(qrk, L + B_LRK, tm, tn, r32, hi);
        }
        RK_SYNC();
        if (wv == 0 && !(VAR & 7)) {
            const LAS float* Lf = (const LAS float*)(L + B_AB);
            float Tr[64];
#pragma unroll
            for (int t = 0; t < 64; ++t) Tr[t] = 0.f;
#pragma unroll
            for (int t = 0; t < 64; ++t) { float a0 = Lf[t * 64 + lane], a1 = 0.f, a2 = 0.f, a3 = 0.f;
#pragma unroll
                for (int q = 0; q < (t + 3) / 4; ++q) { const f32x4 lv = *(const LAS f32x4*)(Lf + t * 64 + 4 * q);
                    a0 += lv[0] * Tr[4 * q + 0]; a1 += lv[1] * Tr[4 * q + 1]; a2 += lv[2] * Tr[4 * q + 2]; a3 += lv[3] * Tr[4 * q + 3]; }
                const float acc = (a0 + a1) + (a2 + a3);
                Tr[t] = acc; *(LAS bf16*)(L + B_T + RSW(t, lane)) = (bf16)f2bf(lane == t ? 1.0f + acc : acc); }
        } else if (cw && !(VAR & 6)) {
            for (int tile = (wv == 1 ? 0 : wv); tile < (wv == 1 ? 2 : wv + 1); ++tile) { f32x16 x = {}; mm(x, L + B_LAK, L + B_VT, tile >> 1, tile & 1, r32, hi); store_t(x, L + B_KT, tile >> 1, tile & 1, r32, hi); }
        }
        RK_SYNC();
        if (cw && !(VAR & 6)) { f32x16 u = {}, w = {}; mm(u, L + B_T, L + B_KT, tm, tn, r32, hi); mm(w, L + B_T, L + B_ATT, tm, tn, r32, hi);
            store_t(u, L + B_LAK, tm, tn, r32, hi); store_t(w, L + B_AB, tm, tn, r32, hi); }
        RK_SYNC();
        if (cw && !(VAR & 6)) {
            { f32x16 q = {}; mm(q, L + B_AB, L + B_LRB, tm, tn, r32, hi);
#pragma unroll
              for (int g = 0; g < 4; ++g) { const v2u rw = *(LAS const v2u*)(L + B_RT + RSW(32 * tn + r32, 32 * tm + 8 * g + 4 * hi));
                  q[4 * g] += blo(rw.x); q[4 * g + 1] += bhi(rw.x); q[4 * g + 2] += blo(rw.y); q[4 * g + 3] += bhi(rw.y); }
              v4u* dst = (v4u*)(blob + O_RH) + (size_t)(tn * 4 + 2 * tm) * 64 + lane; dst[0] = frag8(q, 0); dst[64] = frag8(q, 1); }
            { f32x16 q = {}; mm(q, L + B_AB, L + B_BHT, tm, tn, r32, hi);
              const float gcv = ((const LAS float*)(L + B_MISC))[256 + 32 * tn + r32];
#pragma unroll
              for (int r = 0; r < 16; ++r) if (32 * tm + crow(r, hi) == 32 * tn + r32) q[r] += gcv;
              v4u* dst = (v4u*)(blob + O_PT) + (size_t)(tn * 4 + 2 * tm) * 64 + lane; dst[0] = frag8(q, 0); dst[64] = frag8(q, 1); }
            { f32x16 q = {}; mm(q, L + B_LRB, L + B_LAK, tm, tn, r32, hi); mm(q, L + B_LRK, L + B_VT, tm, tn, r32, hi);
              float* dst = (float*)(blob + O_Y0) + (size_t)(2 * tm + tn) * 1024 + lane;
#pragma unroll
              for (int r = 0; r < 16; ++r) dst[r * 64] = q[r]; }
            { f32x16 q = {}; mm(q, L + B_BHT, L + B_LAK, tm, tn, r32, hi); mm(q, L + B_KHT, L + B_VT, tm, tn, r32, hi);
              float* dst = (float*)(blob + O_LMT) + (size_t)(2 * tm + tn) * 1024 + lane;
#pragma unroll
              for (int r = 0; r < 16; ++r) dst[r * 64] = q[r]; }
        }
        RK_SYNC();
    }
#undef RK_HELPN
#undef RK_LOAD
#undef RK_LOAD2
#undef RK_FIN
#undef RK_ISS
#undef RK_SYNC
}
__device__ __forceinline__ void rk_sequential(KArgs a, Frame& F, int l) {
    const int bx = pg8::obid();
    if (bx >= 32) {
        LAS float* scr = (LAS float*)(F.lds + RING_OFF + F.wave * 16384);
        for (int it = NIT_A + (bx - 32) * NWAVES + F.wave; it < NIT; it += ((int)gridDim.x - 32) * NWAVES) convert_item(a, F.ws, l, it, scr, F.lane);
        return; }
    if (F.wave >= 2) return;
    const int ii = F.wave, lane = F.lane; unsigned char* blobs = F.ws + WS_RKC + (size_t)bx * 64 * BLOB;
    f32x16 xa0 = {}, xa1 = {}, xb0, xb1, xc0, xc1; v4u pa[8], pb[8], pc[8];
#define RKS_LDP(P, c_) do { if ((c_) < 64) { const v4u* pt_ = (const v4u*)(blobs + (size_t)(c_) * BLOB + O_PT) + lane; _Pragma("unroll") for (int q = 0; q < 8; ++q) P[q] = pt_[q * 64]; } } while (0)
#define RKS_LDL(L0, L1, c_) do { if ((c_) < 64) { const float* lm_ = (const float*)(blobs + (size_t)(c_) * BLOB + O_LMT) + lane; \
        _Pragma("unroll") for (int r = 0; r < 16; ++r) { L0[r] = lm_[(size_t)(0 + ii) * 1024 + r * 64]; L1[r] = lm_[(size_t)(2 + ii) * 1024 + r * 64]; } } } while (0)
#define RKS_STEP(P, s0, s1, l0, l1, c_) do { unsigned char* blob = blobs + (size_t)(c_) * BLOB; \
        v4u bf[4]; bf[0] = frag8(s0, 0); bf[1] = frag8(s0, 1); bf[2] = frag8(s1, 0); bf[3] = frag8(s1, 1); \
        { v4u* sc = (v4u*)(blob + O_SC) + (size_t)ii * 256 + lane; sc[0] = bf[0]; sc[64] = bf[1]; sc[128] = bf[2]; sc[192] = bf[3]; } \
        RKS_LDL(s0, s1, (c_) + 2); \
        _Pragma("unroll") for (int ks = 0; ks < 4; ++ks) { l0 = __builtin_amdgcn_mfma_f32_32x32x16_bf16(__builtin_bit_cast(bf16x8, P[ks]), __builtin_bit_cast(bf16x8, bf[ks]), l0, 0, 0, 0); \
                                                         l1 = __builtin_amdgcn_mfma_f32_32x32x16_bf16(__builtin_bit_cast(bf16x8, P[4 + ks]), __builtin_bit_cast(bf16x8, bf[ks]), l1, 0, 0, 0); } \
        RKS_LDP(P, (c_) + 3); } while (0)
    RKS_LDP(pa, 0); RKS_LDL(xb0, xb1, 0); RKS_LDP(pb, 1); RKS_LDL(xc0, xc1, 1); RKS_LDP(pc, 2);
#pragma unroll 1
    for (int c = 0; c < 63; c += 3) {
        RKS_STEP(pa, xa0, xa1, xb0, xb1, c);
        RKS_STEP(pb, xb0, xb1, xc0, xc1, c + 1);
        RKS_STEP(pc, xc0, xc1, xa0, xa1, c + 2);
    }
    RKS_STEP(pa, xa0, xa1, xb0, xb1, 63);
#undef RKS_LDP
#undef RKS_LDL
#undef RKS_STEP
}
template <int CHECK> __device__ __forceinline__ void rk_output(Frame& F, float* RWY, const float* REF, float* errw) {
    float e2 = 0.f, r2 = 0.f;
    const int gw = F.vcu * NWAVES + F.wave, NGW = F.G * NWAVES, lane = F.lane, r32 = lane & 31, hi = lane >> 5;
    for (int task = gw; task < NCHUNK * 2; task += NGW) { const int chunk = task >> 1, ii = task & 1; const int seq = chunk >> 6, c = chunk & 63, b = seq >> 4, h = seq & 15;
        const unsigned char* blob = F.ws + WS_RKC + (size_t)chunk * BLOB;
        v4u bf[4]; { const v4u* sc = (const v4u*)(blob + O_SC) + (size_t)ii * 256 + lane; bf[0] = sc[0]; bf[1] = sc[64]; bf[2] = sc[128]; bf[3] = sc[192]; }
#pragma unroll
        for (int tt = 0; tt < 2; ++tt) { f32x16 y; const float* y0 = (const float*)(blob + O_Y0) + (size_t)(2 * tt + ii) * 1024 + lane;
#pragma unroll
            for (int r = 0; r < 16; ++r) y[r] = y0[r * 64];
            const v4u* rh = (const v4u*)(blob + O_RH) + (size_t)(tt * 4) * 64 + lane;
#pragma unroll
            for (int ks = 0; ks < 4; ++ks) y = __builtin_amdgcn_mfma_f32_32x32x16_bf16(__builtin_bit_cast(bf16x8, rh[ks * 64]), __builtin_bit_cast(bf16x8, bf[ks]), y, 0, 0, 0);
            float* dst = RWY + ((size_t)b * SEQ + (size_t)c * 64 + 32 * tt) * 1024 + h * 64 + 32 * ii + r32;
#pragma unroll
            for (int r = 0; r < 16; ++r) dst[(size_t)crow(r, hi) * 1024] = y[r];
            if (CHECK) { const float* rf = REF + (dst - RWY);
#pragma unroll
                for (int r = 0; r < 16; ++r) { const float o = rf[(size_t)crow(r, hi) * 1024], d = y[r] - o; e2 += d * d; r2 += o * o; } } }
    }
    if (CHECK) { e2 = wave_sum(e2); r2 = wave_sum(r2); if (lane == 0) { atomicAdd(errw, e2); atomicAdd(errw + 1, r2); } }
}
#undef RSW
}
namespace att {
constexpr int SHM_K = 64 * 128 * 2, SHM_V = 64 * 128 * 2;
constexpr float ATT_STOP = -40.0f;
#define KSWZ(row, colB) ((row) * 256 + ((colB) ^ (((row) & 7) << 4)))
__device__ __forceinline__ int v_st(int k, int c) { const int kk = (k & ~0xC) | ((k & 4) << 1) | ((k & 8) >> 1); return ((kk >> 3) * 4 + (c >> 5)) * 512 + ((kk & 7) * 32 + (c & 31)) * 2; }
__device__ __forceinline__ int v_rd_base(int lane) { return ((lane & 3) << 3) | (((lane >> 2) & 3) << 6) | (((lane >> 4) & 1) << 5) | (((lane >> 5) & 1) << 8); }
constexpr int v_rd_off(int d0, int ks, int half) { return d0 * 512 + ks * 4096 + half * 2048; }
__device__ __forceinline__ int crow(int r, int hi) { return (r & 3) + 8 * (r >> 2) + 4 * hi; }
__device__ __forceinline__ unsigned cvtpk(float lo, float hi) { unsigned r; asm volatile("v_cvt_pk_bf16_f32 %0, %1, %2" : "=v"(r) : "v"(lo), "v"(hi)); return r; }
__device__ __forceinline__ int kperm(int m) { return 16 * ((m >> 2) & 1) + 4 * (m >> 3) + (m & 3); }

__device__ __forceinline__ void qkt(f32x16& p0, f32x16& p1, LAS const char* K_lds, int r32, int hi, const bf16x8* qr) {
    p0 = f32x16{}; p1 = f32x16{};
    LAS const char* kb[4];
#pragma unroll
    for (int dd = 0; dd < 4; ++dd) kb[dd] = K_lds + KSWZ(r32, (dd * 16 + hi * 8) * 2);
#pragma unroll
    for (int d0 = 0; d0 < 8; ++d0) { LAS const char* ap = kb[d0 & 3] + (d0 >> 2) * 128;
        const bf16x8 b0 = *(LAS const bf16x8*)ap;
        const bf16x8 b1 = *(LAS const bf16x8*)(ap + 32 * 256);
        p0 = __builtin_amdgcn_mfma_f32_32x32x16_bf16(b0, qr[d0], p0, 0, 0, 0);
        p1 = __builtin_amdgcn_mfma_f32_32x32x16_bf16(b1, qr[d0], p1, 0, 0, 0); }
}
__device__ __forceinline__ void pv_tile(f32x16* o, int vb0, bf16x8 pa0, bf16x8 pa1, bf16x8 pa2, bf16x8 pa3) {
#define TRRD(dst, off) asm volatile("ds_read_b64_tr_b16 %0, %1 offset:%2" : "=&v"(dst) : "v"(vb0), "i"(off) : "memory")
#define PV_D0(d0) do { s16x4 l0, l1, l2, l3, h0, h1, h2, h3; constexpr int b_ = v_rd_off(d0, 0, 0); \
        TRRD(l0, b_); TRRD(h0, b_ + 2048); TRRD(l1, b_ + 4096); TRRD(h1, b_ + 6144); TRRD(l2, b_ + 8192); TRRD(h2, b_ + 10240); TRRD(l3, b_ + 12288); TRRD(h3, b_ + 14336); \
        asm volatile("s_waitcnt lgkmcnt(0)" ::: "memory"); __builtin_amdgcn_sched_barrier(0); \
        o[d0] = __builtin_amdgcn_mfma_f32_32x32x16_bf16(pa0, (bf16x8){l0[0], l0[1], l0[2], l0[3], h0[0], h0[1], h0[2], h0[3]}, o[d0], 0, 0, 0);   \
        o[d0] = __builtin_amdgcn_mfma_f32_32x32x16_bf16(pa1, (bf16x8){l1[0], l1[1], l1[2], l1[3], h1[0], h1[1], h1[2], h1[3]}, o[d0], 0, 0, 0);   \
        o[d0] = __builtin_amdgcn_mfma_f32_32x32x16_bf16(pa2, (bf16x8){l2[0], l2[1], l2[2], l2[3], h2[0], h2[1], h2[2], h2[3]}, o[d0], 0, 0, 0);   \
        o[d0] = __builtin_amdgcn_mfma_f32_32x32x16_bf16(pa3, (bf16x8){l3[0], l3[1], l3[2], l3[3], h3[0], h3[1], h3[2], h3[3]}, o[d0], 0, 0, 0); } while (0)
    PV_D0(0); PV_D0(1); PV_D0(2); PV_D0(3);
#undef PV_D0
#undef TRRD
}
__device__ __forceinline__ void stick_tile(f32x16& p0, f32x16& p1, float& c, int t, int kb0, int hi) {
    const float CS = 0.08838834764831845f * 1.4426950408889634f;
    const int k0 = kb0 + 16 * hi, k1 = k0 + 32;
    float f0[16], f1[16]; float T0 = 0.f, T1 = 0.f;
#pragma unroll
    for (int r = 0; r < 16; ++r) {
        const float y0 = p0[r] * CS, y1 = p1[r] * CS;
        const float sp0 = __builtin_amdgcn_logf(1.0f + __builtin_amdgcn_exp2f(y0)), sp1 = __builtin_amdgcn_logf(1.0f + __builtin_amdgcn_exp2f(y1));
        f0[r] = (k0 + r < t) ? -sp0 : 0.f; f1[r] = (k1 + r < t) ? -sp1 : 0.f;
        p0[r] = y0 - sp0; p1[r] = y1 - sp1;
        T0 += f0[r]; T1 += f1[r];
    }
    const auto s1 = __builtin_amdgcn_permlane32_swap(__float_as_uint(T1), __float_as_uint(T1), false, false);
    const auto s0 = __builtin_amdgcn_permlane32_swap(__float_as_uint(T0), __float_as_uint(T0), false, false);
    const float T1lo = __uint_as_float(s1[0]), T1hi = __uint_as_float(s1[1]), T0lo = __uint_as_float(s0[0]), T0hi = __uint_as_float(s0[1]);
    const float c1 = c + T1hi, c2 = c1 + T1lo, c3 = c2 + T0hi, c4 = c3 + T0lo;
    float run1 = hi ? c : c1, run0 = hi ? c2 : c3;
#pragma unroll
    for (int r = 15; r >= 0; --r) {
        const float w1 = (k1 + r < t) ? __builtin_amdgcn_exp2f(p1[r] + run1) : 0.f; run1 += f1[r]; p1[r] = w1;
        const float w0 = (k0 + r < t) ? __builtin_amdgcn_exp2f(p0[r] + run0) : 0.f; run0 += f0[r]; p0[r] = w0;
    }
    c = c4;
}
#define PK4(P, B_, OUT) do { unsigned a0 = cvtpk(P[B_+0], P[B_+1]), a1 = cvtpk(P[B_+2], P[B_+3]);                          \
        unsigned b0 = cvtpk(P[B_+4], P[B_+5]), b1 = cvtpk(P[B_+6], P[B_+7]);                                             \
        auto r0 = __builtin_amdgcn_permlane32_swap(a0, b0, false, false); auto r1 = __builtin_amdgcn_permlane32_swap(a1, b1, false, false); \
        v4u w = {r0[0], r1[0], r0[1], r1[1]}; OUT = __builtin_bit_cast(bf16x8, w); } while (0)

__device__ __forceinline__ void attn_unit(LAS unsigned char* lds, const bf16* QKV, bf16* O, int b, int h, int qb) {
    const int tid = pg8::otid(), wid = __builtin_amdgcn_readfirstlane(tid >> 6), lane = tid & 63, r32 = lane & 31, hi = lane >> 5;
    LAS char* V_lds = (LAS char*)lds; LAS char* K_lds = (LAS char*)lds + SHM_V; volatile LAS int* flags = (volatile LAS int*)(lds + SHM_V + SHM_K);
    const bf16* Qp = QKV + (size_t)b * SEQ * 3072 + h * 128; const bf16* Kp = Qp + 1024; const bf16* Vp = Qp + 2048;
    const int qlo = qb * 256 + wid * 32, t = qlo + r32;
    bf16x8 qr[8];
#pragma unroll
    for (int d0 = 0; d0 < 8; ++d0) qr[d0] = *(const bf16x8*)(Qp + (size_t)t * 3072 + d0 * 16 + hi * 8);
    const int sr = tid >> 4, sc = (tid & 15) * 8, kr = kperm(sr);
    const int kws = KSWZ(sr, sc * 2), vst0 = v_st(sr, sc), vst1 = v_st(32 + sr, sc);
    const int vb0 = (int)(unsigned)(uintptr_t)V_lds + v_rd_base(lane);
    f32x16 o[4] = {}; float c = 0.f; bool done = false;
    if (tid < 8) flags[tid] = 0;
    for (int j = 4 * qb + 3; j >= 0; --j) {
        const int kb0 = j * 64;
        const bf16x8 k0v = *(const bf16x8*)(Kp + (size_t)(kb0 + kr) * 3072 + sc), k1v = *(const bf16x8*)(Kp + (size_t)(kb0 + 32 + kr) * 3072 + sc);
        const bf16x8 v0v = *(const bf16x8*)(Vp + (size_t)(kb0 + kr) * 3072 + sc), v1v = *(const bf16x8*)(Vp + (size_t)(kb0 + 32 + kr) * 3072 + sc);
        __syncthreads();
        bool all_done = true;
#pragma unroll
        for (int w = 0; w < 8; ++w) all_done = all_done && (flags[w] != 0);
        if (all_done) break;
        *(LAS bf16x8*)(K_lds + kws) = k0v; *(LAS bf16x8*)(K_lds + kws + 32 * 256) = k1v;
        *(LAS bf16x8*)(V_lds + vst0) = v0v; *(LAS bf16x8*)(V_lds + vst1) = v1v;
        __syncthreads();
        if (!done && kb0 <= qlo + 30) {
            f32x16 p0, p1;
            qkt(p0, p1, K_lds, r32, hi, qr);
            stick_tile(p0, p1, c, t, kb0, hi);
            bf16x8 pa0, pa1, pa2, pa3;
            PK4(p0, 0, pa0); PK4(p0, 8, pa1); PK4(p1, 0, pa2); PK4(p1, 8, pa3);
            pv_tile(o, vb0, pa0, pa1, pa2, pa3);
            done = __all(c < ATT_STOP) != 0;
            if (lane == 0 && done) flags[wid] = 1;
        }
    }
    bf16* Ow = O + ((size_t)b * SEQ + qlo) * 1024 + h * 128;
#pragma unroll
    for (int r = 0; r < 16; ++r) { const int orow = crow(r, hi);
#pragma unroll
        for (int d0 = 0; d0 < 4; ++d0) { const float v = o[d0][r]; const float vn = __shfl_xor(v, 1);
            if ((r32 & 1) == 0) *(unsigned*)(Ow + (size_t)orow * 1024 + d0 * 32 + r32) = cvtpk(v, vn); } }
    __syncthreads();
}
#undef PK4
#undef KSWZ
}
__device__ __forceinline__ float shx(float v, int m) { return __shfl_xor(v, m); }
__device__ __forceinline__ float rdl(float v, int l) { return __builtin_bit_cast(float, __builtin_amdgcn_readlane(__builtin_bit_cast(int, v), l)); }
__device__ __forceinline__ void ph9_ln_router(KArgs a, Frame& F, int l) {
    volatile LAS int* lhist = (volatile LAS int*)(F.lds + RING_OFF);
    const float* PRE = (const float*)(F.ws + WS_PRELN); float* X1 = (float*)(F.ws + WS_X1); bf16* XS = (bf16*)(F.ws + WS_XS);
    int* HIST = (int*)(F.ws + WS_HIST); int* SELE = (int*)(F.ws + WS_SELE); float* SELW = (float*)(F.ws + WS_SELW);
    const float* g1 = a->in[16] + (size_t)l * DM; const float* b1 = a->in[17] + (size_t)l * DM;
    const float* WR = a->in[18] + (size_t)l * DM * 64; const float* rbias = a->in[19] + (size_t)l * 64;
    const int lane = F.lane;
    for (int grp = pg8::obid(); grp < 256; grp += F.G) {
        if (F.tid < 64) lhist[F.tid] = 0;
        __syncthreads();
        const int t0 = grp * 32 + F.wave * 4;
#pragma unroll 1
        for (int k = 0; k < 4; ++k) {
            f32x4 v[8];
            const f32x4* row = (const f32x4*)(PRE + (size_t)(t0 + k) * DM) + lane; float s = 0.f;
#pragma unroll
            for (int j = 0; j < 8; ++j) { v[j] = row[64 * j]; s += (v[j][0] + v[j][1]) + (v[j][2] + v[j][3]); }
            const float mean = wave_sum(s) * (1.0f / DM); float s2 = 0.f;
#pragma unroll
            for (int j = 0; j < 8; ++j) { v[j] = v[j] - mean; s2 += (v[j][0] * v[j][0] + v[j][1] * v[j][1]) + (v[j][2] * v[j][2] + v[j][3] * v[j][3]); }
            const float rstd = 1.0f / sqrtf(wave_sum(s2) * (1.0f / DM) + LN_EPS);
            f32x4* xo = (f32x4*)(X1 + (size_t)(t0 + k) * DM) + lane; v2u* bo = (v2u*)(XS + (size_t)(t0 + k) * DM) + lane;
#pragma unroll
            for (int j = 0; j < 8; ++j) { const f32x4 gg = ((const f32x4*)g1)[64 * j + lane], bb = ((const f32x4*)b1)[64 * j + lane];
                v[j] = v[j] * rstd * gg + bb; xo[64 * j] = v[j];
                v2u w; w.x = pk2(v[j][0], v[j][1]); w.y = pk2(v[j][2], v[j][3]); bo[64 * j] = w; }
        }
        __syncthreads();
        LAS float* XC = (LAS float*)(F.lds + RING_OFF + 1024);
        LAS float* WC = (LAS float*)(F.lds + RING_OFF + 1024 + 33024);
        f32x16 ac0 = {}, ac1 = {};
#pragma unroll 1
        for (int j = 0; j < 8; ++j) {
            __syncthreads();
#pragma unroll
            for (int i = 0; i < 4; ++i) { const int idx = F.tid + 512 * i, xrow = idx >> 6, c4 = idx & 63;
                const f32x4 xv = *(const f32x4*)(X1 + (size_t)(grp * 32 + xrow) * DM + 256 * j + 4 * c4);
                LAS float* xr = XC + xrow * 257 + 4 * c4; xr[0] = xv[0]; xr[1] = xv[1]; xr[2] = xv[2]; xr[3] = xv[3]; }
            { const f32x4* wsrc = (const f32x4*)(WR + (size_t)256 * j * 64);
#pragma unroll
              for (int i = 0; i < 8; ++i) ((LAS f32x4*)WC)[F.tid + 512 * i] = wsrc[F.tid + 512 * i]; }
            __syncthreads();
#pragma unroll
            for (int kk = 0; kk < 16; ++kk) { const int kidx = 32 * F.wave + 2 * kk + (lane >> 5);
                const float av = XC[(lane & 31) * 257 + kidx], b0 = WC[kidx * 64 + (lane & 31)], b1 = WC[kidx * 64 + 32 + (lane & 31)];
                ac0 = __builtin_amdgcn_mfma_f32_32x32x2f32(av, b0, ac0, 0, 0, 0); ac1 = __builtin_amdgcn_mfma_f32_32x32x2f32(av, b1, ac1, 0, 0, 0); }
        }
        __syncthreads();
        { LAS float* RED = WC; const int hi = lane >> 5, e = lane & 31;
#pragma unroll
          for (int r = 0; r < 16; ++r) { const int tok = (r & 3) + 8 * (r >> 2) + 4 * hi; RED[(F.wave * 32 + tok) * 64 + e] = ac0[r]; RED[(F.wave * 32 + tok) * 64 + 32 + e] = ac1[r]; } }
        __syncthreads();
        float acc[4];
#pragma unroll
        for (int k = 0; k < 4; ++k) { float sacc = 0.f;
#pragma unroll
            for (int w2 = 0; w2 < 8; ++w2) sacc += WC[(w2 * 32 + F.wave * 4 + k) * 64 + lane];
            acc[k] = sacc; }
        const float rb = rbias[lane];
#pragma unroll
        for (int k = 0; k < 4; ++k) {
            const int t = t0 + k;
            const float sc = 1.0f / (1.0f + expf(-acc[k])); const float bz = sc + rb;
            float m1 = bz; m1 = fmaxf(m1, shx(m1, 1)); m1 = fmaxf(m1, shx(m1, 2)); m1 = fmaxf(m1, shx(m1, 4));
            const unsigned long long eq = __ballot(bz == m1);
            const int g = lane >> 3; const unsigned gb = (unsigned)((eq >> (8 * g)) & 0xffull); const int first = __ffs((int)gb) - 1;
            float m2 = ((lane & 7) == first) ? -__builtin_inff() : bz; m2 = fmaxf(m2, shx(m2, 1)); m2 = fmaxf(m2, shx(m2, 2)); m2 = fmaxf(m2, shx(m2, 4));
            const float gs = m1 + m2;
            int grank = 0;
#pragma unroll
            for (int g2 = 0; g2 < 8; ++g2) { const float o = rdl(gs, 8 * g2); grank += ((o > gs) || (o == gs && g2 < g)) ? 1 : 0; }
            const bool gsel = grank < 4;
            const float mv = gsel ? bz : -__builtin_inff();
            int rank = 0;
            for (int e2 = 0; e2 < 64; ++e2) { const float o = rdl(mv, e2); rank += ((o > mv) || (o == mv && e2 < lane)) ? 1 : 0; }
            const bool sel = gsel && rank < 8;
            const float ssum = wave_sum(sel ? sc : 0.f);
            const float wgt = sc / ssum * ROUTED_SCALE;
            const unsigned long long m = __ballot(sel);
            const int slot = __popcll(m & ((1ull << lane) - 1ull));
            if (sel) { SELE[t * 8 + slot] = lane; SELW[t * 8 + slot] = wgt; __hip_atomic_fetch_add((LAS int*)&lhist[lane], 1, __ATOMIC_RELAXED, __HIP_MEMORY_SCOPE_WORKGROUP); }
        }
        __syncthreads();
        if (F.tid < 64) HIST[grp * 64 + F.tid] = lhist[F.tid];
        __syncthreads();
    }
}
__device__ __forceinline__ void ph10_lists(Frame& F) {
    volatile LAS int* L = (volatile LAS int*)(F.lds + RING_OFF);
    volatile LAS int* partT = L, * partB = L + 512, * rowbase = L + 1024, * lsel = L + 1088, * lpos = L + 1344;
    const int* HIST = (const int*)(F.ws + WS_HIST); const int* SELE = (const int*)(F.ws + WS_SELE); const float* SELW = (const float*)(F.ws + WS_SELW);
    int* SLOT = (int*)(F.ws + WS_SLOT); float* ROWW = (float*)(F.ws + WS_ROWW); int* TSEG = (int*)(F.ws + WS_TSEG); int* ROWT = (int*)(F.ws + WS_ROWT); int* XT = (int*)(F.ws + WS_XT);
    for (int grp = pg8::obid(); grp < 256; grp += F.G) {
        { const int e = F.tid & 63, part = F.tid >> 6; int s = 0, bs = 0;
          for (int w = 32 * part; w < 32 * part + 32; ++w) { const int hv = HIST[w * 64 + e]; s += hv; bs += (w < grp) ? hv : 0; }
          partT[part * 64 + e] = s; partB[part * 64 + e] = bs; }
        __syncthreads();
        if (F.tid < 64) { int tot = 0, bef = 0;
#pragma unroll
            for (int p = 0; p < 8; ++p) { tot += partT[p * 64 + F.tid]; bef += partB[p * 64 + F.tid]; }
            const int nt = (tot + 255) >> 8; int incl = nt;
#pragma unroll
            for (int o = 1; o < 64; o <<= 1) { const int u = __shfl_up(incl, o); if (F.lane >= o) incl += u; }
            const int excl = incl - nt;
            rowbase[F.tid] = 8192 + 256 * excl + bef;
            if (grp == 0) { for (int i = 0; i < nt; ++i) TSEG[16 + 32 + excl + i] = F.tid + 1;
                for (int r = 8192 + 256 * excl + tot; r < 8192 + 256 * (excl + nt); ++r) ROWT[r] = 0;
                if (F.tid < 32) TSEG[16 + F.tid] = 0;
                if (F.tid == 63) TSEG[0] = 32 + incl; } }
        if (F.tid < 256) lsel[F.tid] = SELE[grp * 256 + F.tid];
        __syncthreads();
        if (F.tid < 256) { const int j = F.tid >> 3, e = lsel[F.tid]; int rank = 0;
            for (int q = 0; q < 8 * j; ++q) rank += (lsel[q] == e) ? 1 : 0;
            const int pos = rowbase[e] + rank; const int t = grp * 32 + j;
            SLOT[t * 8 + (F.tid & 7)] = pos; ROWW[pos] = SELW[grp * 256 + F.tid]; ROWT[pos] = t; }
        else if (F.tid < 288) { ROWW[grp * 32 + F.tid - 256] = 1.0f; ROWT[grp * 32 + F.tid - 256] = grp * 32 + F.tid - 256; }
        __syncthreads();
    }
}
__device__ __forceinline__ void ph13_combine(KArgs a, Frame& F, int l, float poison) {
    const int gw = F.vcu * NWAVES + F.wave, NGW = F.G * NWAVES, lane = F.lane;
    const float* X1 = (const float*)(F.ws + WS_X1); const bf16* YS = (const bf16*)(F.ws + WS_YS); const int* SLOT = (const int*)(F.ws + WS_SLOT);
    float* outf = (l == NLAYER - 1) ? a->out : (float*)(F.ws + WS_X2); bf16* XB = (bf16*)(F.ws + WS_XB);
    const float* g2 = a->in[26] + (size_t)l * DM; const float* b2 = a->in[27] + (size_t)l * DM;
    for (int t = gw; t < NTOK; t += NGW) {
        const int mypos = (lane < 8) ? SLOT[t * 8 + lane] : t;
        float acc[4][8];
#pragma unroll
        for (int q = 0; q < 4; ++q) { const f32x4 p0 = *(const f32x4*)(X1 + (size_t)t * DM + 512 * q + 8 * lane), p1 = *(const f32x4*)(X1 + (size_t)t * DM + 512 * q + 8 * lane + 4);
#pragma unroll
            for (int j = 0; j < 4; ++j) { acc[q][j] = ALPHA * p0[j]; acc[q][4 + j] = ALPHA * p1[j]; } }
#pragma unroll
        for (int s = 0; s < 9; ++s) { const int row = __builtin_amdgcn_readlane(mypos, s); const v4u* yr = (const v4u*)(YS + (size_t)row * DM) + lane;
#pragma unroll
            for (int q = 0; q < 4; ++q) { float u[8]; unpack8(yr[64 * q], u);
#pragma unroll
                for (int j = 0; j < 8; ++j) acc[q][j] += u[j]; } }
        float s1 = 0.f;
#pragma unroll
        for (int q = 0; q < 4; ++q)
#pragma unroll
            for (int j = 0; j < 8; ++j) s1 += acc[q][j];
        const float mean = wave_sum(s1) * (1.0f / DM); float s2 = 0.f;
#pragma unroll
        for (int q = 0; q < 4; ++q)
#pragma unroll
            for (int j = 0; j < 8; ++j) { acc[q][j] -= mean; s2 += acc[q][j] * acc[q][j]; }
        const float rstd = 1.0f / sqrtf(wave_sum(s2) * (1.0f / DM) + LN_EPS);
#pragma unroll
        for (int q = 0; q < 4; ++q) { const int col = 512 * q + 8 * lane;
            const f32x4 ga = *(const f32x4*)(g2 + col), gb = *(const f32x4*)(g2 + col + 4), ba = *(const f32x4*)(b2 + col), bb = *(const f32x4*)(b2 + col + 4);
            float y[8];
#pragma unroll
            for (int j = 0; j < 4; ++j) { y[j] = (acc[q][j] * rstd * ga[j] + ba[j]) * poison; y[4 + j] = (acc[q][4 + j] * rstd * gb[j] + bb[j]) * poison; }
            *(f32x4*)(outf + (size_t)t * DM + col) = (f32x4){y[0], y[1], y[2], y[3]}; *(f32x4*)(outf + (size_t)t * DM + col + 4) = (f32x4){y[4], y[5], y[6], y[7]};
            *(v4u*)(XB + (size_t)t * DM + col) = pack8(y); }
    }
}
__device__ __forceinline__ KArgs kargs() { KArgs p = (KArgs)__builtin_amdgcn_kernarg_segment_ptr(); asm volatile("" : "+s"(p)); return p; }
__device__ __forceinline__ Frame mkframe(LAS unsigned char* lds) {
    Frame F; KArgs ka = kargs();
    F.lds = lds; F.MISC = (volatile LAS unsigned*)(lds + MISC_OFF);
    F.tid = pg8::otid(); F.lane = F.tid & 63; F.wave = __builtin_amdgcn_readfirstlane(F.tid >> 6);
    F.G = gridDim.x; { const int bx = pg8::obid(); F.vcu = (F.G % 8 == 0) ? (bx % 8) * (F.G / 8) + bx / 8 : bx; }
    F.ws = ka->ws; F.ctl = (gu32*)(ka->ws + WS_CTL);
    return F;
}
__device__ __forceinline__ void grid_seam(LAS unsigned char* lds) {
    XcdBarrier b; b.bar = (unsigned*)((gu32*)(kargs()->ws + WS_CTL) + CW_BAR); b.x = xb_xcc_id(); b.st = (volatile LAS unsigned*)(lds + MISC_OFF) + 8;
    xcd_barrier(b);
}
__global__ void __launch_bounds__(NWAVES * 64, 2) fwd_kernel(Args args_unused) {
    extern __shared__ __attribute__((aligned(16))) unsigned char lds_raw[];
    LAS unsigned char* lds = (LAS unsigned char*)lds_raw;
    for (int u = threadIdx.x; u < (LDS_BYTES - LDSCTL_OFF) / 4; u += NWAVES * 64) ((LAS unsigned*)(lds + LDSCTL_OFF))[u] = 0u;
    __syncthreads();
    if (kargs()->ph_hi - kargs()->ph_lo > 1) (void)xcd_barrier_post((unsigned*)((gu32*)(kargs()->ws + WS_CTL) + CW_BAR), (volatile LAS unsigned*)(lds + MISC_OFF) + 8);
#ifndef PH_MASK
#define PH_MASK 0xffff
#endif
#define IN(k) (((PH_MASK >> (k)) & 1) && kargs()->ph_lo <= (pb + (k)) && (pb + (k)) < kargs()->ph_hi)
#ifndef REP_MASK
#define REP_MASK 0
#endif
#define REPS(k) _Pragma("unroll 1") for (int rep_ = 0; rep_ < ((((REP_MASK) >> (k)) & 1) ? 2 : 1); ++rep_)
#define REPSEAM() do { if (rep_) grid_seam(lds); } while (0)
#define SEAM(k) do { if (IN(k) && (pb + (k) + 1) < kargs()->ph_hi) grid_seam(lds); } while (0)
#pragma unroll 1
    for (int l = 0; l < NLAYER; ++l) {
        const int pb = l * NPHASE;
        if (IN(0)) REPS(0) { REPSEAM(); Frame F = mkframe(lds); ph0_convert(kargs(), F, l); } SEAM(0);
        if (IN(1)) REPS(1) { REPSEAM(); unsigned char* ws = kargs()->ws;
            pg8::Gemm g{(const pg8::bf16_t*)(ws + WS_XB), (const pg8::bf16_t*)(ws + WS_WIN), NTOK, INP, DM}; pg8::StaticOrder S; S.init(NTOK, INP, (int)gridDim.x, pg8::obid());
            pg8::EpiInProj E{(pg8::bf16_t*)(ws + WS_PCONV), (pg8::bf16_t*)(ws + WS_PQKV), (pg8::bf16_t*)(ws + WS_PRKV), (pg8::bf16_t*)(ws + WS_PLORA), (pg8::bf16_t*)(ws + WS_PGATE)};
            pg8::gemm_phase<pg8::EpiInProj, pg8::StaticOrder, true, true>(lds + RING_OFF, g, S, E);
        } SEAM(1);
        if (IN(2)) REPS(2) { REPSEAM(); unsigned char* ws = kargs()->ws;
            for (int u = pg8::obid(); u < 256; u += gridDim.x) att::attn_unit(lds + RING_OFF, (const bf16*)(ws + WS_PQKV), (bf16*)(ws + WS_YBR) + (size_t)NTOK * 1024, u >> 7, (u >> 4) & 7, u & 15);
            Frame F = mkframe(lds); ph2_elementwise(kargs(), F, l);
        } SEAM(2);
        if (IN(3)) REPS(3) { REPSEAM(); unsigned char* ws = kargs()->ws;
            pg8::Gemm g{(const pg8::bf16_t*)(ws + WS_LORAA), (const pg8::bf16_t*)(ws + WS_WLORA), NTOK, 3072, 512}; pg8::StaticOrder S; S.init(NTOK, 3072, (int)gridDim.x, pg8::obid());
            pg8::EpiLora E{(float*)(ws + WS_RWW), (long)((WS_RWA - WS_RWW) / 4), (long)((WS_RWG - WS_RWW) / 4), kargs()->in[4] + (size_t)l * 1024, kargs()->in[6] + (size_t)l * 1024};
            pg8::gemm_phase<pg8::EpiLora, pg8::StaticOrder, true, true>(lds + RING_OFF, g, S, E);
        } SEAM(3);
#define MOE_C ((pg8::obid() & 7) * ((int)gridDim.x >> 3) + (pg8::obid() >> 3))
#ifndef DOWN_ALIGN
#define DOWN_ALIGN true
#endif
#ifndef RK_FUSE_PREP
#define RK_FUSE_PREP 0
#endif
#ifndef RWKV_MODE
#define RWKV_MODE 1
#endif
#ifndef RK_CHECK
#define RK_CHECK 0
#endif
#ifndef RK_CHECK_TOL
#define RK_CHECK_TOL 0.02f
#endif
        if ((RWKV_MODE == 0 || RK_CHECK || !RK_FUSE_PREP) && IN(4)) REPS(4) { REPSEAM(); Frame F = mkframe(lds); ph4_prep(kargs(), F, l); if ((pb + 5) < kargs()->ph_hi) grid_seam(lds); }

        if (IN(5)) REPS(5) { REPSEAM(); Frame F = mkframe(lds);
            if (RWKV_MODE == 0 || RK_CHECK) { ph5_scan<0>(kargs(), F, l); }
            if (RWKV_MODE == 1) { if (RK_CHECK) grid_seam(lds); rk::rk_chunk_local<RK_CHECK ? 0 : 1, (RK_CHECK || !RK_FUSE_PREP) ? 0 : 1>(kargs(), F, l); }
        } SEAM(5);
#ifdef RK_PROBE
        if (IN(5)) { Frame F = mkframe(lds); rk::rk_chunk_local<0, 0, RK_PROBE>(kargs(), F, l); grid_seam(lds); }
#endif
        if (IN(6)) REPS(6) { REPSEAM(); Frame F = mkframe(lds); if (RWKV_MODE == 1) rk::rk_sequential(kargs(), F, l); } SEAM(6);
        if (IN(7)) REPS(7) { REPSEAM(); Frame F = mkframe(lds);
            if (RWKV_MODE == 1) rk::rk_output<RK_CHECK>(F, (float*)(F.ws + (RK_CHECK ? WS_M + 720 * MiB : WS_RWY)), (const float*)(F.ws + WS_RWY), (float*)(F.ctl + 2048 + 2 * l)); } SEAM(7);
        if (IN(8)) REPS(8) { REPSEAM(); Frame F = mkframe(lds); ph6_rwkv_out(kargs(), F, l); } SEAM(8);
        if (IN(9)) REPS(9) { REPSEAM(); unsigned char* ws = kargs()->ws;
            pg8::Gemm g{(const pg8::bf16_t*)(ws + WS_YBR), (const pg8::bf16_t*)(ws + WS_WBR), 3 * NTOK, 3 * DM, 1024}; pg8::BranchOrder S; S.so.init(NTOK, DM, (int)gridDim.x, pg8::obid());
            pg8::EpiGate E{(const pg8::bf16_t*)(ws + WS_PGATE), (pg8::bf16_t*)(ws + WS_PRELN), (pg8::bf16_t*)(ws + WS_MERGED)};
            pg8::gemm_phase<pg8::EpiGate, pg8::BranchOrder, true, true>(lds + RING_OFF, g, S, E);
        } SEAM(9);
        if (IN(10)) REPS(10) { REPSEAM(); unsigned char* ws = kargs()->ws;
            pg8::Gemm g{(const pg8::bf16_t*)(ws + WS_MERGED), (const pg8::bf16_t*)(ws + WS_WO), NTOK, DM, DM}; pg8::StaticOrder S; S.init(NTOK, DM, (int)gridDim.x, pg8::obid());
            pg8::EpiWo E{l == 0 ? kargs()->in[0] : (const float*)(ws + WS_X2), (float*)(ws + WS_PRELN), ALPHA};
            pg8::gemm_phase<pg8::EpiWo, pg8::StaticOrder, true, true>(lds + RING_OFF, g, S, E);
        } SEAM(10);
        if (IN(11)) REPS(11) { REPSEAM(); Frame F = mkframe(lds); ph9_ln_router(kargs(), F, l); } SEAM(11);
        if (IN(12)) REPS(12) { REPSEAM(); Frame F = mkframe(lds); ph10_lists(F); } SEAM(12);
        if (IN(13)) REPS(13) { REPSEAM(); unsigned char* ws = kargs()->ws;
            const int ntiles = __builtin_amdgcn_readfirstlane(ld_i32((const int*)(ws + WS_TSEG)));
            pg8::Gemm g{(const pg8::bf16_t*)(ws + WS_XS), (const pg8::bf16_t*)(ws + WS_WGU), ntiles * 256, NSEG * 1024, DM};
            pg8::MoeOrder S{(const int*)(ws + WS_TSEG) + 16, ntiles, 4, (int)gridDim.x, MOE_C};
            pg8::EpiSwiglu E{(pg8::bf16_t*)(ws + WS_H), (const float*)(ws + WS_ROWW)};
            pg8::gemm_phase_gather<pg8::EpiSwiglu, pg8::MoeOrder, true, true>(lds + RING_OFF, g, S, E, (const int*)(ws + WS_ROWT));
        } SEAM(13);
        if (IN(14)) REPS(14) { REPSEAM(); unsigned char* ws = kargs()->ws;
            const int ntiles = __builtin_amdgcn_readfirstlane(ld_i32((const int*)(ws + WS_TSEG)));
            pg8::Gemm g{(const pg8::bf16_t*)(ws + WS_H), (const pg8::bf16_t*)(ws + WS_WD), ntiles * 256, NSEG * 2048, 512};
            pg8::MoeOrder S{(const int*)(ws + WS_TSEG) + 16, ntiles, 8, (int)gridDim.x, MOE_C};
            pg8::EpiDown E{(pg8::bf16_t*)(ws + WS_YS), (const float*)(ws + WS_ROWW)};
            pg8::gemm_phase<pg8::EpiDown, pg8::MoeOrder, DOWN_ALIGN, true>(lds + RING_OFF, g, S, E);
        } SEAM(14);
        if (IN(15)) REPS(15) { REPSEAM(); Frame F = mkframe(lds); ph13_combine(kargs(), F, l, (RK_CHECK && ld_f32((const float*)(F.ctl + 2048 + 2 * l)) > RK_CHECK_TOL * RK_CHECK_TOL * ld_f32((const float*)(F.ctl + 2049 + 2 * l))) ? 1000.f : 1.f); } SEAM(15);
    }
#undef IN
#undef SEAM
}

#ifndef MK_PER_PHASE
#define MK_PER_PHASE 0
#endif
extern "C" void kernel_launch(void* const* d_in, const int* in_sizes, int n_in, void* d_out, int out_size, void* d_ws, size_t ws_size, hipStream_t stream) {
    static int grid = 0;
    if (grid == 0) {
        if (n_in != 28 || out_size != NTOK * DM || ws_size < WS_END) { fprintf(stderr, "kernel_launch: unexpected problem shape (n_in %d out %d ws %zu)\n", n_in, out_size, ws_size); grid = -1; return; }
        int dev = 0, cus = 0, per_cu = 0;
        if (hipGetDevice(&dev) != hipSuccess || hipDeviceGetAttribute(&cus, hipDeviceAttributeMultiprocessorCount, dev) != hipSuccess) { grid = -1; return; }
        if (hipFuncSetAttribute((const void*)fwd_kernel, hipFuncAttributeMaxDynamicSharedMemorySize, LDS_BYTES) != hipSuccess) { fprintf(stderr, "kernel_launch: hipFuncSetAttribute failed\n"); grid = -1; return; }
        if (hipOccupancyMaxActiveBlocksPerMultiprocessor(&per_cu, (const void*)fwd_kernel, NWAVES * 64, LDS_BYTES) != hipSuccess || per_cu < 1) fprintf(stderr, "kernel_launch: occupancy query reports %d\n", per_cu);
        (void)hipGetLastError();
        grid = cus;
    }
    if (grid < 0) return;
    (void)hipMemsetAsync((char*)d_ws + WS_CTL, 0, CTL_ZERO_BYTES, stream);
    Args a{};
    for (int i = 0; i < 28; ++i) a.in[i] = (const float*)d_in[i];
    a.out = (float*)d_out; a.ws = (unsigned char*)d_ws; a.li = 0; a.pad = 0;
#if MK_PER_PHASE
    for (int p = 0; p < NLAYER * NPHASE; ++p) { a.ph_lo = p; a.ph_hi = p + 1; hipLaunchKernelGGL(fwd_kernel, dim3(grid), dim3(NWAVES * 64), LDS_BYTES, stream, a); }
#else
    a.ph_lo = 0; a.ph_hi = NLAYER * NPHASE;
    hipLaunchKernelGGL(fwd_kernel, dim3(grid), dim3(NWAVES * 64), LDS_BYTES, stream, a);
#endif
}
```

```cpp
#include <hip/hip_runtime.h>
#include <cstdio>
#include <cstdint>
namespace pg8 {
#define PG8_LAS __attribute__((address_space(3)))
typedef unsigned short bf16_t;
typedef short bf16x8 __attribute__((ext_vector_type(8)));
typedef float f32x4 __attribute__((ext_vector_type(4)));
typedef unsigned u32x4 __attribute__((ext_vector_type(4)));
typedef unsigned u32x2 __attribute__((ext_vector_type(2)));
constexpr int BM = 256, BK = 64, HALF = 128, HTB = HALF * BK * 2  , STAGE_BYTES = 8 * HTB, NXCD = 8, WGM = 8;

__host__ __device__ __forceinline__ int lds_byte(int r, int c) { const int st = (r >> 4) * 2 + (c >> 5), rr = r & 15, cc = c & 31, ob = rr * 64 + cc * 2; return st * 1024 + (ob ^ (((ob >> 9) & 1) << 5)); }
__host__ __device__ __forceinline__ void stage_rc(int b, int& R, int& C) { const int st = b / 1024, sb = b % 1024, swz = sb ^ (((sb >> 9) & 1) << 5); R = (st >> 1) * 16 + swz / 64; C = (st & 1) * 32 + (swz % 64) / 2; }
__host__ __device__ __forceinline__ int perm32(int rho) { const int n = rho >> 4, i = rho & 15; return 8 * (i >> 2) + 4 * n + (i & 3); }

struct Unit { int pm, pn; };
struct Gemm { const bf16_t* A; const bf16_t* Bt; int M, N, K; };

struct StaticOrder {
    int nM, nN, nwg, G, c;
    __host__ __device__ void init(int M, int N, int G_, int c_) { nM = M / BM; nN = N / BM; nwg = nM * nN; G = G_; c = c_; }
    __host__ __device__ bool next(int i, Unit& u) const {
        const long L = (long)i * G + c; if (L >= nwg) return false;
        int wgid = (int)L; { const int q = nwg / NXCD, r = nwg % NXCD, xcd = wgid % NXCD, off = wgid / NXCD; wgid = (xcd < r ? xcd * (q + 1) : r * (q + 1) + (xcd - r) * q) + off; }
        const int nig = WGM * nN, gid = wgid / nig, fm = gid * WGM, gsz = (nM - fm) < WGM ? (nM - fm) : WGM;
        u.pm = fm + ((wgid % nig) % gsz); u.pn = (wgid % nig) / gsz; return true;
    }
    __device__ __forceinline__ void a_ready(const Unit&) const {}
    __device__ __forceinline__ void done(const Unit&) const {}
};

__device__ __forceinline__ int otid() { int t = threadIdx.x; asm volatile("" : "+v"(t)); return t; }
__device__ __forceinline__ int obid() { int t = blockIdx.x; asm volatile("" : "+s"(t)); return t; }
typedef __bf16 bf16x2c_t __attribute__((ext_vector_type(2))); typedef float f32x2c_t __attribute__((ext_vector_type(2)));
__device__ __forceinline__ unsigned cvt_pk_bf16(float lo, float hi) { f32x2c_t v = {lo, hi}; bf16x2c_t b = __builtin_convertvector(v, bf16x2c_t); return __builtin_bit_cast(unsigned, b); }
__device__ __forceinline__ float bflo(unsigned w) { return __uint_as_float(w << 16); }
__device__ __forceinline__ float bfhi(unsigned w) { return __uint_as_float(w & 0xffff0000u); }
__device__ __forceinline__ void st16_sc1(void* p, u32x4 v) { asm volatile("global_store_dwordx4 %0, %1, off sc1\n\ts_nop 2" :: "v"(p), "v"(v) : "memory"); }
__device__ __forceinline__ float sigmoidf_(float x) { return 1.0f / (1.0f + __expf(-x)); }

struct EpiInProj {
    static constexpr bool PERM = true, AFTER_DRAIN = false;
    bf16_t *conv, *qkv, *rkv, *lora, *gate;
    __device__ __forceinline__ void operator()(const f32x4 (&acc)[2][2][4][2], const Unit& u, int wr, int wc, int fr, int fq) const {
        const int pn = u.pn; bf16_t* base; int ldc, colt;
        if (pn < 12) { base = conv; ldc = 3072; colt = pn * 256; }
        else if (pn < 24) { base = qkv; ldc = 3072; colt = (pn - 12) * 256; }
        else if (pn < 36) { base = rkv; ldc = 3072; colt = (pn - 24) * 256; }
        else if (pn < 38) { base = lora; ldc = 512; colt = (pn - 36) * 256; }
        else { base = gate; ldc = 6144; colt = (pn - 38) * 256; }
        const int row0 = u.pm * BM + wr * 64 + fr, col0 = colt + wc * 32 + 8 * fq;
#pragma unroll
        for (int ai = 0; ai < 2; ++ai)
#pragma unroll
            for (int m = 0; m < 4; ++m) { bf16_t* rowp = base + (size_t)(row0 + ai * HALF + m * 16) * ldc + col0;
#pragma unroll
                for (int bj = 0; bj < 2; ++bj) { const f32x4 v0 = acc[ai][bj][m][0], v1 = acc[ai][bj][m][1];
                    u32x4 w; w.x = cvt_pk_bf16(v0[0], v0[1]); w.y = cvt_pk_bf16(v0[2], v0[3]); w.z = cvt_pk_bf16(v1[0], v1[1]); w.w = cvt_pk_bf16(v1[2], v1[3]);
                    *(u32x4*)(rowp + bj * HALF) = w; } }
    }
};
struct EpiLora {
    static constexpr bool PERM = false, AFTER_DRAIN = false;
    float* Wd; long offA, offG; const float *w0, *a0;
    __device__ __forceinline__ void operator()(const f32x4 (&acc)[2][2][4][2], const Unit& u, int wr, int wc, int fr, int fq) const {
        const int sec = u.pn >> 2, colt = (u.pn & 3) * 256;
        float* out = Wd + (sec == 0 ? 0l : (sec == 1 ? offA : offG));
        const float* bp = sec == 0 ? w0 : a0;
        const int row0 = (u.pm & 31) * BM + wr * 64 + fr, col0 = colt + wc * 32 + 4 * fq;
        f32x4 bv[2][2];
#pragma unroll
        for (int bj = 0; bj < 2; ++bj)
#pragma unroll
            for (int n = 0; n < 2; ++n) { const f32x4 t = *(const f32x4*)(bp + col0 + bj * HALF + n * 16); bv[bj][n] = sec == 2 ? (f32x4){0.f, 0.f, 0.f, 0.f} : t; }
#pragma unroll
        for (int ai = 0; ai < 2; ++ai)
#pragma unroll
            for (int m = 0; m < 4; ++m) { float* rowp = out + (size_t)(row0 + ai * HALF + m * 16) * 1024 + col0;
#pragma unroll
                for (int bj = 0; bj < 2; ++bj)
#pragma unroll
                    for (int n = 0; n < 2; ++n) { f32x4 v = acc[ai][bj][m][n] + bv[bj][n];
                        if (sec == 0) {
#pragma unroll
                            for (int j = 0; j < 4; ++j) { const float x = v[j]; const float sp = fmaxf(-x, 0.f) + __logf(1.0f + __expf(-fabsf(x)));
                                v[j] = __expf(-__expf(-sp - 0.5f)); }
                        } else if (sec == 1) {
#pragma unroll
                            for (int j = 0; j < 4; ++j) v[j] = 1.0f / (1.0f + __expf(-v[j]));
                        }
                        if (sec == 0) *(f32x4*)(rowp + bj * HALF + n * 16) = v;
                        else { u32x2 w; w.x = cvt_pk_bf16(v[0], v[1]); w.y = cvt_pk_bf16(v[2], v[3]);
                            *(u32x2*)((bf16_t*)out + (size_t)(row0 + ai * HALF + m * 16) * 1024 + col0 + bj * HALF + n * 16) = w; } } }
    }
};
struct EpiGate {
    static constexpr bool PERM = true, AFTER_DRAIN = false;
    const bf16_t* gate; bf16_t* tmp; bf16_t* out;
    __device__ __forceinline__ void operator()(const f32x4 (&acc)[2][2][4][2], const Unit& u, int wr, int wc, int fr, int fq) const {
        const int mode = u.pn >> 3;
        const int row0 = (u.pm & 31) * BM + wr * 64 + fr, col0 = (u.pn & 7) * BM + wc * 32 + 8 * fq;
        const bf16_t* gp = gate + mode * 2048;
#pragma unroll
        for (int ai = 0; ai < 2; ++ai)
#pragma unroll
            for (int m = 0; m < 4; ++m) { const size_t row = (size_t)(row0 + ai * HALF + m * 16);
#pragma unroll
                for (int bj = 0; bj < 2; ++bj) { const int col = col0 + bj * HALF;
                    const u32x4 gw = *(const u32x4*)(gp + row * 6144 + col);
                    f32x4 v0 = acc[ai][bj][m][0], v1 = acc[ai][bj][m][1];
                    v0[0] *= sigmoidf_(bflo(gw.x)); v0[1] *= sigmoidf_(bfhi(gw.x)); v0[2] *= sigmoidf_(bflo(gw.y)); v0[3] *= sigmoidf_(bfhi(gw.y));
                    v1[0] *= sigmoidf_(bflo(gw.z)); v1[1] *= sigmoidf_(bfhi(gw.z)); v1[2] *= sigmoidf_(bflo(gw.w)); v1[3] *= sigmoidf_(bfhi(gw.w));
                    bf16_t* tp = tmp + row * 2048 + col;
                    if (mode != 0) { const u32x4 tw = *(const u32x4*)tp; v0[0] += bflo(tw.x); v0[1] += bfhi(tw.x); v0[2] += bflo(tw.y); v0[3] += bfhi(tw.y); v1[0] += bflo(tw.z); v1[1] += bfhi(tw.z); v1[2] += bflo(tw.w); v1[3] += bfhi(tw.w); }
                    if (mode != 2) { u32x4 w; w.x = cvt_pk_bf16(v0[0], v0[1]); w.y = cvt_pk_bf16(v0[2], v0[3]); w.z = cvt_pk_bf16(v1[0], v1[1]); w.w = cvt_pk_bf16(v1[2], v1[3]); *(u32x4*)tp = w; }
                    else { u32x4 w; w.x = cvt_pk_bf16(v0[0], v0[1]); w.y = cvt_pk_bf16(v0[2], v0[3]); w.z = cvt_pk_bf16(v1[0], v1[1]); w.w = cvt_pk_bf16(v1[2], v1[3]);
                        *(u32x4*)(out + row * 2048 + col) = w; } } }
    }
};
struct LoraOrder {
    int G, c;
    __device__ __forceinline__ bool next(int i, Unit& u) const { const int L = i * G + c; if (L >= 384) return false; const int sec = L >> 7, rem = L & 127; u.pm = sec * 32 + (rem >> 2); u.pn = sec * 4 + (rem & 3); return true; }
    __device__ __forceinline__ void a_ready(const Unit&) const {}
    __device__ __forceinline__ void done(const Unit&) const {}
};
struct BranchOrder {
    StaticOrder so;
    __device__ __forceinline__ bool next(int i, Unit& u) const { Unit t; if (!so.next(i / 3, t)) return false; const int n = i % 3; u.pm = n * 32 + t.pm; u.pn = n * 8 + t.pn; return true; }
    __device__ __forceinline__ void a_ready(const Unit&) const {}
    __device__ __forceinline__ void done(const Unit&) const {}
};
struct EpiWo {
    static constexpr bool PERM = false, AFTER_DRAIN = false;
    const float* xin; float* out; float alpha; const bf16_t* xb;
    __device__ __forceinline__ void operator()(const f32x4 (&acc)[2][2][4][2], const Unit& u, int wr, int wc, int fr, int fq) const {
        const int row0 = u.pm * BM + wr * 64 + fr, col0 = u.pn * BM + wc * 32 + 4 * fq;
        if (xin) {
#pragma unroll
        for (int ai = 0; ai < 2; ++ai)
#pragma unroll
            for (int m = 0; m < 4; ++m) { const size_t off = (size_t)(row0 + ai * HALF + m * 16) * 2048 + col0;
#pragma unroll
                for (int bj = 0; bj < 2; ++bj)
#pragma unroll
                    for (int n = 0; n < 2; ++n) { const f32x4 xv = *(const f32x4*)(xin + off + bj * HALF + n * 16);
                        *(f32x4*)(out + off + bj * HALF + n * 16) = xv * alpha + acc[ai][bj][m][n]; } }
        } else {
#pragma unroll
        for (int ai = 0; ai < 2; ++ai)
#pragma unroll
            for (int m = 0; m < 4; ++m) { const size_t off = (size_t)(row0 + ai * HALF + m * 16) * 2048 + col0;
#pragma unroll
                for (int bj = 0; bj < 2; ++bj)
#pragma unroll
                    for (int n = 0; n < 2; ++n) { const unsigned long long w = *(const unsigned long long*)(xb + off + bj * HALF + n * 16); const unsigned lo = (unsigned)w, hi = (unsigned)(w >> 32);
                        const f32x4 xv = {bflo(lo), bfhi(lo), bflo(hi), bfhi(hi)};
                        *(f32x4*)(out + off + bj * HALF + n * 16) = xv * alpha + acc[ai][bj][m][n]; } }
        }
    }
};
struct PanelStats8 {
    unsigned* xbuf;
    unsigned* cnt;
    unsigned* tmo;
    float eps;
    __device__ __forceinline__ bool run(const f32x4 (&v)[2][2][4][2], const Unit& u, int wr, int wc, int fr, int fq, PG8_LAS unsigned char* lds, int wid, int lane) const {
        typedef float f32x2v __attribute__((ext_vector_type(2)));
        PG8_LAS f32x2v* P = (PG8_LAS f32x2v*)lds;
        PG8_LAS f32x2v* S = (PG8_LAS f32x2v*)(lds + 8192);
        PG8_LAS unsigned* flag = (PG8_LAS unsigned*)(lds + 8192 + 2048);
#pragma unroll
        for (int ai = 0; ai < 2; ++ai)
#pragma unroll
            for (int m = 0; m < 4; ++m) {
                float s = 0.f;
#pragma unroll
                for (int bj = 0; bj < 2; ++bj)
#pragma unroll
                    for (int n = 0; n < 2; ++n) { const f32x4 x = v[ai][bj][m][n]; s += (x[0] + x[1]) + (x[2] + x[3]); }
                s += __shfl_xor(s, 16); s += __shfl_xor(s, 32);
                const float mw = s * (1.0f / 64.0f); float q = 0.f;
#pragma unroll
                for (int bj = 0; bj < 2; ++bj)
#pragma unroll
                    for (int n = 0; n < 2; ++n) { const f32x4 d = v[ai][bj][m][n] - mw; q += (d[0] * d[0] + d[1] * d[1]) + (d[2] * d[2] + d[3] * d[3]); }
                q += __shfl_xor(q, 16); q += __shfl_xor(q, 32);
                if (fq == 0) P[(ai * HALF + wr * 64 + m * 16 + fr) * 4 + wc] = (f32x2v){mw, q};
            }
        asm volatile("s_waitcnt lgkmcnt(0)" ::: "memory"); __builtin_amdgcn_s_barrier(); asm volatile("" ::: "memory");
        const int row = wid * 32 + (lane & 31);
        if (lane < 32) {
            const f32x2v a = P[row * 4 + 0], b = P[row * 4 + 1], c = P[row * 4 + 2], d = P[row * 4 + 3];
            const float mt = (a.x + b.x + c.x + d.x) * 0.25f;
            const float da = a.x - mt, db = b.x - mt, dc = c.x - mt, dd = d.x - mt;
            const float m2 = (a.y + b.y) + (c.y + d.y) + 64.0f * ((da * da + db * db) + (dc * dc + dd * dd));
            unsigned long long* slot = (unsigned long long*)xbuf + ((size_t)(u.pm * BM + row) * 8 + u.pn);
            __hip_atomic_store(slot, ((unsigned long long)__float_as_uint(m2) << 32) | __float_as_uint(mt), __ATOMIC_RELAXED, __HIP_MEMORY_SCOPE_AGENT);
        }
        asm volatile("s_waitcnt vmcnt(0)" ::: "memory");
        if (lane == 0) __hip_atomic_fetch_add(cnt + 64 * u.pm, 1u, __ATOMIC_RELAXED, __HIP_MEMORY_SCOPE_AGENT);
        if (wid == 0) {
            bool dead = false; const unsigned long long t0 = __builtin_amdgcn_s_memrealtime(); const unsigned want = 64u;
            for (;;) {
                if ((unsigned)__builtin_amdgcn_readfirstlane(__hip_atomic_load(cnt + 64 * u.pm, __ATOMIC_RELAXED, __HIP_MEMORY_SCOPE_AGENT)) >= want) break;
                if (__builtin_amdgcn_s_memrealtime() - t0 > 2000000ull) { if (lane == 0) __hip_atomic_store(tmo, 1u, __ATOMIC_RELAXED, __HIP_MEMORY_SCOPE_AGENT); dead = true; break; }
                __builtin_amdgcn_s_sleep(2);
            }
            __builtin_amdgcn_fence(__ATOMIC_ACQUIRE, "agent");
            if (lane == 0) flag[0] = dead ? 1u : 0u;
        }
        asm volatile("s_waitcnt vmcnt(0) lgkmcnt(0)" ::: "memory"); __builtin_amdgcn_s_barrier(); asm volatile("" ::: "memory");
        const bool bad = flag[0] != 0u;
        if (lane < 32) {
            const unsigned long long* slot = (const unsigned long long*)xbuf + (size_t)(u.pm * BM + row) * 8; float mt[8], m2[8]; float ms = 0.f;
#pragma unroll
            for (int t = 0; t < 8; ++t) { const unsigned long long w = __hip_atomic_load(slot + t, __ATOMIC_RELAXED, __HIP_MEMORY_SCOPE_AGENT); mt[t] = __uint_as_float((unsigned)w); m2[t] = __uint_as_float((unsigned)(w >> 32)); ms += mt[t]; }
            const float mean = ms * 0.125f; float q = 0.f;
#pragma unroll
            for (int t = 0; t < 8; ++t) { const float dm = mt[t] - mean; q += m2[t] + 256.0f * dm * dm; }
            S[row] = (f32x2v){mean, 1.0f / sqrtf(q * (1.0f / 2048.0f) + eps)};
        }
        asm volatile("s_waitcnt lgkmcnt(0)" ::: "memory"); __builtin_amdgcn_s_barrier(); asm volatile("" ::: "memory");
        return bad;
    }
};
struct EpiWoLn {
    static constexpr bool PERM = false, AFTER_DRAIN = true;
    const float* xin; float* x1; bf16_t* xs; const float* g; const float* b; float alpha; PanelStats8 st;
    __device__ __forceinline__ void fused(f32x4 (&acc)[2][2][4][2], const Unit& u, int wr, int wc, int fr, int fq, PG8_LAS unsigned char* lds, int wid, int lane) const {
        typedef float f32x2v __attribute__((ext_vector_type(2))); typedef unsigned u32x2v __attribute__((ext_vector_type(2)));
        const PG8_LAS f32x2v* S = (const PG8_LAS f32x2v*)(lds + 8192);
        const int col0 = u.pn * BM + wc * 32 + 4 * fq;
#pragma unroll
        for (int ai = 0; ai < 2; ++ai)
#pragma unroll
            for (int m = 0; m < 4; ++m) { const size_t off = (size_t)(u.pm * BM + ai * HALF + wr * 64 + m * 16 + fr) * 2048 + col0;
#pragma unroll
                for (int bj = 0; bj < 2; ++bj)
#pragma unroll
                    for (int n = 0; n < 2; ++n) acc[ai][bj][m][n] += *(const f32x4*)(xin + off + bj * HALF + n * 16) * alpha;
                asm volatile("" : "+v"(acc[ai][0][m][0]), "+v"(acc[ai][0][m][1]), "+v"(acc[ai][1][m][0]), "+v"(acc[ai][1][m][1]));
            }
        const bool bad = st.run(acc, u, wr, wc, fr, fq, lds, wid, lane);
        const float qnan = __builtin_nanf("");
        f32x4 gv[2][2], bv[2][2];
#pragma unroll
        for (int bj = 0; bj < 2; ++bj)
#pragma unroll
            for (int n = 0; n < 2; ++n) { gv[bj][n] = *(const f32x4*)(g + col0 + bj * HALF + n * 16); bv[bj][n] = *(const f32x4*)(b + col0 + bj * HALF + n * 16); }
#pragma unroll
        for (int ai = 0; ai < 2; ++ai)
#pragma unroll
            for (int m = 0; m < 4; ++m) { const int r = ai * HALF + wr * 64 + m * 16 + fr; const f32x2v sr = S[r]; const size_t off = (size_t)(u.pm * BM + r) * 2048 + col0;
#pragma unroll
                for (int bj = 0; bj < 2; ++bj)
#pragma unroll
                    for (int n = 0; n < 2; ++n) { f32x4 o = (acc[ai][bj][m][n] - sr.x) * sr.y * gv[bj][n] + bv[bj][n];
                        if (bad) o = (f32x4){qnan, qnan, qnan, qnan};
                        *(f32x4*)(x1 + off + bj * HALF + n * 16) = o;
                        u32x2v w; w.x = cvt_pk_bf16(o[0], o[1]); w.y = cvt_pk_bf16(o[2], o[3]); *(u32x2v*)(xs + off + bj * HALF + n * 16) = w; } }
    }
};
template <bool WT  > struct EpiSwiglu {
    static constexpr bool PERM = true, AFTER_DRAIN = false;
    bf16_t* H; const float* roww;
    __device__ __forceinline__ void operator()(const f32x4 (&acc)[2][2][4][2], const Unit& u, int wr, int wc, int fr, int fq) const {
        const int row0 = u.pm * BM + wr * 64 + fr, col0 = (u.pn & 3) * 128 + wc * 32 + 8 * fq;
        float rw[2][4];
#pragma unroll
        for (int ai = 0; ai < 2; ++ai)
#pragma unroll
            for (int m = 0; m < 4; ++m) rw[ai][m] = roww[row0 + ai * HALF + m * 16];
#pragma unroll
        for (int ai = 0; ai < 2; ++ai)
#pragma unroll
            for (int m = 0; m < 4; ++m) { bf16_t* rowp = H + (size_t)(row0 + ai * HALF + m * 16) * 512 + col0;
                float h[8];
#pragma unroll
                for (int n = 0; n < 2; ++n)
#pragma unroll
                    for (int j = 0; j < 4; ++j) { const float g = acc[ai][0][m][n][j], up = acc[ai][1][m][n][j]; h[n * 4 + j] = g * sigmoidf_(g) * up * rw[ai][m]; }
                u32x4 w; w.x = cvt_pk_bf16(h[0], h[1]); w.y = cvt_pk_bf16(h[2], h[3]); w.z = cvt_pk_bf16(h[4], h[5]); w.w = cvt_pk_bf16(h[6], h[7]);
                if (WT) st16_sc1(rowp, w); else *(u32x4*)rowp = w; }
    }
};
struct EpiDown {
    static constexpr bool PERM = true, AFTER_DRAIN = false;
    bf16_t* Y; const float* roww;
    __device__ __forceinline__ void operator()(const f32x4 (&acc)[2][2][4][2], const Unit& u, int wr, int wc, int fr, int fq) const {
        const int row0 = u.pm * BM + wr * 64 + fr, col0 = (u.pn & 7) * 256 + wc * 32 + 8 * fq;
#pragma unroll
        for (int ai = 0; ai < 2; ++ai)
#pragma unroll
            for (int m = 0; m < 4; ++m) { const int row = row0 + ai * HALF + m * 16; bf16_t* rowp = Y + (size_t)row * 2048 + col0;
#pragma unroll
                for (int bj = 0; bj < 2; ++bj) { const f32x4 v0 = acc[ai][bj][m][0], v1 = acc[ai][bj][m][1];
                    u32x4 w; w.x = cvt_pk_bf16(v0[0], v0[1]); w.y = cvt_pk_bf16(v0[2], v0[3]); w.z = cvt_pk_bf16(v1[0], v1[1]); w.w = cvt_pk_bf16(v1[2], v1[3]);
                    *(u32x4*)(rowp + bj * HALF) = w; } }
    }
};
struct MoeOrder {
    const int* seg; int ntiles, npn, G, c;
    unsigned* cnt; unsigned* tmo; int mode;
    __device__ __forceinline__ bool next(int i, Unit& u) const {
        const long L = (long)i * G + c; if (L >= (long)ntiles * npn) return false;
        const int pm = (int)(L / npn), pl = (int)(L % npn); u.pm = pm; u.pn = __builtin_amdgcn_readfirstlane(__hip_atomic_load(seg + pm, __ATOMIC_RELAXED, __HIP_MEMORY_SCOPE_AGENT)) * npn + pl; return true;
    }
    __device__ __forceinline__ void a_ready(const Unit& u) const {
        if (mode != 2) return;
        if (threadIdx.x < 64) {
            const unsigned long long t0 = __builtin_amdgcn_s_memrealtime(); unsigned polls = 0;
            while ((unsigned)__builtin_amdgcn_readfirstlane(__hip_atomic_load(cnt + 64 * u.pm, __ATOMIC_RELAXED, __HIP_MEMORY_SCOPE_AGENT)) < 32u) {
                if ((++polls & 255u) == 0u && __builtin_amdgcn_readfirstlane(__hip_atomic_load(tmo, __ATOMIC_RELAXED, __HIP_MEMORY_SCOPE_AGENT)) != 0u) break;
                if (__builtin_amdgcn_s_memrealtime() - t0 > 2000000ull) { if (threadIdx.x == 0) __hip_atomic_store(tmo, 1u, __ATOMIC_RELAXED, __HIP_MEMORY_SCOPE_AGENT); break; }
                __builtin_amdgcn_s_sleep(2); }
            __builtin_amdgcn_fence(__ATOMIC_ACQUIRE, "agent");
            asm volatile("s_waitcnt vmcnt(0)" ::: "memory");
        }
        asm volatile("" ::: "memory"); __builtin_amdgcn_s_barrier(); asm volatile("" ::: "memory");
    }
    __device__ __forceinline__ void done(const Unit& u) const {
        if (mode != 1) return;
        asm volatile("s_waitcnt vmcnt(0)" ::: "memory");
#ifdef HANDOFF_FENCE
        __builtin_amdgcn_fence(__ATOMIC_RELEASE, "agent"); asm volatile("s_waitcnt vmcnt(0)" ::: "memory");
#endif
        if ((threadIdx.x & 63) == 0) __hip_atomic_fetch_add(cnt + 64 * u.pm, 1u, __ATOMIC_RELAXED, __HIP_MEMORY_SCOPE_AGENT);
    }
};
template <class Epi, class Sched, bool ALIGN_EPI = false, bool SP2 = false>
__device__ __forceinline__ void gemm_phase(PG8_LAS unsigned char* lds, const Gemm g, const Sched& S, const Epi& E) {
    const int tid = otid(), wid = __builtin_amdgcn_readfirstlane(tid >> 6), lane = tid & 63, wr = wid >> 2, wc = wid & 3, fr = lane & 15, fq = lane >> 4;
    const int K = g.K, nt = K / BK;
    unsigned voffA[2], voffB[2];
#pragma unroll
    for (int i = 0; i < 2; ++i) { int R, C; stage_rc(tid * 16 + i * 8192, R, C); const int Rb = Epi::PERM ? ((R & ~31) + perm32(R & 31)) : R;
        voffA[i] = (unsigned)(R * K + C) * 2u; voffB[i] = (unsigned)(Rb * BK + C) * 2u; }
    const size_t kstep = (size_t)(BK * 2);
    const size_t hstep = (size_t)HALF * K * 2;
    const size_t tstep = 2 * hstep;
    const size_t kstepB = (size_t)g.N * (BK * 2), hstepB = (size_t)HALF * BK * 2, tstepB = 2 * hstepB;
    const unsigned ldsw = (unsigned)wid * 1024u;
    const int aoff = lds_byte(wr * 64 + fr, fq * 8), boff = lds_byte(wc * 32 + fr, fq * 8);
#define PG8_SA(b, h) (((b) * 2 + (h)) * HTB)
#define PG8_SB(b, h) ((4 + (b) * 2 + (h)) * HTB)
#define PG8_STAGE(bufoff, gbase, voff) do { _Pragma("unroll") for (int _i = 0; _i < 2; ++_i) \
        __builtin_amdgcn_global_load_lds((const unsigned*)((const char*)(gbase) + (voff)[_i]), (PG8_LAS unsigned*)(lds + (bufoff) + ldsw + _i * 8192), 16, 0, 0); } while (0)
#define PG8_LDA(dst, b, h) do { _Pragma("unroll") for (int m = 0; m < 4; ++m) _Pragma("unroll") for (int k = 0; k < 2; ++k) dst[m][k] = *(const PG8_LAS bf16x8*)(lds + PG8_SA(b, h) + aoff + m * 2048 + k * 1024); } while (0)
#define PG8_LDB(dst, b, h) do { _Pragma("unroll") for (int n = 0; n < 2; ++n) _Pragma("unroll") for (int k = 0; k < 2; ++k) dst[n][k] = *(const PG8_LAS bf16x8*)(lds + PG8_SB(b, h) + boff + n * 2048 + k * 1024); } while (0)
#define PG8_MMA(ai, bj, At, Bt) do { __builtin_amdgcn_s_setprio(1); _Pragma("unroll") for (int m = 0; m < 4; ++m) _Pragma("unroll") for (int n = 0; n < 2; ++n) _Pragma("unroll") for (int k = 0; k < 2; ++k) \
        acc[ai][bj][m][n] = __builtin_amdgcn_mfma_f32_16x16x32_bf16(Bt[n][k], At[m][k], acc[ai][bj][m][n], 0, 0, 0); __builtin_amdgcn_s_setprio(0); } while (0)
#define PG8_WAIT_V(n) asm volatile("s_waitcnt vmcnt(" #n ")" ::: "memory")
#define PG8_WAIT_L(n) asm volatile("s_waitcnt lgkmcnt(" #n ")" ::: "memory")
#define PG8_BAR __builtin_amdgcn_s_barrier()
#define PG8_SCHED __builtin_amdgcn_sched_barrier(0)
    Unit cur, nxt; int ui = 0;
    if (!S.next(0, cur)) return;
    f32x4 acc[2][2][4][2];
#pragma unroll
    for (int a = 0; a < 2; ++a)
#pragma unroll
        for (int b = 0; b < 2; ++b)
#pragma unroll
            for (int m = 0; m < 4; ++m)
#pragma unroll
                for (int n = 0; n < 2; ++n) acc[a][b][m][n] = (f32x4){0.f, 0.f, 0.f, 0.f};
    bf16x8 At[4][2], B0[2][2], B1[2][2];
    const char* cA = (const char*)g.A + (size_t)cur.pm * tstep; const char* cB = (const char*)g.Bt + (size_t)cur.pn * tstepB;
    S.a_ready(cur);
    if constexpr (SP2) {
        PG8_STAGE(PG8_SB(0, 0), cB, voffB); PG8_STAGE(PG8_SB(0, 1), cB + hstepB, voffB); PG8_STAGE(PG8_SA(0, 0), cA, voffA); PG8_STAGE(PG8_SA(0, 1), cA + hstep, voffA);
        if (wr == 1) PG8_BAR;
        PG8_WAIT_V(2); PG8_BAR;
        PG8_STAGE(PG8_SB(1, 0), cB + kstepB, voffB); PG8_STAGE(PG8_SA(1, 0), cA + kstep, voffA); PG8_STAGE(PG8_SB(1, 1), cB + hstepB + kstepB, voffB);
        PG8_WAIT_V(6); PG8_BAR;
    } else {
        PG8_STAGE(PG8_SB(0, 0), cB, voffB); PG8_STAGE(PG8_SA(0, 0), cA, voffA); PG8_STAGE(PG8_SB(0, 1), cB + hstepB, voffB); PG8_STAGE(PG8_SA(0, 1), cA + hstep, voffA);
        if (wr == 1) PG8_BAR;
        PG8_WAIT_V(4); PG8_BAR;
        PG8_STAGE(PG8_SB(1, 0), cB + kstepB, voffB); PG8_STAGE(PG8_SA(1, 0), cA + kstep, voffA); PG8_STAGE(PG8_SB(1, 1), cB + hstepB + kstepB, voffB);
        PG8_WAIT_V(6); PG8_BAR;
    }
    for (;;) {
        const bool has_next = S.next(ui + 1, nxt);
        const char* nA = has_next ? (const char*)g.A + (size_t)nxt.pm * tstep : cA; const char* nB = has_next ? (const char*)g.Bt + (size_t)nxt.pn * tstepB : cB;
        for (int t = 0; t < nt; t += 2) {
            const bool last = (t == nt - 2);
            const char* a1 = cA + (size_t)(t + 1) * kstep;
            const char* a2 = last ? nA : cA + (size_t)(t + 2) * kstep; const char* b2 = last ? nB : cB + (size_t)(t + 2) * kstepB;
            const char* a3 = a2 + kstep; const char* b3 = b2 + kstepB;
            if (last && has_next) S.a_ready(nxt);
            if constexpr (SP2) {
            PG8_LDB(B0, 0, 0); PG8_LDB(B1, 0, 1); PG8_SCHED; PG8_LDA(At, 0, 0); PG8_STAGE(PG8_SA(1, 1), a1 + hstep, voffA);
            PG8_WAIT_V(8); PG8_WAIT_L(0); PG8_BAR; PG8_MMA(0, 0, At, B0); PG8_MMA(0, 1, At, B1); PG8_BAR; PG8_SCHED;
            PG8_LDA(At, 0, 1); PG8_STAGE(PG8_SB(0, 0), b2, voffB); PG8_STAGE(PG8_SB(0, 1), b2 + hstepB, voffB); PG8_STAGE(PG8_SA(0, 0), a2, voffA);
            PG8_WAIT_V(8); PG8_WAIT_L(0); PG8_BAR; PG8_MMA(1, 0, At, B0); PG8_MMA(1, 1, At, B1); PG8_BAR; PG8_SCHED;
            PG8_LDB(B0, 1, 0); PG8_LDB(B1, 1, 1); PG8_SCHED; PG8_LDA(At, 1, 0); PG8_STAGE(PG8_SA(0, 1), a2 + hstep, voffA);
            PG8_WAIT_V(8); PG8_WAIT_L(0); PG8_BAR; PG8_MMA(0, 0, At, B0); PG8_MMA(0, 1, At, B1); PG8_BAR; PG8_SCHED;
            PG8_LDA(At, 1, 1); PG8_STAGE(PG8_SB(1, 0), b3, voffB); PG8_STAGE(PG8_SB(1, 1), b3 + hstepB, voffB); PG8_STAGE(PG8_SA(1, 0), a3, voffA);
            PG8_WAIT_V(8); PG8_WAIT_L(0); PG8_BAR; PG8_MMA(1, 0, At, B0); PG8_MMA(1, 1, At, B1); PG8_BAR; PG8_SCHED;
            } else {
            PG8_LDB(B0, 0, 0); PG8_SCHED; PG8_LDA(At, 0, 0); PG8_STAGE(PG8_SA(1, 1), a1 + hstep, voffA);
            PG8_WAIT_L(8); PG8_BAR; PG8_WAIT_L(0); PG8_MMA(0, 0, At, B0); PG8_BAR; PG8_SCHED;
            PG8_LDB(B1, 0, 1); PG8_STAGE(PG8_SB(0, 0), b2, voffB);
            PG8_BAR; PG8_WAIT_L(0); PG8_MMA(0, 1, At, B1); PG8_BAR;
            PG8_LDA(At, 0, 1); PG8_STAGE(PG8_SA(0, 0), a2, voffA);
            PG8_BAR; PG8_WAIT_L(0); PG8_MMA(1, 0, At, B0); PG8_BAR; PG8_SCHED;
            PG8_STAGE(PG8_SB(0, 1), b2 + hstepB, voffB);
            PG8_WAIT_V(6); PG8_BAR; PG8_MMA(1, 1, At, B1); PG8_BAR;
            PG8_LDB(B0, 1, 0); PG8_SCHED; PG8_LDA(At, 1, 0); PG8_STAGE(PG8_SA(0, 1), a2 + hstep, voffA);
            PG8_WAIT_L(8); PG8_BAR; PG8_WAIT_L(0); PG8_MMA(0, 0, At, B0); PG8_BAR; PG8_SCHED;
            PG8_LDB(B1, 1, 1); PG8_STAGE(PG8_SB(1, 0), b3, voffB);
            PG8_BAR; PG8_WAIT_L(0); PG8_MMA(0, 1, At, B1); PG8_BAR;
            PG8_LDA(At, 1, 1); PG8_STAGE(PG8_SA(1, 0), a3, voffA);
            PG8_BAR; PG8_WAIT_L(0); PG8_MMA(1, 0, At, B0); PG8_BAR; PG8_SCHED;
            PG8_STAGE(PG8_SB(1, 1), b3 + hstepB, voffB);
            PG8_WAIT_V(6); PG8_BAR; PG8_MMA(1, 1, At, B1); PG8_BAR;
            }
        }
        if constexpr (ALIGN_EPI) { if (wr == 0) PG8_BAR; }
        if constexpr (!Epi::AFTER_DRAIN) { E(acc, cur, wr, wc, fr, fq); S.done(cur); }
        if (!has_next) break;
#pragma unroll
        for (int a = 0; a < 2; ++a)
#pragma unroll
            for (int b = 0; b < 2; ++b)
#pragma unroll
                for (int m = 0; m < 4; ++m)
#pragma unroll
                    for (int n = 0; n < 2; ++n) acc[a][b][m][n] = (f32x4){0.f, 0.f, 0.f, 0.f};
        cur = nxt; cA = nA; cB = nB; ++ui;
        if constexpr (ALIGN_EPI) { if (wr == 1) PG8_BAR; }
    }
    PG8_WAIT_V(0);
    if constexpr (!ALIGN_EPI) { if (wr == 0) PG8_BAR; }
    PG8_BAR;
    if constexpr (Epi::AFTER_DRAIN) { E.fused(acc, cur, wr, wc, fr, fq, lds, wid, lane); S.done(cur); }
#undef PG8_SA
#undef PG8_SB
#undef PG8_STAGE
#undef PG8_LDA
#undef PG8_LDB
#undef PG8_MMA
#undef PG8_WAIT_V
#undef PG8_WAIT_L
#undef PG8_BAR
#undef PG8_SCHED
}

template <class Epi, class Sched, bool ALIGN_EPI = false, bool SP2 = true>
__device__ __forceinline__ void gemm_phase_gather(PG8_LAS unsigned char* lds, const Gemm g, const Sched& S, const Epi& E, const int* rowtab) {
    static_assert(SP2, "gather variant: SP2 loop only");
    const int tid = otid(), wid = __builtin_amdgcn_readfirstlane(tid >> 6), lane = tid & 63, wr = wid >> 2, wc = wid & 3, fr = lane & 15, fq = lane >> 4;
    const int K = g.K, nt = K / BK;
    unsigned voffA[2], voffB[2]; int RA[2]; unsigned CA[2];
#pragma unroll
    for (int i = 0; i < 2; ++i) { int R, C; stage_rc(tid * 16 + i * 8192, R, C); const int Rb = Epi::PERM ? ((R & ~31) + perm32(R & 31)) : R;
        voffA[i] = (unsigned)(R * K + C) * 2u; voffB[i] = (unsigned)(Rb * BK + C) * 2u; RA[i] = R; CA[i] = (unsigned)C * 2u; }
    unsigned gA[4], gN[4];
#define PG8_GLOAD(G, pm_) do { _Pragma("unroll") for (int h_ = 0; h_ < 2; ++h_) _Pragma("unroll") for (int i_ = 0; i_ < 2; ++i_) \
        G[2 * h_ + i_] = (unsigned)rowtab[(pm_) * BM + h_ * HALF + RA[i_]] * (unsigned)(K * 2) + CA[i_]; } while (0)
#define PG8_STAGEG(bufoff, gbase, G, h_) do { _Pragma("unroll") for (int _i = 0; _i < 2; ++_i) \
        __builtin_amdgcn_global_load_lds((const unsigned*)((const char*)(gbase) + G[2 * (h_) + _i]), (PG8_LAS unsigned*)(lds + (bufoff) + ldsw + _i * 8192), 16, 0, 0); } while (0)
    const size_t kstep = (size_t)(BK * 2);
    const size_t hstep = (size_t)HALF * K * 2;
    const size_t tstep = 2 * hstep;
    const size_t kstepB = (size_t)g.N * (BK * 2), hstepB = (size_t)HALF * BK * 2, tstepB = 2 * hstepB;
    const unsigned ldsw = (unsigned)wid * 1024u;
    const int aoff = lds_byte(wr * 64 + fr, fq * 8), boff = lds_byte(wc * 32 + fr, fq * 8);
#define PG8_SA(b, h) (((b) * 2 + (h)) * HTB)
#define PG8_SB(b, h) ((4 + (b) * 2 + (h)) * HTB)
#define PG8_STAGE(bufoff, gbase, voff) do { _Pragma("unroll") for (int _i = 0; _i < 2; ++_i) \
        __builtin_amdgcn_global_load_lds((const unsigned*)((const char*)(gbase) + (voff)[_i]), (PG8_LAS unsigned*)(lds + (bufoff) + ldsw + _i * 8192), 16, 0, 0); } while (0)
#define PG8_LDA(dst, b, h) do { _Pragma("unroll") for (int m = 0; m < 4; ++m) _Pragma("unroll") for (int k = 0; k < 2; ++k) dst[m][k] = *(const PG8_LAS bf16x8*)(lds + PG8_SA(b, h) + aoff + m * 2048 + k * 1024); } while (0)
#define PG8_LDB(dst, b, h) do { _Pragma("unroll") for (int n = 0; n < 2; ++n) _Pragma("unroll") for (int k = 0; k < 2; ++k) dst[n][k] = *(const PG8_LAS bf16x8*)(lds + PG8_SB(b, h) + boff + n * 2048 + k * 1024); } while (0)
#define PG8_MMA(ai, bj, At, Bt) do { __builtin_amdgcn_s_setprio(1); _Pragma("unroll") for (int m = 0; m < 4; ++m) _Pragma("unroll") for (int n = 0; n < 2; ++n) _Pragma("unroll") for (int k = 0; k < 2; ++k) \
        acc[ai][bj][m][n] = __builtin_amdgcn_mfma_f32_16x16x32_bf16(Bt[n][k], At[m][k], acc[ai][bj][m][n], 0, 0, 0); __builtin_amdgcn_s_setprio(0); } while (0)
#define PG8_WAIT_V(n) asm volatile("s_waitcnt vmcnt(" #n ")" ::: "memory")
#define PG8_WAIT_L(n) asm volatile("s_waitcnt lgkmcnt(" #n ")" ::: "memory")
#define PG8_BAR __builtin_amdgcn_s_barrier()
#define PG8_SCHED __builtin_amdgcn_sched_barrier(0)
    Unit cur, nxt; int ui = 0;
    if (!S.next(0, cur)) return;
    f32x4 acc[2][2][4][2];
#pragma unroll
    for (int a = 0; a < 2; ++a)
#pragma unroll
        for (int b = 0; b < 2; ++b)
#pragma unroll
            for (int m = 0; m < 4; ++m)
#pragma unroll
                for (int n = 0; n < 2; ++n) acc[a][b][m][n] = (f32x4){0.f, 0.f, 0.f, 0.f};
    bf16x8 At[4][2], B0[2][2], B1[2][2];
    const char* A0 = (const char*)g.A; const char* cB = (const char*)g.Bt + (size_t)cur.pn * tstepB;
    PG8_GLOAD(gA, cur.pm);
    S.a_ready(cur);
    if constexpr (SP2) {
        PG8_STAGE(PG8_SB(0, 0), cB, voffB); PG8_STAGE(PG8_SB(0, 1), cB + hstepB, voffB); PG8_STAGEG(PG8_SA(0, 0), A0, gA, 0); PG8_STAGEG(PG8_SA(0, 1), A0, gA, 1);
        if (wr == 1) PG8_BAR;
        PG8_WAIT_V(2); PG8_BAR;
        PG8_STAGE(PG8_SB(1, 0), cB + kstepB, voffB); PG8_STAGEG(PG8_SA(1, 0), A0 + kstep, gA, 0); PG8_STAGE(PG8_SB(1, 1), cB + hstepB + kstepB, voffB);
        PG8_WAIT_V(6); PG8_BAR;
    } else {
        ;
    }
    for (;;) {
        const bool has_next = S.next(ui + 1, nxt);
        const char* nB = has_next ? (const char*)g.Bt + (size_t)nxt.pn * tstepB : cB;
        if (has_next) PG8_GLOAD(gN, nxt.pm); else { gN[0] = gA[0]; gN[1] = gA[1]; gN[2] = gA[2]; gN[3] = gA[3]; }
        for (int t = 0; t < nt; t += 2) {
            const bool last = (t == nt - 2);
            const char* a1 = A0 + (size_t)(t + 1) * kstep;
            const char* a2 = last ? A0 : A0 + (size_t)(t + 2) * kstep; const char* b2 = last ? nB : cB + (size_t)(t + 2) * kstepB;
            unsigned gs[4] = {gA[0], gA[1], gA[2], gA[3]};
            if (last) { gs[0] = gN[0]; gs[1] = gN[1]; gs[2] = gN[2]; gs[3] = gN[3]; }
            const char* a3 = a2 + kstep; const char* b3 = b2 + kstepB;
            if (last && has_next) S.a_ready(nxt);
            if constexpr (SP2) {
            PG8_LDB(B0, 0, 0); PG8_LDB(B1, 0, 1); PG8_SCHED; PG8_LDA(At, 0, 0); PG8_STAGEG(PG8_SA(1, 1), a1, gA, 1);
            PG8_WAIT_V(8); PG8_WAIT_L(0); PG8_BAR; PG8_MMA(0, 0, At, B0); PG8_MMA(0, 1, At, B1); PG8_BAR; PG8_SCHED;
            PG8_LDA(At, 0, 1); PG8_STAGE(PG8_SB(0, 0), b2, voffB); PG8_STAGE(PG8_SB(0, 1), b2 + hstepB, voffB); PG8_STAGEG(PG8_SA(0, 0), a2, gs, 0);
            PG8_WAIT_V(8); PG8_WAIT_L(0); PG8_BAR; PG8_MMA(1, 0, At, B0); PG8_MMA(1, 1, At, B1); PG8_BAR; PG8_SCHED;
            PG8_LDB(B0, 1, 0); PG8_LDB(B1, 1, 1); PG8_SCHED; PG8_LDA(At, 1, 0); PG8_STAGEG(PG8_SA(0, 1), a2, gs, 1);
            PG8_WAIT_V(8); PG8_WAIT_L(0); PG8_BAR; PG8_MMA(0, 0, At, B0); PG8_MMA(0, 1, At, B1); PG8_BAR; PG8_SCHED;
            PG8_LDA(At, 1, 1); PG8_STAGE(PG8_SB(1, 0), b3, voffB); PG8_STAGE(PG8_SB(1, 1), b3 + hstepB, voffB); PG8_STAGEG(PG8_SA(1, 0), a3, gs, 0);
            PG8_WAIT_V(8); PG8_WAIT_L(0); PG8_BAR; PG8_MMA(1, 0, At, B0); PG8_MMA(1, 1, At, B1); PG8_BAR; PG8_SCHED;
            }
        }
        if constexpr (ALIGN_EPI) { if (wr == 0) PG8_BAR; }
        if constexpr (!Epi::AFTER_DRAIN) { E(acc, cur, wr, wc, fr, fq); S.done(cur); }
        if (!has_next) break;
#pragma unroll
        for (int a = 0; a < 2; ++a)
#pragma unroll
            for (int b = 0; b < 2; ++b)
#pragma unroll
                for (int m = 0; m < 4; ++m)
#pragma unroll
                    for (int n = 0; n < 2; ++n) acc[a][b][m][n] = (f32x4){0.f, 0.f, 0.f, 0.f};
        cur = nxt; cB = nB; ++ui; gA[0] = gN[0]; gA[1] = gN[1]; gA[2] = gN[2]; gA[3] = gN[3];
        if constexpr (ALIGN_EPI) { if (wr == 1) PG8_BAR; }
    }
    PG8_WAIT_V(0);
    if constexpr (!ALIGN_EPI) { if (wr == 0) PG8_BAR; }
    PG8_BAR;
    if constexpr (Epi::AFTER_DRAIN) { E.fused(acc, cur, wr, wc, fr, fq, lds, wid, lane); S.done(cur); }
#undef PG8_SA
#undef PG8_SB
#undef PG8_STAGE
#undef PG8_STAGEG
#undef PG8_GLOAD
#undef PG8_LDA
#undef PG8_LDB
#undef PG8_MMA
#undef PG8_WAIT_V
#undef PG8_WAIT_L
#undef PG8_BAR
#undef PG8_SCHED
}
}

constexpr int NTOK = 8192, SEQ = 4096, DM = 2048, NLAYER = 2;
constexpr int IN_COLS = 15808, INP = 15872;
constexpr int NSEG = 65;
constexpr int XS_ROWS = 8192 + 65536 + 64 * 256;
constexpr int NPHASE = 16;
constexpr float LN_EPS = 1e-5f, GN_EPS = 64e-5f, ALPHA = 1.4142135623730951f  , ROUTED_SCALE = 2.5f;

constexpr size_t MiB = 1u << 20, KiB = 1u << 10;
constexpr size_t WS_CTL = 0, CTL_ZERO_BYTES = 512 * KiB;
constexpr size_t WS_HIST = 1 * MiB;
constexpr size_t WS_SELE = WS_HIST + 64 * KiB;
constexpr size_t WS_SELW = WS_SELE + 256 * KiB;
constexpr size_t WS_SLOT = WS_SELW + 256 * KiB;
constexpr size_t WS_ROWW = WS_SLOT + 256 * KiB;
constexpr size_t WS_TSEG = WS_ROWW + 352 * KiB;
constexpr size_t WS_BON = WS_TSEG + 4 * KiB;
constexpr size_t WS_ROWT = WS_BON + 576 * KiB;
constexpr size_t WS_XT = WS_ROWT + 352 * KiB;
constexpr size_t WS_LNX = WS_XT + 16 * KiB;
constexpr size_t WS_WIN = 4 * MiB;
constexpr size_t WS_WLORA = 66 * MiB;
constexpr size_t WS_WBR = 69 * MiB;
constexpr size_t WS_WO = 81 * MiB;
constexpr size_t WS_WGU = 89 * MiB;
constexpr size_t WS_WD = 349 * MiB;
constexpr size_t WS_XB = 479 * MiB;
constexpr size_t WS_MERGED = 511 * MiB;
constexpr size_t WS_PRELN = 543 * MiB;
constexpr size_t WS_X1 = 607 * MiB;
constexpr size_t WS_X2 = 671 * MiB;
constexpr size_t WS_M = 735 * MiB;
constexpr size_t WS_PCONV = WS_M, WS_PQKV = WS_M + 48 * MiB, WS_PRKV = WS_M + 96 * MiB, WS_PLORA = WS_M + 144 * MiB, WS_PGATE = WS_M + 152 * MiB;
constexpr size_t WS_YBR = WS_M + 248 * MiB;
constexpr size_t WS_LORAA = WS_M + 760 * MiB;
constexpr size_t WS_RWR = WS_M + 304 * MiB, WS_RWW = WS_RWR + 32 * MiB, WS_RWK = WS_RWW + 32 * MiB, WS_RWV = WS_RWK + 32 * MiB, WS_RWKK = WS_RWV + 32 * MiB,
                 WS_RWB = WS_RWKK + 32 * MiB, WS_RWA = WS_RWB + 32 * MiB, WS_RWG = WS_RWA + 32 * MiB, WS_RWY = WS_RWG + 32 * MiB;
constexpr size_t WS_XS = WS_M;
constexpr size_t WS_H = WS_XS + 352 * MiB;
constexpr size_t WS_YS = WS_H + 88 * MiB;
constexpr size_t WS_END = WS_YS + 352 * MiB;
static_assert(WS_RWY + 32 * MiB <= WS_END && (size_t)XS_ROWS * 2048 * 2 == 352 * MiB && (size_t)XS_ROWS * 512 * 2 == 88 * MiB, "ws map");
static_assert(WS_LNX + 512 * KiB <= WS_WIN && WS_WIN + (size_t)INP * 2048 * 2 <= WS_WLORA && WS_WGU + (size_t)65 * 1024 * 2048 * 2 <= WS_WD && WS_WD + (size_t)65 * 2048 * 512 * 2 <= WS_XB, "ws map 2");
constexpr int CW_TMO = 0, CW_BAR = 4096, CW_LNC = 16384, CW_HC = 32768;

constexpr int RING_OFF = 0, RING_BYTES = 131072;
constexpr int LDS_BYTES = 147456;
constexpr int LDSCTL_OFF = LDS_BYTES - 1024, MISC_OFF = LDSCTL_OFF + 320;
constexpr int NWAVES = 8;

#define GAS __attribute__((address_space(1)))
#define LAS __attribute__((address_space(3)))
typedef unsigned short bf16;
typedef unsigned v4u __attribute__((ext_vector_type(4)));
typedef unsigned v2u __attribute__((ext_vector_type(2)));
typedef float f32x4 __attribute__((ext_vector_type(4)));
typedef float f32x16 __attribute__((ext_vector_type(16)));
typedef short bf16x8 __attribute__((ext_vector_type(8)));
typedef short s16x4 __attribute__((ext_vector_type(4)));
typedef GAS unsigned gu32;
#define RLX_AGENT __ATOMIC_RELAXED, __HIP_MEMORY_SCOPE_AGENT
#define LDS_WAIT() asm volatile("s_waitcnt lgkmcnt(0)" ::: "memory")
#define VM_WAIT() asm volatile("s_waitcnt vmcnt(0)" ::: "memory")
__device__ __forceinline__ unsigned f2bf(float f) { unsigned u = __builtin_bit_cast(unsigned, f); return (u + 0x7fffu + ((u >> 16) & 1u)) >> 16; }
__device__ __forceinline__ unsigned pk2(float lo, float hi) { return f2bf(lo) | (f2bf(hi) << 16); }
__device__ __forceinline__ float bf2f(bf16 b) { return __uint_as_float((unsigned)b << 16); }
__device__ __forceinline__ float blo(unsigned w) { return __uint_as_float(w << 16); }
__device__ __forceinline__ float bhi(unsigned w) { return __uint_as_float(w & 0xffff0000u); }
__device__ __forceinline__ int ld_i32(const int* p) { return __hip_atomic_load(p, RLX_AGENT); }
__device__ __forceinline__ float ld_f32(const float* p) { return __hip_atomic_load(p, RLX_AGENT); }

#define XB_TMO      128
#define XB_XCNT(j)  (256  + 64 * (j))
#define XB_XSUB(j)  (1280 + 64 * (j))
#define XB_XGEN(j)  (2304 + 64 * (j))
#define XB_TOP      3328
#define XB_TOPGEN   3392
#define XCD_BAR_WORDS 3456
#define XB_SPIN_CAP (1u << 18)

__device__ __forceinline__ unsigned xb_ld(unsigned* p)              { return __hip_atomic_load(p, __ATOMIC_RELAXED, __HIP_MEMORY_SCOPE_AGENT); }
__device__ __forceinline__ unsigned xb_add(unsigned* p, unsigned v) { return __hip_atomic_fetch_add(p, v, __ATOMIC_RELAXED, __HIP_MEMORY_SCOPE_AGENT); }
__device__ __forceinline__ unsigned xb_xcc_id() { return (unsigned)__builtin_amdgcn_s_getreg((3 << 11) | 20) & 0xFu; }
#define XB_SPIN(cond, bar) do { unsigned _sp = 0; while (cond) { __builtin_amdgcn_s_sleep(1); \
    if ((++_sp & 255u) == 0u) { if (xb_ld(&(bar)[XB_TMO])) break; if (_sp > XB_SPIN_CAP) { atomicAdd(&(bar)[XB_TMO], 1u); break; } } } } while (0)

struct XcdBarrier {
    unsigned* bar; unsigned x;
    volatile LAS unsigned* st;
};

__device__ __forceinline__ XcdBarrier xcd_barrier_post(unsigned* bar, volatile LAS unsigned* st) {
    XcdBarrier b; b.bar = bar; b.x = xb_xcc_id(); b.st = st;
    if (threadIdx.x == 0) (void)xb_add(&bar[XB_XCNT(b.x)], 1u);
    return b;
}
__device__ __forceinline__ void xcd_barrier_complete(unsigned* bar, unsigned x, unsigned& nloc, unsigned& nx) {
    const unsigned G = gridDim.x * gridDim.y * gridDim.z;
    unsigned sum, cnt, mine, sp = 0u;
    for (;;) {
        sum = 0u; cnt = 0u; mine = 0u;
#pragma unroll
        for (unsigned j = 0; j < 16; ++j) { const unsigned c = xb_ld(&bar[XB_XCNT(j)]); sum += c; cnt += (c > 0u) ? 1u : 0u; mine = (j == x) ? c : mine; }
        if (sum == G) break;
        __builtin_amdgcn_s_sleep(1);
        if ((++sp & 255u) == 0u) { if (xb_ld(&bar[XB_TMO])) break; if (sp > XB_SPIN_CAP) { atomicAdd(&bar[XB_TMO], 1u); break; } }
    }
    nloc = mine > 0u ? mine : 1u; nx = cnt > 0u ? cnt : 1u;
}

__device__ __forceinline__ void xcd_barrier(const XcdBarrier& b) {
    asm volatile("s_waitcnt vmcnt(0)" ::: "memory");
    __syncthreads();
    if (threadIdx.x == 0) {
        unsigned* bar = b.bar;
        __builtin_amdgcn_s_waitcnt(0);
        unsigned nloc = b.st[0], nx = b.st[1];
        if (nloc == 0u) { xcd_barrier_complete(bar, b.x, nloc, nx); b.st[0] = nloc; b.st[1] = nx; }
        const unsigned old = xb_add(&bar[XB_XSUB(b.x)], 1u);
        const unsigned gen = old / nloc;
        if (old + 1u == (gen + 1u) * nloc) {
            __builtin_amdgcn_fence(__ATOMIC_RELEASE, "agent");
            asm volatile("s_waitcnt vmcnt(0)" ::: "memory");
            const unsigned og = xb_add(&bar[XB_TOP], 1u);
            const unsigned tg = og / nx;
            if (og + 1u == (tg + 1u) * nx) xb_add(&bar[XB_TOPGEN], 1u);
            else XB_SPIN(xb_ld(&bar[XB_TOPGEN]) == tg, bar);
            __builtin_amdgcn_fence(__ATOMIC_ACQUIRE, "agent");
            xb_add(&bar[XB_XGEN(b.x)], 1u);
            asm volatile("s_waitcnt vmcnt(0)" ::: "memory");
        } else {
            XB_SPIN(xb_ld(&bar[XB_XGEN(b.x)]) == gen, bar);
            __builtin_amdgcn_fence(__ATOMIC_ACQUIRE, "agent");
            asm volatile("s_waitcnt vmcnt(0)" ::: "memory");
        }
    }
    __syncthreads();
}

struct Args { const float* in[28]; float* out; unsigned char* ws; int ph_lo, ph_hi, li, pad; };
typedef const __attribute__((address_space(4))) Args* KArgs;
struct Frame {
    LAS unsigned char* lds;
    volatile LAS unsigned* MISC;
    gu32* ctl;
    unsigned char* ws;
    int tid, lane, wave, vcu, G;
};
__device__ __forceinline__ float wave_sum(float v) {
#pragma unroll
    for (int o = 1; o < 64; o <<= 1) v += __shfl_xor(v, o);
    return v;
}
__device__ __forceinline__ float dpp16(float v) {
    v += __builtin_bit_cast(float, __builtin_amdgcn_update_dpp(0, __builtin_bit_cast(int, v), 0xB1, 0xF, 0xF, true));
    v += __builtin_bit_cast(float, __builtin_amdgcn_update_dpp(0, __builtin_bit_cast(int, v), 0x4E, 0xF, 0xF, true));
    v += __builtin_bit_cast(float, __builtin_amdgcn_update_dpp(0, __builtin_bit_cast(int, v), 0x141, 0xF, 0xF, true));
    v += __builtin_bit_cast(float, __builtin_amdgcn_update_dpp(0, __builtin_bit_cast(int, v), 0x140, 0xF, 0xF, true));
    return v;
}
__device__ __forceinline__ v4u pack8(const float* v) { v4u o; o.x = pk2(v[0], v[1]); o.y = pk2(v[2], v[3]); o.z = pk2(v[4], v[5]); o.w = pk2(v[6], v[7]); return o; }
__device__ __forceinline__ void unpack8(v4u w, float* v) { v[0] = blo(w.x); v[1] = bhi(w.x); v[2] = blo(w.y); v[3] = bhi(w.y); v[4] = blo(w.z); v[5] = bhi(w.z); v[6] = blo(w.w); v[7] = bhi(w.w); }

struct TrItem { const float* src; bf16* dst; int ldn, k0, n0, Kd; };
__device__ __forceinline__ void tr_issue(const TrItem& d, int lane, float (&hv)[32]) {
    const float* base = d.src + (size_t)d.k0 * d.ldn + d.n0;
    const unsigned off = (unsigned)(lane >> 3) * (unsigned)d.ldn + 4u * (unsigned)(lane & 7), step = 8u * (unsigned)d.ldn;
#pragma unroll
    for (int i = 0; i < 8; ++i) { const f32x4 v = __builtin_nontemporal_load((const f32x4*)(base + (off + (unsigned)i * step))); hv[4 * i] = v[0]; hv[4 * i + 1] = v[1]; hv[4 * i + 2] = v[2]; hv[4 * i + 3] = v[3]; }
}
__device__ __forceinline__ void tr_finish(const TrItem& d, int lane, const float (&hv)[32], LAS float* scr) {
    { LAS float* w = scr + (lane >> 3) * 33 + 4 * (lane & 7);
#pragma unroll
      for (int i = 0; i < 8; ++i) { w[i * 8 * 33] = hv[4 * i]; w[i * 8 * 33 + 1] = hv[4 * i + 1]; w[i * 8 * 33 + 2] = hv[4 * i + 2]; w[i * 8 * 33 + 3] = hv[4 * i + 3]; } }
    LDS_WAIT(); asm volatile("" ::: "memory");
    const int c = lane & 7;
#pragma unroll
    for (int j = 0; j < 4; ++j) { const int n = (lane >> 3) + 8 * j; const LAS float* s = scr + (8 * c) * 33 + n;
        v4u o; o.x = pg8::cvt_pk_bf16(s[0 * 33], s[1 * 33]); o.y = pg8::cvt_pk_bf16(s[2 * 33], s[3 * 33]); o.z = pg8::cvt_pk_bf16(s[4 * 33], s[5 * 33]); o.w = pg8::cvt_pk_bf16(s[6 * 33], s[7 * 33]);
        __builtin_nontemporal_store(o, (GAS v4u*)(d.dst + (size_t)n * d.Kd + 8 * c)); }
    LDS_WAIT(); asm volatile("" ::: "memory");
}
constexpr int I_IN = 32 * 494, I_BR = 3 * 16 * 64, I_WO = 32 * 64, I_G = 65 * 512, I_D = 65 * 512;
constexpr int NIT = I_IN + I_BR + I_WO + 2 * I_G + I_D;
#ifndef HN0
#define HN0 4
#define HN1 2
#define HN2 0
#define HN3 0
#define HN4 4
#define HN5 0
#define HN6 2
#endif
#ifndef P0_EXTRA
#define P0_EXTRA 0
#endif
#ifndef SEQ_ITEMS
#define SEQ_ITEMS 12544
#endif
constexpr int NIT_A = NIT - SEQ_ITEMS;
__device__ __forceinline__ TrItem decode_item(KArgs a, unsigned char* ws, int l, int it) {
    bf16* WIN = (bf16*)(ws + WS_WIN); bf16* WBR = (bf16*)(ws + WS_WBR); bf16* WO = (bf16*)(ws + WS_WO); bf16* WGU = (bf16*)(ws + WS_WGU); bf16* WD = (bf16*)(ws + WS_WD);
    int r = it; TrItem d;
    if (r < I_IN) { const int kb = r / 494, nb = r % 494, n0 = 32 * nb; d.src = a->in[1] + (size_t)l * 2048 * IN_COLS; d.ldn = IN_COLS; d.k0 = 64 * kb; d.n0 = n0; d.dst = WIN + ((size_t)kb * INP + (size_t)(n0 + (n0 >= 9408 ? 64 : 0))) * 64; d.Kd = 64; return d; }
    r -= I_IN;
    if (r < I_BR) { const int nbr = r / 1024, rr = r % 1024, kb = rr / 64, nb = rr % 64; d.src = a->in[14] + (size_t)l * 3 * 1024 * 2048 + (size_t)nbr * 1024 * 2048; d.ldn = 2048; d.k0 = 64 * kb; d.n0 = 32 * nb;
        d.dst = WBR + ((size_t)kb * (3 * DM) + (size_t)(nbr * 2048 + 32 * nb)) * 64; d.Kd = 64; return d; }
    r -= I_BR;
    if (r < I_WO) { const int kb = r / 64, nb = r % 64; d.src = a->in[15] + (size_t)l * 2048 * 2048; d.ldn = 2048; d.k0 = 64 * kb; d.n0 = 32 * nb; d.dst = WO + ((size_t)kb * DM + (size_t)(32 * nb)) * 64; d.Kd = 64; return d; }
    r -= I_WO;
    if (r < 2 * I_G) { const int up = r >= I_G ? 1 : 0; if (up) r -= I_G; const int seg = r / 512, rr = r % 512, kb = rr / 16, nb = rr % 16, n0 = 32 * nb;
        d.src = seg == 0 ? (up ? a->in[24] : a->in[23]) + (size_t)l * 2048 * 512 : (up ? a->in[21] : a->in[20]) + (size_t)(l * 64 + seg - 1) * 2048 * 512;
        d.ldn = 512; d.k0 = 64 * kb; d.n0 = n0; d.dst = WGU + ((size_t)kb * (NSEG * 1024) + (size_t)(seg * 1024 + (n0 >> 7) * 256 + (n0 & 127) + up * 128)) * 64; d.Kd = 64; return d; }
    r -= 2 * I_G;
    { const int seg = r / 512, rr = r % 512, kb = rr / 64, nb = rr % 64;
        d.src = seg == 0 ? a->in[25] + (size_t)l * 512 * 2048 : a->in[22] + (size_t)(l * 64 + seg - 1) * 512 * 2048;
        d.ldn = 2048; d.k0 = 64 * kb; d.n0 = 32 * nb; d.dst = WD + ((size_t)kb * (NSEG * 2048) + (size_t)(seg * 2048 + 32 * nb)) * 64; d.Kd = 64; return d; }
}
__device__ __forceinline__ void convert_item(KArgs a, unsigned char* ws, int l, int it, LAS float* scr, int lane) {
    const TrItem d = decode_item(a, ws, l, it); float hv[32]; tr_issue(d, lane, hv); tr_finish(d, lane, hv, scr);
}
#ifndef P1_ITEMS
#define P1_ITEMS 8192
#endif
__device__ __forceinline__ int p1_items() { return ((int)gridDim.x == 256) ? P1_ITEMS : 0; }
__device__ __forceinline__ void convert_range(KArgs a, Frame& F, int l, int first, int last, int start, int stride) {
    LAS float* scr = (LAS float*)(F.lds + RING_OFF + F.wave * 16384);
    int it = first + start; const int nw = stride;
    float ha[32], hb[32], hc[32], hd[32]; TrItem da = {}, db = {}, dc = {}, dd = {}; bool pa = false, pb = false, pc = false, pd = false;
#define P1_ISS(hv, d, p) do { if (it < last) { d = decode_item(a, F.ws, l, it); tr_issue(d, F.lane, hv); p = true; it += nw; } } while (0)
#define P1_FIN(hv, d, p) do { if (p) { tr_finish(d, F.lane, hv, scr); p = false; } } while (0)
    P1_ISS(ha, da, pa); P1_ISS(hb, db, pb); P1_ISS(hc, dc, pc); P1_ISS(hd, dd, pd);
    while (pa || pb || pc || pd) { P1_FIN(ha, da, pa); P1_ISS(ha, da, pa); P1_FIN(hb, db, pb); P1_ISS(hb, db, pb); P1_FIN(hc, dc, pc); P1_ISS(hc, dc, pc); P1_FIN(hd, dd, pd); P1_ISS(hd, dd, pd); }
#undef P1_ISS
#undef P1_FIN
}
__device__ __forceinline__ void p1_convert(KArgs a, Frame& F, int l) {
    convert_range(a, F, l, I_IN + P0_EXTRA, I_IN + P0_EXTRA + P1_ITEMS, (pg8::obid() - 248) * NWAVES + F.wave, 8 * NWAVES);
}
#ifndef NEXT_WIN_RMAX
#define NEXT_WIN_RMAX 64
#endif
__device__ __forceinline__ bool next_win_early(const unsigned char* ws) {
    if ((int)gridDim.x != 256 || NEXT_WIN_RMAX <= 0) return false;
    const int R = (4 * __builtin_amdgcn_readfirstlane(ld_i32((const int*)(ws + WS_TSEG)))) & 255;
    return R > 0 && R <= NEXT_WIN_RMAX;
}
#ifndef SHADOW_CONVERT
#define SHADOW_CONVERT 1
#endif
__device__ __forceinline__ void ph0_convert(KArgs a, Frame& F, int l) {
    LAS float* scr = (LAS float*)(F.lds + RING_OFF + F.wave * 16384);
    const int gw = F.vcu * NWAVES + F.wave, NGW = F.G * NWAVES;
    bf16* WIN = (bf16*)(F.ws + WS_WIN); bf16* WLORA = (bf16*)(F.ws + WS_WLORA);
    const int it0 = (l > 0 && next_win_early(F.ws)) ? I_IN : 0;
    for (int it = it0 + gw; it < (SHADOW_CONVERT ? I_IN + P0_EXTRA : NIT); it += NGW) convert_item(a, F.ws, l, it, scr, F.lane);
    const size_t gt = (size_t)F.vcu * 512 + F.tid, NT = (size_t)F.G * 512;
    for (size_t i = gt; i < 64 * 2048 / 8; i += NT) { const size_t kt = i >> 9, w = i & 511; ((v4u*)(WIN + (kt * INP + 9408) * 64))[w] = (v4u){0u, 0u, 0u, 0u}; }
    { const float* w2 = a->in[5] + (size_t)l * 96 * 1024; const float* a2 = a->in[7] + (size_t)l * 96 * 1024; const float* g2 = a->in[8] + (size_t)l * 256 * 1024;
      for (size_t i = gt; i < (size_t)3072 * 256; i += NT) { const int k = (int)(i / 3072), n = (int)(i % 3072), sec = n >> 10, nn = n & 1023; float v = 0.f;
          if (sec == 0) { if (k < 96) v = w2[k * 1024 + nn]; } else if (sec == 1) { if (k < 96) v = a2[k * 1024 + nn]; } else v = g2[k * 1024 + nn];
          WLORA[((size_t)(k >> 6) * 3072 + n) * 64 + (k & 63)] = (bf16)f2bf(v); } }
    if (l == 0) { const f32x4* x = (const f32x4*)a->in[0]; v4u* xb = (v4u*)(F.ws + WS_XB);
        for (size_t i = gt; i < (size_t)NTOK * DM / 8; i += NT) { const f32x4 p = x[2 * i], q = x[2 * i + 1]; v4u o; o.x = pk2(p[0], p[1]); o.y = pk2(p[2], p[3]); o.z = pk2(q[0], q[1]); o.w = pk2(q[2], q[3]); xb[i] = o; } }
}

__device__ __forceinline__ void ph2_elementwise(KArgs a, Frame& F, int l) {
    const size_t gt = (size_t)F.vcu * 512 + F.tid, NT = (size_t)F.G * 512;
    const bf16* PC = (const bf16*)(F.ws + WS_PCONV); bf16* Y0 = (bf16*)(F.ws + WS_YBR);
    const float* cw = a->in[2] + (size_t)l * 3 * 1024;
    for (size_t i = gt; i < (size_t)NTOK * 128; i += NT) { const int t = (int)(i >> 7), c = (int)(i & 127) * 8, tt = t & (SEQ - 1);
        const bf16* row = PC + (size_t)t * 3072;
        float gb[8], g0[8], h0[8], u0[8], u1[8], u2[8];
        unpack8(*(const v4u*)(row + c), gb); unpack8(*(const v4u*)(row + 1024 + c), g0); unpack8(*(const v4u*)(row + 2048 + c), h0);
#pragma unroll
        for (int j = 0; j < 8; ++j) { u0[j] = g0[j] * h0[j]; u1[j] = 0.f; u2[j] = 0.f; }
        if (tt >= 1) { unpack8(*(const v4u*)(row - 3072 + 1024 + c), g0); unpack8(*(const v4u*)(row - 3072 + 2048 + c), h0);
#pragma unroll
            for (int j = 0; j < 8; ++j) u1[j] = g0[j] * h0[j]; }
        if (tt >= 2) { unpack8(*(const v4u*)(row - 6144 + 1024 + c), g0); unpack8(*(const v4u*)(row - 6144 + 2048 + c), h0);
#pragma unroll
            for (int j = 0; j < 8; ++j) u2[j] = g0[j] * h0[j]; }
        float y[8];
#pragma unroll
        for (int j = 0; j < 8; ++j) y[j] = gb[j] * (cw[c + j] * u2[j] + cw[1024 + c + j] * u1[j] + cw[2048 + c + j] * u0[j]);
        *(v4u*)(Y0 + (size_t)t * 1024 + c) = pack8(y); }
    const bf16* PR = (const bf16*)(F.ws + WS_PRKV); const float* mix = a->in[3] + (size_t)l * 3520;
    bf16* RWR = (bf16*)(F.ws + WS_RWR); bf16* RWK = (bf16*)(F.ws + WS_RWK); bf16* RWV = (bf16*)(F.ws + WS_RWV);
    for (size_t i = gt; i < (size_t)NTOK * 384; i += NT) { const int t = (int)(i / 384), c = (int)(i % 384) * 8, tt = t & (SEQ - 1);
        float p[8], q[8];
        unpack8(*(const v4u*)(PR + (size_t)t * 3072 + c), p);
        if (tt >= 1) unpack8(*(const v4u*)(PR + (size_t)(t - 1) * 3072 + c), q); else {
#pragma unroll
            for (int j = 0; j < 8; ++j) q[j] = 0.f; }
#pragma unroll
        for (int j = 0; j < 8; ++j) p[j] = p[j] + (q[j] - p[j]) * mix[c + j];
        bf16* dst = (c < 1024 ? RWR : (c < 2048 ? RWK : RWV)) + (size_t)t * 1024 + (c & 1023);
        *(v4u*)dst = pack8(p); }
    const bf16* PL = (const bf16*)(F.ws + WS_PLORA); bf16* LA = (bf16*)(F.ws + WS_LORAA);
    for (size_t i = gt; i < (size_t)NTOK * 96; i += NT) { const int t = (int)(i / 96), c8 = (int)(i % 96), sec = c8 >> 5, c = (c8 & 31) * 8, tt = t & (SEQ - 1);
        float p[8], q[8];
        if (sec < 2 && c >= 96) {
#pragma unroll
            for (int j = 0; j < 8; ++j) p[j] = 0.f;
        } else {
            const int sc = sec == 0 ? c : (sec == 1 ? 96 + c : 256 + c);
            unpack8(*(const v4u*)(PL + (size_t)t * 512 + sc), p);
            if (tt >= 1) unpack8(*(const v4u*)(PL + (size_t)(t - 1) * 512 + sc), q); else {
#pragma unroll
                for (int j = 0; j < 8; ++j) q[j] = 0.f; }
            const int mi = sec == 0 ? 3072 + c : (sec == 1 ? 3168 + c : 3264 + c);
#pragma unroll
            for (int j = 0; j < 8; ++j) { const float v = p[j] + (q[j] - p[j]) * mix[mi + j]; p[j] = sec == 0 ? tanhf(v) : (sec == 1 ? v : 1.0f / (1.0f + expf(-v))); }
        }
        *(v4u*)(LA + ((size_t)sec * NTOK + t) * 256 + c) = pack8(p); }
}

__device__ __forceinline__ void ph4_prep(KArgs a, Frame& F, int l) {
    const int gw = F.vcu * NWAVES + F.wave, NGW = F.G * NWAVES;
    const bf16* RWR = (const bf16*)(F.ws + WS_RWR); bf16* RWK = (bf16*)(F.ws + WS_RWK); bf16* RWKK = (bf16*)(F.ws + WS_RWKK); bf16* RWB = (bf16*)(F.ws + WS_RWB);
    const bf16* RWA = (const bf16*)(F.ws + WS_RWA); float* BON = (float*)(F.ws + WS_BON);
    const float* kkw = a->in[9] + (size_t)l * 1024; const float* kaw = a->in[10] + (size_t)l * 1024; const float* rkw = a->in[11] + (size_t)l * 1024;
    for (int task = gw; task < NTOK * 4; task += NGW) { const int t = task >> 2, hq = task & 3, c = hq * 256 + 4 * F.lane; const size_t idx = (size_t)t * 1024 + c;
        const v2u rw = *(const v2u*)(RWR + idx), kw = *(const v2u*)(RWK + idx);
        const f32x4 r = {blo(rw.x), bhi(rw.x), blo(rw.y), bhi(rw.y)}, k = {blo(kw.x), bhi(kw.x), blo(kw.y), bhi(kw.y)};
        const v2u aw = *(const v2u*)(RWA + idx); const f32x4 av = {blo(aw.x), bhi(aw.x), blo(aw.y), bhi(aw.y)};
        const f32x4 kkr = k * *(const f32x4*)(kkw + c);
        const float n2 = dpp16((kkr[0] * kkr[0] + kkr[1] * kkr[1]) + (kkr[2] * kkr[2] + kkr[3] * kkr[3]));
        const f32x4 kk = kkr * (1.0f / fmaxf(sqrtf(n2), 1e-12f));
        const f32x4 k2 = k * (1.0f + (av - 1.0f) * *(const f32x4*)(kaw + c));
        const f32x4 bb = kk * av;
        { v2u w; w.x = pk2(k2[0], k2[1]); w.y = pk2(k2[2], k2[3]); *(v2u*)(RWK + idx) = w; } { v2u w; w.x = pk2(kk[0], kk[1]); w.y = pk2(kk[2], kk[3]); *(v2u*)(RWKK + idx) = w; }
        { v2u w; w.x = pk2(bb[0], bb[1]); w.y = pk2(bb[2], bb[3]); *(v2u*)(RWB + idx) = w; }
        const f32x4 pr = r * k2 * *(const f32x4*)(rkw + c);
        const float bon = dpp16((pr[0] + pr[1]) + (pr[2] + pr[3]));
        if ((F.lane & 15) == 0) BON[t * 16 + hq * 4 + (F.lane >> 4)] = bon; }
}
__device__ __forceinline__ void ph6_rwkv_out(KArgs a, Frame& F, int l) {
    const int gw = F.vcu * NWAVES + F.wave, NGW = F.G * NWAVES;
    const float* RWY = (const float*)(F.ws + WS_RWY); const float* RWV = (const float*)(F.ws + WS_RWV); const float* RWG = (const float*)(F.ws + WS_RWG); const float* BON = (const float*)(F.ws + WS_BON);
    bf16* Y2 = (bf16*)(F.ws + WS_YBR) + (size_t)2 * NTOK * 1024;
    const float* lg = a->in[12] + (size_t)l * 1024; const float* lb = a->in[13] + (size_t)l * 1024;
    for (int task = gw; task < NTOK * 4; task += NGW) { const int t = task >> 2, hq = task & 3, c = hq * 256 + 4 * F.lane; const size_t idx = (size_t)t * 1024 + c;
        const f32x4 y = *(const f32x4*)(RWY + idx);
        const float mu = dpp16((y[0] + y[1]) + (y[2] + y[3])) * (1.0f / 64.0f); const f32x4 d = y - mu;
        const float var = dpp16((d[0] * d[0] + d[1] * d[1]) + (d[2] * d[2] + d[3] * d[3])) * (1.0f / 64.0f);
        f32x4 yn = d * rsqrtf(var + GN_EPS) * *(const f32x4*)(lg + c) + *(const f32x4*)(lb + c);
        yn += BON[t * 16 + hq * 4 + (F.lane >> 4)] * *(const f32x4*)(RWV + idx);
        yn *= *(const f32x4*)(RWG + idx);
        v2u w; w.x = pk2(yn[0], yn[1]); w.y = pk2(yn[2], yn[3]); *(v2u*)(Y2 + idx) = w; }
}

typedef float f32x2_t __attribute__((ext_vector_type(2)));
__device__ __forceinline__ void reduce2(float q, float p, float& Q, float& P) {
    const auto a = __builtin_amdgcn_permlane16_swap(__float_as_uint(q), __float_as_uint(p), false, false);
    float x = __uint_as_float(a[0]) + __uint_as_float(a[1]);
    x = dpp16(x);
    const auto b = __builtin_amdgcn_permlane16_swap(__float_as_uint(x), __float_as_uint(x), false, false);
    Q = __uint_as_float(b[0]); P = __uint_as_float(b[1]);
}
template <int MODE  > __device__ __forceinline__ void ph5_scan(KArgs a, Frame& F, int l) {
#define LDS_BAR() do { asm volatile("s_waitcnt lgkmcnt(0)" ::: "memory"); __builtin_amdgcn_s_barrier(); asm volatile("" ::: "memory"); } while (0)
    const int bx = pg8::obid();
    const int seq = bx >> 3, b = seq >> 4, h = seq & 15, i0 = (bx & 7) * 8 + F.wave * 2;
    const bool active = F.wave < 4;
    LAS float* buf = (LAS float*)(F.lds + RING_OFF);
    constexpr int BSZ = 6 * 32 * 64, ASZ = 32 * 64, NBLK = SEQ / 32;
    const float* A0 = (const float*)(F.ws + WS_RWKK) + 1024; const float* A1 = (const float*)(F.ws + WS_RWB); const float* A2 = (const float*)(F.ws + WS_RWW);
    const float* A3 = (const float*)(F.ws + WS_RWK); const float* A4 = (const float*)(F.ws + WS_RWR); const float* A5 = (const float*)(F.ws + WS_RWV);
    float* RWY = (float*)(F.ws + (MODE == 0 ? WS_RWY : WS_M + 600 * MiB));
    const size_t tok0 = (size_t)b * SEQ; const int col0 = h * 64;
    const int st = F.tid >> 4, sq = F.tid & 15;
    const size_t soff = (tok0 + st) * 1024 + col0 + sq * 4;
    const int loff = st * 64 + sq * 4;
    const int rl = F.lane >> 5, jq = F.lane & 31, irow = i0 + rl;
    float S0 = 0.f, S1 = 0.f, yreg = 0.f, sa = 0.f;
#define SC_LOAD(R, blk_) do { if (MODE == 1) break; const size_t o_ = soff + (size_t)(blk_) * 32 * 1024; R##0 = *(const f32x4*)(A0 + o_); R##1 = *(const f32x4*)(A1 + o_); R##2 = *(const f32x4*)(A2 + o_); \
        R##3 = *(const f32x4*)(A3 + o_); R##4 = *(const f32x4*)(A4 + o_); R##5 = *(const f32x4*)(A5 + o_); } while (0)
#define SC_WRITE(R, bufi) do { if (MODE == 1) break; LAS float* nb_ = buf + (bufi) * BSZ; *(LAS f32x4*)(nb_ + 0 * ASZ + loff) = R##0; *(LAS f32x4*)(nb_ + 1 * ASZ + loff) = R##1; *(LAS f32x4*)(nb_ + 2 * ASZ + loff) = R##2; \
        *(LAS f32x4*)(nb_ + 3 * ASZ + loff) = R##3; *(LAS f32x4*)(nb_ + 4 * ASZ + loff) = R##4; *(LAS f32x4*)(nb_ + 5 * ASZ + loff) = R##5; } while (0)
#define SC_COMPUTE(bufi, blk_) do { if (active) { const LAS float* bb = buf + (bufi) * BSZ; \
        _Pragma("unroll 4") for (int tl = 0; tl < 32; ++tl) { const LAS float* base = bb + tl * 64; \
            const f32x2_t b2 = *(const LAS f32x2_t*)(base + 1 * ASZ + 2 * jq), w2 = *(const LAS f32x2_t*)(base + 2 * ASZ + 2 * jq), k2 = *(const LAS f32x2_t*)(base + 3 * ASZ + 2 * jq), \
                          r2 = *(const LAS f32x2_t*)(base + 4 * ASZ + 2 * jq), kn = *(const LAS f32x2_t*)(base + 0 * ASZ + 2 * jq); \
            const float v = base[5 * ASZ + irow]; \
            S0 = S0 * w2[0] + (sa * b2[0] + v * k2[0]); S1 = S1 * w2[1] + (sa * b2[1] + v * k2[1]); \
            float Q, P; reduce2(S0 * r2[0] + S1 * r2[1], S0 * kn[0] + S1 * kn[1], Q, P); \
            sa = -P; \
            if (jq == (tl & 15)) yreg = Q; \
            if ((tl & 15) == 15) { if (jq < 16) RWY[(tok0 + (size_t)(blk_) * 32 + (tl - 15) + jq) * 1024 + col0 + irow] = yreg; } } } } while (0)
    int hit = (SHADOW_CONVERT && MODE == 0 && !active) ? I_IN + (bx * 4 + (F.wave - 4)) : NIT;
    LAS float* hscr = (LAS float*)(F.lds + RING_OFF + (F.wave < 7 ? 98304 + (F.wave - 4) * 8448 : 132096));
    float hv[32]; TrItem hd = {}; bool hpend = false;
    if (active) __builtin_amdgcn_s_setprio(3);
#define SC_HELP() do { if (hpend) { tr_finish(hd, F.lane, hv, hscr); hpend = false; } if (hit < NIT) { hd = decode_item(a, F.ws, l, hit); tr_issue(hd, F.lane, hv); hpend = true; hit += 4 * (int)gridDim.x; } } while (0)
    f32x4 ra0 = {}, ra1 = {}, ra2 = {}, ra3 = {}, ra4 = {}, ra5 = {}, rb0 = {}, rb1 = {}, rb2 = {}, rb3 = {}, rb4 = {}, rb5 = {};
    SC_LOAD(ra, 0); SC_LOAD(rb, 1);
    SC_WRITE(ra, 0);
    SC_LOAD(ra, 2);
    for (int blk = 0; blk < NBLK; blk += 2) {
        LDS_BAR();
        SC_COMPUTE(0, blk);
        SC_WRITE(rb, 1);
        if (blk + 3 < NBLK) SC_LOAD(rb, blk + 3);
        SC_HELP();
        LDS_BAR();
        SC_COMPUTE(1, blk + 1);
        if (blk + 2 < NBLK) { SC_WRITE(ra, 0); if (blk + 4 < NBLK) SC_LOAD(ra, blk + 4); }
        SC_HELP();
    }
    __builtin_amdgcn_s_setprio(0);
    while (hit < NIT || hpend) SC_HELP();
    LDS_BAR();
#undef SC_HELP
#undef LDS_BAR
#undef SC_LOAD
#undef SC_WRITE
#undef SC_COMPUTE
}
namespace rk {
constexpr int NCHUNK = 32 * 64;
constexpr size_t BLOB = 57344;
constexpr size_t O_RH = 0, O_PT = 8192, O_Y0 = 16384, O_LMT = 32768, O_SC = 49152;
constexpr size_t WS_RKC = WS_M + 600 * MiB;
static_assert(WS_RKC + (size_t)NCHUNK * BLOB <= WS_END, "chunk blobs");
constexpr int B_AB = 0, B_KT = 16384, B_RT = 24576, B_VT = 32768, B_ATT = 40960, B_BHT = 49152, B_KHT = 57344, B_LAK = 65536, B_LRB = 73728, B_LRK = 81920, B_T = 90112, B_MISC = 98304, B_HSCR = 100352, B_X2 = 138240;
static_assert(B_HSCR + 4 * 8448 <= LDSCTL_OFF, "phase A LDS map");
#define RSW(row, col) ((row) * 128 + ((((col) * 2)) ^ (((row) & 7) << 4)))
__device__ __forceinline__ int crow(int r, int hi) { return (r & 3) + 8 * (r >> 2) + 4 * hi; }
__device__ __forceinline__ unsigned cvtpk(float lo, float hi) { return pg8::cvt_pk_bf16(lo, hi); }
__device__ __forceinline__ void mm(f32x16& acc, LAS const char* A, LAS const char* Bt, int tm, int tn, int r32, int hi) {
#pragma unroll
    for (int s = 0; s < 4; ++s) { const bf16x8 a = *(LAS const bf16x8*)(A + RSW(32 * tm + r32, 16 * s + 8 * hi)), b = *(LAS const bf16x8*)(Bt + RSW(32 * tn + r32, 16 * s + 8 * hi));
        acc = __builtin_amdgcn_mfma_f32_32x32x16_bf16(a, b, acc, 0, 0, 0); }
}
__device__ __forceinline__ void store_n(const f32x16& acc, LAS char* dst, int tm, int tn, int r32, int hi) {
#pragma unroll
    for (int r = 0; r < 16; ++r) *(LAS bf16*)(dst + RSW(32 * tm + crow(r, hi), 32 * tn + r32)) = (bf16)f2bf(acc[r]);
}
__device__ __forceinline__ void store_t(const f32x16& acc, LAS char* dst, int tm, int tn, int r32, int hi) {
#pragma unroll
    for (int g = 0; g < 4; ++g) { v2u w; w.x = cvtpk(acc[4 * g], acc[4 * g + 1]); w.y = cvtpk(acc[4 * g + 2], acc[4 * g + 3]); *(LAS v2u*)(dst + RSW(32 * tn + r32, 32 * tm + 8 * g + 4 * hi)) = w; }
}
__device__ __forceinline__ v4u frag8(const f32x16& acc, int sl) {
    v4u w; w.x = cvtpk(acc[8 * sl], acc[8 * sl + 1]); w.y = cvtpk(acc[8 * sl + 2], acc[8 * sl + 3]); w.z = cvtpk(acc[8 * sl + 4], acc[8 * sl + 5]); w.w = cvtpk(acc[8 * sl + 6], acc[8 * sl + 7]); return w;
}
#define RK_BAR() do { asm volatile("s_waitcnt lgkmcnt(0)" ::: "memory"); __builtin_amdgcn_s_barrier(); asm volatile("" ::: "memory"); } while (0)

template <int HELP, int FUSE_PREP, int VAR = 0  > __device__ __forceinline__ void rk_chunk_local(KArgs a, Frame& F, int l) {
    LAS char* L = (LAS char*)(F.lds + RING_OFF);
    const int lane0 = F.lane, wv = F.wave;
    const bool cw = wv < 4; const int tm = (wv >> 1) & 1, tn = wv & 1;
    const float* GW = (const float*)(F.ws + WS_RWW); static_assert(!FUSE_PREP, "kk, b, k, r, v are bf16 arrays written by the preparation phase");
    const unsigned short* GKK = (const unsigned short*)(F.ws + WS_RWKK); const unsigned short* GB = (const unsigned short*)(F.ws + WS_RWB);
    const unsigned short* GK = (const unsigned short*)(F.ws + WS_RWK); const unsigned short* GR = (const unsigned short*)(F.ws + WS_RWR); const unsigned short* GV = (const unsigned short*)(F.ws + WS_RWV);
#define RK_BF(x) __uint_as_float((unsigned)(x) << 16)
    unsigned char* blobs = F.ws + WS_RKC;
    int hit = (HELP && !cw) ? I_IN + P0_EXTRA + p1_items() + (pg8::obid() * 4 + (wv - 4)) : NIT_A; const int hstride = 4 * (int)gridDim.x;
    LAS float* hscr = (LAS float*)(L + B_HSCR + (wv & 3) * 8448);
    float hva[32], hvb[32], hvc[32], hvd[32]; TrItem hda = {}, hdb = {}, hdc = {}, hdd = {}; bool pa = false, pb = false, pc = false, pd = false;
#define RK_FIN(hv, hd, pp) do { if (pp) { tr_finish(hd, lane0, hv, hscr); pp = false; } } while (0)
#define RK_ISS(hv, hd, pp) do { if (hit < NIT_A) { hd = decode_item(a, F.ws, l, hit); tr_issue(hd, lane0, hv); pp = true; hit += hstride; } } while (0)
#define RK_HELPN(n) do { RK_FIN(hva, hda, pa); RK_FIN(hvb, hdb, pb); RK_FIN(hvc, hdc, pc); RK_FIN(hvd, hdd, pd); \
        if ((n) > 0) RK_ISS(hva, hda, pa); if ((n) > 1) RK_ISS(hvb, hdb, pb); if ((n) > 2) RK_ISS(hvc, hdc, pc); if ((n) > 3) RK_ISS(hvd, hdd, pd); } while (0)
#define RK_SYNC() RK_BAR()
    if (!cw) {
#pragma unroll 1
        for (int chunk = pg8::obid(); chunk < NCHUNK; chunk += (int)gridDim.x) {
            if (HELP) RK_HELPN(HN0); RK_BAR();
            if (HELP) RK_HELPN(HN1); RK_BAR();
            if (HELP) RK_HELPN(HN2); RK_BAR();
            if (HELP) RK_HELPN(HN3); RK_BAR();
            if (HELP) RK_HELPN(HN4); RK_BAR();
            if (HELP) RK_HELPN(HN5); RK_BAR();
            if (HELP) RK_HELPN(HN6); RK_BAR(); }
        if (HELP) { while (hit < NIT_A || pa || pb || pc || pd) RK_HELPN(4); }
        return;
    }
    float wv16[16], kk16[16], bb16[16], k16[16], r16[16], v16[16];
#define RK_LOAD(ch_) do { const int sq_ = (ch_) >> 6, cc_ = (ch_) & 63; const size_t g0_ = ((size_t)(sq_ >> 4) * SEQ + (size_t)cc_ * 64 + 16 * (wv & 3)) * 1024 + (sq_ & 15) * 64 + lane0; \
        _Pragma("unroll") for (int tt = 0; tt < 16; ++tt) { const size_t o = g0_ + (size_t)tt * 1024; wv16[tt] = GW[o]; kk16[tt] = RK_BF(GKK[o]); bb16[tt] = RK_BF(GB[o]); k16[tt] = RK_BF(GK[o]); r16[tt] = RK_BF(GR[o]); v16[tt] = RK_BF(GV[o]); } } while (0)
#define RK_LOAD2(ch_) do { const int sq_ = (ch_) >> 6, cc_ = (ch_) & 63; const size_t g0_ = ((size_t)(sq_ >> 4) * SEQ + (size_t)cc_ * 64 + 16 * (wv & 3)) * 1024 + (sq_ & 15) * 64 + lane0; \
        _Pragma("unroll") for (int tt = 0; tt < 16; ++tt) { const size_t o = g0_ + (size_t)tt * 1024; k16[tt] = RK_BF(GK[o]); r16[tt] = RK_BF(GR[o]); v16[tt] = RK_BF(GV[o]); } } while (0)
    RK_LOAD(pg8::obid());
#pragma unroll 1
    for (int chunk = pg8::obid(); chunk < NCHUNK; chunk += (int)gridDim.x) {
        int lane = lane0; asm volatile("" : "+v"(lane));
        const int r32 = lane & 31, hi = lane >> 5;
        const int seq = chunk >> 6, c = chunk & 63, b = seq >> 4, h = seq & 15;
        const size_t tok0 = (size_t)b * SEQ + (size_t)c * 64;
        unsigned char* blob = VAR ? F.ws + WS_M + 724 * MiB + (size_t)(chunk & 63) * BLOB : blobs + (size_t)chunk * BLOB;
        float cs[16];
        const int j = lane, tg = wv & 3;
        {
            float run = 0.f;
#pragma unroll
            for (int tt = 0; tt < 16; ++tt) { run += __logf(wv16[tt]); cs[tt] = run; }
            ((LAS float*)(L + B_MISC))[tg * 64 + j] = run;
        }
        RK_SYNC();
        if (cw) {
            const LAS float* ct = (const LAS float*)(L + B_MISC);
            const float t0 = ct[j], t1 = ct[64 + j], t2 = ct[128 + j], t3 = ct[192 + j];
            const float base = tg == 0 ? 0.f : (tg == 1 ? t0 : (tg == 2 ? t0 + t1 : t0 + t1 + t2)), total = (t0 + t1) + (t2 + t3);
            float prev = base;
#pragma unroll
            for (int tt = 0; tt < 16; ++tt) { const int t = 16 * tg + tt; const float cum = base + cs[tt];
                const float eP = __expf(cum), eM = __expf(-cum), ePm1 = __expf(prev), eC = __expf(total - cum); prev = cum;
                const float at = -kk16[tt] * ePm1;
                *(LAS bf16*)(L + B_AB + RSW(t, j)) = (bf16)f2bf(at);
                *(LAS bf16*)(L + B_AB + 8192 + RSW(t, j)) = (bf16)f2bf(bb16[tt] * eM);
                *(LAS bf16*)(L + B_KT + RSW(t, j)) = (bf16)f2bf(k16[tt] * eM);
                *(LAS bf16*)(L + B_RT + RSW(t, j)) = (bf16)f2bf(r16[tt] * eP);
                *(LAS bf16*)(L + B_VT + RSW(j, t)) = (bf16)f2bf(v16[tt]);
                *(LAS bf16*)(L + B_ATT + RSW(j, t)) = (bf16)f2bf(at);
                *(LAS bf16*)(L + B_BHT + RSW(j, t)) = (bf16)f2bf(bb16[tt] * eC);
                *(LAS bf16*)(L + B_KHT + RSW(j, t)) = (bf16)f2bf(k16[tt] * eC); }
            if (tg == 0) ((LAS float*)(L + B_MISC))[256 + j] = __expf(total);
            if (chunk + (int)gridDim.x < NCHUNK) RK_LOAD(chunk + (int)gridDim.x);
        }
        RK_SYNC();
        f32x16 qab = {}, qak = {}, qrb = {}, qrk = {};
        if (cw && !(VAR & 2)) { mm(qab, L + B_AB, L + B_AB + 8192, tm, tn, r32, hi); mm(qak, L + B_AB, L + B_KT, tm, tn, r32, hi); mm(qrb, L + B_RT, L + B_AB + 8192, tm, tn, r32, hi); mm(qrk, L + B_RT, L + B_KT, tm, tn, r32, hi); }
        RK_SYNC();
        if (cw && !(VAR & 2)) {
#pragma unroll
            for (int r = 0; r < 16; ++r) { const int t = 32 * tm + crow(r, hi), s = 32 * tn + r32;
                ((LAS float*)(L + B_AB))[t * 64 + s] = s < t ? qab[r] : 0.f;
                qak[r] = s < t ? qak[r] : 0.f; qrb[r] = s <= t ? qrb[r] : 0.f; qrk[r] = s <= t ? qrk[r] : 0.f; }
            store_n(qak, L + B_LAK, tm, tn, r32, hi); store_n(qrb, L + B_LRB, tm, tn, r32, hi); store_n(qrk, L + B_LRK, tm, tn, r32, hi);
            if (wv == 2) store_t(qab, L + B_T, 1, 0, r32, hi);
        }
        RK_SYNC();
        if (wv == 0 && !(VAR & 7)) {
            const int blk = lane >> 5, cc = lane & 31;
            const LAS float* Lf = (const LAS float*)(L + B_AB) + (32 * blk) * 64 + 32 * blk;
            float Tr[32];
#pragma unroll
            for (int t = 0; t < 32; ++t) Tr[t] = 0.f;
#pragma unroll
            for (int t = 0; t < 32; ++t) { float a0 = Lf[t * 64 + cc], a1 = 0.f, a2 = 0.f, a3 = 0.f;
#pragma unroll
                for (int q = 0; q < (t + 3) / 4; ++q) { const f32x4 lv = *(const LAS f32x4*)(Lf + t * 64 + 4 * q);
                    a0 += lv[0] * Tr[4 * q + 0]; a1 += lv[1] * Tr[4 * q + 1]; a2 += lv[2] * Tr[4 * q + 2]; a3 += lv[3] * Tr[4 * q + 3]; }
                const float acc = (a0 + a1) + (a2 + a3); Tr[t] = acc;
                const bf16 tv = (bf16)f2bf(cc == t ? 1.0f + acc : acc);
                *(LAS bf16*)(L + B_T + RSW(32 * blk + t, 32 * blk + cc)) = tv;
                if (blk == 0) *(LAS bf16*)(L + B_X2 + cc * 64 + t * 2) = tv; }
            LDS_WAIT(); asm volatile("" ::: "memory");
            f32x16 z = {};
#pragma unroll
            for (int ks = 0; ks < 2; ++ks) { const bf16x8 af = *(LAS const bf16x8*)(L + B_T + RSW(32 + r32, 32 + 16 * ks + 8 * hi)), bfr = *(LAS const bf16x8*)(L + B_T + RSW(r32, 32 + 16 * ks + 8 * hi));
                z = __builtin_amdgcn_mfma_f32_32x32x16_bf16(af, bfr, z, 0, 0, 0); }
#pragma unroll
            for (int r = 0; r < 16; ++r) *(LAS bf16*)(L + B_T + RSW(32 + crow(r, hi), r32)) = (bf16)f2bf(z[r]);
            LDS_WAIT(); asm volatile("" ::: "memory");
            f32x16 t21 = {};
#pragma unroll
            for (int ks = 0; ks < 2; ++ks) { const bf16x8 af = *(LAS const bf16x8*)(L + B_T + RSW(32 + r32, 16 * ks + 8 * hi)), bfr = *(LAS const bf16x8*)(L + B_X2 + r32 * 64 + (16 * ks + 8 * hi) * 2);
                t21 = __builtin_amdgcn_mfma_f32_32x32x16_bf16(af, bfr, t21, 0, 0, 0); }
            LDS_WAIT(); asm volatile("" ::: "memory");
#pragma unroll
            for (int r = 0; r < 16; ++r) *(LAS bf16*)(L + B_T + RSW(32 + crow(r, hi), r32)) = (bf16)f2bf(t21[r]);
            *(LAS v4u*)(L + B_T + RSW(r32, 32 + 16 * hi)) = (v4u){0u, 0u, 0u, 0u}; *(LAS v4u*)(L + B_T + RSW(r32, 32 + 16 * hi + 8)) = (v4u){0u, 0u, 0u, 0u};
        } else if (cw && !(VAR & 6)) {
            for (int tile = (wv == 1 ? 0 : wv); tile < (wv == 1 ? 2 : wv + 1); ++tile) { f32x16 x = {}; mm(x, L + B_LAK, L + B_VT, tile >> 1, tile & 1, r32, hi); store_t(x, L + B_KT, tile >> 1, tile & 1, r32, hi); }
        }
        RK_SYNC();
        if (cw && !(VAR & 6)) { f32x16 u = {}, w = {}; mm(u, L + B_T, L + B_KT, tm, tn, r32, hi); mm(w, L + B_T, L + B_ATT, tm, tn, r32, hi);
            store_t(u, L + B_LAK, tm, tn, r32, hi); store_t(w, L + B_AB, tm, tn, r32, hi); }
        RK_SYNC();
        if (cw && !(VAR & 6)) {
            { f32x16 q = {}; mm(q, L + B_AB, L + B_LRB, tm, tn, r32, hi);
#pragma unroll
              for (int g = 0; g < 4; ++g) { const v2u rw = *(LAS const v2u*)(L + B_RT + RSW(32 * tn + r32, 32 * tm + 8 * g + 4 * hi));
                  q[4 * g] += blo(rw.x); q[4 * g + 1] += bhi(rw.x); q[4 * g + 2] += blo(rw.y); q[4 * g + 3] += bhi(rw.y); }
              v4u* dst = (v4u*)(blob + O_RH) + (size_t)(tn * 4 + 2 * tm) * 64 + lane; dst[0] = frag8(q, 0); dst[64] = frag8(q, 1); }
            { f32x16 q = {}; mm(q, L + B_AB, L + B_BHT, tm, tn, r32, hi);
              const float gcv = ((const LAS float*)(L + B_MISC))[256 + 32 * tn + r32];
#pragma unroll
              for (int r = 0; r < 16; ++r) if (32 * tm + crow(r, hi) == 32 * tn + r32) q[r] += gcv;
              v4u* dst = (v4u*)(blob + O_PT) + (size_t)(tn * 4 + 2 * tm) * 64 + lane; dst[0] = frag8(q, 0); dst[64] = frag8(q, 1); }
            { f32x16 q = {}; mm(q, L + B_LRB, L + B_LAK, tm, tn, r32, hi); mm(q, L + B_LRK, L + B_VT, tm, tn, r32, hi);
              unsigned* dst = (unsigned*)(blob + O_Y0) + (size_t)(2 * tm + tn) * 1024 + lane;
#pragma unroll
              for (int p = 0; p < 8; ++p) dst[p * 64] = pg8::cvt_pk_bf16(q[2 * p], q[2 * p + 1]); }
            { f32x16 q = {}; mm(q, L + B_BHT, L + B_LAK, tm, tn, r32, hi); mm(q, L + B_KHT, L + B_VT, tm, tn, r32, hi);
              unsigned* dst = (unsigned*)(blob + O_LMT) + (size_t)(2 * tm + tn) * 1024 + lane;
#pragma unroll
              for (int p = 0; p < 8; ++p) dst[p * 64] = pg8::cvt_pk_bf16(q[2 * p], q[2 * p + 1]); }
        }
        RK_SYNC();
    }
#undef RK_HELPN
#undef RK_LOAD
#undef RK_LOAD2
#undef RK_FIN
#undef RK_ISS
#undef RK_SYNC
}
__device__ __forceinline__ void rk_sequential(KArgs a, Frame& F, int l) {
    const int bx = pg8::obid();
    if (bx >= 32) {
        LAS float* scr = (LAS float*)(F.lds + RING_OFF + F.wave * 16384);
        for (int it = NIT_A + (bx - 32) * NWAVES + F.wave; it < NIT; it += ((int)gridDim.x - 32) * NWAVES) convert_item(a, F.ws, l, it, scr, F.lane);
        return; }
    if (F.wave >= 2) return;
    const int ii = F.wave, lane = F.lane; unsigned char* blobs = F.ws + WS_RKC + (size_t)bx * 64 * BLOB;
    f32x16 xa0 = {}, xa1 = {}, xb0, xb1, xc0, xc1; v4u pa[8], pb[8], pc[8];
#define RKS_LDP(P, c_) do { if ((c_) < 64) { const v4u* pt_ = (const v4u*)(blobs + (size_t)(c_) * BLOB + O_PT) + lane; _Pragma("unroll") for (int q = 0; q < 8; ++q) P[q] = pt_[q * 64]; } } while (0)
#define RKS_LDL(L0, L1, c_) do { if ((c_) < 64) { const unsigned* lm_ = (const unsigned*)(blobs + (size_t)(c_) * BLOB + O_LMT) + lane; \
        _Pragma("unroll") for (int p = 0; p < 8; ++p) { const unsigned w0_ = lm_[(size_t)(0 + ii) * 1024 + p * 64], w1_ = lm_[(size_t)(2 + ii) * 1024 + p * 64]; \
            L0[2 * p] = blo(w0_); L0[2 * p + 1] = bhi(w0_); L1[2 * p] = blo(w1_); L1[2 * p + 1] = bhi(w1_); } } } while (0)
#define RKS_STEP(P, s0, s1, l0, l1, c_) do { unsigned char* blob = blobs + (size_t)(c_) * BLOB; \
        v4u bf[4]; bf[0] = frag8(s0, 0); bf[1] = frag8(s0, 1); bf[2] = frag8(s1, 0); bf[3] = frag8(s1, 1); \
        { v4u* sc = (v4u*)(blob + O_SC) + (size_t)ii * 256 + lane; sc[0] = bf[0]; sc[64] = bf[1]; sc[128] = bf[2]; sc[192] = bf[3]; } \
        RKS_LDL(s0, s1, (c_) + 2); \
        _Pragma("unroll") for (int ks = 0; ks < 4; ++ks) { l0 = __builtin_amdgcn_mfma_f32_32x32x16_bf16(__builtin_bit_cast(bf16x8, P[ks]), __builtin_bit_cast(bf16x8, bf[ks]), l0, 0, 0, 0); \
                                                         l1 = __builtin_amdgcn_mfma_f32_32x32x16_bf16(__builtin_bit_cast(bf16x8, P[4 + ks]), __builtin_bit_cast(bf16x8, bf[ks]), l1, 0, 0, 0); } \
        RKS_LDP(P, (c_) + 3); } while (0)
    RKS_LDP(pa, 0); RKS_LDL(xb0, xb1, 0); RKS_LDP(pb, 1); RKS_LDL(xc0, xc1, 1); RKS_LDP(pc, 2);
#pragma unroll 1
    for (int c = 0; c < 63; c += 3) {
        RKS_STEP(pa, xa0, xa1, xb0, xb1, c);
        RKS_STEP(pb, xb0, xb1, xc0, xc1, c + 1);
        RKS_STEP(pc, xc0, xc1, xa0, xa1, c + 2);
    }
    RKS_STEP(pa, xa0, xa1, xb0, xb1, 63);
#undef RKS_LDP
#undef RKS_LDL
#undef RKS_STEP
}
template <int CHECK> __device__ __forceinline__ void rk_output(Frame& F, float* RWY, const float* REF, float* errw) {
    float e2 = 0.f, r2 = 0.f;
    const int gw = F.vcu * NWAVES + F.wave, NGW = F.G * NWAVES, lane = F.lane, r32 = lane & 31, hi = lane >> 5;
    for (int task = gw; task < NCHUNK * 2; task += NGW) { const int chunk = task >> 1, ii = task & 1; const int seq = chunk >> 6, c = chunk & 63, b = seq >> 4, h = seq & 15;
        const unsigned char* blob = F.ws + WS_RKC + (size_t)chunk * BLOB;
        v4u bf[4]; { const v4u* sc = (const v4u*)(blob + O_SC) + (size_t)ii * 256 + lane; bf[0] = sc[0]; bf[1] = sc[64]; bf[2] = sc[128]; bf[3] = sc[192]; }
#pragma unroll
        for (int tt = 0; tt < 2; ++tt) { f32x16 y; const unsigned* y0 = (const unsigned*)(blob + O_Y0) + (size_t)(2 * tt + ii) * 1024 + lane;
#pragma unroll
            for (int p = 0; p < 8; ++p) { const unsigned w = y0[p * 64]; y[2 * p] = blo(w); y[2 * p + 1] = bhi(w); }
            const v4u* rh = (const v4u*)(blob + O_RH) + (size_t)(tt * 4) * 64 + lane;
#pragma unroll
            for (int ks = 0; ks < 4; ++ks) y = __builtin_amdgcn_mfma_f32_32x32x16_bf16(__builtin_bit_cast(bf16x8, rh[ks * 64]), __builtin_bit_cast(bf16x8, bf[ks]), y, 0, 0, 0);
            float* dst = RWY + ((size_t)b * SEQ + (size_t)c * 64 + 32 * tt) * 1024 + h * 64 + 32 * ii + r32;
#pragma unroll
            for (int r = 0; r < 16; ++r) dst[(size_t)crow(r, hi) * 1024] = y[r];
            if (CHECK) { const float* rf = REF + (dst - RWY);
#pragma unroll
                for (int r = 0; r < 16; ++r) { const float o = rf[(size_t)crow(r, hi) * 1024], d = y[r] - o; e2 += d * d; r2 += o * o; } } }
    }
    if (CHECK) { e2 = wave_sum(e2); r2 = wave_sum(r2); if (lane == 0) { atomicAdd(errw, e2); atomicAdd(errw + 1, r2); } }
}
__device__ __forceinline__ void rk_output_fused(KArgs a, Frame& F, int l) {
    LAS float* ybuf = (LAS float*)(F.lds + RING_OFF);
    const int lane = F.lane, r32 = lane & 31, hi = lane >> 5, wv = F.wave;
    const bf16* RWV = (const bf16*)(F.ws + WS_RWV); const bf16* RWG = (const bf16*)(F.ws + WS_RWG); const float* BON = (const float*)(F.ws + WS_BON);
    bf16* Y2 = (bf16*)(F.ws + WS_YBR) + (size_t)2 * NTOK * 1024;
    const float* lg = a->in[12] + (size_t)l * 1024; const float* lb = a->in[13] + (size_t)l * 1024;
    for (int grp = pg8::obid(); grp < 512; grp += (int)gridDim.x) { const int hq = grp & 3, c = (grp >> 2) & 63, b = grp >> 8;
        { const int h = 4 * hq + (wv >> 1), ii = wv & 1, chunk = (b * 16 + h) * 64 + c;
          const unsigned char* blob = F.ws + WS_RKC + (size_t)chunk * BLOB;
          v4u bf[4]; { const v4u* sc = (const v4u*)(blob + O_SC) + (size_t)ii * 256 + lane; bf[0] = sc[0]; bf[1] = sc[64]; bf[2] = sc[128]; bf[3] = sc[192]; }
#pragma unroll
          for (int tt = 0; tt < 2; ++tt) { f32x16 y; const unsigned* y0 = (const unsigned*)(blob + O_Y0) + (size_t)(2 * tt + ii) * 1024 + lane;
#pragma unroll
              for (int p = 0; p < 8; ++p) { const unsigned w = y0[p * 64]; y[2 * p] = blo(w); y[2 * p + 1] = bhi(w); }
              const v4u* rh = (const v4u*)(blob + O_RH) + (size_t)(tt * 4) * 64 + lane;
#pragma unroll
              for (int ks = 0; ks < 4; ++ks) y = __builtin_amdgcn_mfma_f32_32x32x16_bf16(__builtin_bit_cast(bf16x8, rh[ks * 64]), __builtin_bit_cast(bf16x8, bf[ks]), y, 0, 0, 0);
              LAS float* dst = ybuf + (32 * tt) * 256 + (wv >> 1) * 64 + 32 * ii + r32;
#pragma unroll
              for (int r = 0; r < 16; ++r) dst[crow(r, hi) * 256] = y[r]; } }
        __syncthreads();
#pragma unroll 1
        for (int q = 0; q < 8; ++q) { const int tl = 8 * wv + q; const int t = b * SEQ + c * 64 + tl; const int cc = hq * 256 + 4 * lane; const size_t idx = (size_t)t * 1024 + cc;
            const f32x4 y = *(const LAS f32x4*)(ybuf + tl * 256 + 4 * lane);
            const float mu = dpp16((y[0] + y[1]) + (y[2] + y[3])) * (1.0f / 64.0f); const f32x4 d = y - mu;
            const float var = dpp16((d[0] * d[0] + d[1] * d[1]) + (d[2] * d[2] + d[3] * d[3])) * (1.0f / 64.0f);
            f32x4 yn = d * rsqrtf(var + GN_EPS) * *(const f32x4*)(lg + cc) + *(const f32x4*)(lb + cc);
            { const v2u vw = *(const v2u*)(RWV + idx); yn += BON[t * 16 + hq * 4 + (lane >> 4)] * (f32x4){blo(vw.x), bhi(vw.x), blo(vw.y), bhi(vw.y)}; }
            { const v2u gw = *(const v2u*)(RWG + idx); yn *= (f32x4){blo(gw.x), bhi(gw.x), blo(gw.y), bhi(gw.y)}; }
            v2u w; w.x = pk2(yn[0], yn[1]); w.y = pk2(yn[2], yn[3]); *(v2u*)(Y2 + idx) = w; }
        __syncthreads();
    }
}
#undef RSW
}
namespace att {
constexpr int SHM_K = 64 * 128 * 2, SHM_V = 64 * 128 * 2;
constexpr float ATT_STOP = -40.0f;
#define KSWZ(row, colB) ((row) * 256 + ((colB) ^ (((row) & 7) << 4)))
__device__ __forceinline__ int v_st(int k, int c) { const int kk = (k & ~0xC) | ((k & 4) << 1) | ((k & 8) >> 1); return ((kk >> 3) * 4 + (c >> 5)) * 512 + ((kk & 7) * 32 + (c & 31)) * 2; }
__device__ __forceinline__ int v_rd_base(int lane) { return ((lane & 3) << 3) | (((lane >> 2) & 3) << 6) | (((lane >> 4) & 1) << 5) | (((lane >> 5) & 1) << 8); }
constexpr int v_rd_off(int d0, int ks, int half) { return d0 * 512 + ks * 4096 + half * 2048; }
__device__ __forceinline__ int crow(int r, int hi) { return (r & 3) + 8 * (r >> 2) + 4 * hi; }
__device__ __forceinline__ unsigned cvtpk(float lo, float hi) { return pg8::cvt_pk_bf16(lo, hi); }
__device__ __forceinline__ int kperm(int m) { return 16 * ((m >> 2) & 1) + 4 * (m >> 3) + (m & 3); }

__device__ __forceinline__ void qkt(f32x16& p0, f32x16& p1, LAS const char* K_lds, int r32, int hi, const bf16x8* qr) {
    p0 = f32x16{}; p1 = f32x16{};
    LAS const char* kb[4];
#pragma unroll
    for (int dd = 0; dd < 4; ++dd) kb[dd] = K_lds + KSWZ(r32, (dd * 16 + hi * 8) * 2);
#pragma unroll
    for (int d0 = 0; d0 < 8; ++d0) { LAS const char* ap = kb[d0 & 3] + (d0 >> 2) * 128;
        const bf16x8 b0 = *(LAS const bf16x8*)ap;
        const bf16x8 b1 = *(LAS const bf16x8*)(ap + 32 * 256);
        p0 = __builtin_amdgcn_mfma_f32_32x32x16_bf16(b0, qr[d0], p0, 0, 0, 0);
        p1 = __builtin_amdgcn_mfma_f32_32x32x16_bf16(b1, qr[d0], p1, 0, 0, 0); }
}
__device__ __forceinline__ void pv_tile(f32x16* o, int vb0, bf16x8 pa0, bf16x8 pa1, bf16x8 pa2, bf16x8 pa3) {
#define TRRD(dst, off) asm volatile("ds_read_b64_tr_b16 %0, %1 offset:%2" : "=&v"(dst) : "v"(vb0), "i"(off) : "memory")
#define PV_D0(d0) do { s16x4 l0, l1, l2, l3, h0, h1, h2, h3; constexpr int b_ = v_rd_off(d0, 0, 0); \
        TRRD(l0, b_); TRRD(h0, b_ + 2048); TRRD(l1, b_ + 4096); TRRD(h1, b_ + 6144); TRRD(l2, b_ + 8192); TRRD(h2, b_ + 10240); TRRD(l3, b_ + 12288); TRRD(h3, b_ + 14336); \
        asm volatile("s_waitcnt lgkmcnt(0)" ::: "memory"); __builtin_amdgcn_sched_barrier(0); \
        o[d0] = __builtin_amdgcn_mfma_f32_32x32x16_bf16(pa0, (bf16x8){l0[0], l0[1], l0[2], l0[3], h0[0], h0[1], h0[2], h0[3]}, o[d0], 0, 0, 0);   \
        o[d0] = __builtin_amdgcn_mfma_f32_32x32x16_bf16(pa1, (bf16x8){l1[0], l1[1], l1[2], l1[3], h1[0], h1[1], h1[2], h1[3]}, o[d0], 0, 0, 0);   \
        o[d0] = __builtin_amdgcn_mfma_f32_32x32x16_bf16(pa2, (bf16x8){l2[0], l2[1], l2[2], l2[3], h2[0], h2[1], h2[2], h2[3]}, o[d0], 0, 0, 0);   \
        o[d0] = __builtin_amdgcn_mfma_f32_32x32x16_bf16(pa3, (bf16x8){l3[0], l3[1], l3[2], l3[3], h3[0], h3[1], h3[2], h3[3]}, o[d0], 0, 0, 0); } while (0)
    PV_D0(0); PV_D0(1); PV_D0(2); PV_D0(3);
#undef PV_D0
#undef TRRD
}
__device__ __forceinline__ void stick_tile(f32x16& p0, f32x16& p1, float& c, int t, int kb0, int hi) {
    const float CS = 0.08838834764831845f * 1.4426950408889634f;
    const int k0 = kb0 + 16 * hi, k1 = k0 + 32;
    float f0[16], f1[16]; float T0 = 0.f, T1 = 0.f;
#pragma unroll
    for (int r = 0; r < 16; ++r) {
        const float y0 = p0[r] * CS, y1 = p1[r] * CS;
        const float sp0 = __builtin_amdgcn_logf(1.0f + __builtin_amdgcn_exp2f(y0)), sp1 = __builtin_amdgcn_logf(1.0f + __builtin_amdgcn_exp2f(y1));
        f0[r] = (k0 + r < t) ? -sp0 : 0.f; f1[r] = (k1 + r < t) ? -sp1 : 0.f;
        p0[r] = y0 - sp0; p1[r] = y1 - sp1;
        T0 += f0[r]; T1 += f1[r];
    }
    const auto s1 = __builtin_amdgcn_permlane32_swap(__float_as_uint(T1), __float_as_uint(T1), false, false);
    const auto s0 = __builtin_amdgcn_permlane32_swap(__float_as_uint(T0), __float_as_uint(T0), false, false);
    const float T1lo = __uint_as_float(s1[0]), T1hi = __uint_as_float(s1[1]), T0lo = __uint_as_float(s0[0]), T0hi = __uint_as_float(s0[1]);
    const float c1 = c + T1hi, c2 = c1 + T1lo, c3 = c2 + T0hi, c4 = c3 + T0lo;
    float run1 = hi ? c : c1, run0 = hi ? c2 : c3;
#pragma unroll
    for (int r = 15; r >= 0; --r) {
        const float w1 = (k1 + r < t) ? __builtin_amdgcn_exp2f(p1[r] + run1) : 0.f; run1 += f1[r]; p1[r] = w1;
        const float w0 = (k0 + r < t) ? __builtin_amdgcn_exp2f(p0[r] + run0) : 0.f; run0 += f0[r]; p0[r] = w0;
    }
    c = c4;
}
#define PK4(P, B_, OUT) do { unsigned a0 = cvtpk(P[B_+0], P[B_+1]), a1 = cvtpk(P[B_+2], P[B_+3]);                          \
        unsigned b0 = cvtpk(P[B_+4], P[B_+5]), b1 = cvtpk(P[B_+6], P[B_+7]);                                             \
        auto r0 = __builtin_amdgcn_permlane32_swap(a0, b0, false, false); auto r1 = __builtin_amdgcn_permlane32_swap(a1, b1, false, false); \
        v4u w = {r0[0], r1[0], r0[1], r1[1]}; OUT = __builtin_bit_cast(bf16x8, w); } while (0)

__device__ __forceinline__ void attn_unit(LAS unsigned char* lds, const bf16* QKV, bf16* O, int b, int h, int qb) {
    const int tid = pg8::otid(), wid = __builtin_amdgcn_readfirstlane(tid >> 6), lane = tid & 63, r32 = lane & 31, hi = lane >> 5;
    LAS char* V_lds = (LAS char*)lds; LAS char* K_lds = (LAS char*)lds + SHM_V; volatile LAS int* flags = (volatile LAS int*)(lds + SHM_V + SHM_K);
    const bf16* Qp = QKV + (size_t)b * SEQ * 3072 + h * 128; const bf16* Kp = Qp + 1024; const bf16* Vp = Qp + 2048;
    const int qlo = qb * 256 + wid * 32, t = qlo + r32;
    bf16x8 qr[8];
#pragma unroll
    for (int d0 = 0; d0 < 8; ++d0) qr[d0] = *(const bf16x8*)(Qp + (size_t)t * 3072 + d0 * 16 + hi * 8);
    const int sr = tid >> 4, sc = (tid & 15) * 8, kr = kperm(sr);
    const int kws = KSWZ(sr, sc * 2), vst0 = v_st(sr, sc), vst1 = v_st(32 + sr, sc);
    const int vb0 = (int)(unsigned)(uintptr_t)V_lds + v_rd_base(lane);
    f32x16 o[4] = {}; float c = 0.f; bool done = false;
    if (tid < 8) flags[tid] = 0;
    bf16x8 k0v, k1v, v0v, v1v;
#define ATT_LOAD(j_) do { const int kb_ = (j_) * 64; k0v = *(const bf16x8*)(Kp + (size_t)(kb_ + kr) * 3072 + sc); k1v = *(const bf16x8*)(Kp + (size_t)(kb_ + 32 + kr) * 3072 + sc); \
        v0v = *(const bf16x8*)(Vp + (size_t)(kb_ + kr) * 3072 + sc); v1v = *(const bf16x8*)(Vp + (size_t)(kb_ + 32 + kr) * 3072 + sc); } while (0)
#define ATT_BAR() do { asm volatile("s_waitcnt lgkmcnt(0)" ::: "memory"); __builtin_amdgcn_s_barrier(); asm volatile("" ::: "memory"); } while (0)
    ATT_LOAD(4 * qb + 3);
    for (int j = 4 * qb + 3; j >= 0; --j) {
        const int kb0 = j * 64;
        ATT_BAR();
        bool all_done = true;
#pragma unroll
        for (int w = 0; w < 8; ++w) all_done = all_done && (flags[w] != 0);
        if (all_done) break;
        *(LAS bf16x8*)(K_lds + kws) = k0v; *(LAS bf16x8*)(K_lds + kws + 32 * 256) = k1v;
        *(LAS bf16x8*)(V_lds + vst0) = v0v; *(LAS bf16x8*)(V_lds + vst1) = v1v;
        if (j > 0) ATT_LOAD(j - 1);
        ATT_BAR();
        if (!done && kb0 <= qlo + 30) {
            f32x16 p0, p1;
            qkt(p0, p1, K_lds, r32, hi, qr);
            stick_tile(p0, p1, c, t, kb0, hi);
            bf16x8 pa0, pa1, pa2, pa3;
            PK4(p0, 0, pa0); PK4(p0, 8, pa1); PK4(p1, 0, pa2); PK4(p1, 8, pa3);
            pv_tile(o, vb0, pa0, pa1, pa2, pa3);
            done = __all(c < ATT_STOP) != 0;
            if (lane == 0 && done) flags[wid] = 1;
        }
    }
#undef ATT_LOAD
#undef ATT_BAR
    bf16* Ow = O + ((size_t)b * SEQ + qlo) * 1024 + h * 128;
#pragma unroll
    for (int r = 0; r < 16; ++r) { const int orow = crow(r, hi);
#pragma unroll
        for (int d0 = 0; d0 < 4; ++d0) { const float v = o[d0][r]; const float vn = __shfl_xor(v, 1);
            if ((r32 & 1) == 0) *(unsigned*)(Ow + (size_t)orow * 1024 + d0 * 32 + r32) = cvtpk(v, vn); } }
    __syncthreads();
}
#undef PK4
#undef KSWZ
}
__device__ __forceinline__ float shx(float v, int m) { return __shfl_xor(v, m); }
__device__ __forceinline__ float rdl(float v, int l) { return __builtin_bit_cast(float, __builtin_amdgcn_readlane(__builtin_bit_cast(int, v), l)); }
template <bool DO_LN> __device__ __forceinline__ void ph9_ln_router(KArgs a, Frame& F, int l) {
    volatile LAS int* lhist = (volatile LAS int*)(F.lds + RING_OFF);
    const float* PRE = (const float*)(F.ws + WS_PRELN); float* X1 = (float*)(F.ws + WS_X1); bf16* XS = (bf16*)(F.ws + WS_XS);
    int* HIST = (int*)(F.ws + WS_HIST); int* SELE = (int*)(F.ws + WS_SELE); float* SELW = (float*)(F.ws + WS_SELW);
    const float* g1 = a->in[16] + (size_t)l * DM; const float* b1 = a->in[17] + (size_t)l * DM;
    const float* WR = a->in[18] + (size_t)l * DM * 64; const float* rbias = a->in[19] + (size_t)l * 64;
    const int lane = F.lane;
    for (int grp = pg8::obid(); grp < 256; grp += F.G) {
        if (F.tid < 64) lhist[F.tid] = 0;
        __syncthreads();
        const int t0 = grp * 32 + F.wave * 4;
#pragma unroll 1
        for (int k = 0; k < (DO_LN ? 4 : 0); ++k) {
            f32x4 v[8];
            const f32x4* row = (const f32x4*)(PRE + (size_t)(t0 + k) * DM) + lane; float s = 0.f;
#pragma unroll
            for (int j = 0; j < 8; ++j) { v[j] = row[64 * j]; s += (v[j][0] + v[j][1]) + (v[j][2] + v[j][3]); }
            const float mean = wave_sum(s) * (1.0f / DM); float s2 = 0.f;
#pragma unroll
            for (int j = 0; j < 8; ++j) { v[j] = v[j] - mean; s2 += (v[j][0] * v[j][0] + v[j][1] * v[j][1]) + (v[j][2] * v[j][2] + v[j][3] * v[j][3]); }
            const float rstd = 1.0f / sqrtf(wave_sum(s2) * (1.0f / DM) + LN_EPS);
            f32x4* xo = (f32x4*)(X1 + (size_t)(t0 + k) * DM) + lane; v2u* bo = (v2u*)(XS + (size_t)(t0 + k) * DM) + lane;
#pragma unroll
            for (int j = 0; j < 8; ++j) { const f32x4 gg = ((const f32x4*)g1)[64 * j + lane], bb = ((const f32x4*)b1)[64 * j + lane];
                v[j] = v[j] * rstd * gg + bb; (void)xo;
                v2u w; w.x = pk2(v[j][0], v[j][1]); w.y = pk2(v[j][2], v[j][3]); bo[64 * j] = w; }
            if (lane == 0) { ((LAS float*)(F.lds + RING_OFF + 512))[2 * (F.wave * 4 + k)] = mean; ((LAS float*)(F.lds + RING_OFF + 512))[2 * (F.wave * 4 + k) + 1] = rstd; }
        }
        __syncthreads();
        LAS float* XC = (LAS float*)(F.lds + RING_OFF + 1024);
        LAS float* WC = (LAS float*)(F.lds + RING_OFF + 1024 + 33024);
        f32x16 ac0 = {}, ac1 = {};
        f32x4 px[4], pw[8]; float rmean[4], rrstd[4];
        if (DO_LN) {
#pragma unroll
            for (int i = 0; i < 4; ++i) { const int xrow = (F.tid >> 6) + 8 * i; rmean[i] = ((const LAS float*)(F.lds + RING_OFF + 512))[2 * xrow]; rrstd[i] = ((const LAS float*)(F.lds + RING_OFF + 512))[2 * xrow + 1]; } }
#define RT_LOAD(j_) do { if (DO_LN) { const f32x4 gg_ = *(const f32x4*)(g1 + 256 * (j_) + 4 * lane), bb_ = *(const f32x4*)(b1 + 256 * (j_) + 4 * lane); \
          _Pragma("unroll") for (int i = 0; i < 4; ++i) { const int idx = F.tid + 512 * i, xrow = idx >> 6, c4 = idx & 63; f32x4 t_ = *(const f32x4*)(PRE + (size_t)(grp * 32 + xrow) * DM + 256 * (j_) + 4 * c4); \
              t_ = t_ - rmean[i]; px[i] = t_ * rrstd[i] * gg_ + bb_; } } else { \
          _Pragma("unroll") for (int i = 0; i < 4; ++i) { const int idx = F.tid + 512 * i, xrow = idx >> 6, c4 = idx & 63; px[i] = *(const f32x4*)(X1 + (size_t)(grp * 32 + xrow) * DM + 256 * (j_) + 4 * c4); } } \
        const f32x4* wsrc = (const f32x4*)(WR + (size_t)256 * (j_) * 64); _Pragma("unroll") for (int i = 0; i < 8; ++i) pw[i] = wsrc[F.tid + 512 * i]; } while (0)
#define RT_BAR() do { asm volatile("s_waitcnt lgkmcnt(0)" ::: "memory"); __builtin_amdgcn_s_barrier(); asm volatile("" ::: "memory"); } while (0)
        RT_LOAD(0);
#pragma unroll 1
        for (int j = 0; j < 8; ++j) {
            RT_BAR();
#pragma unroll
            for (int i = 0; i < 4; ++i) { const int idx = F.tid + 512 * i, xrow = idx >> 6, c4 = idx & 63;
                LAS float* xr = XC + xrow * 257 + 4 * c4; xr[0] = px[i][0]; xr[1] = px[i][1]; xr[2] = px[i][2]; xr[3] = px[i][3]; }
#pragma unroll
            for (int i = 0; i < 8; ++i) ((LAS f32x4*)WC)[F.tid + 512 * i] = pw[i];
            if (j + 1 < 8) RT_LOAD(j + 1);
            RT_BAR();
#pragma unroll
            for (int kk = 0; kk < 16; ++kk) { const int kidx = 32 * F.wave + 2 * kk + (lane >> 5);
                const float av = XC[(lane & 31) * 257 + kidx], b0 = WC[kidx * 64 + (lane & 31)], b1 = WC[kidx * 64 + 32 + (lane & 31)];
                ac0 = __builtin_amdgcn_mfma_f32_32x32x2f32(av, b0, ac0, 0, 0, 0); ac1 = __builtin_amdgcn_mfma_f32_32x32x2f32(av, b1, ac1, 0, 0, 0); }
        }
#undef RT_LOAD
#undef RT_BAR
        __syncthreads();
        { LAS float* RED = WC; const int hi = lane >> 5, e = lane & 31;
#pragma unroll
          for (int r = 0; r < 16; ++r) { const int tok = (r & 3) + 8 * (r >> 2) + 4 * hi; RED[(F.wave * 32 + tok) * 64 + e] = ac0[r]; RED[(F.wave * 32 + tok) * 64 + 32 + e] = ac1[r]; } }
        __syncthreads();
        float acc[4];
#pragma unroll
        for (int k = 0; k < 4; ++k) { float sacc = 0.f;
#pragma unroll
            for (int w2 = 0; w2 < 8; ++w2) sacc += WC[(w2 * 32 + F.wave * 4 + k) * 64 + lane];
            acc[k] = sacc; }
        const float rb = rbias[lane];
#pragma unroll
        for (int k = 0; k < 4; ++k) {
            const int t = t0 + k;
            const float lg = (acc[k] == acc[k]) ? acc[k] : 0.f;
            const float sc = 1.0f / (1.0f + expf(-lg)); const float bz = sc + rb;
            float m1 = bz; m1 = fmaxf(m1, shx(m1, 1)); m1 = fmaxf(m1, shx(m1, 2)); m1 = fmaxf(m1, shx(m1, 4));
            const unsigned long long eq = __ballot(bz == m1);
            const int g = lane >> 3; const unsigned gb = (unsigned)((eq >> (8 * g)) & 0xffull); const int first = __ffs((int)gb) - 1;
            float m2 = ((lane & 7) == first) ? -__builtin_inff() : bz; m2 = fmaxf(m2, shx(m2, 1)); m2 = fmaxf(m2, shx(m2, 2)); m2 = fmaxf(m2, shx(m2, 4));
            const float gs = m1 + m2;
            int grank = 0;
#pragma unroll
            for (int g2 = 0; g2 < 8; ++g2) { const float o = rdl(gs, 8 * g2); grank += ((o > gs) || (o == gs && g2 < g)) ? 1 : 0; }
            const bool gsel = grank < 4;
            const float mv = gsel ? bz : -__builtin_inff();
            int rank = 0;
            for (int e2 = 0; e2 < 64; ++e2) { const float o = rdl(mv, e2); rank += ((o > mv) || (o == mv && e2 < lane)) ? 1 : 0; }
            const bool sel = gsel && rank < 8;
            const float ssum = wave_sum(sel ? sc : 0.f);
            const float wgt = sc / ssum * ROUTED_SCALE;
            const unsigned long long m = __ballot(sel);
            const int slot = __popcll(m & ((1ull << lane) - 1ull));
            if (sel && slot < 8) { SELE[t * 8 + slot] = lane; SELW[t * 8 + slot] = wgt; __hip_atomic_fetch_add((LAS int*)&lhist[lane], 1, __ATOMIC_RELAXED, __HIP_MEMORY_SCOPE_WORKGROUP); }
        }
        __syncthreads();
        if (F.tid < 64) HIST[grp * 64 + F.tid] = lhist[F.tid];
        __syncthreads();
    }
}
__device__ __forceinline__ void ph10_lists(Frame& F) {
    volatile LAS int* L = (volatile LAS int*)(F.lds + RING_OFF);
    volatile LAS int* partT = L, * partB = L + 512, * rowbase = L + 1024, * lsel = L + 1088, * lpos = L + 1344;
    const int* HIST = (const int*)(F.ws + WS_HIST); const int* SELE = (const int*)(F.ws + WS_SELE); const float* SELW = (const float*)(F.ws + WS_SELW);
    int* SLOT = (int*)(F.ws + WS_SLOT); float* ROWW = (float*)(F.ws + WS_ROWW); int* TSEG = (int*)(F.ws + WS_TSEG); int* ROWT = (int*)(F.ws + WS_ROWT); int* XT = (int*)(F.ws + WS_XT);
    for (int grp = pg8::obid(); grp < 256; grp += F.G) {
        { const int e = F.tid & 63, part = F.tid >> 6; int s = 0, bs = 0;
          for (int w = 32 * part; w < 32 * part + 32; ++w) { const int hv = HIST[w * 64 + e]; s += hv; bs += (w < grp) ? hv : 0; }
          partT[part * 64 + e] = s; partB[part * 64 + e] = bs; }
        __syncthreads();
        if (F.tid < 64) { int tot = 0, bef = 0;
#pragma unroll
            for (int p = 0; p < 8; ++p) { tot += partT[p * 64 + F.tid]; bef += partB[p * 64 + F.tid]; }
            const int nt = (tot + 255) >> 8; int incl = nt;
#pragma unroll
            for (int o = 1; o < 64; o <<= 1) { const int u = __shfl_up(incl, o); if (F.lane >= o) incl += u; }
            const int excl = incl - nt;
            rowbase[F.tid] = 8192 + 256 * excl + bef;
            if (grp == 0) { for (int i = 0; i < nt; ++i) TSEG[16 + 32 + excl + i] = F.tid + 1;
                for (int r = 8192 + 256 * excl + tot; r < 8192 + 256 * (excl + nt); ++r) ROWT[r] = 0;
                if (F.tid < 32) TSEG[16 + F.tid] = 0;
                if (F.tid == 63) TSEG[0] = 32 + incl; } }
        if (F.tid < 256) lsel[F.tid] = SELE[grp * 256 + F.tid];
        __syncthreads();
        if (F.tid < 256) { const int j = F.tid >> 3, e = lsel[F.tid]; int rank = 0;
            for (int q = 0; q < 8 * j; ++q) rank += (lsel[q] == e) ? 1 : 0;
            const int pos = rowbase[e] + rank; const int t = grp * 32 + j;
            SLOT[t * 8 + (F.tid & 7)] = pos; ROWW[pos] = SELW[grp * 256 + F.tid]; ROWT[pos] = t; }
        else if (F.tid < 288) { ROWW[grp * 32 + F.tid - 256] = 1.0f; ROWT[grp * 32 + F.tid - 256] = grp * 32 + F.tid - 256; }
        __syncthreads();
    }
}
__device__ __forceinline__ void ph13_combine(KArgs a, Frame& F, int l, float poison) {
    const int gw = F.vcu * NWAVES + F.wave, NGW = F.G * NWAVES, lane = F.lane;
    const bf16* X1B = (const bf16*)(F.ws + WS_XS); const bf16* YS = (const bf16*)(F.ws + WS_YS); const int* SLOT = (const int*)(F.ws + WS_SLOT);
    float* outf = (l == NLAYER - 1) ? a->out : (float*)(F.ws + WS_X2); bf16* XB = (bf16*)(F.ws + WS_XB);
    const float* g2 = a->in[26] + (size_t)l * DM; const float* b2 = a->in[27] + (size_t)l * DM;
    for (int t = gw; t < NTOK; t += NGW) {
        const int mypos = (lane < 8) ? SLOT[t * 8 + lane] : t;
        float acc[4][8];
#pragma unroll
        for (int q = 0; q < 4; ++q) { float u[8]; unpack8(*((const v4u*)(X1B + (size_t)t * DM + 512 * q) + lane), u);
#pragma unroll
            for (int j = 0; j < 8; ++j) acc[q][j] = ALPHA * u[j]; }
#pragma unroll
        for (int s = 0; s < 9; ++s) { const int row = __builtin_amdgcn_readlane(mypos, s); const v4u* yr = (const v4u*)(YS + (size_t)row * DM) + lane;
#pragma unroll
            for (int q = 0; q < 4; ++q) { float u[8]; unpack8(yr[64 * q], u);
#pragma unroll
                for (int j = 0; j < 8; ++j) acc[q][j] += u[j]; } }
        float s1 = 0.f;
#pragma unroll
        for (int q = 0; q < 4; ++q)
#pragma unroll
            for (int j = 0; j < 8; ++j) s1 += acc[q][j];
        const float mean = wave_sum(s1) * (1.0f / DM); float s2 = 0.f;
#pragma unroll
        for (int q = 0; q < 4; ++q)
#pragma unroll
            for (int j = 0; j < 8; ++j) { acc[q][j] -= mean; s2 += acc[q][j] * acc[q][j]; }
        const float rstd = 1.0f / sqrtf(wave_sum(s2) * (1.0f / DM) + LN_EPS);
#pragma unroll
        for (int q = 0; q < 4; ++q) { const int col = 512 * q + 8 * lane;
            const f32x4 ga = *(const f32x4*)(g2 + col), gb = *(const f32x4*)(g2 + col + 4), ba = *(const f32x4*)(b2 + col), bb = *(const f32x4*)(b2 + col + 4);
            float y[8];
#pragma unroll
            for (int j = 0; j < 4; ++j) { y[j] = (acc[q][j] * rstd * ga[j] + ba[j]) * poison; y[4 + j] = (acc[q][4 + j] * rstd * gb[j] + bb[j]) * poison; }
            if (l == NLAYER - 1) { *(f32x4*)(outf + (size_t)t * DM + col) = (f32x4){y[0], y[1], y[2], y[3]}; *(f32x4*)(outf + (size_t)t * DM + col + 4) = (f32x4){y[4], y[5], y[6], y[7]}; }
            else *(v4u*)(XB + (size_t)t * DM + col) = pack8(y); }
    }
}
__device__ __forceinline__ KArgs kargs() { KArgs p = (KArgs)__builtin_amdgcn_kernarg_segment_ptr(); asm volatile("" : "+s"(p)); return p; }
__device__ __forceinline__ Frame mkframe(LAS unsigned char* lds) {
    Frame F; KArgs ka = kargs();
    F.lds = lds; F.MISC = (volatile LAS unsigned*)(lds + MISC_OFF);
    F.tid = pg8::otid(); F.lane = F.tid & 63; F.wave = __builtin_amdgcn_readfirstlane(F.tid >> 6);
    F.G = gridDim.x; { const int bx = pg8::obid(); F.vcu = (F.G % 8 == 0) ? (bx % 8) * (F.G / 8) + bx / 8 : bx; }
    F.ws = ka->ws; F.ctl = (gu32*)(ka->ws + WS_CTL);
    return F;
}
__device__ __forceinline__ void grid_seam(LAS unsigned char* lds) {
    XcdBarrier b; b.bar = (unsigned*)((gu32*)(kargs()->ws + WS_CTL) + CW_BAR); b.x = xb_xcc_id(); b.st = (volatile LAS unsigned*)(lds + MISC_OFF) + 8;
    xcd_barrier(b);
}
__global__ void __launch_bounds__(NWAVES * 64, 2) fwd_kernel(Args args_unused) {
    extern __shared__ __attribute__((aligned(16))) unsigned char lds_raw[];
    LAS unsigned char* lds = (LAS unsigned char*)lds_raw;
    for (int u = threadIdx.x; u < (LDS_BYTES - LDSCTL_OFF) / 4; u += NWAVES * 64) ((LAS unsigned*)(lds + LDSCTL_OFF))[u] = 0u;
    __syncthreads();
    if (kargs()->ph_hi - kargs()->ph_lo > 1) (void)xcd_barrier_post((unsigned*)((gu32*)(kargs()->ws + WS_CTL) + CW_BAR), (volatile LAS unsigned*)(lds + MISC_OFF) + 8);
#ifndef PH_MASK
#define PH_MASK 0xffff
#endif
#define IN(k) (((PH_MASK >> (k)) & 1) && kargs()->ph_lo <= (pb + (k)) && (pb + (k)) < kargs()->ph_hi)
#ifndef REP_MASK
#define REP_MASK 0
#endif
#define REPS(k) _Pragma("unroll 1") for (int rep_ = 0; rep_ < ((((REP_MASK) >> (k)) & 1) ? 2 : 1); ++rep_)
#define REPSEAM() do { if (rep_) grid_seam(lds); } while (0)
#define SEAM(k) do { if (IN(k) && (pb + (k) + 1) < kargs()->ph_hi) grid_seam(lds); } while (0)
#pragma unroll 1
    for (int l = 0; l < NLAYER; ++l) {
        const int pb = l * NPHASE;
        if (IN(0)) REPS(0) { REPSEAM(); Frame F = mkframe(lds); ph0_convert(kargs(), F, l); } SEAM(0);
        if (IN(1)) REPS(1) { REPSEAM(); unsigned char* ws = kargs()->ws;
            if (p1_items() > 0 && pg8::obid() >= 248) { Frame F = mkframe(lds); if (rep_ == 0) p1_convert(kargs(), F, l); } else {
            pg8::Gemm g{(const pg8::bf16_t*)(ws + WS_XB), (const pg8::bf16_t*)(ws + WS_WIN), NTOK, INP, DM}; pg8::StaticOrder S; S.init(NTOK, INP, p1_items() > 0 ? 248 : (int)gridDim.x, pg8::obid());
            pg8::EpiInProj E{(pg8::bf16_t*)(ws + WS_PCONV), (pg8::bf16_t*)(ws + WS_PQKV), (pg8::bf16_t*)(ws + WS_PRKV), (pg8::bf16_t*)(ws + WS_PLORA), (pg8::bf16_t*)(ws + WS_PGATE)};
            pg8::gemm_phase<pg8::EpiInProj, pg8::StaticOrder, true, true>(lds + RING_OFF, g, S, E); }
        } SEAM(1);
        if (IN(2)) REPS(2) { REPSEAM(); unsigned char* ws = kargs()->ws;
            for (int u = pg8::obid(); u < 256; u += gridDim.x) att::attn_unit(lds + RING_OFF, (const bf16*)(ws + WS_PQKV), (bf16*)(ws + WS_YBR) + (size_t)NTOK * 1024, u >> 7, (u >> 4) & 7, u & 15);
            Frame F = mkframe(lds); ph2_elementwise(kargs(), F, l);
        } SEAM(2);
        if (IN(3)) REPS(3) { REPSEAM(); unsigned char* ws = kargs()->ws;
            int k256 = 256; asm volatile("" : "+s"(k256));
            pg8::Gemm g{(const pg8::bf16_t*)(ws + WS_LORAA), (const pg8::bf16_t*)(ws + WS_WLORA), 3 * NTOK, 3072, k256}; pg8::LoraOrder S{(int)gridDim.x, pg8::obid()};
            pg8::EpiLora E{(float*)(ws + WS_RWW), (long)((WS_RWA - WS_RWW) / 4), (long)((WS_RWG - WS_RWW) / 4), kargs()->in[4] + (size_t)l * 1024, kargs()->in[6] + (size_t)l * 1024};
            pg8::gemm_phase<pg8::EpiLora, pg8::LoraOrder, true, true>(lds + RING_OFF, g, S, E);
        } SEAM(3);
#define MOE_C ((pg8::obid() & 7) * ((int)gridDim.x >> 3) + (pg8::obid() >> 3))
#ifndef FUSE_LN1
#define FUSE_LN1 0
#endif
#ifndef DOWN_ALIGN
#define DOWN_ALIGN true
#endif
#ifndef RK_FUSE_PREP
#define RK_FUSE_PREP 0
#endif
#ifndef RWKV_MODE
#define RWKV_MODE 1
#endif
#ifndef RK_CHECK
#define RK_CHECK 0
#endif
#ifndef RK_CHECK_HELP
#define RK_CHECK_HELP 0
#endif
#ifndef RK_CHECK_TOL
#define RK_CHECK_TOL 0.02f
#endif
        if ((RWKV_MODE == 0 || RK_CHECK || !RK_FUSE_PREP) && IN(4)) REPS(4) { REPSEAM(); Frame F = mkframe(lds); ph4_prep(kargs(), F, l); if ((pb + 5) < kargs()->ph_hi) grid_seam(lds); }

        if (IN(5)) REPS(5) { REPSEAM(); Frame F = mkframe(lds);
            if (RWKV_MODE == 0 || RK_CHECK) { ph5_scan<0>(kargs(), F, l); }
            if (RWKV_MODE == 1) { if (RK_CHECK) grid_seam(lds); rk::rk_chunk_local<(RK_CHECK && !RK_CHECK_HELP) ? 0 : 1, (RK_CHECK || !RK_FUSE_PREP) ? 0 : 1>(kargs(), F, l); }
        } SEAM(5);
#ifdef RK_PROBE
        if (IN(5)) { Frame F = mkframe(lds); rk::rk_chunk_local<0, 0, RK_PROBE>(kargs(), F, l); grid_seam(lds); }
#endif
        if (IN(6)) REPS(6) { REPSEAM(); Frame F = mkframe(lds); if (RWKV_MODE == 1) rk::rk_sequential(kargs(), F, l); } SEAM(6);
#ifndef RK_FUSE_OUT
#define RK_FUSE_OUT 1
#endif
        if (IN(7)) REPS(7) { REPSEAM(); Frame F = mkframe(lds);
            if (RWKV_MODE == 1 && RK_FUSE_OUT && !RK_CHECK) rk::rk_output_fused(kargs(), F, l);
            else if (RWKV_MODE == 1) rk::rk_output<RK_CHECK>(F, (float*)(F.ws + (RK_CHECK ? WS_M + 720 * MiB : WS_RWY)), (const float*)(F.ws + WS_RWY), (float*)(F.ctl + 2048 + 2 * l)); } SEAM(7);
        if (!(RWKV_MODE == 1 && RK_FUSE_OUT && !RK_CHECK) && IN(8)) REPS(8) { REPSEAM(); Frame F = mkframe(lds); ph6_rwkv_out(kargs(), F, l); if ((pb + 9) < kargs()->ph_hi) grid_seam(lds); }
        if (IN(9)) REPS(9) { REPSEAM(); unsigned char* ws = kargs()->ws;
            pg8::Gemm g{(const pg8::bf16_t*)(ws + WS_YBR), (const pg8::bf16_t*)(ws + WS_WBR), 3 * NTOK, 3 * DM, 1024}; pg8::BranchOrder S; S.so.init(NTOK, DM, (int)gridDim.x, pg8::obid());
            pg8::EpiGate E{(const pg8::bf16_t*)(ws + WS_PGATE), (pg8::bf16_t*)(ws + WS_PRELN), (pg8::bf16_t*)(ws + WS_MERGED)};
            pg8::gemm_phase<pg8::EpiGate, pg8::BranchOrder, true, true>(lds + RING_OFF, g, S, E);
        } SEAM(9);
        if (IN(10)) REPS(10) { REPSEAM(); unsigned char* ws = kargs()->ws;
            pg8::Gemm g{(const pg8::bf16_t*)(ws + WS_MERGED), (const pg8::bf16_t*)(ws + WS_WO), NTOK, DM, DM}; pg8::StaticOrder S; S.init(NTOK, DM, (int)gridDim.x, pg8::obid());
#if FUSE_LN1
            pg8::PanelStats8 st{(unsigned*)(ws + WS_LNX), (unsigned*)((gu32*)(ws + WS_CTL) + CW_LNC + l * 4096), (unsigned*)((gu32*)(ws + WS_CTL) + CW_TMO), LN_EPS};
            pg8::EpiWoLn E{l == 0 ? kargs()->in[0] : (const float*)(ws + WS_X2), (float*)(ws + WS_X1), (pg8::bf16_t*)(ws + WS_XS), kargs()->in[16] + (size_t)l * DM, kargs()->in[17] + (size_t)l * DM, ALPHA, st};
            pg8::gemm_phase<pg8::EpiWoLn, pg8::StaticOrder, false, true>(lds + RING_OFF, g, S, E);
#else
            pg8::EpiWo E{l == 0 ? kargs()->in[0] : (const float*)nullptr, (float*)(ws + WS_PRELN), ALPHA, (const pg8::bf16_t*)(ws + WS_XB)};
            pg8::gemm_phase<pg8::EpiWo, pg8::StaticOrder, true, true>(lds + RING_OFF, g, S, E);
#endif
        } SEAM(10);
        if (IN(11)) REPS(11) { REPSEAM(); Frame F = mkframe(lds); ph9_ln_router<!FUSE_LN1>(kargs(), F, l); } SEAM(11);
        if (IN(12)) REPS(12) { REPSEAM(); Frame F = mkframe(lds); ph10_lists(F); } SEAM(12);
#ifndef MOE_WT
#define MOE_WT 0
#endif
#ifndef MOE_HANDOFF
#define MOE_HANDOFF 0
#endif
        if (IN(13)) REPS(13) { REPSEAM(); unsigned char* ws = kargs()->ws;
            const int ntiles = __builtin_amdgcn_readfirstlane(ld_i32((const int*)(ws + WS_TSEG)));
            unsigned* hc = (unsigned*)((gu32*)(ws + WS_CTL) + CW_HC + l * 24576); unsigned* tmo = (unsigned*)((gu32*)(ws + WS_CTL) + CW_TMO);
            { pg8::Gemm g{(const pg8::bf16_t*)(ws + WS_XS), (const pg8::bf16_t*)(ws + WS_WGU), ntiles * 256, NSEG * 1024, DM};
              pg8::MoeOrder S{(const int*)(ws + WS_TSEG) + 16, ntiles, 4, (int)gridDim.x, MOE_C, hc, tmo, MOE_HANDOFF ? 1 : 0};
              pg8::EpiSwiglu<(MOE_HANDOFF != 0) || MOE_WT> E{(pg8::bf16_t*)(ws + WS_H), (const float*)(ws + WS_ROWW)};
              pg8::gemm_phase_gather<pg8::EpiSwiglu<(MOE_HANDOFF != 0) || MOE_WT>, pg8::MoeOrder, true, true>(lds + RING_OFF, g, S, E, (const int*)(ws + WS_ROWT)); }
            if (l + 1 < NLAYER && rep_ == 0 && next_win_early(kargs()->ws)) {
                const int R = (4 * __builtin_amdgcn_readfirstlane(ld_i32((const int*)(kargs()->ws + WS_TSEG)))) & 255, c = MOE_C;
                if (c >= R) { Frame F = mkframe(lds); convert_range(kargs(), F, l + 1, 0, I_IN, (c - R) * NWAVES + F.wave, (256 - R) * NWAVES); }
            }
#if MOE_HANDOFF
            { pg8::Gemm g{(const pg8::bf16_t*)(ws + WS_H), (const pg8::bf16_t*)(ws + WS_WD), ntiles * 256, NSEG * 2048, 512};
              pg8::MoeOrder S{(const int*)(ws + WS_TSEG) + 16, ntiles, 8, (int)gridDim.x, MOE_C, hc, tmo, 2};
              pg8::EpiDown E{(pg8::bf16_t*)(ws + WS_YS), (const float*)(ws + WS_ROWW)};
              pg8::gemm_phase<pg8::EpiDown, pg8::MoeOrder, DOWN_ALIGN, true>(lds + RING_OFF, g, S, E); }
#endif
        } SEAM(13);
        if (!MOE_HANDOFF && IN(14)) REPS(14) { REPSEAM(); unsigned char* ws = kargs()->ws;
            const int ntiles = __builtin_amdgcn_readfirstlane(ld_i32((const int*)(ws + WS_TSEG)));
            pg8::Gemm g{(const pg8::bf16_t*)(ws + WS_H), (const pg8::bf16_t*)(ws + WS_WD), ntiles * 256, NSEG * 2048, 512};
            pg8::MoeOrder S{(const int*)(ws + WS_TSEG) + 16, ntiles, 8, (int)gridDim.x, MOE_C, nullptr, nullptr, 0};
            pg8::EpiDown E{(pg8::bf16_t*)(ws + WS_YS), (const float*)(ws + WS_ROWW)};
            pg8::gemm_phase<pg8::EpiDown, pg8::MoeOrder, DOWN_ALIGN, true>(lds + RING_OFF, g, S, E);
            if ((pb + 15) < kargs()->ph_hi) grid_seam(lds);
        }
        if (IN(15)) REPS(15) { REPSEAM(); Frame F = mkframe(lds); ph13_combine(kargs(), F, l, (RK_CHECK && !(ld_f32((const float*)(F.ctl + 2048 + 2 * l)) <= RK_CHECK_TOL * RK_CHECK_TOL * ld_f32((const float*)(F.ctl + 2049 + 2 * l)))) ? 1000.f : 1.f); } SEAM(15);
    }
#undef IN
#undef SEAM
}

#ifndef MK_PER_PHASE
#define MK_PER_PHASE 0
#endif
extern "C" void kernel_launch(void* const* d_in, const int* in_sizes, int n_in, void* d_out, int out_size, void* d_ws, size_t ws_size, hipStream_t stream) {
    static int grid = 0;
    if (grid == 0) {
        if (n_in != 28 || out_size != NTOK * DM || ws_size < WS_END) { fprintf(stderr, "kernel_launch: unexpected problem shape (n_in %d out %d ws %zu)\n", n_in, out_size, ws_size); grid = -1; return; }
        int dev = 0, cus = 0, per_cu = 0;
        if (hipGetDevice(&dev) != hipSuccess || hipDeviceGetAttribute(&cus, hipDeviceAttributeMultiprocessorCount, dev) != hipSuccess) { grid = -1; return; }
        if (hipFuncSetAttribute((const void*)fwd_kernel, hipFuncAttributeMaxDynamicSharedMemorySize, LDS_BYTES) != hipSuccess) { fprintf(stderr, "kernel_launch: hipFuncSetAttribute failed\n"); grid = -1; return; }
        if (hipOccupancyMaxActiveBlocksPerMultiprocessor(&per_cu, (const void*)fwd_kernel, NWAVES * 64, LDS_BYTES) != hipSuccess || per_cu < 1) fprintf(stderr, "kernel_launch: occupancy query reports %d\n", per_cu);
        (void)hipGetLastError();
        grid = cus;
    }
    if (grid < 0) return;
    (void)hipMemsetAsync((char*)d_ws + WS_CTL, 0, CTL_ZERO_BYTES, stream);
    Args a{};
    for (int i = 0; i < 28; ++i) a.in[i] = (const float*)d_in[i];
    a.out = (float*)d_out; a.ws = (unsigned char*)d_ws; a.li = 0; a.pad = 0;
#if MK_PER_PHASE
    for (int p = 0; p < NLAYER * NPHASE; ++p) { a.ph_lo = p; a.ph_hi = p + 1; hipLaunchKernelGGL(fwd_kernel, dim3(grid), dim3(NWAVES * 64), LDS_BYTES, stream, a); }
#else
    a.ph_lo = 0; a.ph_hi = NLAYER * NPHASE;
    hipLaunchKernelGGL(fwd_kernel, dim3(grid), dim3(NWAVES * 64), LDS_BYTES, stream, a);
#endif
}
```

```cpp
#include <hip/hip_runtime.h>
#include <cstdio>
#include <cstdint>
namespace pg8 {
#define PG8_LAS __attribute__((address_space(3)))
typedef unsigned short bf16_t;
typedef short bf16x8 __attribute__((ext_vector_type(8)));
typedef float f32x4 __attribute__((ext_vector_type(4)));
typedef unsigned u32x4 __attribute__((ext_vector_type(4)));
typedef unsigned u32x2 __attribute__((ext_vector_type(2)));
constexpr int BM = 256, BK = 64, HALF = 128, HTB = HALF * BK * 2  , STAGE_BYTES = 8 * HTB, NXCD = 8, WGM = 8;

__host__ __device__ __forceinline__ int lds_byte(int r, int c) { const int st = (r >> 4) * 2 + (c >> 5), rr = r & 15, cc = c & 31, ob = rr * 64 + cc * 2; return st * 1024 + (ob ^ (((ob >> 9) & 1) << 5)); }
__host__ __device__ __forceinline__ void stage_rc(int b, int& R, int& C) { const int st = b / 1024, sb = b % 1024, swz = sb ^ (((sb >> 9) & 1) << 5); R = (st >> 1) * 16 + swz / 64; C = (st & 1) * 32 + (swz % 64) / 2; }
__host__ __device__ __forceinline__ int perm32(int rho) { const int n = rho >> 4, i = rho & 15; return 8 * (i >> 2) + 4 * n + (i & 3); }

struct Unit { int pm, pn; };
struct Gemm { const bf16_t* A; const bf16_t* Bt; int M, N, K; };

struct StaticOrder {
    int nM, nN, nwg, G, c;
    __host__ __device__ void init(int M, int N, int G_, int c_) { nM = M / BM; nN = N / BM; nwg = nM * nN; G = G_; c = c_; }
    __host__ __device__ bool next(int i, Unit& u) const {
        const long L = (long)i * G + c; if (L >= nwg) return false;
        int wgid = (int)L; { const int q = nwg / NXCD, r = nwg % NXCD, xcd = wgid % NXCD, off = wgid / NXCD; wgid = (xcd < r ? xcd * (q + 1) : r * (q + 1) + (xcd - r) * q) + off; }
        const int nig = WGM * nN, gid = wgid / nig, fm = gid * WGM, gsz = (nM - fm) < WGM ? (nM - fm) : WGM;
        u.pm = fm + ((wgid % nig) % gsz); u.pn = (wgid % nig) / gsz; return true;
    }
    __device__ __forceinline__ void a_ready(const Unit&) const {}
    __device__ __forceinline__ void done(const Unit&) const {}
};

__device__ __forceinline__ int otid() { int t = threadIdx.x; asm volatile("" : "+v"(t)); return t; }
__device__ __forceinline__ int obid() { int t = blockIdx.x; asm volatile("" : "+s"(t)); return t; }
typedef __bf16 bf16x2c_t __attribute__((ext_vector_type(2))); typedef float f32x2c_t __attribute__((ext_vector_type(2)));
__device__ __forceinline__ unsigned cvt_pk_bf16(float lo, float hi) { f32x2c_t v = {lo, hi}; bf16x2c_t b = __builtin_convertvector(v, bf16x2c_t); return __builtin_bit_cast(unsigned, b); }
__device__ __forceinline__ float bflo(unsigned w) { return __uint_as_float(w << 16); }
__device__ __forceinline__ float bfhi(unsigned w) { return __uint_as_float(w & 0xffff0000u); }
__device__ __forceinline__ void st16_sc1(void* p, u32x4 v) { asm volatile("global_store_dwordx4 %0, %1, off sc1\n\ts_nop 2" :: "v"(p), "v"(v) : "memory"); }
__device__ __forceinline__ float sigmoidf_(float x) { return __builtin_amdgcn_rcpf(1.0f + __expf(-x)); }

struct EpiInProj {
    static constexpr bool PERM = true, AFTER_DRAIN = false;
    bf16_t *conv, *qkv, *rkv, *lora, *gate;
    __device__ __forceinline__ void operator()(const f32x4 (&acc)[2][2][4][2], const Unit& u, int wr, int wc, int fr, int fq) const {
        const int pn = u.pn; bf16_t* base; int ldc, colt;
        if (pn < 12) { base = conv; ldc = 3072; colt = pn * 256; }
        else if (pn < 24) { base = qkv; ldc = 3072; colt = (pn - 12) * 256; }
        else if (pn < 36) { base = rkv; ldc = 3072; colt = (pn - 24) * 256; }
        else if (pn < 38) { base = lora; ldc = 512; colt = (pn - 36) * 256; }
        else { base = gate; ldc = 6144; colt = (pn - 38) * 256; }
        const int row0 = u.pm * BM + wr * 64 + fr, col0 = colt + wc * 32 + 8 * fq;
#pragma unroll
        for (int ai = 0; ai < 2; ++ai)
#pragma unroll
            for (int m = 0; m < 4; ++m) { bf16_t* rowp = base + (size_t)(row0 + ai * HALF + m * 16) * ldc + col0;
#pragma unroll
                for (int bj = 0; bj < 2; ++bj) { const f32x4 v0 = acc[ai][bj][m][0], v1 = acc[ai][bj][m][1];
                    u32x4 w; w.x = cvt_pk_bf16(v0[0], v0[1]); w.y = cvt_pk_bf16(v0[2], v0[3]); w.z = cvt_pk_bf16(v1[0], v1[1]); w.w = cvt_pk_bf16(v1[2], v1[3]);
                    *(u32x4*)(rowp + bj * HALF) = w; } }
    }
};
struct EpiLora {
    static constexpr bool PERM = false, AFTER_DRAIN = false;
    float* Wd; long offA, offG; const float *w0, *a0;
    __device__ __forceinline__ void operator()(const f32x4 (&acc)[2][2][4][2], const Unit& u, int wr, int wc, int fr, int fq) const {
        const int sec = u.pn >> 2, colt = (u.pn & 3) * 256;
        float* out = Wd + (sec == 0 ? 0l : (sec == 1 ? offA : offG));
        const float* bp = sec == 0 ? w0 : a0;
        const int row0 = (u.pm & 31) * BM + wr * 64 + fr, col0 = colt + wc * 32 + 4 * fq;
        f32x4 bv[2][2];
#pragma unroll
        for (int bj = 0; bj < 2; ++bj)
#pragma unroll
            for (int n = 0; n < 2; ++n) { const f32x4 t = *(const f32x4*)(bp + col0 + bj * HALF + n * 16); bv[bj][n] = sec == 2 ? (f32x4){0.f, 0.f, 0.f, 0.f} : t; }
#pragma unroll
        for (int ai = 0; ai < 2; ++ai)
#pragma unroll
            for (int m = 0; m < 4; ++m) { float* rowp = out + (size_t)(row0 + ai * HALF + m * 16) * 1024 + col0;
#pragma unroll
                for (int bj = 0; bj < 2; ++bj)
#pragma unroll
                    for (int n = 0; n < 2; ++n) { f32x4 v = acc[ai][bj][m][n] + bv[bj][n];
                        if (sec == 0) {
#pragma unroll
                            for (int j = 0; j < 4; ++j) { const float x = v[j]; const float sp = fmaxf(-x, 0.f) + __logf(1.0f + __expf(-fabsf(x)));
                                v[j] = __expf(-__expf(-sp - 0.5f)); }
                        } else if (sec == 1) {
#pragma unroll
                            for (int j = 0; j < 4; ++j) v[j] = __builtin_amdgcn_rcpf(1.0f + __expf(-v[j]));
                        }
                        if (sec == 0) *(f32x4*)(rowp + bj * HALF + n * 16) = v;
                        else { u32x2 w; w.x = cvt_pk_bf16(v[0], v[1]); w.y = cvt_pk_bf16(v[2], v[3]);
                            *(u32x2*)((bf16_t*)out + (size_t)(row0 + ai * HALF + m * 16) * 1024 + col0 + bj * HALF + n * 16) = w; } } }
    }
};
struct EpiGate {
    static constexpr bool PERM = true, AFTER_DRAIN = false;
    const bf16_t* gate; bf16_t* tmp; bf16_t* out;
    template <int MODE> __device__ __forceinline__ void run(const f32x4 (&acc)[2][2][4][2], const Unit& u, int wr, int wc, int fr, int fq) const {
        const int row0 = (u.pm & 31) * BM + wr * 64 + fr, col0 = (u.pn & 7) * BM + wc * 32 + 8 * fq;
        const bf16_t* gp = gate + MODE * 2048;
#pragma unroll
        for (int am = 0; am < 4; ++am) { const int ai = am >> 1, mh = (am & 1) * 2;
            u32x4 gw[2][2], tw[2][2];
            __builtin_amdgcn_sched_barrier(0);
#pragma unroll
            for (int mm = 0; mm < 2; ++mm) { const size_t row = (size_t)(row0 + ai * HALF + (mh + mm) * 16);
#pragma unroll
                for (int bj = 0; bj < 2; ++bj) { const int col = col0 + bj * HALF; gw[mm][bj] = *(const u32x4*)(gp + row * 6144 + col); if (MODE != 0) tw[mm][bj] = *(const u32x4*)(tmp + row * 2048 + col); } }
#pragma unroll
            for (int mm = 0; mm < 2; ++mm) { const int m = mh + mm; const size_t row = (size_t)(row0 + ai * HALF + m * 16);
#pragma unroll
                for (int bj = 0; bj < 2; ++bj) { const int col = col0 + bj * HALF; const u32x4 g = gw[mm][bj];
                    f32x4 v0 = acc[ai][bj][m][0], v1 = acc[ai][bj][m][1];
                    v0[0] *= sigmoidf_(bflo(g.x)); v0[1] *= sigmoidf_(bfhi(g.x)); v0[2] *= sigmoidf_(bflo(g.y)); v0[3] *= sigmoidf_(bfhi(g.y));
                    v1[0] *= sigmoidf_(bflo(g.z)); v1[1] *= sigmoidf_(bfhi(g.z)); v1[2] *= sigmoidf_(bflo(g.w)); v1[3] *= sigmoidf_(bfhi(g.w));
                    if (MODE != 0) { const u32x4 t = tw[mm][bj]; v0[0] += bflo(t.x); v0[1] += bfhi(t.x); v0[2] += bflo(t.y); v0[3] += bfhi(t.y); v1[0] += bflo(t.z); v1[1] += bfhi(t.z); v1[2] += bflo(t.w); v1[3] += bfhi(t.w); }
                    u32x4 w; w.x = cvt_pk_bf16(v0[0], v0[1]); w.y = cvt_pk_bf16(v0[2], v0[3]); w.z = cvt_pk_bf16(v1[0], v1[1]); w.w = cvt_pk_bf16(v1[2], v1[3]);
                    *(u32x4*)((MODE != 2 ? tmp : out) + row * 2048 + col) = w; } }
        }
    }
    __device__ __forceinline__ void operator()(const f32x4 (&acc)[2][2][4][2], const Unit& u, int wr, int wc, int fr, int fq) const {
        const int mode = u.pn >> 3;
        if (mode == 0) run<0>(acc, u, wr, wc, fr, fq); else if (mode == 1) run<1>(acc, u, wr, wc, fr, fq); else run<2>(acc, u, wr, wc, fr, fq);
    }
};
struct LoraOrder {
    int G, c;
    __device__ __forceinline__ bool next(int i, Unit& u) const { const int L = i * G + c; if (L >= 384) return false; const int sec = L >> 7, rem = L & 127; u.pm = sec * 32 + (rem >> 2); u.pn = sec * 4 + (rem & 3); return true; }
    __device__ __forceinline__ void a_ready(const Unit&) const {}
    __device__ __forceinline__ void done(const Unit&) const {}
};
struct BranchOrder {
    StaticOrder so;
    __device__ __forceinline__ bool next(int i, Unit& u) const { Unit t; if (!so.next(i / 3, t)) return false; const int n = i % 3; u.pm = n * 32 + t.pm; u.pn = n * 8 + t.pn; return true; }
    __device__ __forceinline__ void a_ready(const Unit&) const {}
    __device__ __forceinline__ void done(const Unit&) const {}
};
struct EpiWo {
    static constexpr bool PERM = false, AFTER_DRAIN = false;
    const float* xin; float* out; float alpha; const bf16_t* xb;
    __device__ __forceinline__ void operator()(const f32x4 (&acc)[2][2][4][2], const Unit& u, int wr, int wc, int fr, int fq) const {
        const int row0 = u.pm * BM + wr * 64 + fr, col0 = u.pn * BM + wc * 32 + 4 * fq;
        if (xin) {
#pragma unroll
        for (int ai = 0; ai < 2; ++ai)
#pragma unroll
            for (int m = 0; m < 4; ++m) { const size_t off = (size_t)(row0 + ai * HALF + m * 16) * 2048 + col0;
#pragma unroll
                for (int bj = 0; bj < 2; ++bj)
#pragma unroll
                    for (int n = 0; n < 2; ++n) { const f32x4 xv = *(const f32x4*)(xin + off + bj * HALF + n * 16);
                        *(f32x4*)(out + off + bj * HALF + n * 16) = xv * alpha + acc[ai][bj][m][n]; } }
        } else {
#pragma unroll
        for (int ai = 0; ai < 2; ++ai)
#pragma unroll
            for (int m = 0; m < 4; ++m) { const size_t off = (size_t)(row0 + ai * HALF + m * 16) * 2048 + col0;
#pragma unroll
                for (int bj = 0; bj < 2; ++bj)
#pragma unroll
                    for (int n = 0; n < 2; ++n) { const unsigned long long w = *(const unsigned long long*)(xb + off + bj * HALF + n * 16); const unsigned lo = (unsigned)w, hi = (unsigned)(w >> 32);
                        const f32x4 xv = {bflo(lo), bfhi(lo), bflo(hi), bfhi(hi)};
                        *(f32x4*)(out + off + bj * HALF + n * 16) = xv * alpha + acc[ai][bj][m][n]; } }
        }
    }
};
struct PanelStats8 {
    unsigned* xbuf;
    unsigned* cnt;
    unsigned* tmo;
    float eps;
    __device__ __forceinline__ bool run(const f32x4 (&v)[2][2][4][2], const Unit& u, int wr, int wc, int fr, int fq, PG8_LAS unsigned char* lds, int wid, int lane) const {
        typedef float f32x2v __attribute__((ext_vector_type(2)));
        PG8_LAS f32x2v* P = (PG8_LAS f32x2v*)lds;
        PG8_LAS f32x2v* S = (PG8_LAS f32x2v*)(lds + 8192);
        PG8_LAS unsigned* flag = (PG8_LAS unsigned*)(lds + 8192 + 2048);
#pragma unroll
        for (int ai = 0; ai < 2; ++ai)
#pragma unroll
            for (int m = 0; m < 4; ++m) {
                float s = 0.f;
#pragma unroll
                for (int bj = 0; bj < 2; ++bj)
#pragma unroll
                    for (int n = 0; n < 2; ++n) { const f32x4 x = v[ai][bj][m][n]; s += (x[0] + x[1]) + (x[2] + x[3]); }
                s += __shfl_xor(s, 16); s += __shfl_xor(s, 32);
                const float mw = s * (1.0f / 64.0f); float q = 0.f;
#pragma unroll
                for (int bj = 0; bj < 2; ++bj)
#pragma unroll
                    for (int n = 0; n < 2; ++n) { const f32x4 d = v[ai][bj][m][n] - mw; q += (d[0] * d[0] + d[1] * d[1]) + (d[2] * d[2] + d[3] * d[3]); }
                q += __shfl_xor(q, 16); q += __shfl_xor(q, 32);
                if (fq == 0) P[(ai * HALF + wr * 64 + m * 16 + fr) * 4 + wc] = (f32x2v){mw, q};
            }
        asm volatile("s_waitcnt lgkmcnt(0)" ::: "memory"); __builtin_amdgcn_s_barrier(); asm volatile("" ::: "memory");
        const int row = wid * 32 + (lane & 31);
        if (lane < 32) {
            const f32x2v a = P[row * 4 + 0], b = P[row * 4 + 1], c = P[row * 4 + 2], d = P[row * 4 + 3];
            const float mt = (a.x + b.x + c.x + d.x) * 0.25f;
            const float da = a.x - mt, db = b.x - mt, dc = c.x - mt, dd = d.x - mt;
            const float m2 = (a.y + b.y) + (c.y + d.y) + 64.0f * ((da * da + db * db) + (dc * dc + dd * dd));
            unsigned long long* slot = (unsigned long long*)xbuf + ((size_t)(u.pm * BM + row) * 8 + u.pn);
            __hip_atomic_store(slot, ((unsigned long long)__float_as_uint(m2) << 32) | __float_as_uint(mt), __ATOMIC_RELAXED, __HIP_MEMORY_SCOPE_AGENT);
        }
        asm volatile("s_waitcnt vmcnt(0)" ::: "memory");
        if (lane == 0) __hip_atomic_fetch_add(cnt + 64 * u.pm, 1u, __ATOMIC_RELAXED, __HIP_MEMORY_SCOPE_AGENT);
        if (wid == 0) {
            bool dead = false; const unsigned long long t0 = __builtin_amdgcn_s_memrealtime(); const unsigned want = 64u;
            for (;;) {
                if ((unsigned)__builtin_amdgcn_readfirstlane(__hip_atomic_load(cnt + 64 * u.pm, __ATOMIC_RELAXED, __HIP_MEMORY_SCOPE_AGENT)) >= want) break;
                if (__builtin_amdgcn_s_memrealtime() - t0 > 2000000ull) { if (lane == 0) __hip_atomic_store(tmo, 1u, __ATOMIC_RELAXED, __HIP_MEMORY_SCOPE_AGENT); dead = true; break; }
                __builtin_amdgcn_s_sleep(2);
            }
            __builtin_amdgcn_fence(__ATOMIC_ACQUIRE, "agent");
            if (lane == 0) flag[0] = dead ? 1u : 0u;
        }
        asm volatile("s_waitcnt vmcnt(0) lgkmcnt(0)" ::: "memory"); __builtin_amdgcn_s_barrier(); asm volatile("" ::: "memory");
        const bool bad = flag[0] != 0u;
        if (lane < 32) {
            const unsigned long long* slot = (const unsigned long long*)xbuf + (size_t)(u.pm * BM + row) * 8; float mt[8], m2[8]; float ms = 0.f;
#pragma unroll
            for (int t = 0; t < 8; ++t) { const unsigned long long w = __hip_atomic_load(slot + t, __ATOMIC_RELAXED, __HIP_MEMORY_SCOPE_AGENT); mt[t] = __uint_as_float((unsigned)w); m2[t] = __uint_as_float((unsigned)(w >> 32)); ms += mt[t]; }
            const float mean = ms * 0.125f; float q = 0.f;
#pragma unroll
            for (int t = 0; t < 8; ++t) { const float dm = mt[t] - mean; q += m2[t] + 256.0f * dm * dm; }
            S[row] = (f32x2v){mean, 1.0f / sqrtf(q * (1.0f / 2048.0f) + eps)};
        }
        asm volatile("s_waitcnt lgkmcnt(0)" ::: "memory"); __builtin_amdgcn_s_barrier(); asm volatile("" ::: "memory");
        return bad;
    }
};
struct EpiWoLn {
    static constexpr bool PERM = false, AFTER_DRAIN = true;
    const float* xin; float* x1; bf16_t* xs; const float* g; const float* b; float alpha; PanelStats8 st;
    __device__ __forceinline__ void fused(f32x4 (&acc)[2][2][4][2], const Unit& u, int wr, int wc, int fr, int fq, PG8_LAS unsigned char* lds, int wid, int lane) const {
        typedef float f32x2v __attribute__((ext_vector_type(2))); typedef unsigned u32x2v __attribute__((ext_vector_type(2)));
        const PG8_LAS f32x2v* S = (const PG8_LAS f32x2v*)(lds + 8192);
        const int col0 = u.pn * BM + wc * 32 + 4 * fq;
#pragma unroll
        for (int ai = 0; ai < 2; ++ai)
#pragma unroll
            for (int m = 0; m < 4; ++m) { const size_t off = (size_t)(u.pm * BM + ai * HALF + wr * 64 + m * 16 + fr) * 2048 + col0;
#pragma unroll
                for (int bj = 0; bj < 2; ++bj)
#pragma unroll
                    for (int n = 0; n < 2; ++n) acc[ai][bj][m][n] += *(const f32x4*)(xin + off + bj * HALF + n * 16) * alpha;
                asm volatile("" : "+v"(acc[ai][0][m][0]), "+v"(acc[ai][0][m][1]), "+v"(acc[ai][1][m][0]), "+v"(acc[ai][1][m][1]));
            }
        const bool bad = st.run(acc, u, wr, wc, fr, fq, lds, wid, lane);
        const float qnan = __builtin_nanf("");
        f32x4 gv[2][2], bv[2][2];
#pragma unroll
        for (int bj = 0; bj < 2; ++bj)
#pragma unroll
            for (int n = 0; n < 2; ++n) { gv[bj][n] = *(const f32x4*)(g + col0 + bj * HALF + n * 16); bv[bj][n] = *(const f32x4*)(b + col0 + bj * HALF + n * 16); }
#pragma unroll
        for (int ai = 0; ai < 2; ++ai)
#pragma unroll
            for (int m = 0; m < 4; ++m) { const int r = ai * HALF + wr * 64 + m * 16 + fr; const f32x2v sr = S[r]; const size_t off = (size_t)(u.pm * BM + r) * 2048 + col0;
#pragma unroll
                for (int bj = 0; bj < 2; ++bj)
#pragma unroll
                    for (int n = 0; n < 2; ++n) { f32x4 o = (acc[ai][bj][m][n] - sr.x) * sr.y * gv[bj][n] + bv[bj][n];
                        if (bad) o = (f32x4){qnan, qnan, qnan, qnan};
                        *(f32x4*)(x1 + off + bj * HALF + n * 16) = o;
                        u32x2v w; w.x = cvt_pk_bf16(o[0], o[1]); w.y = cvt_pk_bf16(o[2], o[3]); *(u32x2v*)(xs + off + bj * HALF + n * 16) = w; } }
    }
};
template <bool WT  > struct EpiSwiglu {
    static constexpr bool PERM = true, AFTER_DRAIN = false;
    bf16_t* H; const float* roww;
    __device__ __forceinline__ void operator()(const f32x4 (&acc)[2][2][4][2], const Unit& u, int wr, int wc, int fr, int fq) const {
        const int row0 = u.pm * BM + wr * 64 + fr, col0 = (u.pn & 3) * 128 + wc * 32 + 8 * fq;
        float rw[2][4];
#pragma unroll
        for (int ai = 0; ai < 2; ++ai)
#pragma unroll
            for (int m = 0; m < 4; ++m) rw[ai][m] = roww[row0 + ai * HALF + m * 16];
#pragma unroll
        for (int ai = 0; ai < 2; ++ai)
#pragma unroll
            for (int m = 0; m < 4; ++m) { bf16_t* rowp = H + (size_t)(row0 + ai * HALF + m * 16) * 512 + col0;
                float h[8];
#pragma unroll
                for (int n = 0; n < 2; ++n)
#pragma unroll
                    for (int j = 0; j < 4; ++j) { const float g = acc[ai][0][m][n][j], up = acc[ai][1][m][n][j]; h[n * 4 + j] = g * sigmoidf_(g) * up * rw[ai][m]; }
                u32x4 w; w.x = cvt_pk_bf16(h[0], h[1]); w.y = cvt_pk_bf16(h[2], h[3]); w.z = cvt_pk_bf16(h[4], h[5]); w.w = cvt_pk_bf16(h[6], h[7]);
                if (WT) st16_sc1(rowp, w); else *(u32x4*)rowp = w; }
    }
};
struct EpiDown {
    static constexpr bool PERM = true, AFTER_DRAIN = false;
    bf16_t* Y; const float* roww;
    __device__ __forceinline__ void operator()(const f32x4 (&acc)[2][2][4][2], const Unit& u, int wr, int wc, int fr, int fq) const {
        const int row0 = u.pm * BM + wr * 64 + fr, col0 = (u.pn & 7) * 256 + wc * 32 + 8 * fq;
#pragma unroll
        for (int ai = 0; ai < 2; ++ai)
#pragma unroll
            for (int m = 0; m < 4; ++m) { const int row = row0 + ai * HALF + m * 16; bf16_t* rowp = Y + (size_t)row * 2048 + col0;
#pragma unroll
                for (int bj = 0; bj < 2; ++bj) { const f32x4 v0 = acc[ai][bj][m][0], v1 = acc[ai][bj][m][1];
                    u32x4 w; w.x = cvt_pk_bf16(v0[0], v0[1]); w.y = cvt_pk_bf16(v0[2], v0[3]); w.z = cvt_pk_bf16(v1[0], v1[1]); w.w = cvt_pk_bf16(v1[2], v1[3]);
                    *(u32x4*)(rowp + bj * HALF) = w; } }
    }
};
struct MoeOrder {
    const int* seg; int ntiles, npn, G, c;
    unsigned* cnt; unsigned* tmo; int mode;
    __device__ __forceinline__ bool next(int i, Unit& u) const {
        const long L = (long)i * G + c; if (L >= (long)ntiles * npn) return false;
        const int pm = (int)(L / npn), pl = (int)(L % npn); u.pm = pm; u.pn = __builtin_amdgcn_readfirstlane(__hip_atomic_load(seg + pm, __ATOMIC_RELAXED, __HIP_MEMORY_SCOPE_AGENT)) * npn + pl; return true;
    }
    __device__ __forceinline__ void a_ready(const Unit& u) const {
        if (mode != 2) return;
        if (threadIdx.x < 64) {
            const unsigned long long t0 = __builtin_amdgcn_s_memrealtime(); unsigned polls = 0;
            while ((unsigned)__builtin_amdgcn_readfirstlane(__hip_atomic_load(cnt + 64 * u.pm, __ATOMIC_RELAXED, __HIP_MEMORY_SCOPE_AGENT)) < 32u) {
                if ((++polls & 255u) == 0u && __builtin_amdgcn_readfirstlane(__hip_atomic_load(tmo, __ATOMIC_RELAXED, __HIP_MEMORY_SCOPE_AGENT)) != 0u) break;
                if (__builtin_amdgcn_s_memrealtime() - t0 > 2000000ull) { if (threadIdx.x == 0) __hip_atomic_store(tmo, 1u, __ATOMIC_RELAXED, __HIP_MEMORY_SCOPE_AGENT); break; }
                __builtin_amdgcn_s_sleep(2); }
            __builtin_amdgcn_fence(__ATOMIC_ACQUIRE, "agent");
            asm volatile("s_waitcnt vmcnt(0)" ::: "memory");
        }
        asm volatile("" ::: "memory"); __builtin_amdgcn_s_barrier(); asm volatile("" ::: "memory");
    }
    __device__ __forceinline__ void done(const Unit& u) const {
        if (mode != 1) return;
        asm volatile("s_waitcnt vmcnt(0)" ::: "memory");
#ifdef HANDOFF_FENCE
        __builtin_amdgcn_fence(__ATOMIC_RELEASE, "agent"); asm volatile("s_waitcnt vmcnt(0)" ::: "memory");
#endif
        if ((threadIdx.x & 63) == 0) __hip_atomic_fetch_add(cnt + 64 * u.pm, 1u, __ATOMIC_RELAXED, __HIP_MEMORY_SCOPE_AGENT);
    }
};
template <class Epi, class Sched, bool ALIGN_EPI = false, bool SP2 = false>
__device__ __forceinline__ void gemm_phase(PG8_LAS unsigned char* lds, const Gemm g, const Sched& S, const Epi& E) {
    const int tid = otid(), wid = __builtin_amdgcn_readfirstlane(tid >> 6), lane = tid & 63, wr = wid >> 2, wc = wid & 3, fr = lane & 15, fq = lane >> 4;
    const int K = g.K, nt = K / BK;
    unsigned voffA[2], voffB[2];
#pragma unroll
    for (int i = 0; i < 2; ++i) { int R, C; stage_rc(tid * 16 + i * 8192, R, C); const int Rb = Epi::PERM ? ((R & ~31) + perm32(R & 31)) : R;
        voffA[i] = (unsigned)(R * K + C) * 2u; voffB[i] = (unsigned)(Rb * K + C) * 2u; }
    const size_t kstep = (size_t)(BK * 2);
    const size_t hstep = (size_t)HALF * K * 2;
    const size_t tstep = 2 * hstep;
    const unsigned ldsw = (unsigned)wid * 1024u;
    const int aoff = lds_byte(wr * 64 + fr, fq * 8), boff = lds_byte(wc * 32 + fr, fq * 8);
#define PG8_SA(b, h) (((b) * 2 + (h)) * HTB)
#define PG8_SB(b, h) ((4 + (b) * 2 + (h)) * HTB)
#define PG8_STAGE(bufoff, gbase, voff) do { _Pragma("unroll") for (int _i = 0; _i < 2; ++_i) \
        __builtin_amdgcn_global_load_lds((const unsigned*)((const char*)(gbase) + (voff)[_i]), (PG8_LAS unsigned*)(lds + (bufoff) + ldsw + _i * 8192), 16, 0, 0); } while (0)
#define PG8_LDA(dst, b, h) do { _Pragma("unroll") for (int m = 0; m < 4; ++m) _Pragma("unroll") for (int k = 0; k < 2; ++k) dst[m][k] = *(const PG8_LAS bf16x8*)(lds + PG8_SA(b, h) + aoff + m * 2048 + k * 1024); } while (0)
#define PG8_LDB(dst, b, h) do { _Pragma("unroll") for (int n = 0; n < 2; ++n) _Pragma("unroll") for (int k = 0; k < 2; ++k) dst[n][k] = *(const PG8_LAS bf16x8*)(lds + PG8_SB(b, h) + boff + n * 2048 + k * 1024); } while (0)
#define PG8_MMA(ai, bj, At, Bt) do { __builtin_amdgcn_s_setprio(1); _Pragma("unroll") for (int m = 0; m < 4; ++m) _Pragma("unroll") for (int n = 0; n < 2; ++n) _Pragma("unroll") for (int k = 0; k < 2; ++k) \
        acc[ai][bj][m][n] = __builtin_amdgcn_mfma_f32_16x16x32_bf16(Bt[n][k], At[m][k], acc[ai][bj][m][n], 0, 0, 0); __builtin_amdgcn_s_setprio(0); } while (0)
#define PG8_WAIT_V(n) asm volatile("s_waitcnt vmcnt(" #n ")" ::: "memory")
#define PG8_WAIT_L(n) asm volatile("s_waitcnt lgkmcnt(" #n ")" ::: "memory")
#define PG8_BAR __builtin_amdgcn_s_barrier()
#define PG8_SCHED __builtin_amdgcn_sched_barrier(0)
    Unit cur, nxt; int ui = 0;
    if (!S.next(0, cur)) return;
    f32x4 acc[2][2][4][2];
#pragma unroll
    for (int a = 0; a < 2; ++a)
#pragma unroll
        for (int b = 0; b < 2; ++b)
#pragma unroll
            for (int m = 0; m < 4; ++m)
#pragma unroll
                for (int n = 0; n < 2; ++n) acc[a][b][m][n] = (f32x4){0.f, 0.f, 0.f, 0.f};
    bf16x8 At[4][2], B0[2][2], B1[2][2];
    const char* cA = (const char*)g.A + (size_t)cur.pm * tstep; const char* cB = (const char*)g.Bt + (size_t)cur.pn * tstep;
    S.a_ready(cur);
    if constexpr (SP2) {
        PG8_STAGE(PG8_SB(0, 0), cB, voffB); PG8_STAGE(PG8_SB(0, 1), cB + hstep, voffB); PG8_STAGE(PG8_SA(0, 0), cA, voffA); PG8_STAGE(PG8_SA(0, 1), cA + hstep, voffA);
        if (wr == 1) PG8_BAR;
        PG8_WAIT_V(2); PG8_BAR;
        PG8_STAGE(PG8_SB(1, 0), cB + kstep, voffB); PG8_STAGE(PG8_SA(1, 0), cA + kstep, voffA); PG8_STAGE(PG8_SB(1, 1), cB + hstep + kstep, voffB);
        PG8_WAIT_V(6); PG8_BAR;
    } else {
        PG8_STAGE(PG8_SB(0, 0), cB, voffB); PG8_STAGE(PG8_SA(0, 0), cA, voffA); PG8_STAGE(PG8_SB(0, 1), cB + hstep, voffB); PG8_STAGE(PG8_SA(0, 1), cA + hstep, voffA);
        if (wr == 1) PG8_BAR;
        PG8_WAIT_V(4); PG8_BAR;
        PG8_STAGE(PG8_SB(1, 0), cB + kstep, voffB); PG8_STAGE(PG8_SA(1, 0), cA + kstep, voffA); PG8_STAGE(PG8_SB(1, 1), cB + hstep + kstep, voffB);
        PG8_WAIT_V(6); PG8_BAR;
    }
    for (;;) {
        const bool has_next = S.next(ui + 1, nxt);
        const char* nA = has_next ? (const char*)g.A + (size_t)nxt.pm * tstep : cA; const char* nB = has_next ? (const char*)g.Bt + (size_t)nxt.pn * tstep : cB;
        for (int t = 0; t < nt; t += 2) {
            const bool last = (t == nt - 2);
            const char* a1 = cA + (size_t)(t + 1) * kstep;
            const char* a2 = last ? nA : cA + (size_t)(t + 2) * kstep; const char* b2 = last ? nB : cB + (size_t)(t + 2) * kstep;
            const char* a3 = a2 + kstep; const char* b3 = b2 + kstep;
            if (last && has_next) S.a_ready(nxt);
            if constexpr (SP2) {
            PG8_LDB(B0, 0, 0); PG8_LDB(B1, 0, 1); PG8_SCHED; PG8_LDA(At, 0, 0); PG8_STAGE(PG8_SA(1, 1), a1 + hstep, voffA);
            PG8_WAIT_V(8); PG8_WAIT_L(0); PG8_BAR; PG8_MMA(0, 0, At, B0); PG8_MMA(0, 1, At, B1); PG8_BAR; PG8_SCHED;
            PG8_LDA(At, 0, 1); PG8_STAGE(PG8_SB(0, 0), b2, voffB); PG8_STAGE(PG8_SB(0, 1), b2 + hstep, voffB); PG8_STAGE(PG8_SA(0, 0), a2, voffA);
            PG8_WAIT_V(8); PG8_WAIT_L(0); PG8_BAR; PG8_MMA(1, 0, At, B0); PG8_MMA(1, 1, At, B1); PG8_BAR; PG8_SCHED;
            PG8_LDB(B0, 1, 0); PG8_LDB(B1, 1, 1); PG8_SCHED; PG8_LDA(At, 1, 0); PG8_STAGE(PG8_SA(0, 1), a2 + hstep, voffA);
            PG8_WAIT_V(8); PG8_WAIT_L(0); PG8_BAR; PG8_MMA(0, 0, At, B0); PG8_MMA(0, 1, At, B1); PG8_BAR; PG8_SCHED;
            PG8_LDA(At, 1, 1); PG8_STAGE(PG8_SB(1, 0), b3, voffB); PG8_STAGE(PG8_SB(1, 1), b3 + hstep, voffB); PG8_STAGE(PG8_SA(1, 0), a3, voffA);
            PG8_WAIT_V(8); PG8_WAIT_L(0); PG8_BAR; PG8_MMA(1, 0, At, B0); PG8_MMA(1, 1, At, B1); PG8_BAR; PG8_SCHED;
            } else {
            PG8_LDB(B0, 0, 0); PG8_SCHED; PG8_LDA(At, 0, 0); PG8_STAGE(PG8_SA(1, 1), a1 + hstep, voffA);
            PG8_WAIT_L(8); PG8_BAR; PG8_WAIT_L(0); PG8_MMA(0, 0, At, B0); PG8_BAR; PG8_SCHED;
            PG8_LDB(B1, 0, 1); PG8_STAGE(PG8_SB(0, 0), b2, voffB);
            PG8_BAR; PG8_WAIT_L(0); PG8_MMA(0, 1, At, B1); PG8_BAR;
            PG8_LDA(At, 0, 1); PG8_STAGE(PG8_SA(0, 0), a2, voffA);
            PG8_BAR; PG8_WAIT_L(0); PG8_MMA(1, 0, At, B0); PG8_BAR; PG8_SCHED;
            PG8_STAGE(PG8_SB(0, 1), b2 + hstep, voffB);
            PG8_WAIT_V(6); PG8_BAR; PG8_MMA(1, 1, At, B1); PG8_BAR;
            PG8_LDB(B0, 1, 0); PG8_SCHED; PG8_LDA(At, 1, 0); PG8_STAGE(PG8_SA(0, 1), a2 + hstep, voffA);
            PG8_WAIT_L(8); PG8_BAR; PG8_WAIT_L(0); PG8_MMA(0, 0, At, B0); PG8_BAR; PG8_SCHED;
            PG8_LDB(B1, 1, 1); PG8_STAGE(PG8_SB(1, 0), b3, voffB);
            PG8_BAR; PG8_WAIT_L(0); PG8_MMA(0, 1, At, B1); PG8_BAR;
            PG8_LDA(At, 1, 1); PG8_STAGE(PG8_SA(1, 0), a3, voffA);
            PG8_BAR; PG8_WAIT_L(0); PG8_MMA(1, 0, At, B0); PG8_BAR; PG8_SCHED;
            PG8_STAGE(PG8_SB(1, 1), b3 + hstep, voffB);
            PG8_WAIT_V(6); PG8_BAR; PG8_MMA(1, 1, At, B1); PG8_BAR;
            }
        }
        if constexpr (ALIGN_EPI) { if (wr == 0) PG8_BAR; }
        if constexpr (!Epi::AFTER_DRAIN) { E(acc, cur, wr, wc, fr, fq); S.done(cur); }
        if (!has_next) break;
#pragma unroll
        for (int a = 0; a < 2; ++a)
#pragma unroll
            for (int b = 0; b < 2; ++b)
#pragma unroll
                for (int m = 0; m < 4; ++m)
#pragma unroll
                    for (int n = 0; n < 2; ++n) acc[a][b][m][n] = (f32x4){0.f, 0.f, 0.f, 0.f};
        cur = nxt; cA = nA; cB = nB; ++ui;
        if constexpr (ALIGN_EPI) { if (wr == 1) PG8_BAR; }
    }
    PG8_WAIT_V(0);
    if constexpr (!ALIGN_EPI) { if (wr == 0) PG8_BAR; }
    PG8_BAR;
    if constexpr (Epi::AFTER_DRAIN) { E.fused(acc, cur, wr, wc, fr, fq, lds, wid, lane); S.done(cur); }
#undef PG8_SA
#undef PG8_SB
#undef PG8_STAGE
#undef PG8_LDA
#undef PG8_LDB
#undef PG8_MMA
#undef PG8_WAIT_V
#undef PG8_WAIT_L
#undef PG8_BAR
#undef PG8_SCHED
}

template <class Epi, class Sched, bool ALIGN_EPI = false, bool SP2 = true>
__device__ __forceinline__ void gemm_phase_gather(PG8_LAS unsigned char* lds, const Gemm g, const Sched& S, const Epi& E, const int* rowtab) {
    static_assert(SP2, "gather variant: SP2 loop only");
    const int tid = otid(), wid = __builtin_amdgcn_readfirstlane(tid >> 6), lane = tid & 63, wr = wid >> 2, wc = wid & 3, fr = lane & 15, fq = lane >> 4;
    const int K = g.K, nt = K / BK;
    unsigned voffA[2], voffB[2]; int RA[2]; unsigned CA[2];
#pragma unroll
    for (int i = 0; i < 2; ++i) { int R, C; stage_rc(tid * 16 + i * 8192, R, C); const int Rb = Epi::PERM ? ((R & ~31) + perm32(R & 31)) : R;
        voffA[i] = (unsigned)(R * K + C) * 2u; voffB[i] = (unsigned)(Rb * K + C) * 2u; RA[i] = R; CA[i] = (unsigned)C * 2u; }
    unsigned gA[4], gN[4];
#define PG8_GLOAD(G, pm_) do { _Pragma("unroll") for (int h_ = 0; h_ < 2; ++h_) _Pragma("unroll") for (int i_ = 0; i_ < 2; ++i_) \
        G[2 * h_ + i_] = (unsigned)rowtab[(pm_) * BM + h_ * HALF + RA[i_]] * (unsigned)(K * 2) + CA[i_]; } while (0)
#define PG8_STAGEG(bufoff, gbase, G, h_) do { _Pragma("unroll") for (int _i = 0; _i < 2; ++_i) \
        __builtin_amdgcn_global_load_lds((const unsigned*)((const char*)(gbase) + G[2 * (h_) + _i]), (PG8_LAS unsigned*)(lds + (bufoff) + ldsw + _i * 8192), 16, 0, 0); } while (0)
    const size_t kstep = (size_t)(BK * 2);
    const size_t hstep = (size_t)HALF * K * 2;
    const size_t tstep = 2 * hstep;
    const unsigned ldsw = (unsigned)wid * 1024u;
    const int aoff = lds_byte(wr * 64 + fr, fq * 8), boff = lds_byte(wc * 32 + fr, fq * 8);
#define PG8_SA(b, h) (((b) * 2 + (h)) * HTB)
#define PG8_SB(b, h) ((4 + (b) * 2 + (h)) * HTB)
#define PG8_STAGE(bufoff, gbase, voff) do { _Pragma("unroll") for (int _i = 0; _i < 2; ++_i) \
        __builtin_amdgcn_global_load_lds((const unsigned*)((const char*)(gbase) + (voff)[_i]), (PG8_LAS unsigned*)(lds + (bufoff) + ldsw + _i * 8192), 16, 0, 0); } while (0)
#define PG8_LDA(dst, b, h) do { _Pragma("unroll") for (int m = 0; m < 4; ++m) _Pragma("unroll") for (int k = 0; k < 2; ++k) dst[m][k] = *(const PG8_LAS bf16x8*)(lds + PG8_SA(b, h) + aoff + m * 2048 + k * 1024); } while (0)
#define PG8_LDB(dst, b, h) do { _Pragma("unroll") for (int n = 0; n < 2; ++n) _Pragma("unroll") for (int k = 0; k < 2; ++k) dst[n][k] = *(const PG8_LAS bf16x8*)(lds + PG8_SB(b, h) + boff + n * 2048 + k * 1024); } while (0)
#define PG8_MMA(ai, bj, At, Bt) do { __builtin_amdgcn_s_setprio(1); _Pragma("unroll") for (int m = 0; m < 4; ++m) _Pragma("unroll") for (int n = 0; n < 2; ++n) _Pragma("unroll") for (int k = 0; k < 2; ++k) \
        acc[ai][bj][m][n] = __builtin_amdgcn_mfma_f32_16x16x32_bf16(Bt[n][k], At[m][k], acc[ai][bj][m][n], 0, 0, 0); __builtin_amdgcn_s_setprio(0); } while (0)
#define PG8_WAIT_V(n) asm volatile("s_waitcnt vmcnt(" #n ")" ::: "memory")
#define PG8_WAIT_L(n) asm volatile("s_waitcnt lgkmcnt(" #n ")" ::: "memory")
#define PG8_BAR __builtin_amdgcn_s_barrier()
#define PG8_SCHED __builtin_amdgcn_sched_barrier(0)
    Unit cur, nxt; int ui = 0;
    if (!S.next(0, cur)) return;
    f32x4 acc[2][2][4][2];
#pragma unroll
    for (int a = 0; a < 2; ++a)
#pragma unroll
        for (int b = 0; b < 2; ++b)
#pragma unroll
            for (int m = 0; m < 4; ++m)
#pragma unroll
                for (int n = 0; n < 2; ++n) acc[a][b][m][n] = (f32x4){0.f, 0.f, 0.f, 0.f};
    bf16x8 At[4][2], B0[2][2], B1[2][2];
    const char* A0 = (const char*)g.A; const char* cB = (const char*)g.Bt + (size_t)cur.pn * tstep;
    PG8_GLOAD(gA, cur.pm);
    S.a_ready(cur);
    if constexpr (SP2) {
        PG8_STAGE(PG8_SB(0, 0), cB, voffB); PG8_STAGE(PG8_SB(0, 1), cB + hstep, voffB); PG8_STAGEG(PG8_SA(0, 0), A0, gA, 0); PG8_STAGEG(PG8_SA(0, 1), A0, gA, 1);
        if (wr == 1) PG8_BAR;
        PG8_WAIT_V(2); PG8_BAR;
        PG8_STAGE(PG8_SB(1, 0), cB + kstep, voffB); PG8_STAGEG(PG8_SA(1, 0), A0 + kstep, gA, 0); PG8_STAGE(PG8_SB(1, 1), cB + hstep + kstep, voffB);
        PG8_WAIT_V(6); PG8_BAR;
    } else {
        ;
    }
    for (;;) {
        const bool has_next = S.next(ui + 1, nxt);
        const char* nB = has_next ? (const char*)g.Bt + (size_t)nxt.pn * tstep : cB;
        if (has_next) PG8_GLOAD(gN, nxt.pm); else { gN[0] = gA[0]; gN[1] = gA[1]; gN[2] = gA[2]; gN[3] = gA[3]; }
        for (int t = 0; t < nt; t += 2) {
            const bool last = (t == nt - 2);
            const char* a1 = A0 + (size_t)(t + 1) * kstep;
            const char* a2 = last ? A0 : A0 + (size_t)(t + 2) * kstep; const char* b2 = last ? nB : cB + (size_t)(t + 2) * kstep;
            unsigned gs[4] = {gA[0], gA[1], gA[2], gA[3]};
            if (last) { gs[0] = gN[0]; gs[1] = gN[1]; gs[2] = gN[2]; gs[3] = gN[3]; }
            const char* a3 = a2 + kstep; const char* b3 = b2 + kstep;
            if (last && has_next) S.a_ready(nxt);
            if constexpr (SP2) {
            PG8_LDB(B0, 0, 0); PG8_LDB(B1, 0, 1); PG8_SCHED; PG8_LDA(At, 0, 0); PG8_STAGEG(PG8_SA(1, 1), a1, gA, 1);
            PG8_WAIT_V(8); PG8_WAIT_L(0); PG8_BAR; PG8_MMA(0, 0, At, B0); PG8_MMA(0, 1, At, B1); PG8_BAR; PG8_SCHED;
            PG8_LDA(At, 0, 1); PG8_STAGE(PG8_SB(0, 0), b2, voffB); PG8_STAGE(PG8_SB(0, 1), b2 + hstep, voffB); PG8_STAGEG(PG8_SA(0, 0), a2, gs, 0);
            PG8_WAIT_V(8); PG8_WAIT_L(0); PG8_BAR; PG8_MMA(1, 0, At, B0); PG8_MMA(1, 1, At, B1); PG8_BAR; PG8_SCHED;
            PG8_LDB(B0, 1, 0); PG8_LDB(B1, 1, 1); PG8_SCHED; PG8_LDA(At, 1, 0); PG8_STAGEG(PG8_SA(0, 1), a2, gs, 1);
            PG8_WAIT_V(8); PG8_WAIT_L(0); PG8_BAR; PG8_MMA(0, 0, At, B0); PG8_MMA(0, 1, At, B1); PG8_BAR; PG8_SCHED;
            PG8_LDA(At, 1, 1); PG8_STAGE(PG8_SB(1, 0), b3, voffB); PG8_STAGE(PG8_SB(1, 1), b3 + hstep, voffB); PG8_STAGEG(PG8_SA(1, 0), a3, gs, 0);
            PG8_WAIT_V(8); PG8_WAIT_L(0); PG8_BAR; PG8_MMA(1, 0, At, B0); PG8_MMA(1, 1, At, B1); PG8_BAR; PG8_SCHED;
            }
        }
        if constexpr (ALIGN_EPI) { if (wr == 0) PG8_BAR; }
        if constexpr (!Epi::AFTER_DRAIN) { E(acc, cur, wr, wc, fr, fq); S.done(cur); }
        if (!has_next) break;
#pragma unroll
        for (int a = 0; a < 2; ++a)
#pragma unroll
            for (int b = 0; b < 2; ++b)
#pragma unroll
                for (int m = 0; m < 4; ++m)
#pragma unroll
                    for (int n = 0; n < 2; ++n) acc[a][b][m][n] = (f32x4){0.f, 0.f, 0.f, 0.f};
        cur = nxt; cB = nB; ++ui; gA[0] = gN[0]; gA[1] = gN[1]; gA[2] = gN[2]; gA[3] = gN[3];
        if constexpr (ALIGN_EPI) { if (wr == 1) PG8_BAR; }
    }
    PG8_WAIT_V(0);
    if constexpr (!ALIGN_EPI) { if (wr == 0) PG8_BAR; }
    PG8_BAR;
    if constexpr (Epi::AFTER_DRAIN) { E.fused(acc, cur, wr, wc, fr, fq, lds, wid, lane); S.done(cur); }
#undef PG8_SA
#undef PG8_SB
#undef PG8_STAGE
#undef PG8_STAGEG
#undef PG8_GLOAD
#undef PG8_LDA
#undef PG8_LDB
#undef PG8_MMA
#undef PG8_WAIT_V
#undef PG8_WAIT_L
#undef PG8_BAR
#undef PG8_SCHED
}
}

constexpr int NTOK = 8192, SEQ = 4096, DM = 2048, NLAYER = 2;
constexpr int IN_COLS = 15808, INP = 15872;
constexpr int NSEG = 65;
constexpr int XS_ROWS = 8192 + 65536 + 64 * 256;
constexpr int NPHASE = 16;
constexpr float LN_EPS = 1e-5f, GN_EPS = 64e-5f, ALPHA = 1.4142135623730951f  , ROUTED_SCALE = 2.5f;

constexpr size_t MiB = 1u << 20, KiB = 1u << 10;
constexpr size_t WS_CTL = 0, CTL_ZERO_BYTES = 512 * KiB;
constexpr size_t WS_HIST = 1 * MiB;
constexpr size_t WS_SELE = WS_HIST + 64 * KiB;
constexpr size_t WS_SELW = WS_SELE + 256 * KiB;
constexpr size_t WS_SLOT = WS_SELW + 256 * KiB;
constexpr size_t WS_ROWW = WS_SLOT + 256 * KiB;
constexpr size_t WS_TSEG = WS_ROWW + 352 * KiB;
constexpr size_t WS_BON = WS_TSEG + 4 * KiB;
constexpr size_t WS_ROWT = WS_BON + 576 * KiB;
constexpr size_t WS_XT = WS_ROWT + 352 * KiB;
constexpr size_t WS_LNX = WS_XT + 16 * KiB;
constexpr size_t WS_WIN = 4 * MiB;
constexpr size_t WS_WLORA = 66 * MiB;
constexpr size_t WS_WBR = 69 * MiB;
constexpr size_t WS_WO = 81 * MiB;
constexpr size_t WS_WGU = 89 * MiB;
constexpr size_t WS_WD = 349 * MiB;
constexpr size_t WS_XB = 479 * MiB;
constexpr size_t WS_MERGED = 511 * MiB;
constexpr size_t WS_PRELN = 543 * MiB;
constexpr size_t WS_X1 = 607 * MiB;
constexpr size_t WS_X2 = 671 * MiB;
constexpr size_t WS_M = 735 * MiB;
constexpr size_t WS_PCONV = WS_M, WS_PQKV = WS_M + 48 * MiB, WS_PRKV = WS_M + 96 * MiB, WS_PLORA = WS_M + 144 * MiB, WS_PGATE = WS_M + 152 * MiB;
constexpr size_t WS_YBR = WS_M + 248 * MiB;
constexpr size_t WS_LORAA = WS_M + 760 * MiB;
constexpr size_t WS_RWR = WS_M + 304 * MiB, WS_RWW = WS_RWR + 32 * MiB, WS_RWK = WS_RWW + 32 * MiB, WS_RWV = WS_RWK + 32 * MiB, WS_RWKK = WS_RWV + 32 * MiB,
                 WS_RWB = WS_RWKK + 32 * MiB, WS_RWA = WS_RWB + 32 * MiB, WS_RWG = WS_RWA + 32 * MiB, WS_RWY = WS_RWG + 32 * MiB;
constexpr size_t WS_XS = WS_M;
constexpr size_t WS_H = WS_XS + 352 * MiB;
constexpr size_t WS_YS = WS_H + 88 * MiB;
constexpr size_t WS_END = WS_YS + 352 * MiB;
static_assert(WS_RWY + 32 * MiB <= WS_END && (size_t)XS_ROWS * 2048 * 2 == 352 * MiB && (size_t)XS_ROWS * 512 * 2 == 88 * MiB, "ws map");
static_assert(WS_LNX + 512 * KiB <= WS_WIN && WS_WIN + (size_t)INP * 2048 * 2 <= WS_WLORA && WS_WGU + (size_t)65 * 1024 * 2048 * 2 <= WS_WD && WS_WD + (size_t)65 * 2048 * 512 * 2 <= WS_XB, "ws map 2");
constexpr int CW_TMO = 0, CW_BAR = 4096, CW_LNC = 16384, CW_HC = 32768;

constexpr int RING_OFF = 0, RING_BYTES = 131072;
constexpr int LDS_BYTES = 147456;
constexpr int LDSCTL_OFF = LDS_BYTES - 1024, MISC_OFF = LDSCTL_OFF + 320;
constexpr int NWAVES = 8;

#define GAS __attribute__((address_space(1)))
#define LAS __attribute__((address_space(3)))
typedef unsigned short bf16;
typedef unsigned v4u __attribute__((ext_vector_type(4)));
typedef unsigned v2u __attribute__((ext_vector_type(2)));
typedef float f32x4 __attribute__((ext_vector_type(4)));
typedef float f32x16 __attribute__((ext_vector_type(16)));
typedef short bf16x8 __attribute__((ext_vector_type(8)));
typedef short s16x4 __attribute__((ext_vector_type(4)));
typedef GAS unsigned gu32;
#define RLX_AGENT __ATOMIC_RELAXED, __HIP_MEMORY_SCOPE_AGENT
#define LDS_WAIT() asm volatile("s_waitcnt lgkmcnt(0)" ::: "memory")
#define VM_WAIT() asm volatile("s_waitcnt vmcnt(0)" ::: "memory")
__device__ __forceinline__ unsigned f2bf(float f) { unsigned u = __builtin_bit_cast(unsigned, f); return (u + 0x7fffu + ((u >> 16) & 1u)) >> 16; }
__device__ __forceinline__ unsigned pk2(float lo, float hi) { return pg8::cvt_pk_bf16(lo, hi); }
__device__ __forceinline__ float bf2f(bf16 b) { return __uint_as_float((unsigned)b << 16); }
__device__ __forceinline__ float blo(unsigned w) { return __uint_as_float(w << 16); }
__device__ __forceinline__ float bhi(unsigned w) { return __uint_as_float(w & 0xffff0000u); }
__device__ __forceinline__ int ld_i32(const int* p) { return __hip_atomic_load(p, RLX_AGENT); }
__device__ __forceinline__ float ld_f32(const float* p) { return __hip_atomic_load(p, RLX_AGENT); }

#define XB_TMO      128
#define XB_XCNT(j)  (256  + 64 * (j))
#define XB_XSUB(j)  (1280 + 64 * (j))
#define XB_XGEN(j)  (2304 + 64 * (j))
#define XB_TOP      3328
#define XB_TOPGEN   3392
#define XCD_BAR_WORDS 3456
#define XB_SPIN_CAP (1u << 18)

__device__ __forceinline__ unsigned xb_ld(unsigned* p)              { return __hip_atomic_load(p, __ATOMIC_RELAXED, __HIP_MEMORY_SCOPE_AGENT); }
__device__ __forceinline__ unsigned xb_add(unsigned* p, unsigned v) { return __hip_atomic_fetch_add(p, v, __ATOMIC_RELAXED, __HIP_MEMORY_SCOPE_AGENT); }
__device__ __forceinline__ unsigned xb_xcc_id() { return (unsigned)__builtin_amdgcn_s_getreg((3 << 11) | 20) & 0xFu; }
#define XB_SPIN(cond, bar) do { unsigned _sp = 0; while (cond) { __builtin_amdgcn_s_sleep(1); \
    if ((++_sp & 255u) == 0u) { if (xb_ld(&(bar)[XB_TMO])) break; if (_sp > XB_SPIN_CAP) { atomicAdd(&(bar)[XB_TMO], 1u); break; } } } } while (0)

struct XcdBarrier {
    unsigned* bar; unsigned x;
    volatile LAS unsigned* st;
};

__device__ __forceinline__ XcdBarrier xcd_barrier_post(unsigned* bar, volatile LAS unsigned* st) {
    XcdBarrier b; b.bar = bar; b.x = xb_xcc_id(); b.st = st;
    if (threadIdx.x == 0) (void)xb_add(&bar[XB_XCNT(b.x)], 1u);
    return b;
}
__device__ __forceinline__ void xcd_barrier_complete(unsigned* bar, unsigned x, unsigned& nloc, unsigned& nx) {
    const unsigned G = gridDim.x * gridDim.y * gridDim.z;
    unsigned sum, cnt, mine, sp = 0u;
    for (;;) {
        sum = 0u; cnt = 0u; mine = 0u;
#pragma unroll
        for (unsigned j = 0; j < 16; ++j) { const unsigned c = xb_ld(&bar[XB_XCNT(j)]); sum += c; cnt += (c > 0u) ? 1u : 0u; mine = (j == x) ? c : mine; }
        if (sum == G) break;
        __builtin_amdgcn_s_sleep(1);
        if ((++sp & 255u) == 0u) { if (xb_ld(&bar[XB_TMO])) break; if (sp > XB_SPIN_CAP) { atomicAdd(&bar[XB_TMO], 1u); break; } }
    }
    nloc = mine > 0u ? mine : 1u; nx = cnt > 0u ? cnt : 1u;
}

__device__ __forceinline__ void xcd_barrier(const XcdBarrier& b) {
    asm volatile("s_waitcnt vmcnt(0)" ::: "memory");
    __syncthreads();
    if (threadIdx.x == 0) {
        unsigned* bar = b.bar;
        __builtin_amdgcn_s_waitcnt(0);
        unsigned nloc = b.st[0], nx = b.st[1];
        if (nloc == 0u) { xcd_barrier_complete(bar, b.x, nloc, nx); b.st[0] = nloc; b.st[1] = nx; }
        const unsigned old = xb_add(&bar[XB_XSUB(b.x)], 1u);
        const unsigned gen = old / nloc;
        if (old + 1u == (gen + 1u) * nloc) {
            __builtin_amdgcn_fence(__ATOMIC_RELEASE, "agent");
            asm volatile("s_waitcnt vmcnt(0)" ::: "memory");
            const unsigned og = xb_add(&bar[XB_TOP], 1u);
            const unsigned tg = og / nx;
            if (og + 1u == (tg + 1u) * nx) xb_add(&bar[XB_TOPGEN], 1u);
            else XB_SPIN(xb_ld(&bar[XB_TOPGEN]) == tg, bar);
            __builtin_amdgcn_fence(__ATOMIC_ACQUIRE, "agent");
            xb_add(&bar[XB_XGEN(b.x)], 1u);
            asm volatile("s_waitcnt vmcnt(0)" ::: "memory");
        } else {
            XB_SPIN(xb_ld(&bar[XB_XGEN(b.x)]) == gen, bar);
            __builtin_amdgcn_fence(__ATOMIC_ACQUIRE, "agent");
            asm volatile("s_waitcnt vmcnt(0)" ::: "memory");
        }
    }
    __syncthreads();
}

struct Args { const float* in[28]; float* out; unsigned char* ws; int ph_lo, ph_hi, li, pad; };
typedef const __attribute__((address_space(4))) Args* KArgs;
struct Frame {
    LAS unsigned char* lds;
    volatile LAS unsigned* MISC;
    gu32* ctl;
    unsigned char* ws;
    int tid, lane, wave, vcu, G;
};
__device__ __forceinline__ float wave_sum(float v) {
#pragma unroll
    for (int o = 1; o < 64; o <<= 1) v += __shfl_xor(v, o);
    return v;
}
__device__ __forceinline__ float dpp16(float v) {
    v += __builtin_bit_cast(float, __builtin_amdgcn_update_dpp(0, __builtin_bit_cast(int, v), 0xB1, 0xF, 0xF, true));
    v += __builtin_bit_cast(float, __builtin_amdgcn_update_dpp(0, __builtin_bit_cast(int, v), 0x4E, 0xF, 0xF, true));
    v += __builtin_bit_cast(float, __builtin_amdgcn_update_dpp(0, __builtin_bit_cast(int, v), 0x141, 0xF, 0xF, true));
    v += __builtin_bit_cast(float, __builtin_amdgcn_update_dpp(0, __builtin_bit_cast(int, v), 0x140, 0xF, 0xF, true));
    return v;
}
__device__ __forceinline__ v4u pack8(const float* v) { v4u o; o.x = pk2(v[0], v[1]); o.y = pk2(v[2], v[3]); o.z = pk2(v[4], v[5]); o.w = pk2(v[6], v[7]); return o; }
__device__ __forceinline__ void unpack8(v4u w, float* v) { v[0] = blo(w.x); v[1] = bhi(w.x); v[2] = blo(w.y); v[3] = bhi(w.y); v[4] = blo(w.z); v[5] = bhi(w.z); v[6] = blo(w.w); v[7] = bhi(w.w); }

struct TrItem { const float* src; bf16* dst; int ldn, k0, n0, Kd; };
__device__ __forceinline__ void tr_issue(const TrItem& d, int lane, float (&hv)[32]) {
    const float* base = d.src + (size_t)d.k0 * d.ldn + d.n0;
    const unsigned off = (unsigned)(lane >> 3) * (unsigned)d.ldn + 4u * (unsigned)(lane & 7), step = 8u * (unsigned)d.ldn;
#pragma unroll
    for (int i = 0; i < 8; ++i) { const f32x4 v = __builtin_nontemporal_load((const f32x4*)(base + (off + (unsigned)i * step))); hv[4 * i] = v[0]; hv[4 * i + 1] = v[1]; hv[4 * i + 2] = v[2]; hv[4 * i + 3] = v[3]; }
}
__device__ __forceinline__ void tr_finish(const TrItem& d, int lane, const float (&hv)[32], LAS float* scr) {
    { LAS float* w = scr + (lane >> 3) * 33 + 4 * (lane & 7);
#pragma unroll
      for (int i = 0; i < 8; ++i) { w[i * 8 * 33] = hv[4 * i]; w[i * 8 * 33 + 1] = hv[4 * i + 1]; w[i * 8 * 33 + 2] = hv[4 * i + 2]; w[i * 8 * 33 + 3] = hv[4 * i + 3]; } }
    LDS_WAIT(); asm volatile("" ::: "memory");
    const int c = lane & 7;
#pragma unroll
    for (int j = 0; j < 4; ++j) { const int n = (lane >> 3) + 8 * j; const LAS float* s = scr + (8 * c) * 33 + n;
        v4u o; o.x = pg8::cvt_pk_bf16(s[0 * 33], s[1 * 33]); o.y = pg8::cvt_pk_bf16(s[2 * 33], s[3 * 33]); o.z = pg8::cvt_pk_bf16(s[4 * 33], s[5 * 33]); o.w = pg8::cvt_pk_bf16(s[6 * 33], s[7 * 33]);
        __builtin_nontemporal_store(o, (GAS v4u*)(d.dst + (size_t)n * d.Kd + d.k0 + 8 * c)); }
    LDS_WAIT(); asm volatile("" ::: "memory");
}
constexpr int I_IN = 32 * 494, I_BR = 3 * 16 * 64, I_WO = 32 * 64, I_G = 65 * 512, I_D = 65 * 512;
constexpr int NIT = I_IN + I_BR + I_WO + 2 * I_G + I_D;
#ifndef HN0
#define HN0 4
#define HN1 2
#define HN2 0
#define HN3 0
#define HN4 4
#define HN5 0
#define HN6 2
#endif
#ifndef P0_EXTRA
#define P0_EXTRA 0
#endif
#ifndef SEQ_ITEMS
#define SEQ_ITEMS 12544
#endif
constexpr int NIT_A = NIT - SEQ_ITEMS;
__device__ __forceinline__ TrItem decode_item(KArgs a, unsigned char* ws, int l, int it) {
    bf16* WIN = (bf16*)(ws + WS_WIN); bf16* WBR = (bf16*)(ws + WS_WBR); bf16* WO = (bf16*)(ws + WS_WO); bf16* WGU = (bf16*)(ws + WS_WGU); bf16* WD = (bf16*)(ws + WS_WD);
    int r = it; TrItem d;
    if (r < I_IN) { const int kb = r / 494, nb = r % 494, n0 = 32 * nb; d.src = a->in[1] + (size_t)l * 2048 * IN_COLS; d.ldn = IN_COLS; d.k0 = 64 * kb; d.n0 = n0; d.dst = WIN + (size_t)(n0 + (n0 >= 9408 ? 64 : 0)) * 2048; d.Kd = 2048; return d; }
    r -= I_IN;
    if (r < I_BR) { const int nbr = r / 1024, rr = r % 1024, kb = rr / 64, nb = rr % 64; d.src = a->in[14] + (size_t)l * 3 * 1024 * 2048 + (size_t)nbr * 1024 * 2048; d.ldn = 2048; d.k0 = 64 * kb; d.n0 = 32 * nb;
        d.dst = WBR + (size_t)nbr * 2048 * 1024 + (size_t)(32 * nb) * 1024; d.Kd = 1024; return d; }
    r -= I_BR;
    if (r < I_WO) { const int kb = r / 64, nb = r % 64; d.src = a->in[15] + (size_t)l * 2048 * 2048; d.ldn = 2048; d.k0 = 64 * kb; d.n0 = 32 * nb; d.dst = WO + (size_t)(32 * nb) * 2048; d.Kd = 2048; return d; }
    r -= I_WO;
    if (r < 2 * I_G) { const int up = r >= I_G ? 1 : 0; if (up) r -= I_G; const int seg = r / 512, rr = r % 512, kb = rr / 16, nb = rr % 16, n0 = 32 * nb;
        d.src = seg == 0 ? (up ? a->in[24] : a->in[23]) + (size_t)l * 2048 * 512 : (up ? a->in[21] : a->in[20]) + (size_t)(l * 64 + seg - 1) * 2048 * 512;
        d.ldn = 512; d.k0 = 64 * kb; d.n0 = n0; d.dst = WGU + (size_t)(seg * 1024 + (n0 >> 7) * 256 + (n0 & 127) + up * 128) * 2048; d.Kd = 2048; return d; }
    r -= 2 * I_G;
    { const int seg = r / 512, rr = r % 512, kb = rr / 64, nb = rr % 64;
        d.src = seg == 0 ? a->in[25] + (size_t)l * 512 * 2048 : a->in[22] + (size_t)(l * 64 + seg - 1) * 512 * 2048;
        d.ldn = 2048; d.k0 = 64 * kb; d.n0 = 32 * nb; d.dst = WD + (size_t)(seg * 2048 + 32 * nb) * 512; d.Kd = 512; return d; }
}
__device__ __forceinline__ void convert_item(KArgs a, unsigned char* ws, int l, int it, LAS float* scr, int lane) {
    const TrItem d = decode_item(a, ws, l, it); float hv[32]; tr_issue(d, lane, hv); tr_finish(d, lane, hv, scr);
}
#ifndef P1_ITEMS
#define P1_ITEMS 8192
#endif
__device__ __forceinline__ int p1_items() { return ((int)gridDim.x == 256) ? P1_ITEMS : 0; }
__device__ __forceinline__ void convert_range(KArgs a, Frame& F, int l, int first, int last, int start, int stride) {
    LAS float* scr = (LAS float*)(F.lds + RING_OFF + F.wave * 16384);
    int it = first + start; const int nw = stride;
    float ha[32], hb[32], hc[32], hd[32]; TrItem da = {}, db = {}, dc = {}, dd = {}; bool pa = false, pb = false, pc = false, pd = false;
#define P1_ISS(hv, d, p) do { if (it < last) { d = decode_item(a, F.ws, l, it); tr_issue(d, F.lane, hv); p = true; it += nw; } } while (0)
#define P1_FIN(hv, d, p) do { if (p) { tr_finish(d, F.lane, hv, scr); p = false; } } while (0)
    P1_ISS(ha, da, pa); P1_ISS(hb, db, pb); P1_ISS(hc, dc, pc); P1_ISS(hd, dd, pd);
    while (pa || pb || pc || pd) { P1_FIN(ha, da, pa); P1_ISS(ha, da, pa); P1_FIN(hb, db, pb); P1_ISS(hb, db, pb); P1_FIN(hc, dc, pc); P1_ISS(hc, dc, pc); P1_FIN(hd, dd, pd); P1_ISS(hd, dd, pd); }
#undef P1_ISS
#undef P1_FIN
}
__device__ __forceinline__ void p1_convert(KArgs a, Frame& F, int l) {
    convert_range(a, F, l, I_IN + P0_EXTRA, I_IN + P0_EXTRA + P1_ITEMS, (pg8::obid() - 248) * NWAVES + F.wave, 8 * NWAVES);
}
#ifndef NEXT_WIN_RMAX
#define NEXT_WIN_RMAX 64
#endif
__device__ __forceinline__ bool next_win_early(const unsigned char* ws) {
    if ((int)gridDim.x != 256 || NEXT_WIN_RMAX <= 0) return false;
    const int R = (4 * __builtin_amdgcn_readfirstlane(ld_i32((const int*)(ws + WS_TSEG)))) & 255;
    return R > 0 && R <= NEXT_WIN_RMAX;
}
#ifndef SHADOW_CONVERT
#define SHADOW_CONVERT 1
#endif
__device__ __forceinline__ void ph0_convert(KArgs a, Frame& F, int l) {
    LAS float* scr = (LAS float*)(F.lds + RING_OFF + F.wave * 16384);
    const int gw = F.vcu * NWAVES + F.wave, NGW = F.G * NWAVES;
    bf16* WIN = (bf16*)(F.ws + WS_WIN); bf16* WLORA = (bf16*)(F.ws + WS_WLORA);
    const int it0 = (l > 0 && next_win_early(F.ws)) ? I_IN : 0;
    convert_range(a, F, l, it0, SHADOW_CONVERT ? I_IN + P0_EXTRA : NIT, gw, NGW);
    const size_t gt = (size_t)F.vcu * 512 + F.tid, NT = (size_t)F.G * 512;
    for (size_t i = gt; i < 64 * 2048 / 8; i += NT) ((v4u*)(WIN + (size_t)9408 * 2048))[i] = (v4u){0u, 0u, 0u, 0u};
    { const float* w2 = a->in[5] + (size_t)l * 96 * 1024; const float* a2 = a->in[7] + (size_t)l * 96 * 1024; const float* g2 = a->in[8] + (size_t)l * 256 * 1024;
      for (size_t i0 = gt; i0 < (size_t)3072 * 256; i0 += 6 * NT) {
          float v[6]; int kq[6], nq[6]; bool ok[6];
#pragma unroll
          for (int u = 0; u < 6; ++u) { const size_t i = i0 + (size_t)u * NT; ok[u] = i < (size_t)3072 * 256; const unsigned ii = ok[u] ? (unsigned)i : (unsigned)gt;
              const int k = (int)(ii / 3072u), n = (int)(ii % 3072u), sec = n >> 10, nn = n & 1023; kq[u] = k; nq[u] = n;
              const bool live = sec == 2 || k < 96; const float* src = sec == 0 ? w2 : (sec == 1 ? a2 : g2);
              v[u] = src[(live ? k : 0) * 1024 + nn] * (live ? 1.f : 0.f); }
#pragma unroll
          for (int u = 0; u < 6; ++u) if (ok[u]) WLORA[(size_t)nq[u] * 256 + kq[u]] = (bf16)f2bf(v[u]); } }
    if (l == 0) { const f32x4* x = (const f32x4*)a->in[0]; v4u* xb = (v4u*)(F.ws + WS_XB);
        for (size_t i = gt; i < (size_t)NTOK * DM / 8; i += 4 * NT) {
            f32x4 p[4], q[4]; bool ok[4];
#pragma unroll
            for (int u = 0; u < 4; ++u) { const size_t ii = i + (size_t)u * NT; ok[u] = ii < (size_t)NTOK * DM / 8; const size_t jj = ok[u] ? ii : i; p[u] = x[2 * jj]; q[u] = x[2 * jj + 1]; }
#pragma unroll
            for (int u = 0; u < 4; ++u) if (ok[u]) { v4u o; o.x = pk2(p[u][0], p[u][1]); o.y = pk2(p[u][2], p[u][3]); o.z = pk2(q[u][0], q[u][1]); o.w = pk2(q[u][2], q[u][3]); xb[i + (size_t)u * NT] = o; } } }
}

__device__ __forceinline__ void ph2_elementwise(KArgs a, Frame& F, int l) {
    const size_t gt = (size_t)F.vcu * 512 + F.tid, NT = (size_t)F.G * 512;
    const bf16* PC = (const bf16*)(F.ws + WS_PCONV); bf16* Y0 = (bf16*)(F.ws + WS_YBR);
    const float* cw = a->in[2] + (size_t)l * 3 * 1024;
    for (size_t i = gt; i < (size_t)NTOK * 128; i += NT) { const int t = (int)(i >> 7), c = (int)(i & 127) * 8, tt = t & (SEQ - 1);
        const bf16* row = PC + (size_t)t * 3072;
        const bf16* r1 = tt >= 1 ? row - 3072 : row; const bf16* r2 = tt >= 2 ? row - 6144 : row; const float m1 = tt >= 1 ? 1.f : 0.f, m2 = tt >= 2 ? 1.f : 0.f;
        const v4u lgb = *(const v4u*)(row + c), la0 = *(const v4u*)(row + 1024 + c), lb0 = *(const v4u*)(row + 2048 + c), la1 = *(const v4u*)(r1 + 1024 + c), lb1 = *(const v4u*)(r1 + 2048 + c),
                  la2 = *(const v4u*)(r2 + 1024 + c), lb2 = *(const v4u*)(r2 + 2048 + c);
        float gb[8], g0[8], h0[8], u0[8], u1[8], u2[8];
        unpack8(lgb, gb); unpack8(la0, g0); unpack8(lb0, h0);
#pragma unroll
        for (int j = 0; j < 8; ++j) u0[j] = g0[j] * h0[j];
        unpack8(la1, g0); unpack8(lb1, h0);
#pragma unroll
        for (int j = 0; j < 8; ++j) u1[j] = g0[j] * h0[j] * m1;
        unpack8(la2, g0); unpack8(lb2, h0);
#pragma unroll
        for (int j = 0; j < 8; ++j) u2[j] = g0[j] * h0[j] * m2;
        float y[8];
#pragma unroll
        for (int j = 0; j < 8; ++j) y[j] = gb[j] * (cw[c + j] * u2[j] + cw[1024 + c + j] * u1[j] + cw[2048 + c + j] * u0[j]);
        *(v4u*)(Y0 + (size_t)t * 1024 + c) = pack8(y); }
    const bf16* PR = (const bf16*)(F.ws + WS_PRKV); const float* mix = a->in[3] + (size_t)l * 3520;
    bf16* RWR = (bf16*)(F.ws + WS_RWR); bf16* RWK = (bf16*)(F.ws + WS_RWK); bf16* RWV = (bf16*)(F.ws + WS_RWV);
    for (size_t i = gt; i < (size_t)NTOK * 384; i += NT) { const int t = (int)((unsigned)i / 384u), c = (int)((unsigned)i % 384u) * 8, tt = t & (SEQ - 1);
        float p[8], q[8];
        const v4u lp = *(const v4u*)(PR + (size_t)t * 3072 + c), lq = *(const v4u*)(PR + (size_t)(tt >= 1 ? t - 1 : t) * 3072 + c);
        const float mq = tt >= 1 ? 1.f : 0.f;
        unpack8(lp, p); unpack8(lq, q);
#pragma unroll
        for (int j = 0; j < 8; ++j) p[j] = p[j] + (q[j] * mq - p[j]) * mix[c + j];
        bf16* dst = (c < 1024 ? RWR : (c < 2048 ? RWK : RWV)) + (size_t)t * 1024 + (c & 1023);
        *(v4u*)dst = pack8(p); }
    const bf16* PL = (const bf16*)(F.ws + WS_PLORA); bf16* LA = (bf16*)(F.ws + WS_LORAA);
    for (size_t i = gt; i < (size_t)NTOK * 96; i += NT) { const int t = (int)((unsigned)i / 96u), c8 = (int)((unsigned)i % 96u), sec = c8 >> 5, c = (c8 & 31) * 8, tt = t & (SEQ - 1);
        float p[8], q[8];
        if (sec < 2 && c >= 96) {
#pragma unroll
            for (int j = 0; j < 8; ++j) p[j] = 0.f;
        } else {
            const int sc = sec == 0 ? c : (sec == 1 ? 96 + c : 256 + c);
            const v4u lp = *(const v4u*)(PL + (size_t)t * 512 + sc), lq = *(const v4u*)(PL + (size_t)(tt >= 1 ? t - 1 : t) * 512 + sc); const float mq = tt >= 1 ? 1.f : 0.f;
            unpack8(lp, p); unpack8(lq, q);
#pragma unroll
            for (int j = 0; j < 8; ++j) q[j] *= mq;
            const int mi = sec == 0 ? 3072 + c : (sec == 1 ? 3168 + c : 3264 + c);
#pragma unroll
            for (int j = 0; j < 8; ++j) { const float v = p[j] + (q[j] - p[j]) * mix[mi + j]; p[j] = sec == 0 ? (1.0f - 2.0f * __builtin_amdgcn_rcpf(1.0f + __expf(2.0f * v))) : (sec == 1 ? v : __builtin_amdgcn_rcpf(1.0f + __expf(-v))); }
        }
        *(v4u*)(LA + ((size_t)sec * NTOK + t) * 256 + c) = pack8(p); }
}

__device__ __forceinline__ void ph4_prep(KArgs a, Frame& F, int l) {
    const int gw = F.vcu * NWAVES + F.wave, NGW = F.G * NWAVES;
    const bf16* RWR = (const bf16*)(F.ws + WS_RWR); bf16* RWK = (bf16*)(F.ws + WS_RWK); bf16* RWKK = (bf16*)(F.ws + WS_RWKK); bf16* RWB = (bf16*)(F.ws + WS_RWB);
    const bf16* RWA = (const bf16*)(F.ws + WS_RWA); float* BON = (float*)(F.ws + WS_BON);
    const float* kkw = a->in[9] + (size_t)l * 1024; const float* kaw = a->in[10] + (size_t)l * 1024; const float* rkw = a->in[11] + (size_t)l * 1024;
    for (int task = gw; task < NTOK * 4; task += NGW) { const int t = task >> 2, hq = task & 3, c = hq * 256 + 4 * F.lane; const size_t idx = (size_t)t * 1024 + c;
        const v2u rw = *(const v2u*)(RWR + idx), kw = *(const v2u*)(RWK + idx);
        const f32x4 r = {blo(rw.x), bhi(rw.x), blo(rw.y), bhi(rw.y)}, k = {blo(kw.x), bhi(kw.x), blo(kw.y), bhi(kw.y)};
        const v2u aw = *(const v2u*)(RWA + idx); const f32x4 av = {blo(aw.x), bhi(aw.x), blo(aw.y), bhi(aw.y)};
        const f32x4 kkr = k * *(const f32x4*)(kkw + c);
        const float n2 = dpp16((kkr[0] * kkr[0] + kkr[1] * kkr[1]) + (kkr[2] * kkr[2] + kkr[3] * kkr[3]));
        const f32x4 kk = kkr * rsqrtf(fmaxf(n2, 1e-24f));
        const f32x4 k2 = k * (1.0f + (av - 1.0f) * *(const f32x4*)(kaw + c));
        const f32x4 bb = kk * av;
        { v2u w; w.x = pk2(k2[0], k2[1]); w.y = pk2(k2[2], k2[3]); *(v2u*)(RWK + idx) = w; } { v2u w; w.x = pk2(kk[0], kk[1]); w.y = pk2(kk[2], kk[3]); *(v2u*)(RWKK + idx) = w; }
        { v2u w; w.x = pk2(bb[0], bb[1]); w.y = pk2(bb[2], bb[3]); *(v2u*)(RWB + idx) = w; }
        const f32x4 pr = r * k2 * *(const f32x4*)(rkw + c);
        const float bon = dpp16((pr[0] + pr[1]) + (pr[2] + pr[3]));
        if ((F.lane & 15) == 0) BON[t * 16 + hq * 4 + (F.lane >> 4)] = bon; }
}
__device__ __forceinline__ void ph6_rwkv_out(KArgs a, Frame& F, int l) {
    const int gw = F.vcu * NWAVES + F.wave, NGW = F.G * NWAVES;
    const float* RWY = (const float*)(F.ws + WS_RWY); const float* RWV = (const float*)(F.ws + WS_RWV); const float* RWG = (const float*)(F.ws + WS_RWG); const float* BON = (const float*)(F.ws + WS_BON);
    bf16* Y2 = (bf16*)(F.ws + WS_YBR) + (size_t)2 * NTOK * 1024;
    const float* lg = a->in[12] + (size_t)l * 1024; const float* lb = a->in[13] + (size_t)l * 1024;
    for (int task = gw; task < NTOK * 4; task += NGW) { const int t = task >> 2, hq = task & 3, c = hq * 256 + 4 * F.lane; const size_t idx = (size_t)t * 1024 + c;
        const f32x4 y = *(const f32x4*)(RWY + idx);
        const float mu = dpp16((y[0] + y[1]) + (y[2] + y[3])) * (1.0f / 64.0f); const f32x4 d = y - mu;
        const float var = dpp16((d[0] * d[0] + d[1] * d[1]) + (d[2] * d[2] + d[3] * d[3])) * (1.0f / 64.0f);
        f32x4 yn = d * rsqrtf(var + GN_EPS) * *(const f32x4*)(lg + c) + *(const f32x4*)(lb + c);
        yn += BON[t * 16 + hq * 4 + (F.lane >> 4)] * *(const f32x4*)(RWV + idx);
        yn *= *(const f32x4*)(RWG + idx);
        v2u w; w.x = pk2(yn[0], yn[1]); w.y = pk2(yn[2], yn[3]); *(v2u*)(Y2 + idx) = w; }
}

typedef float f32x2_t __attribute__((ext_vector_type(2)));
__device__ __forceinline__ void reduce2(float q, float p, float& Q, float& P) {
    const auto a = __builtin_amdgcn_permlane16_swap(__float_as_uint(q), __float_as_uint(p), false, false);
    float x = __uint_as_float(a[0]) + __uint_as_float(a[1]);
    x = dpp16(x);
    const auto b = __builtin_amdgcn_permlane16_swap(__float_as_uint(x), __float_as_uint(x), false, false);
    Q = __uint_as_float(b[0]); P = __uint_as_float(b[1]);
}
template <int MODE  > __device__ __forceinline__ void ph5_scan(KArgs a, Frame& F, int l) {
#define LDS_BAR() do { asm volatile("s_waitcnt lgkmcnt(0)" ::: "memory"); __builtin_amdgcn_s_barrier(); asm volatile("" ::: "memory"); } while (0)
    const int bx = pg8::obid();
    const int seq = bx >> 3, b = seq >> 4, h = seq & 15, i0 = (bx & 7) * 8 + F.wave * 2;
    const bool active = F.wave < 4;
    LAS float* buf = (LAS float*)(F.lds + RING_OFF);
    constexpr int BSZ = 6 * 32 * 64, ASZ = 32 * 64, NBLK = SEQ / 32;
    const float* A0 = (const float*)(F.ws + WS_RWKK) + 1024; const float* A1 = (const float*)(F.ws + WS_RWB); const float* A2 = (const float*)(F.ws + WS_RWW);
    const float* A3 = (const float*)(F.ws + WS_RWK); const float* A4 = (const float*)(F.ws + WS_RWR); const float* A5 = (const float*)(F.ws + WS_RWV);
    float* RWY = (float*)(F.ws + (MODE == 0 ? WS_RWY : WS_M + 600 * MiB));
    const size_t tok0 = (size_t)b * SEQ; const int col0 = h * 64;
    const int st = F.tid >> 4, sq = F.tid & 15;
    const size_t soff = (tok0 + st) * 1024 + col0 + sq * 4;
    const int loff = st * 64 + sq * 4;
    const int rl = F.lane >> 5, jq = F.lane & 31, irow = i0 + rl;
    float S0 = 0.f, S1 = 0.f, yreg = 0.f, sa = 0.f;
#define SC_LOAD(R, blk_) do { if (MODE == 1) break; const size_t o_ = soff + (size_t)(blk_) * 32 * 1024; R##0 = *(const f32x4*)(A0 + o_); R##1 = *(const f32x4*)(A1 + o_); R##2 = *(const f32x4*)(A2 + o_); \
        R##3 = *(const f32x4*)(A3 + o_); R##4 = *(const f32x4*)(A4 + o_); R##5 = *(const f32x4*)(A5 + o_); } while (0)
#define SC_WRITE(R, bufi) do { if (MODE == 1) break; LAS float* nb_ = buf + (bufi) * BSZ; *(LAS f32x4*)(nb_ + 0 * ASZ + loff) = R##0; *(LAS f32x4*)(nb_ + 1 * ASZ + loff) = R##1; *(LAS f32x4*)(nb_ + 2 * ASZ + loff) = R##2; \
        *(LAS f32x4*)(nb_ + 3 * ASZ + loff) = R##3; *(LAS f32x4*)(nb_ + 4 * ASZ + loff) = R##4; *(LAS f32x4*)(nb_ + 5 * ASZ + loff) = R##5; } while (0)
#define SC_COMPUTE(bufi, blk_) do { if (active) { const LAS float* bb = buf + (bufi) * BSZ; \
        _Pragma("unroll 4") for (int tl = 0; tl < 32; ++tl) { const LAS float* base = bb + tl * 64; \
            const f32x2_t b2 = *(const LAS f32x2_t*)(base + 1 * ASZ + 2 * jq), w2 = *(const LAS f32x2_t*)(base + 2 * ASZ + 2 * jq), k2 = *(const LAS f32x2_t*)(base + 3 * ASZ + 2 * jq), \
                          r2 = *(const LAS f32x2_t*)(base + 4 * ASZ + 2 * jq), kn = *(const LAS f32x2_t*)(base + 0 * ASZ + 2 * jq); \
            const float v = base[5 * ASZ + irow]; \
            S0 = S0 * w2[0] + (sa * b2[0] + v * k2[0]); S1 = S1 * w2[1] + (sa * b2[1] + v * k2[1]); \
            float Q, P; reduce2(S0 * r2[0] + S1 * r2[1], S0 * kn[0] + S1 * kn[1], Q, P); \
            sa = -P; \
            if (jq == (tl & 15)) yreg = Q; \
            if ((tl & 15) == 15) { if (jq < 16) RWY[(tok0 + (size_t)(blk_) * 32 + (tl - 15) + jq) * 1024 + col0 + irow] = yreg; } } } } while (0)
    int hit = (SHADOW_CONVERT && MODE == 0 && !active) ? I_IN + (bx * 4 + (F.wave - 4)) : NIT;
    LAS float* hscr = (LAS float*)(F.lds + RING_OFF + (F.wave < 7 ? 98304 + (F.wave - 4) * 8448 : 132096));
    float hv[32]; TrItem hd = {}; bool hpend = false;
    if (active) __builtin_amdgcn_s_setprio(3);
#define SC_HELP() do { if (hpend) { tr_finish(hd, F.lane, hv, hscr); hpend = false; } if (hit < NIT) { hd = decode_item(a, F.ws, l, hit); tr_issue(hd, F.lane, hv); hpend = true; hit += 4 * (int)gridDim.x; } } while (0)
    f32x4 ra0 = {}, ra1 = {}, ra2 = {}, ra3 = {}, ra4 = {}, ra5 = {}, rb0 = {}, rb1 = {}, rb2 = {}, rb3 = {}, rb4 = {}, rb5 = {};
    SC_LOAD(ra, 0); SC_LOAD(rb, 1);
    SC_WRITE(ra, 0);
    SC_LOAD(ra, 2);
    for (int blk = 0; blk < NBLK; blk += 2) {
        LDS_BAR();
        SC_COMPUTE(0, blk);
        SC_WRITE(rb, 1);
        if (blk + 3 < NBLK) SC_LOAD(rb, blk + 3);
        SC_HELP();
        LDS_BAR();
        SC_COMPUTE(1, blk + 1);
        if (blk + 2 < NBLK) { SC_WRITE(ra, 0); if (blk + 4 < NBLK) SC_LOAD(ra, blk + 4); }
        SC_HELP();
    }
    __builtin_amdgcn_s_setprio(0);
    while (hit < NIT || hpend) SC_HELP();
    LDS_BAR();
#undef SC_HELP
#undef LDS_BAR
#undef SC_LOAD
#undef SC_WRITE
#undef SC_COMPUTE
}
namespace rk {
constexpr int NCHUNK = 32 * 64;
constexpr size_t BLOB = 57344;
constexpr size_t O_RH = 0, O_PT = 8192, O_Y0 = 16384, O_LMT = 32768, O_SC = 49152;
constexpr size_t WS_RKC = WS_M + 600 * MiB;
static_assert(WS_RKC + (size_t)NCHUNK * BLOB <= WS_END, "chunk blobs");
constexpr int B_AB = 0, B_KT = 16384, B_RT = 24576, B_VT = 32768, B_ATT = 40960, B_BHT = 49152, B_KHT = 57344, B_LAK = 65536, B_LRB = 73728, B_LRK = 81920, B_T = 90112, B_MISC = 98304, B_HSCR = 100352, B_X2 = 138240;
static_assert(B_HSCR + 4 * 8448 <= LDSCTL_OFF, "phase A LDS map");
#define RSW(row, col) ((row) * 128 + ((((col) * 2)) ^ (((row) & 7) << 4)))
__device__ __forceinline__ int crow(int r, int hi) { return (r & 3) + 8 * (r >> 2) + 4 * hi; }
__device__ __forceinline__ unsigned cvtpk(float lo, float hi) { return pg8::cvt_pk_bf16(lo, hi); }
__device__ __forceinline__ void mm(f32x16& acc, LAS const char* A, LAS const char* Bt, int tm, int tn, int r32, int hi) {
#pragma unroll
    for (int s = 0; s < 4; ++s) { const bf16x8 a = *(LAS const bf16x8*)(A + RSW(32 * tm + r32, 16 * s + 8 * hi)), b = *(LAS const bf16x8*)(Bt + RSW(32 * tn + r32, 16 * s + 8 * hi));
        acc = __builtin_amdgcn_mfma_f32_32x32x16_bf16(a, b, acc, 0, 0, 0); }
}
__device__ __forceinline__ void store_n(const f32x16& acc, LAS char* dst, int tm, int tn, int r32, int hi) {
#pragma unroll
    for (int r = 0; r < 16; ++r) *(LAS bf16*)(dst + RSW(32 * tm + crow(r, hi), 32 * tn + r32)) = (bf16)f2bf(acc[r]);
}
__device__ __forceinline__ void store_t(const f32x16& acc, LAS char* dst, int tm, int tn, int r32, int hi) {
#pragma unroll
    for (int g = 0; g < 4; ++g) { v2u w; w.x = cvtpk(acc[4 * g], acc[4 * g + 1]); w.y = cvtpk(acc[4 * g + 2], acc[4 * g + 3]); *(LAS v2u*)(dst + RSW(32 * tn + r32, 32 * tm + 8 * g + 4 * hi)) = w; }
}
__device__ __forceinline__ v4u frag8(const f32x16& acc, int sl) {
    v4u w; w.x = cvtpk(acc[8 * sl], acc[8 * sl + 1]); w.y = cvtpk(acc[8 * sl + 2], acc[8 * sl + 3]); w.z = cvtpk(acc[8 * sl + 4], acc[8 * sl + 5]); w.w = cvtpk(acc[8 * sl + 6], acc[8 * sl + 7]); return w;
}
#define RK_BAR() do { asm volatile("s_waitcnt lgkmcnt(0)" ::: "memory"); __builtin_amdgcn_s_barrier(); asm volatile("" ::: "memory"); } while (0)

template <int HELP, int FUSE_PREP, int VAR = 0  > __device__ __forceinline__ void rk_chunk_local(KArgs a, Frame& F, int l) {
    LAS char* L = (LAS char*)(F.lds + RING_OFF);
    const int lane0 = F.lane, wv = F.wave;
    const bool cw = wv < 4; const int tm = (wv >> 1) & 1, tn = wv & 1;
    const float* GW = (const float*)(F.ws + WS_RWW); static_assert(!FUSE_PREP, "kk, b, k, r, v are bf16 arrays written by the preparation phase");
    const unsigned short* GKK = (const unsigned short*)(F.ws + WS_RWKK); const unsigned short* GB = (const unsigned short*)(F.ws + WS_RWB);
    const unsigned short* GK = (const unsigned short*)(F.ws + WS_RWK); const unsigned short* GR = (const unsigned short*)(F.ws + WS_RWR); const unsigned short* GV = (const unsigned short*)(F.ws + WS_RWV);
#define RK_BF(x) __uint_as_float((unsigned)(x) << 16)
    unsigned char* blobs = F.ws + WS_RKC;
    int hit = (HELP && !cw) ? I_IN + P0_EXTRA + p1_items() + (pg8::obid() * 4 + (wv - 4)) : NIT_A; const int hstride = 4 * (int)gridDim.x;
    LAS float* hscr = (LAS float*)(L + B_HSCR + (wv & 3) * 8448);
    float hva[32], hvb[32], hvc[32], hvd[32]; TrItem hda = {}, hdb = {}, hdc = {}, hdd = {}; bool pa = false, pb = false, pc = false, pd = false;
#define RK_FIN(hv, hd, pp) do { if (pp) { tr_finish(hd, lane0, hv, hscr); pp = false; } } while (0)
#define RK_ISS(hv, hd, pp) do { if (hit < NIT_A) { hd = decode_item(a, F.ws, l, hit); tr_issue(hd, lane0, hv); pp = true; hit += hstride; } } while (0)
#define RK_HELPN(n) do { RK_FIN(hva, hda, pa); RK_FIN(hvb, hdb, pb); RK_FIN(hvc, hdc, pc); RK_FIN(hvd, hdd, pd); \
        if ((n) > 0) RK_ISS(hva, hda, pa); if ((n) > 1) RK_ISS(hvb, hdb, pb); if ((n) > 2) RK_ISS(hvc, hdc, pc); if ((n) > 3) RK_ISS(hvd, hdd, pd); } while (0)
#define RK_SYNC() RK_BAR()
    if (!cw) {
#pragma unroll 1
        for (int chunk = pg8::obid(); chunk < NCHUNK; chunk += (int)gridDim.x) {
            if (HELP) RK_HELPN(HN0); RK_BAR();
            if (HELP) RK_HELPN(HN1); RK_BAR();
            if (HELP) RK_HELPN(HN2); RK_BAR();
            if (HELP) RK_HELPN(HN3); RK_BAR();
            if (HELP) RK_HELPN(HN4); RK_BAR();
            if (HELP) RK_HELPN(HN5); RK_BAR();
            if (HELP) RK_HELPN(HN6); RK_BAR(); }
        if (HELP) { while (hit < NIT_A || pa || pb || pc || pd) RK_HELPN(4); }
        return;
    }
    float wv16[16], kk16[16], bb16[16], k16[16], r16[16], v16[16];
#define RK_LOAD(ch_) do { const int sq_ = (ch_) >> 6, cc_ = (ch_) & 63; const size_t g0_ = ((size_t)(sq_ >> 4) * SEQ + (size_t)cc_ * 64 + 16 * (wv & 3)) * 1024 + (sq_ & 15) * 64 + lane0; \
        _Pragma("unroll") for (int tt = 0; tt < 16; ++tt) { const size_t o = g0_ + (size_t)tt * 1024; wv16[tt] = GW[o]; kk16[tt] = RK_BF(GKK[o]); bb16[tt] = RK_BF(GB[o]); k16[tt] = RK_BF(GK[o]); r16[tt] = RK_BF(GR[o]); v16[tt] = RK_BF(GV[o]); } } while (0)
#define RK_LOAD2(ch_) do { const int sq_ = (ch_) >> 6, cc_ = (ch_) & 63; const size_t g0_ = ((size_t)(sq_ >> 4) * SEQ + (size_t)cc_ * 64 + 16 * (wv & 3)) * 1024 + (sq_ & 15) * 64 + lane0; \
        _Pragma("unroll") for (int tt = 0; tt < 16; ++tt) { const size_t o = g0_ + (size_t)tt * 1024; k16[tt] = RK_BF(GK[o]); r16[tt] = RK_BF(GR[o]); v16[tt] = RK_BF(GV[o]); } } while (0)
    RK_LOAD(pg8::obid());
#pragma unroll 1
    for (int chunk = pg8::obid(); chunk < NCHUNK; chunk += (int)gridDim.x) {
        int lane = lane0; asm volatile("" : "+v"(lane));
        const int r32 = lane & 31, hi = lane >> 5;
        const int seq = chunk >> 6, c = chunk & 63, b = seq >> 4, h = seq & 15;
        const size_t tok0 = (size_t)b * SEQ + (size_t)c * 64;
        unsigned char* blob = VAR ? F.ws + WS_M + 724 * MiB + (size_t)(chunk & 63) * BLOB : blobs + (size_t)chunk * BLOB;
        float cs[16];
        const int j = lane, tg = wv & 3;
        {
            float run = 0.f;
#pragma unroll
            for (int tt = 0; tt < 16; ++tt) { run += __logf(wv16[tt]); cs[tt] = run; }
            ((LAS float*)(L + B_MISC))[tg * 64 + j] = run;
        }
        RK_SYNC();
        if (cw) {
            const LAS float* ct = (const LAS float*)(L + B_MISC);
            const float t0 = ct[j], t1 = ct[64 + j], t2 = ct[128 + j], t3 = ct[192 + j];
            const float base = tg == 0 ? 0.f : (tg == 1 ? t0 : (tg == 2 ? t0 + t1 : t0 + t1 + t2)), total = (t0 + t1) + (t2 + t3);
            float prev = base;
#pragma unroll
            for (int tt = 0; tt < 16; ++tt) { const int t = 16 * tg + tt; const float cum = base + cs[tt];
                const float eP = __expf(cum), eM = __expf(-cum), ePm1 = __expf(prev), eC = __expf(total - cum); prev = cum;
                const float at = -kk16[tt] * ePm1;
                *(LAS bf16*)(L + B_AB + RSW(t, j)) = (bf16)f2bf(at);
                *(LAS bf16*)(L + B_AB + 8192 + RSW(t, j)) = (bf16)f2bf(bb16[tt] * eM);
                *(LAS bf16*)(L + B_KT + RSW(t, j)) = (bf16)f2bf(k16[tt] * eM);
                *(LAS bf16*)(L + B_RT + RSW(t, j)) = (bf16)f2bf(r16[tt] * eP);
                *(LAS bf16*)(L + B_VT + RSW(j, t)) = (bf16)f2bf(v16[tt]);
                *(LAS bf16*)(L + B_ATT + RSW(j, t)) = (bf16)f2bf(at);
                *(LAS bf16*)(L + B_BHT + RSW(j, t)) = (bf16)f2bf(bb16[tt] * eC);
                *(LAS bf16*)(L + B_KHT + RSW(j, t)) = (bf16)f2bf(k16[tt] * eC); }
            if (tg == 0) ((LAS float*)(L + B_MISC))[256 + j] = __expf(total);
            if (chunk + (int)gridDim.x < NCHUNK) RK_LOAD(chunk + (int)gridDim.x);
        }
        RK_SYNC();
        f32x16 qab = {}, qak = {}, qrb = {}, qrk = {};
        if (cw && !(VAR & 2)) { mm(qab, L + B_AB, L + B_AB + 8192, tm, tn, r32, hi); mm(qak, L + B_AB, L + B_KT, tm, tn, r32, hi); mm(qrb, L + B_RT, L + B_AB + 8192, tm, tn, r32, hi); mm(qrk, L + B_RT, L + B_KT, tm, tn, r32, hi); }
        RK_SYNC();
        if (cw && !(VAR & 2)) {
#pragma unroll
            for (int r = 0; r < 16; ++r) { const int t = 32 * tm + crow(r, hi), s = 32 * tn + r32;
                ((LAS float*)(L + B_AB))[t * 64 + s] = s < t ? qab[r] : 0.f;
                qak[r] = s < t ? qak[r] : 0.f; qrb[r] = s <= t ? qrb[r] : 0.f; qrk[r] = s <= t ? qrk[r] : 0.f; }
            store_n(qak, L + B_LAK, tm, tn, r32, hi); store_n(qrb, L + B_LRB, tm, tn, r32, hi); store_n(qrk, L + B_LRK, tm, tn, r32, hi);
            if (wv == 2) store_t(qab, L + B_T, 1, 0, r32, hi);
        }
        RK_SYNC();
        if (wv == 0 && !(VAR & 7)) {
            const int blk = lane >> 5, cc = lane & 31;
            const LAS float* Lf = (const LAS float*)(L + B_AB) + (32 * blk) * 64 + 32 * blk;
            float Tr[32];
#pragma unroll
            for (int t = 0; t < 32; ++t) Tr[t] = 0.f;
#pragma unroll
            for (int t = 0; t < 32; ++t) { float a0 = Lf[t * 64 + cc], a1 = 0.f, a2 = 0.f, a3 = 0.f;
#pragma unroll
                for (int q = 0; q < (t + 3) / 4; ++q) { const f32x4 lv = *(const LAS f32x4*)(Lf + t * 64 + 4 * q);
                    a0 += lv[0] * Tr[4 * q + 0]; a1 += lv[1] * Tr[4 * q + 1]; a2 += lv[2] * Tr[4 * q + 2]; a3 += lv[3] * Tr[4 * q + 3]; }
                const float acc = (a0 + a1) + (a2 + a3); Tr[t] = acc;
                const bf16 tv = (bf16)f2bf(cc == t ? 1.0f + acc : acc);
                *(LAS bf16*)(L + B_T + RSW(32 * blk + t, 32 * blk + cc)) = tv;
                if (blk == 0) *(LAS bf16*)(L + B_X2 + cc * 64 + t * 2) = tv; }
            LDS_WAIT(); asm volatile("" ::: "memory");
            f32x16 z = {};
#pragma unroll
            for (int ks = 0; ks < 2; ++ks) { const bf16x8 af = *(LAS const bf16x8*)(L + B_T + RSW(32 + r32, 32 + 16 * ks + 8 * hi)), bfr = *(LAS const bf16x8*)(L + B_T + RSW(r32, 32 + 16 * ks + 8 * hi));
                z = __builtin_amdgcn_mfma_f32_32x32x16_bf16(af, bfr, z, 0, 0, 0); }
#pragma unroll
            for (int r = 0; r < 16; ++r) *(LAS bf16*)(L + B_T + RSW(32 + crow(r, hi), r32)) = (bf16)f2bf(z[r]);
            LDS_WAIT(); asm volatile("" ::: "memory");
            f32x16 t21 = {};
#pragma unroll
            for (int ks = 0; ks < 2; ++ks) { const bf16x8 af = *(LAS const bf16x8*)(L + B_T + RSW(32 + r32, 16 * ks + 8 * hi)), bfr = *(LAS const bf16x8*)(L + B_X2 + r32 * 64 + (16 * ks + 8 * hi) * 2);
                t21 = __builtin_amdgcn_mfma_f32_32x32x16_bf16(af, bfr, t21, 0, 0, 0); }
            LDS_WAIT(); asm volatile("" ::: "memory");
#pragma unroll
            for (int r = 0; r < 16; ++r) *(LAS bf16*)(L + B_T + RSW(32 + crow(r, hi), r32)) = (bf16)f2bf(t21[r]);
            *(LAS v4u*)(L + B_T + RSW(r32, 32 + 16 * hi)) = (v4u){0u, 0u, 0u, 0u}; *(LAS v4u*)(L + B_T + RSW(r32, 32 + 16 * hi + 8)) = (v4u){0u, 0u, 0u, 0u};
        } else if (cw && !(VAR & 6)) {
            for (int tile = (wv == 1 ? 0 : wv); tile < (wv == 1 ? 2 : wv + 1); ++tile) { f32x16 x = {}; mm(x, L + B_LAK, L + B_VT, tile >> 1, tile & 1, r32, hi); store_t(x, L + B_KT, tile >> 1, tile & 1, r32, hi); }
        }
        RK_SYNC();
        if (cw && !(VAR & 6)) { f32x16 u = {}, w = {}; mm(u, L + B_T, L + B_KT, tm, tn, r32, hi); mm(w, L + B_T, L + B_ATT, tm, tn, r32, hi);
            store_t(u, L + B_LAK, tm, tn, r32, hi); store_t(w, L + B_AB, tm, tn, r32, hi); }
        RK_SYNC();
        if (cw && !(VAR & 6)) {
            { f32x16 q = {}; mm(q, L + B_AB, L + B_LRB, tm, tn, r32, hi);
#pragma unroll
              for (int g = 0; g < 4; ++g) { const v2u rw = *(LAS const v2u*)(L + B_RT + RSW(32 * tn + r32, 32 * tm + 8 * g + 4 * hi));
                  q[4 * g] += blo(rw.x); q[4 * g + 1] += bhi(rw.x); q[4 * g + 2] += blo(rw.y); q[4 * g + 3] += bhi(rw.y); }
              v4u* dst = (v4u*)(blob + O_RH) + (size_t)(tn * 4 + 2 * tm) * 64 + lane; dst[0] = frag8(q, 0); dst[64] = frag8(q, 1); }
            { f32x16 q = {}; mm(q, L + B_AB, L + B_BHT, tm, tn, r32, hi);
              const float gcv = ((const LAS float*)(L + B_MISC))[256 + 32 * tn + r32];
#pragma unroll
              for (int r = 0; r < 16; ++r) if (32 * tm + crow(r, hi) == 32 * tn + r32) q[r] += gcv;
              v4u* dst = (v4u*)(blob + O_PT) + (size_t)(tn * 4 + 2 * tm) * 64 + lane; dst[0] = frag8(q, 0); dst[64] = frag8(q, 1); }
            { f32x16 q = {}; mm(q, L + B_LRB, L + B_LAK, tm, tn, r32, hi); mm(q, L + B_LRK, L + B_VT, tm, tn, r32, hi);
              unsigned* dst = (unsigned*)(blob + O_Y0) + (size_t)(2 * tm + tn) * 1024 + lane;
#pragma unroll
              for (int p = 0; p < 8; ++p) dst[p * 64] = pg8::cvt_pk_bf16(q[2 * p], q[2 * p + 1]); }
            { f32x16 q = {}; mm(q, L + B_BHT, L + B_LAK, tm, tn, r32, hi); mm(q, L + B_KHT, L + B_VT, tm, tn, r32, hi);
              unsigned* dst = (unsigned*)(blob + O_LMT) + (size_t)(2 * tm + tn) * 1024 + lane;
#pragma unroll
              for (int p = 0; p < 8; ++p) dst[p * 64] = pg8::cvt_pk_bf16(q[2 * p], q[2 * p + 1]); }
        }
        RK_SYNC();
    }
#undef RK_HELPN
#undef RK_LOAD
#undef RK_LOAD2
#undef RK_FIN
#undef RK_ISS
#undef RK_SYNC
}
__device__ __forceinline__ void rk_sequential(KArgs a, Frame& F, int l) {
    const int bx = pg8::obid();
    if (bx >= 32) {
        LAS float* scr = (LAS float*)(F.lds + RING_OFF + F.wave * 16384);
        convert_range(a, F, l, NIT_A, NIT, (bx - 32) * NWAVES + F.wave, ((int)gridDim.x - 32) * NWAVES);
        return; }
    if (F.wave >= 2) return;
    const int ii = F.wave, lane = F.lane; unsigned char* blobs = F.ws + WS_RKC + (size_t)bx * 64 * BLOB;
    f32x16 xa0 = {}, xa1 = {}, xb0, xb1, xc0, xc1; v4u pa[8], pb[8], pc[8];
#define RKS_LDP(P, c_) do { if ((c_) < 64) { const v4u* pt_ = (const v4u*)(blobs + (size_t)(c_) * BLOB + O_PT) + lane; _Pragma("unroll") for (int q = 0; q < 8; ++q) P[q] = pt_[q * 64]; } } while (0)
#define RKS_LDL(L0, L1, c_) do { if ((c_) < 64) { const unsigned* lm_ = (const unsigned*)(blobs + (size_t)(c_) * BLOB + O_LMT) + lane; \
        _Pragma("unroll") for (int p = 0; p < 8; ++p) { const unsigned w0_ = lm_[(size_t)(0 + ii) * 1024 + p * 64], w1_ = lm_[(size_t)(2 + ii) * 1024 + p * 64]; \
            L0[2 * p] = blo(w0_); L0[2 * p + 1] = bhi(w0_); L1[2 * p] = blo(w1_); L1[2 * p + 1] = bhi(w1_); } } } while (0)
#define RKS_STEP(P, s0, s1, l0, l1, c_) do { unsigned char* blob = blobs + (size_t)(c_) * BLOB; \
        v4u bf[4]; bf[0] = frag8(s0, 0); bf[1] = frag8(s0, 1); bf[2] = frag8(s1, 0); bf[3] = frag8(s1, 1); \
        RKS_LDL(s0, s1, (c_) + 2);     \
        { v4u* sc = (v4u*)(blob + O_SC) + (size_t)ii * 256 + lane; sc[0] = bf[0]; sc[64] = bf[1]; sc[128] = bf[2]; sc[192] = bf[3]; } \
        _Pragma("unroll") for (int ks = 0; ks < 4; ++ks) { l0 = __builtin_amdgcn_mfma_f32_32x32x16_bf16(__builtin_bit_cast(bf16x8, P[ks]), __builtin_bit_cast(bf16x8, bf[ks]), l0, 0, 0, 0); \
                                                         l1 = __builtin_amdgcn_mfma_f32_32x32x16_bf16(__builtin_bit_cast(bf16x8, P[4 + ks]), __builtin_bit_cast(bf16x8, bf[ks]), l1, 0, 0, 0); } \
        RKS_LDP(P, (c_) + 3); } while (0)
    RKS_LDP(pa, 0); RKS_LDL(xb0, xb1, 0); RKS_LDP(pb, 1); RKS_LDL(xc0, xc1, 1); RKS_LDP(pc, 2);
#pragma unroll 1
    for (int c = 0; c < 63; c += 3) {
        RKS_STEP(pa, xa0, xa1, xb0, xb1, c);
        RKS_STEP(pb, xb0, xb1, xc0, xc1, c + 1);
        RKS_STEP(pc, xc0, xc1, xa0, xa1, c + 2);
    }
    RKS_STEP(pa, xa0, xa1, xb0, xb1, 63);
#undef RKS_LDP
#undef RKS_LDL
#undef RKS_STEP
}
template <int CHECK> __device__ __forceinline__ void rk_output(Frame& F, float* RWY, const float* REF, float* errw) {
    float e2 = 0.f, r2 = 0.f;
    const int gw = F.vcu * NWAVES + F.wave, NGW = F.G * NWAVES, lane = F.lane, r32 = lane & 31, hi = lane >> 5;
    for (int task = gw; task < NCHUNK * 2; task += NGW) { const int chunk = task >> 1, ii = task & 1; const int seq = chunk >> 6, c = chunk & 63, b = seq >> 4, h = seq & 15;
        const unsigned char* blob = F.ws + WS_RKC + (size_t)chunk * BLOB;
        v4u bf[4]; { const v4u* sc = (const v4u*)(blob + O_SC) + (size_t)ii * 256 + lane; bf[0] = sc[0]; bf[1] = sc[64]; bf[2] = sc[128]; bf[3] = sc[192]; }
#pragma unroll
        for (int tt = 0; tt < 2; ++tt) { f32x16 y; const unsigned* y0 = (const unsigned*)(blob + O_Y0) + (size_t)(2 * tt + ii) * 1024 + lane;
#pragma unroll
            for (int p = 0; p < 8; ++p) { const unsigned w = y0[p * 64]; y[2 * p] = blo(w); y[2 * p + 1] = bhi(w); }
            const v4u* rh = (const v4u*)(blob + O_RH) + (size_t)(tt * 4) * 64 + lane;
#pragma unroll
            for (int ks = 0; ks < 4; ++ks) y = __builtin_amdgcn_mfma_f32_32x32x16_bf16(__builtin_bit_cast(bf16x8, rh[ks * 64]), __builtin_bit_cast(bf16x8, bf[ks]), y, 0, 0, 0);
            float* dst = RWY + ((size_t)b * SEQ + (size_t)c * 64 + 32 * tt) * 1024 + h * 64 + 32 * ii + r32;
#pragma unroll
            for (int r = 0; r < 16; ++r) dst[(size_t)crow(r, hi) * 1024] = y[r];
            if (CHECK) { const float* rf = REF + (dst - RWY);
#pragma unroll
                for (int r = 0; r < 16; ++r) { const float o = rf[(size_t)crow(r, hi) * 1024], d = y[r] - o; e2 += d * d; r2 += o * o; } } }
    }
    if (CHECK) { e2 = wave_sum(e2); r2 = wave_sum(r2); if (lane == 0) { atomicAdd(errw, e2); atomicAdd(errw + 1, r2); } }
}
__device__ __forceinline__ void rk_output_fused(KArgs a, Frame& F, int l) {
    LAS float* ybuf = (LAS float*)(F.lds + RING_OFF);
    const int lane = F.lane, r32 = lane & 31, hi = lane >> 5, wv = F.wave;
    const bf16* RWV = (const bf16*)(F.ws + WS_RWV); const bf16* RWG = (const bf16*)(F.ws + WS_RWG); const float* BON = (const float*)(F.ws + WS_BON);
    bf16* Y2 = (bf16*)(F.ws + WS_YBR) + (size_t)2 * NTOK * 1024;
    const float* lg = a->in[12] + (size_t)l * 1024; const float* lb = a->in[13] + (size_t)l * 1024;
    for (int grp = pg8::obid(); grp < 512; grp += (int)gridDim.x) { const int hq = grp & 3, c = (grp >> 2) & 63, b = grp >> 8;
        { const int h = 4 * hq + (wv >> 1), ii = wv & 1, chunk = (b * 16 + h) * 64 + c;
          const unsigned char* blob = F.ws + WS_RKC + (size_t)chunk * BLOB;
          v4u bf[4]; { const v4u* sc = (const v4u*)(blob + O_SC) + (size_t)ii * 256 + lane; bf[0] = sc[0]; bf[1] = sc[64]; bf[2] = sc[128]; bf[3] = sc[192]; }
#pragma unroll
          for (int tt = 0; tt < 2; ++tt) { f32x16 y; const unsigned* y0 = (const unsigned*)(blob + O_Y0) + (size_t)(2 * tt + ii) * 1024 + lane;
#pragma unroll
              for (int p = 0; p < 8; ++p) { const unsigned w = y0[p * 64]; y[2 * p] = blo(w); y[2 * p + 1] = bhi(w); }
              const v4u* rh = (const v4u*)(blob + O_RH) + (size_t)(tt * 4) * 64 + lane;
#pragma unroll
              for (int ks = 0; ks < 4; ++ks) y = __builtin_amdgcn_mfma_f32_32x32x16_bf16(__builtin_bit_cast(bf16x8, rh[ks * 64]), __builtin_bit_cast(bf16x8, bf[ks]), y, 0, 0, 0);
              LAS float* dst = ybuf + (32 * tt) * 256 + (wv >> 1) * 64 + 32 * ii + r32;
#pragma unroll
              for (int r = 0; r < 16; ++r) dst[crow(r, hi) * 256] = y[r]; } }
        __syncthreads();
        v2u pvw[8], pgw[8]; float pbon[8];
#pragma unroll
        for (int q = 0; q < 8; ++q) { const int tl = 8 * wv + q; const int t = b * SEQ + c * 64 + tl; const size_t idx = (size_t)t * 1024 + hq * 256 + 4 * lane;
            pvw[q] = *(const v2u*)(RWV + idx); pgw[q] = *(const v2u*)(RWG + idx); pbon[q] = BON[t * 16 + hq * 4 + (lane >> 4)]; }
        const f32x4 lgv = *(const f32x4*)(lg + hq * 256 + 4 * lane), lbv = *(const f32x4*)(lb + hq * 256 + 4 * lane);
#pragma unroll
        for (int q = 0; q < 8; ++q) { const int tl = 8 * wv + q; const int t = b * SEQ + c * 64 + tl; const int cc = hq * 256 + 4 * lane; const size_t idx = (size_t)t * 1024 + cc;
            const f32x4 y = *(const LAS f32x4*)(ybuf + tl * 256 + 4 * lane);
            const float mu = dpp16((y[0] + y[1]) + (y[2] + y[3])) * (1.0f / 64.0f); const f32x4 d = y - mu;
            const float var = dpp16((d[0] * d[0] + d[1] * d[1]) + (d[2] * d[2] + d[3] * d[3])) * (1.0f / 64.0f);
            f32x4 yn = d * rsqrtf(var + GN_EPS) * lgv + lbv;
            yn += pbon[q] * (f32x4){blo(pvw[q].x), bhi(pvw[q].x), blo(pvw[q].y), bhi(pvw[q].y)};
            yn *= (f32x4){blo(pgw[q].x), bhi(pgw[q].x), blo(pgw[q].y), bhi(pgw[q].y)};
            v2u w; w.x = pk2(yn[0], yn[1]); w.y = pk2(yn[2], yn[3]); *(v2u*)(Y2 + idx) = w; }
        __syncthreads();
    }
}
#undef RSW
}
namespace att {
constexpr int SHM_K = 64 * 128 * 2, SHM_V = 64 * 128 * 2;
constexpr float ATT_STOP = -40.0f;
#define KSWZ(row, colB) ((row) * 256 + ((colB) ^ (((row) & 7) << 4)))
__device__ __forceinline__ int v_st(int k, int c) { const int kk = (k & ~0xC) | ((k & 4) << 1) | ((k & 8) >> 1); return ((kk >> 3) * 4 + (c >> 5)) * 512 + ((kk & 7) * 32 + (c & 31)) * 2; }
__device__ __forceinline__ int v_rd_base(int lane) { return ((lane & 3) << 3) | (((lane >> 2) & 3) << 6) | (((lane >> 4) & 1) << 5) | (((lane >> 5) & 1) << 8); }
constexpr int v_rd_off(int d0, int ks, int half) { return d0 * 512 + ks * 4096 + half * 2048; }
__device__ __forceinline__ int crow(int r, int hi) { return (r & 3) + 8 * (r >> 2) + 4 * hi; }
__device__ __forceinline__ unsigned cvtpk(float lo, float hi) { return pg8::cvt_pk_bf16(lo, hi); }
__device__ __forceinline__ int kperm(int m) { return 16 * ((m >> 2) & 1) + 4 * (m >> 3) + (m & 3); }

__device__ __forceinline__ void qkt(f32x16& p0, f32x16& p1, LAS const char* K_lds, int r32, int hi, const bf16x8* qr) {
    p0 = f32x16{}; p1 = f32x16{};
    LAS const char* kb[4];
#pragma unroll
    for (int dd = 0; dd < 4; ++dd) kb[dd] = K_lds + KSWZ(r32, (dd * 16 + hi * 8) * 2);
#pragma unroll
    for (int d0 = 0; d0 < 8; ++d0) { LAS const char* ap = kb[d0 & 3] + (d0 >> 2) * 128;
        const bf16x8 b0 = *(LAS const bf16x8*)ap;
        const bf16x8 b1 = *(LAS const bf16x8*)(ap + 32 * 256);
        p0 = __builtin_amdgcn_mfma_f32_32x32x16_bf16(b0, qr[d0], p0, 0, 0, 0);
        p1 = __builtin_amdgcn_mfma_f32_32x32x16_bf16(b1, qr[d0], p1, 0, 0, 0); }
}
__device__ __forceinline__ void pv_tile(f32x16* o, int vb0, bf16x8 pa0, bf16x8 pa1, bf16x8 pa2, bf16x8 pa3) {
#define TRRD(dst, off) asm volatile("ds_read_b64_tr_b16 %0, %1 offset:%2" : "=&v"(dst) : "v"(vb0), "i"(off) : "memory")
#define PV_D0(d0) do { s16x4 l0, l1, l2, l3, h0, h1, h2, h3; constexpr int b_ = v_rd_off(d0, 0, 0); \
        TRRD(l0, b_); TRRD(h0, b_ + 2048); TRRD(l1, b_ + 4096); TRRD(h1, b_ + 6144); TRRD(l2, b_ + 8192); TRRD(h2, b_ + 10240); TRRD(l3, b_ + 12288); TRRD(h3, b_ + 14336); \
        asm volatile("s_waitcnt lgkmcnt(0)" ::: "memory"); __builtin_amdgcn_sched_barrier(0); \
        o[d0] = __builtin_amdgcn_mfma_f32_32x32x16_bf16(pa0, (bf16x8){l0[0], l0[1], l0[2], l0[3], h0[0], h0[1], h0[2], h0[3]}, o[d0], 0, 0, 0);   \
        o[d0] = __builtin_amdgcn_mfma_f32_32x32x16_bf16(pa1, (bf16x8){l1[0], l1[1], l1[2], l1[3], h1[0], h1[1], h1[2], h1[3]}, o[d0], 0, 0, 0);   \
        o[d0] = __builtin_amdgcn_mfma_f32_32x32x16_bf16(pa2, (bf16x8){l2[0], l2[1], l2[2], l2[3], h2[0], h2[1], h2[2], h2[3]}, o[d0], 0, 0, 0);   \
        o[d0] = __builtin_amdgcn_mfma_f32_32x32x16_bf16(pa3, (bf16x8){l3[0], l3[1], l3[2], l3[3], h3[0], h3[1], h3[2], h3[3]}, o[d0], 0, 0, 0); } while (0)
    PV_D0(0); PV_D0(1); PV_D0(2); PV_D0(3);
#undef PV_D0
#undef TRRD
}
__device__ __forceinline__ void stick_tile(f32x16& p0, f32x16& p1, float& c, int t, int kb0, int hi) {
    const float CS = 0.08838834764831845f * 1.4426950408889634f;
    const int k0 = kb0 + 16 * hi, k1 = k0 + 32;
    float f0[16], f1[16]; float T0 = 0.f, T1 = 0.f;
#pragma unroll
    for (int r = 0; r < 16; ++r) {
        const float y0 = p0[r] * CS, y1 = p1[r] * CS;
        const float sp0 = __builtin_amdgcn_logf(1.0f + __builtin_amdgcn_exp2f(y0)), sp1 = __builtin_amdgcn_logf(1.0f + __builtin_amdgcn_exp2f(y1));
        f0[r] = (k0 + r < t) ? -sp0 : 0.f; f1[r] = (k1 + r < t) ? -sp1 : 0.f;
        p0[r] = y0 - sp0; p1[r] = y1 - sp1;
        T0 += f0[r]; T1 += f1[r];
    }
    const auto s1 = __builtin_amdgcn_permlane32_swap(__float_as_uint(T1), __float_as_uint(T1), false, false);
    const auto s0 = __builtin_amdgcn_permlane32_swap(__float_as_uint(T0), __float_as_uint(T0), false, false);
    const float T1lo = __uint_as_float(s1[0]), T1hi = __uint_as_float(s1[1]), T0lo = __uint_as_float(s0[0]), T0hi = __uint_as_float(s0[1]);
    const float c1 = c + T1hi, c2 = c1 + T1lo, c3 = c2 + T0hi, c4 = c3 + T0lo;
    float run1 = hi ? c : c1, run0 = hi ? c2 : c3;
#pragma unroll
    for (int r = 15; r >= 0; --r) {
        const float w1 = (k1 + r < t) ? __builtin_amdgcn_exp2f(p1[r] + run1) : 0.f; run1 += f1[r]; p1[r] = w1;
        const float w0 = (k0 + r < t) ? __builtin_amdgcn_exp2f(p0[r] + run0) : 0.f; run0 += f0[r]; p0[r] = w0;
    }
    c = c4;
}
#define PK4(P, B_, OUT) do { unsigned a0 = cvtpk(P[B_+0], P[B_+1]), a1 = cvtpk(P[B_+2], P[B_+3]);                          \
        unsigned b0 = cvtpk(P[B_+4], P[B_+5]), b1 = cvtpk(P[B_+6], P[B_+7]);                                             \
        auto r0 = __builtin_amdgcn_permlane32_swap(a0, b0, false, false); auto r1 = __builtin_amdgcn_permlane32_swap(a1, b1, false, false); \
        v4u w = {r0[0], r1[0], r0[1], r1[1]}; OUT = __builtin_bit_cast(bf16x8, w); } while (0)

__device__ __forceinline__ void attn_unit(LAS unsigned char* lds, const bf16* QKV, bf16* O, int b, int h, int qb) {
    const int tid = pg8::otid(), wid = __builtin_amdgcn_readfirstlane(tid >> 6), lane = tid & 63, r32 = lane & 31, hi = lane >> 5;
    LAS char* V_lds = (LAS char*)lds; LAS char* K_lds = (LAS char*)lds + SHM_V; volatile LAS int* flags = (volatile LAS int*)(lds + SHM_V + SHM_K);
    const bf16* Qp = QKV + (size_t)b * SEQ * 3072 + h * 128; const bf16* Kp = Qp + 1024; const bf16* Vp = Qp + 2048;
    const int qlo = qb * 256 + wid * 32, t = qlo + r32;
    bf16x8 qr[8];
#pragma unroll
    for (int d0 = 0; d0 < 8; ++d0) qr[d0] = *(const bf16x8*)(Qp + (size_t)t * 3072 + d0 * 16 + hi * 8);
    const int sr = tid >> 4, sc = (tid & 15) * 8, kr = kperm(sr);
    const int kws = KSWZ(sr, sc * 2), vst0 = v_st(sr, sc), vst1 = v_st(32 + sr, sc);
    const int vb0 = (int)(unsigned)(uintptr_t)V_lds + v_rd_base(lane);
    f32x16 o[4] = {}; float c = 0.f; bool done = false;
    if (tid < 8) flags[tid] = 0;
    bf16x8 k0v, k1v, v0v, v1v;
#define ATT_LOAD(j_) do { const int kb_ = (j_) * 64; k0v = *(const bf16x8*)(Kp + (size_t)(kb_ + kr) * 3072 + sc); k1v = *(const bf16x8*)(Kp + (size_t)(kb_ + 32 + kr) * 3072 + sc); \
        v0v = *(const bf16x8*)(Vp + (size_t)(kb_ + kr) * 3072 + sc); v1v = *(const bf16x8*)(Vp + (size_t)(kb_ + 32 + kr) * 3072 + sc); } while (0)
#define ATT_BAR() do { asm volatile("s_waitcnt lgkmcnt(0)" ::: "memory"); __builtin_amdgcn_s_barrier(); asm volatile("" ::: "memory"); } while (0)
    ATT_LOAD(4 * qb + 3);
    for (int j = 4 * qb + 3; j >= 0; --j) {
        const int kb0 = j * 64;
        ATT_BAR();
        bool all_done = true;
#pragma unroll
        for (int w = 0; w < 8; ++w) all_done = all_done && (flags[w] != 0);
        if (all_done) break;
        *(LAS bf16x8*)(K_lds + kws) = k0v; *(LAS bf16x8*)(K_lds + kws + 32 * 256) = k1v;
        *(LAS bf16x8*)(V_lds + vst0) = v0v; *(LAS bf16x8*)(V_lds + vst1) = v1v;
        if (j > 0) ATT_LOAD(j - 1);
        ATT_BAR();
        if (!done && kb0 <= qlo + 30) {
            f32x16 p0, p1;
            qkt(p0, p1, K_lds, r32, hi, qr);
            stick_tile(p0, p1, c, t, kb0, hi);
            bf16x8 pa0, pa1, pa2, pa3;
            PK4(p0, 0, pa0); PK4(p0, 8, pa1); PK4(p1, 0, pa2); PK4(p1, 8, pa3);
            pv_tile(o, vb0, pa0, pa1, pa2, pa3);
            done = __all(c < ATT_STOP) != 0;
            if (lane == 0 && done) flags[wid] = 1;
        }
    }
#undef ATT_LOAD
#undef ATT_BAR
    bf16* Ow = O + ((size_t)b * SEQ + qlo) * 1024 + h * 128;
#pragma unroll
    for (int r = 0; r < 16; ++r) { const int orow = crow(r, hi);
#pragma unroll
        for (int d0 = 0; d0 < 4; ++d0) { const float v = o[d0][r]; const float vn = __shfl_xor(v, 1);
            if ((r32 & 1) == 0) *(unsigned*)(Ow + (size_t)orow * 1024 + d0 * 32 + r32) = cvtpk(v, vn); } }
    __syncthreads();
}
#undef PK4
#undef KSWZ
}
__device__ __forceinline__ float shx(float v, int m) { return __shfl_xor(v, m); }
__device__ __forceinline__ float rdl(float v, int l) { return __builtin_bit_cast(float, __builtin_amdgcn_readlane(__builtin_bit_cast(int, v), l)); }
template <bool DO_LN> __device__ __forceinline__ void ph9_ln_router(KArgs a, Frame& F, int l) {
    volatile LAS int* lhist = (volatile LAS int*)(F.lds + RING_OFF);
    const float* PRE = (const float*)(F.ws + WS_PRELN); float* X1 = (float*)(F.ws + WS_X1); bf16* XS = (bf16*)(F.ws + WS_XS);
    int* HIST = (int*)(F.ws + WS_HIST); int* SELE = (int*)(F.ws + WS_SELE); float* SELW = (float*)(F.ws + WS_SELW);
    const float* g1 = a->in[16] + (size_t)l * DM; const float* b1 = a->in[17] + (size_t)l * DM;
    const float* WR = a->in[18] + (size_t)l * DM * 64; const float* rbias = a->in[19] + (size_t)l * 64;
    const int lane = F.lane;
    LAS f32x4* LG1 = (LAS f32x4*)(F.lds + RING_OFF + 102400); LAS f32x4* LB1 = LG1 + 512;
    if (DO_LN) { LG1[F.tid] = ((const f32x4*)g1)[F.tid]; LB1[F.tid] = ((const f32x4*)b1)[F.tid]; }
    for (int grp = pg8::obid(); grp < 256; grp += F.G) {
        if (F.tid < 64) lhist[F.tid] = 0;
        __syncthreads();
        const int t0 = grp * 32 + F.wave * 4;
#pragma unroll 1
        for (int k = 0; k < (DO_LN ? 4 : 0); ++k) {
            f32x4 v[8];
            const f32x4* row = (const f32x4*)(PRE + (size_t)(t0 + k) * DM) + lane; float s = 0.f;
#pragma unroll
            for (int j = 0; j < 8; ++j) { v[j] = row[64 * j]; s += (v[j][0] + v[j][1]) + (v[j][2] + v[j][3]); }
            const float mean = wave_sum(s) * (1.0f / DM); float s2 = 0.f;
#pragma unroll
            for (int j = 0; j < 8; ++j) { v[j] = v[j] - mean; s2 += (v[j][0] * v[j][0] + v[j][1] * v[j][1]) + (v[j][2] * v[j][2] + v[j][3] * v[j][3]); }
            const float rstd = 1.0f / sqrtf(wave_sum(s2) * (1.0f / DM) + LN_EPS);
            f32x4* xo = (f32x4*)(X1 + (size_t)(t0 + k) * DM) + lane; v2u* bo = (v2u*)(XS + (size_t)(t0 + k) * DM) + lane;
#pragma unroll
            for (int j = 0; j < 8; ++j) { const f32x4 gg = LG1[64 * j + lane], bb = LB1[64 * j + lane];
                v[j] = v[j] * rstd * gg + bb; (void)xo;
                v2u w; w.x = pk2(v[j][0], v[j][1]); w.y = pk2(v[j][2], v[j][3]); bo[64 * j] = w; }
            if (lane == 0) { ((LAS float*)(F.lds + RING_OFF + 512))[2 * (F.wave * 4 + k)] = mean; ((LAS float*)(F.lds + RING_OFF + 512))[2 * (F.wave * 4 + k) + 1] = rstd; }
        }
        __syncthreads();
        LAS float* XC = (LAS float*)(F.lds + RING_OFF + 1024);
        LAS float* WC = (LAS float*)(F.lds + RING_OFF + 1024 + 33024);
        f32x16 ac0 = {}, ac1 = {};
        f32x4 px[4], pw[8]; float rmean[4], rrstd[4];
        if (DO_LN) {
#pragma unroll
            for (int i = 0; i < 4; ++i) { const int xrow = (F.tid >> 6) + 8 * i; rmean[i] = ((const LAS float*)(F.lds + RING_OFF + 512))[2 * xrow]; rrstd[i] = ((const LAS float*)(F.lds + RING_OFF + 512))[2 * xrow + 1]; } }
#define RT_LOAD(j_) do { if (DO_LN) {   \
          _Pragma("unroll") for (int i = 0; i < 4; ++i) { const int idx = F.tid + 512 * i, xrow = idx >> 6, c4 = idx & 63; px[i] = *(const f32x4*)(PRE + (size_t)(grp * 32 + xrow) * DM + 256 * (j_) + 4 * c4); } } else { \
          _Pragma("unroll") for (int i = 0; i < 4; ++i) { const int idx = F.tid + 512 * i, xrow = idx >> 6, c4 = idx & 63; px[i] = *(const f32x4*)(X1 + (size_t)(grp * 32 + xrow) * DM + 256 * (j_) + 4 * c4); } } \
        const f32x4* wsrc = (const f32x4*)(WR + (size_t)256 * (j_) * 64); _Pragma("unroll") for (int i = 0; i < 8; ++i) pw[i] = wsrc[F.tid + 512 * i]; } while (0)
#define RT_BAR() do { asm volatile("s_waitcnt lgkmcnt(0)" ::: "memory"); __builtin_amdgcn_s_barrier(); asm volatile("" ::: "memory"); } while (0)
        RT_LOAD(0);
#pragma unroll 1
        for (int j = 0; j < 8; ++j) {
            RT_BAR();
            if (DO_LN) { const f32x4 gg_ = LG1[64 * j + lane], bb_ = LB1[64 * j + lane];
#pragma unroll
                for (int i = 0; i < 4; ++i) { f32x4 t_ = px[i] - rmean[i]; px[i] = t_ * rrstd[i] * gg_ + bb_; } }
#pragma unroll
            for (int i = 0; i < 4; ++i) { const int idx = F.tid + 512 * i, xrow = idx >> 6, c4 = idx & 63;
                LAS float* xr = XC + xrow * 257 + 4 * c4; xr[0] = px[i][0]; xr[1] = px[i][1]; xr[2] = px[i][2]; xr[3] = px[i][3]; }
#pragma unroll
            for (int i = 0; i < 8; ++i) ((LAS f32x4*)WC)[F.tid + 512 * i] = pw[i];
            if (j + 1 < 8) RT_LOAD(j + 1);
            RT_BAR();
#pragma unroll
            for (int kk = 0; kk < 16; ++kk) { const int kidx = 32 * F.wave + 2 * kk + (lane >> 5);
                const float av = XC[(lane & 31) * 257 + kidx], b0 = WC[kidx * 64 + (lane & 31)], b1 = WC[kidx * 64 + 32 + (lane & 31)];
                ac0 = __builtin_amdgcn_mfma_f32_32x32x2f32(av, b0, ac0, 0, 0, 0); ac1 = __builtin_amdgcn_mfma_f32_32x32x2f32(av, b1, ac1, 0, 0, 0); }
        }
#undef RT_LOAD
#undef RT_BAR
        __syncthreads();
        { LAS float* RED = WC; const int hi = lane >> 5, e = lane & 31;
#pragma unroll
          for (int r = 0; r < 16; ++r) { const int tok = (r & 3) + 8 * (r >> 2) + 4 * hi; RED[(F.wave * 32 + tok) * 64 + e] = ac0[r]; RED[(F.wave * 32 + tok) * 64 + 32 + e] = ac1[r]; } }
        __syncthreads();
        float acc[4];
#pragma unroll
        for (int k = 0; k < 4; ++k) { float sacc = 0.f;
#pragma unroll
            for (int w2 = 0; w2 < 8; ++w2) sacc += WC[(w2 * 32 + F.wave * 4 + k) * 64 + lane];
            acc[k] = sacc; }
        const float rb = rbias[lane];
#pragma unroll
        for (int k = 0; k < 4; ++k) {
            const int t = t0 + k;
            const float lg = (acc[k] == acc[k]) ? acc[k] : 0.f;
            const float sc = 1.0f / (1.0f + expf(-lg)); const float bz = sc + rb;
            float m1 = bz; m1 = fmaxf(m1, shx(m1, 1)); m1 = fmaxf(m1, shx(m1, 2)); m1 = fmaxf(m1, shx(m1, 4));
            const unsigned long long eq = __ballot(bz == m1);
            const int g = lane >> 3; const unsigned gb = (unsigned)((eq >> (8 * g)) & 0xffull); const int first = __ffs((int)gb) - 1;
            float m2 = ((lane & 7) == first) ? -__builtin_inff() : bz; m2 = fmaxf(m2, shx(m2, 1)); m2 = fmaxf(m2, shx(m2, 2)); m2 = fmaxf(m2, shx(m2, 4));
            const float gs = m1 + m2;
            int grank = 0;
#pragma unroll
            for (int g2 = 0; g2 < 8; ++g2) { const float o = rdl(gs, 8 * g2); grank += ((o > gs) || (o == gs && g2 < g)) ? 1 : 0; }
            const bool gsel = grank < 4;
            const float mv = gsel ? bz : -__builtin_inff();
            int rank = 0;
            for (int e2 = 0; e2 < 64; ++e2) { const float o = rdl(mv, e2); rank += ((o > mv) || (o == mv && e2 < lane)) ? 1 : 0; }
            const bool sel = gsel && rank < 8;
            const float ssum = wave_sum(sel ? sc : 0.f);
            const float wgt = sc / ssum * ROUTED_SCALE;
            const unsigned long long m = __ballot(sel);
            const int slot = __popcll(m & ((1ull << lane) - 1ull));
            if (sel && slot < 8) { SELE[t * 8 + slot] = lane; SELW[t * 8 + slot] = wgt; __hip_atomic_fetch_add((LAS int*)&lhist[lane], 1, __ATOMIC_RELAXED, __HIP_MEMORY_SCOPE_WORKGROUP); }
        }
        __syncthreads();
        if (F.tid < 64) HIST[grp * 64 + F.tid] = lhist[F.tid];
        __syncthreads();
    }
}
__device__ __forceinline__ void ph10_lists(Frame& F) {
    volatile LAS int* L = (volatile LAS int*)(F.lds + RING_OFF);
    volatile LAS int* partT = L, * partB = L + 512, * rowbase = L + 1024, * lsel = L + 1088, * lpos = L + 1344;
    LAS unsigned* emask = (LAS unsigned*)(F.lds + RING_OFF) + 1700;
    const int* HIST = (const int*)(F.ws + WS_HIST); const int* SELE = (const int*)(F.ws + WS_SELE); const float* SELW = (const float*)(F.ws + WS_SELW);
    int* SLOT = (int*)(F.ws + WS_SLOT); float* ROWW = (float*)(F.ws + WS_ROWW); int* TSEG = (int*)(F.ws + WS_TSEG); int* ROWT = (int*)(F.ws + WS_ROWT); int* XT = (int*)(F.ws + WS_XT);
    for (int grp = pg8::obid(); grp < 256; grp += F.G) {
        { const int e = F.tid & 63, part = F.tid >> 6; int s = 0, bs = 0;
#pragma unroll
          for (int w2 = 0; w2 < 32; ++w2) { const int w = 32 * part + w2; const int hv = HIST[w * 64 + e]; s += hv; bs += (w < grp) ? hv : 0; }
          partT[part * 64 + e] = s; partB[part * 64 + e] = bs; }
        if (F.tid < 64) emask[F.tid] = 0u;
        __syncthreads();
        if (F.tid < 64) { int tot = 0, bef = 0;
#pragma unroll
            for (int p = 0; p < 8; ++p) { tot += partT[p * 64 + F.tid]; bef += partB[p * 64 + F.tid]; }
            const int nt = (tot + 255) >> 8; int incl = nt;
#pragma unroll
            for (int o = 1; o < 64; o <<= 1) { const int u = __shfl_up(incl, o); if (F.lane >= o) incl += u; }
            const int excl = incl - nt;
            rowbase[F.tid] = 8192 + 256 * excl + bef;
            if (grp == 0) { for (int i = 0; i < nt; ++i) TSEG[16 + 32 + excl + i] = F.tid + 1;
                for (int r = 8192 + 256 * excl + tot; r < 8192 + 256 * (excl + nt); ++r) ROWT[r] = 0;
                if (F.tid < 32) TSEG[16 + F.tid] = 0;
                if (F.tid == 63) TSEG[0] = 32 + incl; } }
        if (F.tid < 256) { const int e = SELE[grp * 256 + F.tid]; lsel[F.tid] = e; __hip_atomic_fetch_or(emask + e, 1u << (F.tid >> 3), __ATOMIC_RELAXED, __HIP_MEMORY_SCOPE_WORKGROUP); }
        __syncthreads();
        if (F.tid < 256) { const int j = F.tid >> 3, e = lsel[F.tid];
            const int rank = __popc(emask[e] & ((1u << j) - 1u));
            const int pos = rowbase[e] + rank; const int t = grp * 32 + j;
            SLOT[t * 8 + (F.tid & 7)] = pos; ROWW[pos] = SELW[grp * 256 + F.tid]; ROWT[pos] = t; }
        else if (F.tid < 288) { ROWW[grp * 32 + F.tid - 256] = 1.0f; ROWT[grp * 32 + F.tid - 256] = grp * 32 + F.tid - 256; }
        __syncthreads();
    }
}
__device__ __forceinline__ void ph13_combine(KArgs a, Frame& F, int l, float poison) {
    const int gw = F.vcu * NWAVES + F.wave, NGW = F.G * NWAVES, lane = F.lane;
    const bf16* X1B = (const bf16*)(F.ws + WS_XS); const bf16* YS = (const bf16*)(F.ws + WS_YS); const int* SLOT = (const int*)(F.ws + WS_SLOT);
    float* outf = (l == NLAYER - 1) ? a->out : (float*)(F.ws + WS_X2); bf16* XB = (bf16*)(F.ws + WS_XB);
    const float* g2 = a->in[26] + (size_t)l * DM; const float* b2 = a->in[27] + (size_t)l * DM;
    LAS f32x4* LG = (LAS f32x4*)(F.lds + RING_OFF); LAS f32x4* LB = LG + 512;
    LG[F.tid] = ((const f32x4*)g2)[F.tid]; LB[F.tid] = ((const f32x4*)b2)[F.tid];
    __syncthreads();
    for (int t = gw; t < NTOK; t += NGW) {
        const int mypos = (lane < 8) ? SLOT[t * 8 + lane] : t;
        float acc[4][8];
#pragma unroll
        for (int q = 0; q < 4; ++q) { float u[8]; unpack8(*((const v4u*)(X1B + (size_t)t * DM + 512 * q) + lane), u);
#pragma unroll
            for (int j = 0; j < 8; ++j) acc[q][j] = ALPHA * u[j]; }
#pragma unroll
        for (int s = 0; s < 9; ++s) { const int row = __builtin_amdgcn_readlane(mypos, s); const v4u* yr = (const v4u*)(YS + (size_t)row * DM) + lane;
#pragma unroll
            for (int q = 0; q < 4; ++q) { float u[8]; unpack8(yr[64 * q], u);
#pragma unroll
                for (int j = 0; j < 8; ++j) acc[q][j] += u[j]; } }
        float s1 = 0.f;
#pragma unroll
        for (int q = 0; q < 4; ++q)
#pragma unroll
            for (int j = 0; j < 8; ++j) s1 += acc[q][j];
        const float mean = wave_sum(s1) * (1.0f / DM); float s2 = 0.f;
#pragma unroll
        for (int q = 0; q < 4; ++q)
#pragma unroll
            for (int j = 0; j < 8; ++j) { acc[q][j] -= mean; s2 += acc[q][j] * acc[q][j]; }
        const float rstd = 1.0f / sqrtf(wave_sum(s2) * (1.0f / DM) + LN_EPS);
#pragma unroll
        for (int q = 0; q < 4; ++q) { const int col = 512 * q + 8 * lane; asm volatile("" ::: "memory");
            const f32x4 ga = LG[128 * q + 2 * lane], gb = LG[128 * q + 2 * lane + 1], ba = LB[128 * q + 2 * lane], bb = LB[128 * q + 2 * lane + 1];
            float y[8];
#pragma unroll
            for (int j = 0; j < 4; ++j) { y[j] = (acc[q][j] * rstd * ga[j] + ba[j]) * poison; y[4 + j] = (acc[q][4 + j] * rstd * gb[j] + bb[j]) * poison; }
            if (l == NLAYER - 1) { *(f32x4*)(outf + (size_t)t * DM + col) = (f32x4){y[0], y[1], y[2], y[3]}; *(f32x4*)(outf + (size_t)t * DM + col + 4) = (f32x4){y[4], y[5], y[6], y[7]}; }
            else *(v4u*)(XB + (size_t)t * DM + col) = pack8(y); }
    }
}
__device__ __forceinline__ KArgs kargs() { KArgs p = (KArgs)__builtin_amdgcn_kernarg_segment_ptr(); asm volatile("" : "+s"(p)); return p; }
__device__ __forceinline__ Frame mkframe(LAS unsigned char* lds) {
    Frame F; KArgs ka = kargs();
    F.lds = lds; F.MISC = (volatile LAS unsigned*)(lds + MISC_OFF);
    F.tid = pg8::otid(); F.lane = F.tid & 63; F.wave = __builtin_amdgcn_readfirstlane(F.tid >> 6);
    F.G = gridDim.x; { const int bx = pg8::obid(); F.vcu = (F.G % 8 == 0) ? (bx % 8) * (F.G / 8) + bx / 8 : bx; }
    F.ws = ka->ws; F.ctl = (gu32*)(ka->ws + WS_CTL);
    return F;
}
__device__ __forceinline__ void grid_seam(LAS unsigned char* lds) {
    XcdBarrier b; b.bar = (unsigned*)((gu32*)(kargs()->ws + WS_CTL) + CW_BAR); b.x = xb_xcc_id(); b.st = (volatile LAS unsigned*)(lds + MISC_OFF) + 8;
    xcd_barrier(b);
}
__global__ void __launch_bounds__(NWAVES * 64, 2) fwd_kernel(Args args_unused) {
    extern __shared__ __attribute__((aligned(16))) unsigned char lds_raw[];
    LAS unsigned char* lds = (LAS unsigned char*)lds_raw;
    for (int u = threadIdx.x; u < (LDS_BYTES - LDSCTL_OFF) / 4; u += NWAVES * 64) ((LAS unsigned*)(lds + LDSCTL_OFF))[u] = 0u;
    __syncthreads();
    if (kargs()->ph_hi - kargs()->ph_lo > 1) (void)xcd_barrier_post((unsigned*)((gu32*)(kargs()->ws + WS_CTL) + CW_BAR), (volatile LAS unsigned*)(lds + MISC_OFF) + 8);
#ifndef PH_MASK
#define PH_MASK 0xffff
#endif
#define IN(k) (((PH_MASK >> (k)) & 1) && kargs()->ph_lo <= (pb + (k)) && (pb + (k)) < kargs()->ph_hi)
#ifndef REP_MASK
#define REP_MASK 0
#endif
#define REPS(k) _Pragma("unroll 1") for (int rep_ = 0; rep_ < ((((REP_MASK) >> (k)) & 1) ? 2 : 1); ++rep_)
#define REPSEAM() do { if (rep_) grid_seam(lds); } while (0)
#define SEAM(k) do { if (IN(k) && (pb + (k) + 1) < kargs()->ph_hi) grid_seam(lds); } while (0)
#pragma unroll 1
    for (int l = 0; l < NLAYER; ++l) {
        const int pb = l * NPHASE;
        if (IN(0)) REPS(0) { REPSEAM(); Frame F = mkframe(lds); ph0_convert(kargs(), F, l); } SEAM(0);
        if (IN(1)) REPS(1) { REPSEAM(); unsigned char* ws = kargs()->ws;
            if (p1_items() > 0 && pg8::obid() >= 248) { Frame F = mkframe(lds); if (rep_ == 0) p1_convert(kargs(), F, l); } else {
            pg8::Gemm g{(const pg8::bf16_t*)(ws + WS_XB), (const pg8::bf16_t*)(ws + WS_WIN), NTOK, INP, DM}; pg8::StaticOrder S; S.init(NTOK, INP, p1_items() > 0 ? 248 : (int)gridDim.x, pg8::obid());
            pg8::EpiInProj E{(pg8::bf16_t*)(ws + WS_PCONV), (pg8::bf16_t*)(ws + WS_PQKV), (pg8::bf16_t*)(ws + WS_PRKV), (pg8::bf16_t*)(ws + WS_PLORA), (pg8::bf16_t*)(ws + WS_PGATE)};
            pg8::gemm_phase<pg8::EpiInProj, pg8::StaticOrder, true, true>(lds + RING_OFF, g, S, E); }
        } SEAM(1);
        if (IN(2)) REPS(2) { REPSEAM(); unsigned char* ws = kargs()->ws;
            for (int u = pg8::obid(); u < 256; u += gridDim.x) att::attn_unit(lds + RING_OFF, (const bf16*)(ws + WS_PQKV), (bf16*)(ws + WS_YBR) + (size_t)NTOK * 1024, u >> 7, (u >> 4) & 7, u & 15);
            Frame F = mkframe(lds); ph2_elementwise(kargs(), F, l);
        } SEAM(2);
        if (IN(3)) REPS(3) { REPSEAM(); unsigned char* ws = kargs()->ws;
            int k256 = 256; asm volatile("" : "+s"(k256));
            pg8::Gemm g{(const pg8::bf16_t*)(ws + WS_LORAA), (const pg8::bf16_t*)(ws + WS_WLORA), 3 * NTOK, 3072, k256}; pg8::LoraOrder S{(int)gridDim.x, pg8::obid()};
            pg8::EpiLora E{(float*)(ws + WS_RWW), (long)((WS_RWA - WS_RWW) / 4), (long)((WS_RWG - WS_RWW) / 4), kargs()->in[4] + (size_t)l * 1024, kargs()->in[6] + (size_t)l * 1024};
            pg8::gemm_phase<pg8::EpiLora, pg8::LoraOrder, true, true>(lds + RING_OFF, g, S, E);
        } SEAM(3);
#define MOE_C ((pg8::obid() & 7) * ((int)gridDim.x >> 3) + (pg8::obid() >> 3))
#ifndef FUSE_LN1
#define FUSE_LN1 0
#endif
#ifndef DOWN_ALIGN
#define DOWN_ALIGN true
#endif
#ifndef RK_FUSE_PREP
#define RK_FUSE_PREP 0
#endif
#ifndef RWKV_MODE
#define RWKV_MODE 1
#endif
#ifndef RK_CHECK
#define RK_CHECK 0
#endif
#ifndef RK_CHECK_HELP
#define RK_CHECK_HELP 0
#endif
#ifndef RK_CHECK_TOL
#define RK_CHECK_TOL 0.02f
#endif
        if ((RWKV_MODE == 0 || RK_CHECK || !RK_FUSE_PREP) && IN(4)) REPS(4) { REPSEAM(); Frame F = mkframe(lds); ph4_prep(kargs(), F, l); if ((pb + 5) < kargs()->ph_hi) grid_seam(lds); }

        if (IN(5)) REPS(5) { REPSEAM(); Frame F = mkframe(lds);
            if (RWKV_MODE == 0 || RK_CHECK) { ph5_scan<0>(kargs(), F, l); }
            if (RWKV_MODE == 1) { if (RK_CHECK) grid_seam(lds); rk::rk_chunk_local<(RK_CHECK && !RK_CHECK_HELP) ? 0 : 1, (RK_CHECK || !RK_FUSE_PREP) ? 0 : 1>(kargs(), F, l); }
        } SEAM(5);
#ifdef RK_PROBE
        if (IN(5)) { Frame F = mkframe(lds); rk::rk_chunk_local<0, 0, RK_PROBE>(kargs(), F, l); grid_seam(lds); }
#endif
        if (IN(6)) REPS(6) { REPSEAM(); Frame F = mkframe(lds); if (RWKV_MODE == 1) rk::rk_sequential(kargs(), F, l); } SEAM(6);
#ifndef RK_FUSE_OUT
#define RK_FUSE_OUT 1
#endif
        if (IN(7)) REPS(7) { REPSEAM(); Frame F = mkframe(lds);
            if (RWKV_MODE == 1 && RK_FUSE_OUT && !RK_CHECK) rk::rk_output_fused(kargs(), F, l);
            else if (RWKV_MODE == 1) rk::rk_output<RK_CHECK>(F, (float*)(F.ws + (RK_CHECK ? WS_M + 720 * MiB : WS_RWY)), (const float*)(F.ws + WS_RWY), (float*)(F.ctl + 2048 + 2 * l)); } SEAM(7);
        if (!(RWKV_MODE == 1 && RK_FUSE_OUT && !RK_CHECK) && IN(8)) REPS(8) { REPSEAM(); Frame F = mkframe(lds); ph6_rwkv_out(kargs(), F, l); if ((pb + 9) < kargs()->ph_hi) grid_seam(lds); }
        if (IN(9)) REPS(9) { REPSEAM(); unsigned char* ws = kargs()->ws;
            pg8::Gemm g{(const pg8::bf16_t*)(ws + WS_YBR), (const pg8::bf16_t*)(ws + WS_WBR), 3 * NTOK, 3 * DM, 1024}; pg8::BranchOrder S; S.so.init(NTOK, DM, (int)gridDim.x, pg8::obid());
            pg8::EpiGate E{(const pg8::bf16_t*)(ws + WS_PGATE), (pg8::bf16_t*)(ws + WS_PRELN), (pg8::bf16_t*)(ws + WS_MERGED)};
            pg8::gemm_phase<pg8::EpiGate, pg8::BranchOrder, true, true>(lds + RING_OFF, g, S, E);
        } SEAM(9);
        if (IN(10)) REPS(10) { REPSEAM(); unsigned char* ws = kargs()->ws;
            pg8::Gemm g{(const pg8::bf16_t*)(ws + WS_MERGED), (const pg8::bf16_t*)(ws + WS_WO), NTOK, DM, DM}; pg8::StaticOrder S; S.init(NTOK, DM, (int)gridDim.x, pg8::obid());
#if FUSE_LN1
            pg8::PanelStats8 st{(unsigned*)(ws + WS_LNX), (unsigned*)((gu32*)(ws + WS_CTL) + CW_LNC + l * 4096), (unsigned*)((gu32*)(ws + WS_CTL) + CW_TMO), LN_EPS};
            pg8::EpiWoLn E{l == 0 ? kargs()->in[0] : (const float*)(ws + WS_X2), (float*)(ws + WS_X1), (pg8::bf16_t*)(ws + WS_XS), kargs()->in[16] + (size_t)l * DM, kargs()->in[17] + (size_t)l * DM, ALPHA, st};
            pg8::gemm_phase<pg8::EpiWoLn, pg8::StaticOrder, false, true>(lds + RING_OFF, g, S, E);
#else
            pg8::EpiWo E{l == 0 ? kargs()->in[0] : (const float*)nullptr, (float*)(ws + WS_PRELN), ALPHA, (const pg8::bf16_t*)(ws + WS_XB)};
            pg8::gemm_phase<pg8::EpiWo, pg8::StaticOrder, true, true>(lds + RING_OFF, g, S, E);
#endif
        } SEAM(10);
        if (IN(11)) REPS(11) { REPSEAM(); Frame F = mkframe(lds); ph9_ln_router<!FUSE_LN1>(kargs(), F, l); } SEAM(11);
        if (IN(12)) REPS(12) { REPSEAM(); Frame F = mkframe(lds); ph10_lists(F); } SEAM(12);
#ifndef MOE_WT
#define MOE_WT 0
#endif
#ifndef MOE_HANDOFF
#define MOE_HANDOFF 0
#endif
        if (IN(13)) REPS(13) { REPSEAM(); unsigned char* ws = kargs()->ws;
            const int ntiles = __builtin_amdgcn_readfirstlane(ld_i32((const int*)(ws + WS_TSEG)));
            unsigned* hc = (unsigned*)((gu32*)(ws + WS_CTL) + CW_HC + l * 24576); unsigned* tmo = (unsigned*)((gu32*)(ws + WS_CTL) + CW_TMO);
            { pg8::Gemm g{(const pg8::bf16_t*)(ws + WS_XS), (const pg8::bf16_t*)(ws + WS_WGU), ntiles * 256, NSEG * 1024, DM};
              pg8::MoeOrder S{(const int*)(ws + WS_TSEG) + 16, ntiles, 4, (int)gridDim.x, MOE_C, hc, tmo, MOE_HANDOFF ? 1 : 0};
              pg8::EpiSwiglu<(MOE_HANDOFF != 0) || MOE_WT> E{(pg8::bf16_t*)(ws + WS_H), (const float*)(ws + WS_ROWW)};
              pg8::gemm_phase_gather<pg8::EpiSwiglu<(MOE_HANDOFF != 0) || MOE_WT>, pg8::MoeOrder, true, true>(lds + RING_OFF, g, S, E, (const int*)(ws + WS_ROWT)); }
            if (l + 1 < NLAYER && rep_ == 0 && next_win_early(kargs()->ws)) {
                const int R = (4 * __builtin_amdgcn_readfirstlane(ld_i32((const int*)(kargs()->ws + WS_TSEG)))) & 255, c = MOE_C;
                if (c >= R) { Frame F = mkframe(lds); convert_range(kargs(), F, l + 1, 0, I_IN, (c - R) * NWAVES + F.wave, (256 - R) * NWAVES); }
            }
#if MOE_HANDOFF
            { pg8::Gemm g{(const pg8::bf16_t*)(ws + WS_H), (const pg8::bf16_t*)(ws + WS_WD), ntiles * 256, NSEG * 2048, 512};
              pg8::MoeOrder S{(const int*)(ws + WS_TSEG) + 16, ntiles, 8, (int)gridDim.x, MOE_C, hc, tmo, 2};
              pg8::EpiDown E{(pg8::bf16_t*)(ws + WS_YS), (const float*)(ws + WS_ROWW)};
              pg8::gemm_phase<pg8::EpiDown, pg8::MoeOrder, DOWN_ALIGN, true>(lds + RING_OFF, g, S, E); }
#endif
        } SEAM(13);
        if (!MOE_HANDOFF && IN(14)) REPS(14) { REPSEAM(); unsigned char* ws = kargs()->ws;
            const int ntiles = __builtin_amdgcn_readfirstlane(ld_i32((const int*)(ws + WS_TSEG)));
            pg8::Gemm g{(const pg8::bf16_t*)(ws + WS_H), (const pg8::bf16_t*)(ws + WS_WD), ntiles * 256, NSEG * 2048, 512};
            pg8::MoeOrder S{(const int*)(ws + WS_TSEG) + 16, ntiles, 8, (int)gridDim.x, MOE_C, nullptr, nullptr, 0};
            pg8::EpiDown E{(pg8::bf16_t*)(ws + WS_YS), (const float*)(ws + WS_ROWW)};
            pg8::gemm_phase<pg8::EpiDown, pg8::MoeOrder, DOWN_ALIGN, true>(lds + RING_OFF, g, S, E);
            if ((pb + 15) < kargs()->ph_hi) grid_seam(lds);
        }
        if (IN(15)) REPS(15) { REPSEAM(); Frame F = mkframe(lds); ph13_combine(kargs(), F, l, (RK_CHECK && !(ld_f32((const float*)(F.ctl + 2048 + 2 * l)) <= RK_CHECK_TOL * RK_CHECK_TOL * ld_f32((const float*)(F.ctl + 2049 + 2 * l)))) ? 1000.f : 1.f); } SEAM(15);
    }
#undef IN
#undef SEAM
}

#ifndef MK_PER_PHASE
#define MK_PER_PHASE 0
#endif
extern "C" void kernel_launch(void* const* d_in, const int* in_sizes, int n_in, void* d_out, int out_size, void* d_ws, size_t ws_size, hipStream_t stream) {
    static int grid = 0;
    if (grid == 0) {
        if (n_in != 28 || out_size != NTOK * DM || ws_size < WS_END) { fprintf(stderr, "kernel_launch: unexpected problem shape (n_in %d out %d ws %zu)\n", n_in, out_size, ws_size); grid = -1; return; }
        int dev = 0, cus = 0, per_cu = 0;
        if (hipGetDevice(&dev) != hipSuccess || hipDeviceGetAttribute(&cus, hipDeviceAttributeMultiprocessorCount, dev) != hipSuccess) { grid = -1; return; }
        if (hipFuncSetAttribute((const void*)fwd_kernel, hipFuncAttributeMaxDynamicSharedMemorySize, LDS_BYTES) != hipSuccess) { fprintf(stderr, "kernel_launch: hipFuncSetAttribute failed\n"); grid = -1; return; }
        if (hipOccupancyMaxActiveBlocksPerMultiprocessor(&per_cu, (const void*)fwd_kernel, NWAVES * 64, LDS_BYTES) != hipSuccess || per_cu < 1) fprintf(stderr, "kernel_launch: occupancy query reports %d\n", per_cu);
        (void)hipGetLastError();
        grid = cus;
    }
    if (grid < 0) return;
    (void)hipMemsetAsync((char*)d_ws + WS_CTL, 0, CTL_ZERO_BYTES, stream);
    Args a{};
    for (int i = 0; i < 28; ++i) a.in[i] = (const float*)d_in[i];
    a.out = (float*)d_out; a.ws = (unsigned char*)d_ws; a.li = 0; a.pad = 0;
#if MK_PER_PHASE
    for (int p = 0; p < NLAYER * NPHASE; ++p) { a.ph_lo = p; a.ph_hi = p + 1; hipLaunchKernelGGL(fwd_kernel, dim3(grid), dim3(NWAVES * 64), LDS_BYTES, stream, a); }
#else
    a.ph_lo = 0; a.ph_hi = NLAYER * NPHASE;
    hipLaunchKernelGGL(fwd_kernel, dim3(grid), dim3(NWAVES * 64), LDS_BYTES, stream, a);
#endif
}
```
